# Optimizing an MI355X kernel written in HIP

```python
import math
import jax, jax.numpy as jnp
from jax import lax
import numpy as np

D_MODEL = 1024
BATCH = 4
SEQ = 8192
DEPTH = 1

CHUNK = 64
MIX_WIDTH = D_MODEL
A_HEADS = 4
A_HEAD_DIM = 128
A_WIDTH = A_HEADS * A_HEAD_DIM
SGU_BLOCK = 128
B_GROUPS = 4
B_GROUP_DIM = 128
B_WIDTH = B_GROUPS * B_GROUP_DIM
POOL_WINDOWS = (2, 4, 8, 16)
IN_WIDTH = 2 * A_WIDTH + B_WIDTH
D_FF = 2816
CONV_W = 3
N_MOD = 6
EPS = 1e-6

kernel_name = "hybrid_sgu_pool_convffn_block"


def rmsnorm(x, g):
    xf = x.astype(jnp.float32)
    y = xf * lax.rsqrt(jnp.mean(xf * xf, axis=-1, keepdims=True) + EPS)
    return (y * g.astype(jnp.float32)).astype(x.dtype)


def chunk_causal_block_mask():
    pos = jnp.arange(SGU_BLOCK)
    return (pos[None, :] // CHUNK) <= (pos[:, None] // CHUNK)


def sgu_mixer(a_in, norm_g, w_s, b_s):
    bsz, seq, _ = a_in.shape
    a = jax.nn.gelu(a_in)
    u, v = a[..., :A_WIDTH], a[..., A_WIDTH:]
    nb = seq // SGU_BLOCK
    v = v.reshape(bsz, nb, SGU_BLOCK, A_HEADS, A_HEAD_DIM)
    v = rmsnorm(v, norm_g[None, None, None])
    w_m = jnp.where(chunk_causal_block_mask()[None], w_s, jnp.zeros_like(w_s))
    z = jnp.einsum('hij,bnjhc->bnihc', w_m, v) + b_s.T[None, None, :, :, None]
    return u * z.reshape(bsz, seq, A_WIDTH)


def pool_mixer(p_in, w_pool, pool_scale):
    bsz, seq, _ = p_in.shape
    pg = p_in.reshape(bsz, seq, B_GROUPS, B_GROUP_DIM)
    t = jnp.arange(seq)
    outs = []
    for g, w in enumerate(POOL_WINDOWS):
        xf = pg[:, :, g].astype(jnp.float32)
        cs = jnp.cumsum(xf, axis=1)
        cs_full = jnp.pad(cs, ((0, 0), (w, 0), (0, 0)))
        win_sum = cs_full[:, w:] - cs_full[:, :seq]
        cnt = jnp.minimum(t + 1, w).astype(jnp.float32)[None, :, None]
        outs.append((win_sum / cnt - xf).astype(p_in.dtype))
    pooled = jnp.stack(outs, axis=2)
    y = jnp.einsum('bsgc,gcd->bsgd', pooled, w_pool)
    return y.reshape(bsz, seq, B_WIDTH) * pool_scale


def conv_ffn(h, w_up, conv_w, conv_b, w_down):
    up = jnp.einsum('bsd,df->bsf', h, w_up)
    upp = jnp.pad(up, ((0, 0), (CONV_W - 1, 0), (0, 0)))
    seq = up.shape[1]
    y = conv_b + upp[:, 0:seq] * conv_w[0] + upp[:, 1:seq + 1] * conv_w[1] + upp[:, 2:seq + 2] * conv_w[2]
    gate, val = y[..., :D_FF], y[..., D_FF:]
    return jnp.einsum('bsf,fd->bsd', jax.nn.silu(gate) * val, w_down)


def setup_inputs(seed: int = 0) -> dict:
    key = jax.random.key(seed)
    ks = jax.random.split(key, 20)
    f32 = jnp.float32
    nrm = lambda k, shape, s: jax.random.normal(k, shape, f32) * s
    L = DEPTH
    return {
        "x": nrm(ks[0], (BATCH, SEQ, D_MODEL), 1.0),
        "c": nrm(ks[1], (BATCH, D_MODEL), 1.0),
        "w_ada": nrm(ks[2], (L, D_MODEL, N_MOD * D_MODEL), D_MODEL ** -0.5),
        "b_ada": nrm(ks[3], (L, N_MOD * D_MODEL), 0.02),
        "pre_mix_g": 1.0 + nrm(ks[4], (L, D_MODEL), 0.02),
        "post_mix_g": 1.0 + nrm(ks[5], (L, D_MODEL), 0.02),
        "w_in": nrm(ks[6], (L, D_MODEL, IN_WIDTH), D_MODEL ** -0.5),
        "sgu_norm_g": 1.0 + nrm(ks[7], (L, A_HEADS, A_HEAD_DIM), 0.02),
        "w_spatial": nrm(ks[8], (L, A_HEADS, SGU_BLOCK, SGU_BLOCK), SGU_BLOCK ** -0.5),
        "b_spatial": 1.0 + nrm(ks[9], (L, A_HEADS, SGU_BLOCK), 0.02),
        "w_pool": nrm(ks[10], (L, B_GROUPS, B_GROUP_DIM, B_GROUP_DIM), B_GROUP_DIM ** -0.5),
        "pool_scale": 1.0 + nrm(ks[11], (L, B_WIDTH), 0.02),
        "w_out": nrm(ks[12], (L, MIX_WIDTH, D_MODEL), MIX_WIDTH ** -0.5),
        "pre_ffn_g": 1.0 + nrm(ks[13], (L, D_MODEL), 0.02),
        "post_ffn_g": 1.0 + nrm(ks[14], (L, D_MODEL), 0.02),
        "w_up": nrm(ks[15], (L, D_MODEL, 2 * D_FF), D_MODEL ** -0.5),
        "conv_w": nrm(ks[16], (L, CONV_W, 2 * D_FF), CONV_W ** -0.5),
        "conv_b": nrm(ks[17], (L, 2 * D_FF), 0.02),
        "w_down": nrm(ks[18], (L, D_FF, D_MODEL), D_FF ** -0.5),
    }


def reference(x, c, w_ada, b_ada, pre_mix_g, post_mix_g, w_in, sgu_norm_g, w_spatial,
              b_spatial, w_pool, pool_scale, w_out, pre_ffn_g, post_ffn_g, w_up, conv_w,
              conv_b, w_down):
    sc = jax.nn.silu(c)
    for l in range(DEPTH):
        mod = (jnp.einsum('bd,de->be', sc, w_ada[l]) + b_ada[l])[:, None, :]
        sh_m, sc_m, g_m, sh_f, sc_f, g_f = jnp.split(mod, N_MOD, axis=-1)

        h = rmsnorm(x, pre_mix_g[l]) * (1.0 + sc_m) + sh_m
        proj = jnp.einsum('bsd,de->bse', h, w_in[l])
        out_a = sgu_mixer(proj[..., :2 * A_WIDTH], sgu_norm_g[l], w_spatial[l], b_spatial[l])
        out_b = pool_mixer(proj[..., 2 * A_WIDTH:], w_pool[l], pool_scale[l])
        mixed = jnp.einsum('bse,ed->bsd', jnp.concatenate([out_a, out_b], axis=-1), w_out[l])
        x = x + g_m * rmsnorm(mixed, post_mix_g[l])

        h = rmsnorm(x, pre_ffn_g[l]) * (1.0 + sc_f) + sh_f
        f = conv_ffn(h, w_up[l], conv_w[l], conv_b[l], w_down[l])
        x = x + g_f * rmsnorm(f, post_ffn_g[l])
    return x
```

```cpp
#include <hip/hip_runtime.h>
#include <hip/hip_cooperative_groups.h>
#include <cstdio>
#include <cstdint>
namespace cg = cooperative_groups;
#ifndef MK_N_LAUNCHES
#define MK_N_LAUNCHES 1
#endif
#ifndef MK_REPEAT
#define MK_REPEAT -1
#endif
namespace pg8 {
#define PG8_LAS __attribute__((address_space(3)))
typedef unsigned short bf16_t;
typedef short bf16x8 __attribute__((ext_vector_type(8)));
typedef float f32x4 __attribute__((ext_vector_type(4)));
typedef unsigned u32x4 __attribute__((ext_vector_type(4)));
constexpr int BM = 256, BK = 64, HALF = 128, HTB = HALF * BK * 2  , STAGE_BYTES = 8 * HTB, NXCD = 8, WGM = 8;

__host__ __device__ __forceinline__ int lds_byte(int r, int c) { const int st = (r >> 4) * 2 + (c >> 5), rr = r & 15, cc = c & 31, ob = rr * 64 + cc * 2; return st * 1024 + (ob ^ (((ob >> 9) & 1) << 5)); }
__host__ __device__ __forceinline__ void stage_rc(int b, int& R, int& C) { const int st = b / 1024, sb = b % 1024, swz = sb ^ (((sb >> 9) & 1) << 5); R = (st >> 1) * 16 + swz / 64; C = (st & 1) * 32 + (swz % 64) / 2; }
__host__ __device__ __forceinline__ int perm32(int rho) { const int n = rho >> 4, i = rho & 15; return 8 * (i >> 2) + 4 * n + (i & 3); }

struct Unit { int pm, pn; };
struct Gemm { const bf16_t* A; const bf16_t* Bt; int M, N, K; };

struct StaticOrder {
    int nM, nN, nwg, G, c;
    __host__ __device__ void init(int M, int N, int G_, int c_) { nM = M / BM; nN = N / BM; nwg = nM * nN; G = G_; c = c_; }
    __host__ __device__ bool next(int i, Unit& u) const {
        const long L = (long)i * G + c; if (L >= nwg) return false;
        int wgid = (int)L; { const int q = nwg / NXCD, r = nwg % NXCD, xcd = wgid % NXCD, off = wgid / NXCD; wgid = (xcd < r ? xcd * (q + 1) : r * (q + 1) + (xcd - r) * q) + off; }
        const int nig = WGM * nN, gid = wgid / nig, fm = gid * WGM, gsz = (nM - fm) < WGM ? (nM - fm) : WGM;
        u.pm = fm + ((wgid % nig) % gsz); u.pn = (wgid % nig) / gsz; return true;
    }
    __device__ __forceinline__ void a_ready(const Unit&) const {}
    __device__ __forceinline__ void done(const Unit&) const {}
};

__device__ __forceinline__ unsigned cvt_pk_bf16(float lo, float hi) { unsigned r; asm volatile("v_cvt_pk_bf16_f32 %0, %1, %2" : "=v"(r) : "v"(lo), "v"(hi)); return r; }
typedef float f32x2 __attribute__((ext_vector_type(2)));
typedef unsigned u32x2 __attribute__((ext_vector_type(2)));
__device__ __forceinline__ float fast_sigmoid_arg2(float p) { return __builtin_amdgcn_rcpf(1.0f + __builtin_amdgcn_exp2f(p)); }
__device__ __forceinline__ float gelu_tanh(float x) {
    const float t = x * x; const float p = x * (-2.302208198f + (-0.1029432397f) * t); return x * fast_sigmoid_arg2(p);
}
__device__ __forceinline__ float silu_f(float x) { return x * fast_sigmoid_arg2(x * (-1.4426950409f)); }
__device__ __forceinline__ float dpp_ror1(float x) { return __builtin_bit_cast(float, __builtin_amdgcn_update_dpp(0, __builtin_bit_cast(int, x), 0x121, 0xf, 0xf, false)); }
__device__ __forceinline__ float dpp_ror2(float x) { return __builtin_bit_cast(float, __builtin_amdgcn_update_dpp(0, __builtin_bit_cast(int, x), 0x122, 0xf, 0xf, false)); }

struct EpiProj {
    static constexpr bool PERM = true, AFTER_DRAIN = false, PERMA = false, HAS_PRE = false;
    bf16_t* O; int ldc;
    __device__ __forceinline__ void operator()(const f32x4 (&acc)[2][2][4][2], const Unit& u, int wr, int wc, int fr, int fq) const {
        const int row0 = u.pm * BM + wr * 64 + fr, col0 = u.pn * BM + wc * 32 + 8 * fq; const bool act = u.pn < 4;
#pragma unroll
        for (int ai = 0; ai < 2; ++ai)
#pragma unroll
            for (int m = 0; m < 4; ++m) { bf16_t* rowp = O + (size_t)(row0 + ai * HALF + m * 16) * ldc + col0;
#pragma unroll
                for (int bj = 0; bj < 2; ++bj) { f32x4 v0 = acc[ai][bj][m][0], v1 = acc[ai][bj][m][1];
                    if (act) {
#pragma unroll
                        for (int j = 0; j < 4; ++j) { v0[j] = gelu_tanh(v0[j]); v1[j] = gelu_tanh(v1[j]); } }
                    u32x4 w; w.x = cvt_pk_bf16(v0[0], v0[1]); w.y = cvt_pk_bf16(v0[2], v0[3]); w.z = cvt_pk_bf16(v1[0], v1[1]); w.w = cvt_pk_bf16(v1[2], v1[3]);
                    *(u32x4*)(rowp + bj * HALF) = w; } }
    }
};

struct EpiF32SS {
    static constexpr bool PERM = false, AFTER_DRAIN = false, PERMA = false, HAS_PRE = false;
    float* O; int ldc; float* ss;
    __device__ __forceinline__ void operator()(const f32x4 (&acc)[2][2][4][2], const Unit& u, int wr, int wc, int fr, int fq) const {
        const int row0 = u.pm * BM + wr * 64 + fr, col0 = u.pn * BM + wc * 32 + 4 * fq;
#pragma unroll
        for (int ai = 0; ai < 2; ++ai)
#pragma unroll
            for (int m = 0; m < 4; ++m) { const int row = row0 + ai * HALF + m * 16; float* rowp = O + (size_t)row * ldc + col0; float s = 0.f;
#pragma unroll
                for (int bj = 0; bj < 2; ++bj)
#pragma unroll
                    for (int n = 0; n < 2; ++n) { const f32x4 x = acc[ai][bj][m][n]; s += (x[0] * x[0] + x[1] * x[1]) + (x[2] * x[2] + x[3] * x[3]); *(f32x4*)(rowp + bj * HALF + n * 16) = x; }
                s += __shfl_xor(s, 16); s += __shfl_xor(s, 32);
                if (fq == 0) atomicAdd(ss + row, s); }
    }
};

struct EpiBf16SS {
    static constexpr bool PERM = true, AFTER_DRAIN = false, PERMA = false, HAS_PRE = false;
    bf16_t* O; int ldc; float* ss;
    __device__ __forceinline__ void operator()(const f32x4 (&acc)[2][2][4][2], const Unit& u, int wr, int wc, int fr, int fq) const {
        const int row0 = u.pm * BM + wr * 64 + fr, col0 = u.pn * BM + wc * 32 + 8 * fq;
#pragma unroll
        for (int ai = 0; ai < 2; ++ai)
#pragma unroll
            for (int m = 0; m < 4; ++m) { const int row = row0 + ai * HALF + m * 16; bf16_t* rowp = O + (size_t)row * ldc + col0; float s = 0.f;
#pragma unroll
                for (int bj = 0; bj < 2; ++bj) { const f32x4 v0 = acc[ai][bj][m][0], v1 = acc[ai][bj][m][1];
                    s += ((v0[0] * v0[0] + v0[1] * v0[1]) + (v0[2] * v0[2] + v0[3] * v0[3])) + ((v1[0] * v1[0] + v1[1] * v1[1]) + (v1[2] * v1[2] + v1[3] * v1[3]));
                    u32x4 w; w.x = cvt_pk_bf16(v0[0], v0[1]); w.y = cvt_pk_bf16(v0[2], v0[3]); w.z = cvt_pk_bf16(v1[0], v1[1]); w.w = cvt_pk_bf16(v1[2], v1[3]);
                    *(u32x4*)(rowp + bj * HALF) = w; }
                s += __shfl_xor(s, 16); s += __shfl_xor(s, 32);
                if (fq == 0) atomicAdd(ss + row, s); }
    }
};

__device__ __forceinline__ float dpp_shr1(float x) { return __builtin_bit_cast(float, __builtin_amdgcn_update_dpp(0, __builtin_bit_cast(int, x), 0x111, 0xf, 0xf, true)); }
struct EpiConv {
    static constexpr bool PERM = true, AFTER_DRAIN = false, PERMA = true, HAS_PRE = true;
    bf16_t* ACT; bf16_t* RAW; const float* cw; const float* cb; int FF; PG8_LAS unsigned char* CB;
    __device__ __forceinline__ void pre(const Unit& u, int par) const {
        const int tid = threadIdx.x, w = __builtin_amdgcn_readfirstlane(tid >> 6), l = tid & 63;
        if (w < 4) { const int vec = 2 * w + (l >> 5), k = vec & 3, hv = vec >> 2; const float* src = (k < 3 ? cw + (size_t)k * 2 * FF : cb) + hv * FF + u.pn * HALF + (l & 31) * 4;
            __builtin_amdgcn_global_load_lds((const unsigned*)src, (PG8_LAS unsigned*)(CB + par * 4096 + w * 1024), 16, 0, 0); }
    }
    __device__ __forceinline__ void run(const f32x4 (&acc)[2][2][4][2], const Unit& u, int wr, int wc, int fr, int fq, int par) const {
        const int f0 = u.pn * HALF + wc * 32 + 8 * fq; const int rowt = u.pm * BM + wr * 64 + 4 * fr; const int FF2 = 2 * FF;
        const PG8_LAS float* cbuf = (const PG8_LAS float*)(CB + par * 4096) + wc * 32 + 8 * fq;
        unsigned stash[2][4][2];
#pragma unroll
        for (int n = 0; n < 2; ++n) { const int f = f0 + 4 * n; const PG8_LAS float* cn = cbuf + 4 * n;
            const f32x4 w0g = *(const PG8_LAS f32x4*)(cn), w1g = *(const PG8_LAS f32x4*)(cn + 128), w2g = *(const PG8_LAS f32x4*)(cn + 256), bg = *(const PG8_LAS f32x4*)(cn + 384);
            const f32x4 w0v = *(const PG8_LAS f32x4*)(cn + 512), w1v = *(const PG8_LAS f32x4*)(cn + 640), w2v = *(const PG8_LAS f32x4*)(cn + 768), bv = *(const PG8_LAS f32x4*)(cn + 896);
#pragma unroll
            for (int ai = 0; ai < 2; ++ai) {
                f32x4 gm1, gm2, vm1, vm2;
#pragma unroll
                for (int j = 0; j < 4; ++j) { gm1[j] = dpp_shr1(acc[ai][0][3][n][j]); gm2[j] = dpp_shr1(acc[ai][0][2][n][j]); vm1[j] = dpp_shr1(acc[ai][1][3][n][j]); vm2[j] = dpp_shr1(acc[ai][1][2][n][j]); }
#pragma unroll
                for (int m = 0; m < 4; ++m) { const f32x4 g = acc[ai][0][m][n], v = acc[ai][1][m][n];
                    const f32x4 pg1 = (m == 0) ? gm1 : acc[ai][0][m > 0 ? m - 1 : 0][n], pg2 = (m == 0) ? gm2 : (m == 1 ? gm1 : acc[ai][0][m > 1 ? m - 2 : 0][n]);
                    const f32x4 pv1 = (m == 0) ? vm1 : acc[ai][1][m > 0 ? m - 1 : 0][n], pv2 = (m == 0) ? vm2 : (m == 1 ? vm1 : acc[ai][1][m > 1 ? m - 2 : 0][n]);
                    const f32x4 yg = bg + w0g * pg2 + w1g * pg1 + w2g * g, yv = bv + w0v * pv2 + w1v * pv1 + w2v * v; f32x4 a;
#pragma unroll
                    for (int j = 0; j < 4; ++j) a[j] = silu_f(yg[j]) * yv[j];
                    const unsigned lo = cvt_pk_bf16(a[0], a[1]), hi = cvt_pk_bf16(a[2], a[3]);
                    if (n == 0) { stash[ai][m][0] = lo; stash[ai][m][1] = hi; }
                    else if (!(m < 2 && fr == 0)) { u32x4 w; w.x = stash[ai][m][0]; w.y = stash[ai][m][1]; w.z = lo; w.w = hi; __builtin_nontemporal_store(w, (u32x4*)(ACT + (size_t)(rowt + ai * HALF + m) * FF + f0)); }
                    if ((m < 2 && fr == 0) || (m >= 2 && fr == 15)) { bf16_t* rp = RAW + ((size_t)((u.pm * 4 + ai * 2 + wr) * 4 + m)) * FF2 + f;
                        u32x2 gw, vw; gw.x = cvt_pk_bf16(g[0], g[1]); gw.y = cvt_pk_bf16(g[2], g[3]); vw.x = cvt_pk_bf16(v[0], v[1]); vw.y = cvt_pk_bf16(v[2], v[3]);
                        *(u32x2*)rp = gw; *(u32x2*)(rp + FF) = vw; } } } }
    }
};

struct RowStat {
    float* ss; unsigned* cnt; unsigned want; float inv_n, eps;
    __device__ __forceinline__ void run(const float (&part)[2][4], float (&rs)[2][4], const Unit& u, int wr, int fr, int fq) const {
        const int row0 = u.pm * BM + wr * 64 + fr; const int lane = fq * 16 + fr;
#pragma unroll
        for (int ai = 0; ai < 2; ++ai)
#pragma unroll
            for (int m = 0; m < 4; ++m) { float s = part[ai][m]; s += __shfl_xor(s, 16); s += __shfl_xor(s, 32); if (fq == 0) atomicAdd(ss + row0 + ai * HALF + m * 16, s); }
        asm volatile("s_waitcnt vmcnt(0)" ::: "memory");
        unsigned* c = cnt + 64 * u.pm;
        if (lane == 0) __hip_atomic_fetch_add(c, 1u, __ATOMIC_RELAXED, __HIP_MEMORY_SCOPE_AGENT);
        if (threadIdx.x < 64) { unsigned sp = 0;
            while ((unsigned)__builtin_amdgcn_readfirstlane(__hip_atomic_load(c, __ATOMIC_RELAXED, __HIP_MEMORY_SCOPE_AGENT)) < want) { __builtin_amdgcn_s_sleep(1); if (++sp > (1u << 22)) break; } }
        asm volatile("s_waitcnt vmcnt(0) lgkmcnt(0)" ::: "memory"); __builtin_amdgcn_s_barrier(); asm volatile("" ::: "memory");
#pragma unroll
        for (int ai = 0; ai < 2; ++ai)
#pragma unroll
            for (int m = 0; m < 4; ++m) { const float v = __hip_atomic_load(ss + row0 + ai * HALF + m * 16, __ATOMIC_RELAXED, __HIP_MEMORY_SCOPE_AGENT); rs[ai][m] = __builtin_amdgcn_rsqf(v * inv_n + eps); }
    }
};
template <int VAR = 0  > struct EpiMid {
    static constexpr bool PERM = false, AFTER_DRAIN = false, PERMA = false, HAS_PRE = false;
    const float* x; float* x1; bf16_t* xn; const float* mod; const float* post_g; const float* ffn_g; const float* sxx; float* ss1; float* ssxm; float* ssmm; unsigned* cnt; PG8_LAS float* A23; int ld, tiles_per_batch;
    __device__ __forceinline__ void operator()(f32x4 (&acc)[2][2][4][2], const Unit& u, int wr, int wc, int fr, int fq) const {
        const int col0 = u.pn * BM + wc * 32 + 4 * fq; const float* mb = mod + (size_t)(u.pm / tiles_per_batch) * (6 * ld); const int tid = threadIdx.x;
        const unsigned voff = (unsigned)((wr * 64 + fr) * ld + col0) * 4u;
        const size_t pbase = (size_t)u.pm * BM * ld; const int row0 = u.pm * BM + wr * 64 + fr;
        if (tid < 256) { const int c = u.pn * BM + tid; A23[tid] = mb[2 * ld + c] * post_g[c]; A23[256 + tid] = ffn_g[c] * (1.0f + mb[4 * ld + c]); A23[512 + tid] = mb[3 * ld + c]; }
        asm volatile("s_waitcnt vmcnt(0) lgkmcnt(0)" ::: "memory"); __builtin_amdgcn_s_barrier(); asm volatile("" ::: "memory");
        const PG8_LAS float* As = A23 + wc * 32 + 4 * fq;
#pragma unroll
        for (int ai = 0; ai < 2; ++ai)
#pragma unroll
            for (int m = 0; m < 4; ++m) { const char* xb = (const char*)(x + pbase + (size_t)(ai * HALF + m * 16) * ld); f32x4 s1 = {0.f, 0.f, 0.f, 0.f}, sx = s1, sm = s1;
#pragma unroll
                for (int bj = 0; bj < 2; ++bj)
#pragma unroll
                    for (int n = 0; n < 2; ++n) { const unsigned o = voff + (unsigned)(bj * HALF + n * 16) * 4u; const f32x4 xv = (VAR == 1) ? (f32x4){1.f, 1.f, 1.f, 1.f} : *(const f32x4*)(xb + o); const f32x4 mx = acc[ai][bj][m][n], cm = mx * *(const PG8_LAS f32x4*)(As + bj * HALF + n * 16);
                        s1 += mx * mx; sx += xv * cm; sm += cm * cm; }
                float a = (s1[0] + s1[1]) + (s1[2] + s1[3]), b = (sx[0] + sx[1]) + (sx[2] + sx[3]), c = (sm[0] + sm[1]) + (sm[2] + sm[3]);
                a += __shfl_xor(a, 16); a += __shfl_xor(a, 32); b += __shfl_xor(b, 16); b += __shfl_xor(b, 32); c += __shfl_xor(c, 16); c += __shfl_xor(c, 32);
                if (fq == 0) { const int r = row0 + ai * HALF + m * 16; atomicAdd(ss1 + r, a); atomicAdd(ssxm + r, b); atomicAdd(ssmm + r, c); }
                if (m == 3) asm volatile("" ::: "memory"); }
        asm volatile("s_waitcnt vmcnt(0)" ::: "memory");
        unsigned* cw = cnt + 64 * u.pm;
        if ((tid & 63) == 0) __hip_atomic_fetch_add(cw, 1u, __ATOMIC_RELAXED, __HIP_MEMORY_SCOPE_AGENT);
        if (tid < 64) { unsigned sp = 0;
            while ((unsigned)__builtin_amdgcn_readfirstlane(__hip_atomic_load(cw, __ATOMIC_RELAXED, __HIP_MEMORY_SCOPE_AGENT)) < 32u) { __builtin_amdgcn_s_sleep(1); if (++sp > (1u << 22)) break; } }
        asm volatile("s_waitcnt vmcnt(0) lgkmcnt(0)" ::: "memory"); __builtin_amdgcn_s_barrier(); asm volatile("" ::: "memory");
        const float inv_n = 1.0f / (float)ld; float rs1[2][4], rs2[2][4];
#pragma unroll
        for (int ai = 0; ai < 2; ++ai)
#pragma unroll
            for (int m = 0; m < 4; ++m) { const int r = row0 + ai * HALF + m * 16;
                const float S1 = __hip_atomic_load(ss1 + r, __ATOMIC_RELAXED, __HIP_MEMORY_SCOPE_AGENT), Sxm = __hip_atomic_load(ssxm + r, __ATOMIC_RELAXED, __HIP_MEMORY_SCOPE_AGENT), Smm = __hip_atomic_load(ssmm + r, __ATOMIC_RELAXED, __HIP_MEMORY_SCOPE_AGENT);
                const float r1 = __builtin_amdgcn_rsqf(S1 * inv_n + 1e-6f); rs1[ai][m] = r1;
                const float s2 = sxx[r] + 2.0f * r1 * Sxm + r1 * r1 * Smm; rs2[ai][m] = __builtin_amdgcn_rsqf(s2 * inv_n + 1e-6f); }
        if (VAR != 0) { if (rs1[0][0] + rs2[1][3] + rs1[1][2] + rs2[0][1] == 1.2345e33f) x1[row0] = rs1[0][1]; return; }
#pragma unroll
        for (int ai = 0; ai < 2; ++ai)
#pragma unroll
            for (int m = 0; m < 4; ++m) { const size_t gb = pbase + (size_t)(ai * HALF + m * 16) * ld; const char* xb = (const char*)(x + gb); char* ob = (char*)(x1 + gb); char* nb = (char*)(xn + gb);
#pragma unroll
                for (int bj = 0; bj < 2; ++bj)
#pragma unroll
                    for (int n = 0; n < 2; ++n) { const unsigned o = voff + (unsigned)(bj * HALF + n * 16) * 4u; const f32x4 xv = *(const f32x4*)(xb + o);
                        const f32x4 v = xv + acc[ai][bj][m][n] * rs1[ai][m] * *(const PG8_LAS f32x4*)(As + bj * HALF + n * 16);
                        *(f32x4*)(ob + o) = v;
                        const f32x4 a2 = *(const PG8_LAS f32x4*)(As + 256 + bj * HALF + n * 16), a3 = *(const PG8_LAS f32x4*)(As + 512 + bj * HALF + n * 16); const f32x4 h = v * rs2[ai][m] * a2 + a3;
                        u32x2 wv; wv.x = cvt_pk_bf16(h[0], h[1]); wv.y = cvt_pk_bf16(h[2], h[3]); *(u32x2*)(nb + (o >> 1)) = wv; }
                if (m == 3) asm volatile("" ::: "memory"); }
    }
};
struct EpiFinal {
    static constexpr bool PERM = false, AFTER_DRAIN = false, PERMA = false, HAS_PRE = false;
    const bf16_t* src; float* out; const float* mod; const float* post_g; RowStat st; int ld, tiles_per_batch;
    __device__ __forceinline__ void operator()(f32x4 (&acc)[2][2][4][2], const Unit& u, int wr, int wc, int fr, int fq) const {
        const int col0 = u.pn * BM + wc * 32 + 4 * fq; const float* mb = mod + (size_t)(u.pm / tiles_per_batch) * (6 * ld);
        const unsigned voff = (unsigned)((wr * 64 + fr) * ld + col0) * 4u, cvo = (unsigned)col0 * 4u; const size_t pbase = (size_t)u.pm * BM * ld;
        float part[2][4], rs[2][4];
#pragma unroll
        for (int ai = 0; ai < 2; ++ai)
#pragma unroll
            for (int m = 0; m < 4; ++m) { float s = 0.f;
#pragma unroll
                for (int bj = 0; bj < 2; ++bj)
#pragma unroll
                    for (int n = 0; n < 2; ++n) { const f32x4 v = acc[ai][bj][m][n]; s += (v[0] * v[0] + v[1] * v[1]) + (v[2] * v[2] + v[3] * v[3]); }
                part[ai][m] = s; }
        u32x2 xpre[2][4][2][2];
#pragma unroll
        for (int ai = 0; ai < 2; ++ai)
#pragma unroll
            for (int m = 0; m < 4; ++m) { const char* sb = (const char*)(src + pbase + (size_t)(ai * HALF + m * 16) * ld);
#pragma unroll
                for (int bj = 0; bj < 2; ++bj)
#pragma unroll
                    for (int n = 0; n < 2; ++n) xpre[ai][m][bj][n] = *(const u32x2*)(sb + ((voff + (unsigned)(bj * HALF + n * 16) * 4u) >> 1)); }
        st.run(part, rs, u, wr, fr, fq);
        f32x4 A1[2][2];
#pragma unroll
        for (int bj = 0; bj < 2; ++bj)
#pragma unroll
            for (int n = 0; n < 2; ++n) { const unsigned co = cvo + (unsigned)(bj * HALF + n * 16) * 4u; A1[bj][n] = *(const f32x4*)((const char*)(mb + 5 * ld) + co) * *(const f32x4*)((const char*)post_g + co); }
#pragma unroll
        for (int ai = 0; ai < 2; ++ai)
#pragma unroll
            for (int m = 0; m < 4; ++m) { char* ob = (char*)(out + pbase + (size_t)(ai * HALF + m * 16) * ld);
#pragma unroll
                for (int bj = 0; bj < 2; ++bj)
#pragma unroll
                    for (int n = 0; n < 2; ++n) { const unsigned o = voff + (unsigned)(bj * HALF + n * 16) * 4u; const u32x2 xw = xpre[ai][m][bj][n];
                        const f32x4 xv = {__builtin_bit_cast(float, xw.x << 16), __builtin_bit_cast(float, xw.x & 0xffff0000u), __builtin_bit_cast(float, xw.y << 16), __builtin_bit_cast(float, xw.y & 0xffff0000u)};
                        *(f32x4*)(ob + o) = xv + acc[ai][bj][m][n] * rs[ai][m] * A1[bj][n]; }
                if (m == 3) asm volatile("" ::: "memory"); }
    }
};

struct EpiSink {
    static constexpr bool PERM = false, AFTER_DRAIN = false, PERMA = false, HAS_PRE = false;
    float* O;
    __device__ __forceinline__ void operator()(f32x4 (&acc)[2][2][4][2], const Unit& u, int wr, int wc, int fr, int fq) const {
        f32x4 s = {0.f, 0.f, 0.f, 0.f};
#pragma unroll
        for (int ai = 0; ai < 2; ++ai)
#pragma unroll
            for (int bj = 0; bj < 2; ++bj)
#pragma unroll
                for (int m = 0; m < 4; ++m)
#pragma unroll
                    for (int n = 0; n < 2; ++n) s += acc[ai][bj][m][n];
        if (s[0] + s[1] + s[2] + s[3] == 1.2345e33f) O[u.pm * 256 + wr * 64 + fr + wc + fq] = s[0];
    }
};
template <class Epi, class Sched, bool ALIGN_EPI = false, bool SP2 = false>
__device__ __forceinline__ void gemm_phase(PG8_LAS unsigned char* lds, const Gemm g, const Sched& S, const Epi& E) {
    const int tid = threadIdx.x, wid = __builtin_amdgcn_readfirstlane(tid >> 6), lane = tid & 63, wr = wid >> 2, wc = wid & 3, fr = lane & 15, fq = lane >> 4;
    const int K = g.K, nt = K / BK;
    unsigned voffA[2], voffB[2];
#pragma unroll
    for (int i = 0; i < 2; ++i) { int R, C; stage_rc(tid * 16 + i * 8192, R, C); const int Rb = Epi::PERM ? ((R & ~31) + perm32(R & 31)) : R;
        const int Ra = Epi::PERMA ? ((R & ~63) + 4 * (R & 15) + ((R & 63) >> 4)) : R;
        voffA[i] = (unsigned)(Ra * K + C) * 2u; voffB[i] = (unsigned)(Rb * K + C) * 2u; }
    const size_t kstep = (size_t)(BK * 2);
    const size_t hstep = (size_t)HALF * K * 2;
    const size_t tstep = 2 * hstep;
    const unsigned ldsw = (unsigned)wid * 1024u;
    const int aoff = lds_byte(wr * 64 + fr, fq * 8), boff = lds_byte(wc * 32 + fr, fq * 8);
#define PG8_SA(b, h) (((b) * 2 + (h)) * HTB)
#define PG8_SB(b, h) ((4 + (b) * 2 + (h)) * HTB)
#define PG8_STAGE(bufoff, gbase, voff) do { _Pragma("unroll") for (int _i = 0; _i < 2; ++_i) \
        __builtin_amdgcn_global_load_lds((const unsigned*)((const char*)(gbase) + (voff)[_i]), (PG8_LAS unsigned*)(lds + (bufoff) + ldsw + _i * 8192), 16, 0, 0); } while (0)
#define PG8_LDA(dst, b, h) do { _Pragma("unroll") for (int m = 0; m < 4; ++m) _Pragma("unroll") for (int k = 0; k < 2; ++k) dst[m][k] = *(const PG8_LAS bf16x8*)(lds + PG8_SA(b, h) + aoff + m * 2048 + k * 1024); } while (0)
#define PG8_LDB(dst, b, h) do { _Pragma("unroll") for (int n = 0; n < 2; ++n) _Pragma("unroll") for (int k = 0; k < 2; ++k) dst[n][k] = *(const PG8_LAS bf16x8*)(lds + PG8_SB(b, h) + boff + n * 2048 + k * 1024); } while (0)
#define PG8_MMA(ai, bj, At, Bt) do { __builtin_amdgcn_s_setprio(1); _Pragma("unroll") for (int m = 0; m < 4; ++m) _Pragma("unroll") for (int n = 0; n < 2; ++n) _Pragma("unroll") for (int k = 0; k < 2; ++k) \
        acc[ai][bj][m][n] = __builtin_amdgcn_mfma_f32_16x16x32_bf16(Bt[n][k], At[m][k], acc[ai][bj][m][n], 0, 0, 0); __builtin_amdgcn_s_setprio(0); } while (0)
#define PG8_WAIT_V(n) asm volatile("s_waitcnt vmcnt(" #n ")" ::: "memory")
#define PG8_WAIT_L(n) asm volatile("s_waitcnt lgkmcnt(" #n ")" ::: "memory")
#define PG8_BAR __builtin_amdgcn_s_barrier()
#define PG8_SCHED __builtin_amdgcn_sched_barrier(0)
    Unit cur, nxt; int ui = 0;
    if (!S.next(0, cur)) return;
    f32x4 acc[2][2][4][2];
#pragma unroll
    for (int a = 0; a < 2; ++a)
#pragma unroll
        for (int b = 0; b < 2; ++b)
#pragma unroll
            for (int m = 0; m < 4; ++m)
#pragma unroll
                for (int n = 0; n < 2; ++n) acc[a][b][m][n] = (f32x4){0.f, 0.f, 0.f, 0.f};
    bf16x8 At[4][2], B0[2][2], B1[2][2];
    const char* cA = (const char*)g.A + (size_t)cur.pm * tstep; const char* cB = (const char*)g.Bt + (size_t)cur.pn * tstep;
    S.a_ready(cur);
    if constexpr (Epi::HAS_PRE) E.pre(cur, 0);
    if constexpr (SP2) {
        PG8_STAGE(PG8_SB(0, 0), cB, voffB); PG8_STAGE(PG8_SB(0, 1), cB + hstep, voffB); PG8_STAGE(PG8_SA(0, 0), cA, voffA); PG8_STAGE(PG8_SA(0, 1), cA + hstep, voffA);
        if (wr == 1) PG8_BAR;
        PG8_WAIT_V(2); PG8_BAR;
        PG8_STAGE(PG8_SB(1, 0), cB + kstep, voffB); PG8_STAGE(PG8_SA(1, 0), cA + kstep, voffA); PG8_STAGE(PG8_SB(1, 1), cB + hstep + kstep, voffB);
        PG8_WAIT_V(6); PG8_BAR;
    } else {
        PG8_STAGE(PG8_SB(0, 0), cB, voffB); PG8_STAGE(PG8_SA(0, 0), cA, voffA); PG8_STAGE(PG8_SB(0, 1), cB + hstep, voffB); PG8_STAGE(PG8_SA(0, 1), cA + hstep, voffA);
        if (wr == 1) PG8_BAR;
        PG8_WAIT_V(4); PG8_BAR;
        PG8_STAGE(PG8_SB(1, 0), cB + kstep, voffB); PG8_STAGE(PG8_SA(1, 0), cA + kstep, voffA); PG8_STAGE(PG8_SB(1, 1), cB + hstep + kstep, voffB);
        PG8_WAIT_V(6); PG8_BAR;
    }
    for (;;) {
        const bool has_next = S.next(ui + 1, nxt);
        const char* nA = has_next ? (const char*)g.A + (size_t)nxt.pm * tstep : cA; const char* nB = has_next ? (const char*)g.Bt + (size_t)nxt.pn * tstep : cB;
        for (int t = 0; t < nt; t += 2) {
            const bool last = (t == nt - 2);
            const char* a1 = cA + (size_t)(t + 1) * kstep;
            const char* a2 = last ? nA : cA + (size_t)(t + 2) * kstep; const char* b2 = last ? nB : cB + (size_t)(t + 2) * kstep;
            const char* a3 = a2 + kstep; const char* b3 = b2 + kstep;
            if (last && has_next) S.a_ready(nxt);
            if constexpr (SP2) {
            PG8_LDB(B0, 0, 0); PG8_LDB(B1, 0, 1); PG8_SCHED; PG8_LDA(At, 0, 0); PG8_STAGE(PG8_SA(1, 1), a1 + hstep, voffA);
            PG8_WAIT_V(8); PG8_WAIT_L(0); PG8_BAR; PG8_MMA(0, 0, At, B0); PG8_MMA(0, 1, At, B1); PG8_BAR; PG8_SCHED;
            PG8_LDA(At, 0, 1); PG8_STAGE(PG8_SB(0, 0), b2, voffB); PG8_STAGE(PG8_SB(0, 1), b2 + hstep, voffB); PG8_STAGE(PG8_SA(0, 0), a2, voffA);
            PG8_WAIT_V(8); PG8_WAIT_L(0); PG8_BAR; PG8_MMA(1, 0, At, B0); PG8_MMA(1, 1, At, B1); PG8_BAR; PG8_SCHED;
            PG8_LDB(B0, 1, 0); PG8_LDB(B1, 1, 1); PG8_SCHED; PG8_LDA(At, 1, 0); PG8_STAGE(PG8_SA(0, 1), a2 + hstep, voffA);
            PG8_WAIT_V(8); PG8_WAIT_L(0); PG8_BAR; PG8_MMA(0, 0, At, B0); PG8_MMA(0, 1, At, B1); PG8_BAR; PG8_SCHED;
            PG8_LDA(At, 1, 1); PG8_STAGE(PG8_SB(1, 0), b3, voffB); PG8_STAGE(PG8_SB(1, 1), b3 + hstep, voffB); PG8_STAGE(PG8_SA(1, 0), a3, voffA);
            PG8_WAIT_V(8); PG8_WAIT_L(0); PG8_BAR; PG8_MMA(1, 0, At, B0); PG8_MMA(1, 1, At, B1); PG8_BAR; PG8_SCHED;
            } else {
            PG8_LDB(B0, 0, 0); PG8_SCHED; PG8_LDA(At, 0, 0); PG8_STAGE(PG8_SA(1, 1), a1 + hstep, voffA);
            PG8_WAIT_L(8); PG8_BAR; PG8_WAIT_L(0); PG8_MMA(0, 0, At, B0); PG8_BAR; PG8_SCHED;
            PG8_LDB(B1, 0, 1); PG8_STAGE(PG8_SB(0, 0), b2, voffB);
            PG8_BAR; PG8_WAIT_L(0); PG8_MMA(0, 1, At, B1); PG8_BAR;
            PG8_LDA(At, 0, 1); PG8_STAGE(PG8_SA(0, 0), a2, voffA);
            PG8_BAR; PG8_WAIT_L(0); PG8_MMA(1, 0, At, B0); PG8_BAR; PG8_SCHED;
            PG8_STAGE(PG8_SB(0, 1), b2 + hstep, voffB);
            PG8_WAIT_V(6); PG8_BAR; PG8_MMA(1, 1, At, B1); PG8_BAR;
            PG8_LDB(B0, 1, 0); PG8_SCHED; PG8_LDA(At, 1, 0); PG8_STAGE(PG8_SA(0, 1), a2 + hstep, voffA);
            PG8_WAIT_L(8); PG8_BAR; PG8_WAIT_L(0); PG8_MMA(0, 0, At, B0); PG8_BAR; PG8_SCHED;
            PG8_LDB(B1, 1, 1); PG8_STAGE(PG8_SB(1, 0), b3, voffB);
            PG8_BAR; PG8_WAIT_L(0); PG8_MMA(0, 1, At, B1); PG8_BAR;
            PG8_LDA(At, 1, 1); PG8_STAGE(PG8_SA(1, 0), a3, voffA);
            PG8_BAR; PG8_WAIT_L(0); PG8_MMA(1, 0, At, B0); PG8_BAR; PG8_SCHED;
            PG8_STAGE(PG8_SB(1, 1), b3 + hstep, voffB);
            PG8_WAIT_V(6); PG8_BAR; PG8_MMA(1, 1, At, B1); PG8_BAR;
            }
        }
        if constexpr (ALIGN_EPI) { if (wr == 0) PG8_BAR; }
        if constexpr (Epi::HAS_PRE) { if (has_next) E.pre(nxt, (ui + 1) & 1); E.run(acc, cur, wr, wc, fr, fq, ui & 1); S.done(cur); }
        else if constexpr (!Epi::AFTER_DRAIN) { E(acc, cur, wr, wc, fr, fq); S.done(cur); }
        if (!has_next) break;
#pragma unroll
        for (int a = 0; a < 2; ++a)
#pragma unroll
            for (int b = 0; b < 2; ++b)
#pragma unroll
                for (int m = 0; m < 4; ++m)
#pragma unroll
                    for (int n = 0; n < 2; ++n) acc[a][b][m][n] = (f32x4){0.f, 0.f, 0.f, 0.f};
        cur = nxt; cA = nA; cB = nB; ++ui;
        if constexpr (ALIGN_EPI) { if (wr == 1) PG8_BAR; }
    }
    PG8_WAIT_V(0);
    if constexpr (!ALIGN_EPI) { if (wr == 0) PG8_BAR; }
    PG8_BAR;
    if constexpr (Epi::AFTER_DRAIN) { E.fused(acc, cur, wr, wc, fr, fq, lds, wid, lane); S.done(cur); }
#undef PG8_SA
#undef PG8_SB
#undef PG8_STAGE
#undef PG8_LDA
#undef PG8_LDB
#undef PG8_MMA
#undef PG8_WAIT_V
#undef PG8_WAIT_L
#undef PG8_BAR
#undef PG8_SCHED
}
}
constexpr int NWAVES = 8;
constexpr int BATCH = 4, SEQ = 8192, D = 1024, M = BATCH * SEQ;
constexpr int INW = 1536, AW = 512, FF = 2816, FF2 = 2 * FF, NMOD = 6 * D;
constexpr float EPS = 1e-6f;
constexpr size_t MiB = 1u << 20;
constexpr size_t WS_CTL = 0, CTL_ZERO_BYTES = 1 * MiB;
constexpr size_t OFF_MOD = 0, OFF_SS1 = 128 * 1024, OFF_SS2 = 256 * 1024, OFF_SS3 = 384 * 1024, OFF_BAR = 512 * 1024, OFF_CNT = 544 * 1024, OFF_SS4 = 896 * 1024;
constexpr size_t WS_WIN = 1 * MiB, WS_WOUT = 4 * MiB, WS_WUP = 6 * MiB, WS_WDOWN = 17 * MiB, WS_WSP = 23 * MiB, WS_WPOOL = WS_WSP + 256 * 1024;
constexpr size_t WS_SXX = 23 * MiB + 512 * 1024;
constexpr size_t WS_XN = 24 * MiB;
constexpr size_t WS_PROJ = 88 * MiB;
constexpr size_t WS_MIXIN = 184 * MiB;
constexpr size_t WS_MIXED = 248 * MiB;
constexpr size_t WS_ACT = 88 * MiB;
constexpr size_t WS_RAW = 264 * MiB;
constexpr size_t WS_F = 308 * MiB;
constexpr size_t WS_X1B = 372 * MiB;
constexpr size_t WS_END = 436 * MiB;
static_assert(WS_ACT + (size_t)M * FF * 2 <= WS_RAW && WS_RAW + (size_t)(M / 64) * 4 * FF2 * 4 <= WS_F && WS_F + (size_t)M * D * 4 <= WS_END, "d_ws map");
static_assert(WS_WUP + (size_t)FF2 * D * 2 <= WS_WDOWN && WS_WDOWN + (size_t)D * FF * 2 <= WS_WSP && WS_WPOOL + 4 * 128 * 128 * 2 <= WS_XN, "d_ws weights");
constexpr int RING_BYTES = 131072, LDSCTL_OFF = RING_BYTES, LDS_BYTES = 147456;

#define GAS __attribute__((address_space(1)))
#define LAS __attribute__((address_space(3)))
typedef unsigned short bf16;
typedef unsigned v4u __attribute__((ext_vector_type(4)));
typedef unsigned v2u __attribute__((ext_vector_type(2)));
typedef float f32x4 __attribute__((ext_vector_type(4)));
typedef short bf16x8 __attribute__((ext_vector_type(8)));
#define LDS_WAIT() asm volatile("s_waitcnt lgkmcnt(0)" ::: "memory")
__device__ __forceinline__ unsigned f2bf(float f) { unsigned u = __builtin_bit_cast(unsigned, f); return (u + 0x7fffu + ((u >> 16) & 1u)) >> 16; }
__device__ __forceinline__ unsigned pk2(float lo, float hi) { unsigned r; asm("v_cvt_pk_bf16_f32 %0, %1, %2" : "=v"(r) : "v"(lo), "v"(hi)); return r; }
__device__ __forceinline__ float bf_lo(unsigned w) { return __builtin_bit_cast(float, w << 16); }
__device__ __forceinline__ float bf_hi(unsigned w) { return __builtin_bit_cast(float, w & 0xffff0000u); }
__device__ __forceinline__ float wave_sum(float v) {
#pragma unroll
    for (int o = 1; o < 64; o <<= 1) v += __shfl_xor(v, o);
    return v;
}
__device__ __forceinline__ float silu_acc(float x) { return x / (1.0f + __expf(-x)); }

struct Args { const float* in[19]; float* out; unsigned char* ws; int ph_lo, ph_hi; };
enum { I_X = 0, I_C, I_WADA, I_BADA, I_PREMIXG, I_POSTMIXG, I_WIN, I_SGUG, I_WSP, I_BSP, I_WPOOL, I_PSCALE, I_WOUT, I_PREFFNG, I_POSTFFNG, I_WUP, I_CONVW, I_CONVB, I_WDOWN };

__device__ __forceinline__ void transpose_item(const float* W, int K, int N, bf16* WT, int k0, int n0, int drow0, LAS float* scr, int lane) {
#pragma unroll 8
    for (int i = 0; i < 32; ++i) { const int kk = 2 * i + (lane >> 5); scr[kk * 33 + (lane & 31)] = __builtin_nontemporal_load(W + (size_t)(k0 + kk) * N + n0 + (lane & 31)); }
    LDS_WAIT(); asm volatile("" ::: "memory");
    const int c = lane & 7;
#pragma unroll
    for (int j = 0; j < 4; ++j) { const int n = (lane >> 3) + 8 * j; const LAS float* s = scr + (8 * c) * 33 + n;
        v4u o; o.x = pk2(s[0 * 33], s[1 * 33]); o.y = pk2(s[2 * 33], s[3 * 33]); o.z = pk2(s[4 * 33], s[5 * 33]); o.w = pk2(s[6 * 33], s[7 * 33]);
        *(v4u*)(WT + (size_t)(drow0 + n) * K + k0 + 8 * c) = o; }
    LDS_WAIT(); asm volatile("" ::: "memory");
}

__device__ __forceinline__ void p0_prologue(const Args& a, LAS unsigned char* lds, int gw, int NGW, int lane, int wave, bool with_mod, bool with_rest) {
    unsigned char* ws = a.ws;
    float* MOD = (float*)(ws + OFF_MOD);
    const float* c = a.in[I_C]; const float* wada = a.in[I_WADA]; const float* bada = a.in[I_BADA];
    for (int it = with_mod ? gw : 96 * 16; it < 96 * 16; it += NGW) { const int cb = it % 96, ks = it / 96, col = cb * 64 + lane; float a0 = 0.f, a1 = 0.f, a2 = 0.f, a3 = 0.f;
        const float sv0 = silu_acc(c[ks * 64 + lane]), sv1 = silu_acc(c[D + ks * 64 + lane]), sv2 = silu_acc(c[2 * D + ks * 64 + lane]), sv3 = silu_acc(c[3 * D + ks * 64 + lane]);
#pragma unroll 32
        for (int kk = 0; kk < 64; ++kk) { const float w = __builtin_nontemporal_load(wada + (size_t)(ks * 64 + kk) * NMOD + col);
            a0 += __builtin_bit_cast(float, __builtin_amdgcn_readlane(__builtin_bit_cast(int, sv0), kk)) * w; a1 += __builtin_bit_cast(float, __builtin_amdgcn_readlane(__builtin_bit_cast(int, sv1), kk)) * w;
            a2 += __builtin_bit_cast(float, __builtin_amdgcn_readlane(__builtin_bit_cast(int, sv2), kk)) * w; a3 += __builtin_bit_cast(float, __builtin_amdgcn_readlane(__builtin_bit_cast(int, sv3), kk)) * w; }
        if (ks == 0) { const float b = bada[col]; a0 += b; a1 += b; a2 += b; a3 += b; }
        atomicAdd(MOD + col, a0); atomicAdd(MOD + NMOD + col, a1); atomicAdd(MOD + 2 * NMOD + col, a2); atomicAdd(MOD + 3 * NMOD + col, a3); }
    if (!with_rest) return;
    LAS float* scr = (LAS float*)(lds + wave * 16384);
    constexpr int I_IN = (D / 64) * (INW / 32), I_OUT = (D / 64) * (D / 32), I_UP = (D / 64) * (FF2 / 32), I_DOWN = (FF / 64) * (D / 32), I_POOL = 4 * 2 * 4;
    constexpr int NITEMS = I_IN + I_OUT + I_UP + I_DOWN + I_POOL;
    for (int it = gw; it < NITEMS; it += NGW) { int r = it;
        if (r < I_IN) { const int nb = INW / 32, kb = r / nb, n0 = 32 * (r % nb); transpose_item(a.in[I_WIN], D, INW, (bf16*)(ws + WS_WIN), 64 * kb, n0, n0, scr, lane); continue; } r -= I_IN;
        if (r < I_OUT) { const int nb = D / 32, kb = r / nb, n0 = 32 * (r % nb); transpose_item(a.in[I_WOUT], D, D, (bf16*)(ws + WS_WOUT), 64 * kb, n0, n0, scr, lane); continue; } r -= I_OUT;
        if (r < I_UP) { const int nb = FF2 / 32, kb = r / nb, n0 = 32 * (r % nb); const int half = n0 / FF, f = n0 % FF, drow = 256 * (f / 128) + 128 * half + (f % 128);
            transpose_item(a.in[I_WUP], D, FF2, (bf16*)(ws + WS_WUP), 64 * kb, n0, drow, scr, lane); continue; } r -= I_UP;
        if (r < I_DOWN) { const int nb = D / 32, kb = r / nb, n0 = 32 * (r % nb); transpose_item(a.in[I_WDOWN], FF, D, (bf16*)(ws + WS_WDOWN), 64 * kb, n0, n0, scr, lane); continue; } r -= I_DOWN;
        { const int g = r / 8, q = r % 8, kb = q / 4, n0 = 32 * (q % 4); transpose_item(a.in[I_WPOOL] + (size_t)g * 16384, 128, 128, (bf16*)(ws + WS_WPOOL) + (size_t)g * 16384, 64 * kb, n0, n0, scr, lane); } }
    { const float* wsp = a.in[I_WSP]; bf16* o = (bf16*)(ws + WS_WSP);
        for (int e = gw * 64 + lane; e < 4 * 128 * 128; e += NGW * 64) { const int i = (e >> 7) & 127, j = e & 127; const float v = ((j >> 6) <= (i >> 6)) ? wsp[e] : 0.f; o[e] = (bf16)f2bf(v); } }
}

__device__ __forceinline__ void p1_norm(const Args& a, int gw, int NGW, int lane) {
    const float* MOD = (const float*)(a.ws + OFF_MOD); bf16* XN = (bf16*)(a.ws + WS_XN); const float* x = a.in[I_X]; const float* g = a.in[I_PREMIXG]; float* SXX = (float*)(a.ws + WS_SXX);
    const int rpw = M / NGW;
    for (int r0 = gw * rpw; r0 < M; r0 += NGW * rpw) { const int b = r0 / SEQ; const float* mb = MOD + (size_t)b * NMOD;
        f32x4 A[4], B[4];
#pragma unroll
        for (int j = 0; j < 4; ++j) { const int col = 4 * lane + 256 * j; const f32x4 gg = *(const f32x4*)(g + col), sc = *(const f32x4*)(mb + D + col); A[j] = gg * (1.0f + sc); B[j] = *(const f32x4*)(mb + col); }
        f32x4 nx[4];
        { const f32x4* xr = (const f32x4*)(x + (size_t)r0 * D) + lane;
#pragma unroll
            for (int j = 0; j < 4; ++j) nx[j] = __builtin_nontemporal_load(xr + 64 * j); }
        for (int r = r0; r < r0 + rpw; ++r) { f32x4 v[4]; float s = 0.f;
#pragma unroll
            for (int j = 0; j < 4; ++j) { v[j] = nx[j]; s += (v[j].x * v[j].x + v[j].y * v[j].y) + (v[j].z * v[j].z + v[j].w * v[j].w); }
            if (r + 1 < r0 + rpw) { const f32x4* xr = (const f32x4*)(x + (size_t)(r + 1) * D) + lane;
#pragma unroll
                for (int j = 0; j < 4; ++j) nx[j] = __builtin_nontemporal_load(xr + 64 * j); }
            const float st = wave_sum(s);
            const float rs = 1.0f / sqrtf(st * (1.0f / D) + EPS);
            v2u* o = (v2u*)(XN + (size_t)r * D) + lane;
#pragma unroll
            for (int j = 0; j < 4; ++j) { const f32x4 h = v[j] * rs * A[j] + B[j]; const unsigned long long w = (unsigned long long)pk2(h.x, h.y) | ((unsigned long long)pk2(h.z, h.w) << 32);
                __hip_atomic_store((unsigned long long*)(o + 64 * j), w, __ATOMIC_RELAXED, __HIP_MEMORY_SCOPE_AGENT); } } }
}

constexpr int P3_RA = 0, P3_RB = 34816, P3_RP = 69632, P3_RC = 108800, P3_PA = 272, P3_PV = 264;
__device__ __forceinline__ void p3_mma(LAS unsigned char* lds, bool natural_b, f32x4 (&acc)[4][2], int wr, int wc, int fr, int fq) {
#pragma unroll
    for (int m = 0; m < 4; ++m)
#pragma unroll
        for (int n = 0; n < 2; ++n) acc[m][n] = (f32x4){0.f, 0.f, 0.f, 0.f};
#pragma unroll
    for (int kk = 0; kk < 4; ++kk) { bf16x8 af[4], bfr[2];
#pragma unroll
        for (int m = 0; m < 4; ++m) af[m] = *(const LAS bf16x8*)(lds + P3_RA + (64 * wr + 16 * m + fr) * P3_PA + (32 * kk + 8 * fq) * 2);
        if (natural_b) {
            { const unsigned addr = (unsigned)(size_t)(lds + P3_RB) + (unsigned)((32 * kk + 8 * fq + (fr >> 2)) * P3_PV + (32 * wc + 4 * (fr & 3)) * 2);
                v2u l0, h0, l1, h1;
                asm volatile("ds_read_b64_tr_b16 %0, %4\n\tds_read_b64_tr_b16 %1, %4 offset:%5\n\tds_read_b64_tr_b16 %2, %4 offset:32\n\tds_read_b64_tr_b16 %3, %4 offset:%6\n\ts_waitcnt lgkmcnt(0)"
                             : "=&v"(l0), "=&v"(h0), "=&v"(l1), "=&v"(h1) : "v"(addr), "n"(4 * P3_PV), "n"(4 * P3_PV + 32) : "memory");
                v4u w0, w1; w0.x = l0.x; w0.y = l0.y; w0.z = h0.x; w0.w = h0.y; w1.x = l1.x; w1.y = l1.y; w1.z = h1.x; w1.w = h1.y;
                bfr[0] = __builtin_bit_cast(bf16x8, w0); bfr[1] = __builtin_bit_cast(bf16x8, w1); }
        } else {
#pragma unroll
            for (int n = 0; n < 2; ++n) bfr[n] = *(const LAS bf16x8*)(lds + P3_RB + (32 * wc + 16 * n + fr) * P3_PA + (32 * kk + 8 * fq) * 2);
        }
#pragma unroll
        for (int m = 0; m < 4; ++m)
#pragma unroll
            for (int n = 0; n < 2; ++n) acc[m][n] = __builtin_amdgcn_mfma_f32_16x16x32_bf16(bfr[n], af[m], acc[m][n], 0, 0, 0); }
}
template <int W> __device__ __forceinline__ void p3_pool(LAS unsigned char* lds, int tid, int s0) {
    const int ch = tid & 15, tq = 4 * (tid >> 4); const LAS unsigned char* rp = lds + P3_RP + ch * 16; float sum[8];
#pragma unroll
    for (int e = 0; e < 8; ++e) sum[e] = 0.f;
#pragma unroll 3
    for (int k = 1; k < W; ++k) { const v4u r = *(const LAS v4u*)(rp + (16 + tq - k) * P3_PA);
        sum[0] += bf_lo(r.x); sum[1] += bf_hi(r.x); sum[2] += bf_lo(r.y); sum[3] += bf_hi(r.y); sum[4] += bf_lo(r.z); sum[5] += bf_hi(r.z); sum[6] += bf_lo(r.w); sum[7] += bf_hi(r.w); }
#pragma unroll
    for (int rr = 0; rr < 4; ++rr) { const int t = tq + rr; const v4u cur = *(const LAS v4u*)(rp + (16 + t) * P3_PA);
        sum[0] += bf_lo(cur.x); sum[1] += bf_hi(cur.x); sum[2] += bf_lo(cur.y); sum[3] += bf_hi(cur.y); sum[4] += bf_lo(cur.z); sum[5] += bf_hi(cur.z); sum[6] += bf_lo(cur.w); sum[7] += bf_hi(cur.w);
        const int cnt = (s0 + t + 1) < W ? (s0 + t + 1) : W; const float inv = 1.0f / (float)cnt;
        v4u o; o.x = pk2(sum[0] * inv - bf_lo(cur.x), sum[1] * inv - bf_hi(cur.x)); o.y = pk2(sum[2] * inv - bf_lo(cur.y), sum[3] * inv - bf_hi(cur.y));
        o.z = pk2(sum[4] * inv - bf_lo(cur.z), sum[5] * inv - bf_hi(cur.z)); o.w = pk2(sum[6] * inv - bf_lo(cur.w), sum[7] * inv - bf_hi(cur.w));
        *(LAS v4u*)(lds + P3_RA + t * P3_PA + ch * 16) = o;
        if (rr < 3) { const v4u old = *(const LAS v4u*)(rp + (16 + t - (W - 1)) * P3_PA);
            sum[0] -= bf_lo(old.x); sum[1] -= bf_hi(old.x); sum[2] -= bf_lo(old.y); sum[3] -= bf_hi(old.y); sum[4] -= bf_lo(old.z); sum[5] -= bf_hi(old.z); sum[6] -= bf_lo(old.w); sum[7] -= bf_hi(old.w); } }
}
struct P3Regs { v4u a0, a1, a2, a3, b0, b1, b2, b3, b4; };
#define P3_RA_(R, it) ((it) == 0 ? (R).a0 : (it) == 1 ? (R).a1 : (it) == 2 ? (R).a2 : (R).a3)
#define P3_RB_(R, it) ((it) == 0 ? (R).b0 : (it) == 1 ? (R).b1 : (it) == 2 ? (R).b2 : (it) == 3 ? (R).b3 : (R).b4)
__device__ __forceinline__ void p3_prefetch(P3Regs& R, int item, int t0, int s0, int tid, const bf16* PROJ, const bf16* WSP, const bf16* WPOOL) {
    if (item < 4) { const int h = item;
#pragma unroll
        for (int it = 0; it < 4; ++it) { const int idx = tid + 512 * it, row = idx >> 4, ch = idx & 15;
            const v4u va = *(const v4u*)(WSP + (size_t)h * 16384 + row * 128 + ch * 8), vb = __builtin_nontemporal_load((const v4u*)(PROJ + (size_t)(t0 + row) * INW + AW + 128 * h + 8 * ch));
            if (it == 0) { R.a0 = va; R.b0 = vb; } else if (it == 1) { R.a1 = va; R.b1 = vb; } else if (it == 2) { R.a2 = va; R.b2 = vb; } else { R.a3 = va; R.b3 = vb; } }
    } else { const int g = item - 4;
#pragma unroll
        for (int it = 0; it < 4; ++it) { const int idx = tid + 512 * it, row = idx >> 4, ch = idx & 15; const v4u va = *(const v4u*)(WPOOL + (size_t)g * 16384 + row * 128 + ch * 8);
            if (it == 0) R.a0 = va; else if (it == 1) R.a1 = va; else if (it == 2) R.a2 = va; else R.a3 = va; }
#pragma unroll
        for (int it = 0; it < 5; ++it) { const int idx = tid + 512 * it, row = idx >> 4, ch = idx & 15; v4u raw = {0u, 0u, 0u, 0u};
            if (row < 144 && s0 + row >= 16) raw = __builtin_nontemporal_load((const v4u*)(PROJ + (size_t)(t0 + row - 16) * INW + 2 * AW + 128 * g + 8 * ch));
            if (it == 0) R.b0 = raw; else if (it == 1) R.b1 = raw; else if (it == 2) R.b2 = raw; else if (it == 3) R.b3 = raw; else R.b4 = raw; } }
}
__device__ __forceinline__ void p3_item(P3Regs& R, const int item, const int t0, const int s0, const int tid0, LAS unsigned char* lds, const LAS float* RC, const bf16* PROJ, bf16* MIXIN, const bf16* WSP, const bf16* WPOOL,
                                        const int wr, const int wc, const int fr, const int fq) {
    f32x4 acc[4][2];
            int tl = tid0; asm volatile("" : "+v"(tl));
            const int tid = tl;
            if (item < 4) { const int h = item;
#pragma unroll
                for (int it = 0; it < 4; ++it) { const int idx = tid + 512 * it, row = idx >> 4, ch = idx & 15;
                    *(LAS v4u*)(lds + P3_RA + row * P3_PA + ch * 16) = P3_RA_(R, it);
                    const v4u raw = P3_RB_(R, it);
                    float v[8]; v[0] = bf_lo(raw.x); v[1] = bf_hi(raw.x); v[2] = bf_lo(raw.y); v[3] = bf_hi(raw.y); v[4] = bf_lo(raw.z); v[5] = bf_hi(raw.z); v[6] = bf_lo(raw.w); v[7] = bf_hi(raw.w);
                    float s = 0.f;
#pragma unroll
                    for (int e = 0; e < 8; ++e) s += v[e] * v[e];
                    s += __shfl_xor(s, 1); s += __shfl_xor(s, 2); s += __shfl_xor(s, 4); s += __shfl_xor(s, 8);
                    const float rs = __builtin_amdgcn_rsqf(s * (1.0f / 128.0f) + EPS);
                    const f32x4 g0 = *(const LAS f32x4*)(RC + 128 * h + 8 * ch), g1 = *(const LAS f32x4*)(RC + 128 * h + 8 * ch + 4);
                    v2u w0, w1; w0.x = pk2(v[0] * rs * g0.x, v[1] * rs * g0.y); w0.y = pk2(v[2] * rs * g0.z, v[3] * rs * g0.w); w1.x = pk2(v[4] * rs * g1.x, v[5] * rs * g1.y); w1.y = pk2(v[6] * rs * g1.z, v[7] * rs * g1.w);
                    *(LAS v2u*)(lds + P3_RB + row * P3_PV + ch * 16) = w0; *(LAS v2u*)(lds + P3_RB + row * P3_PV + ch * 16 + 8) = w1; }
                __syncthreads();
                if (item + 2 < 8) p3_prefetch(R, item + 2, t0, s0, tid, PROJ, WSP, WPOOL);
                v2u ur[4][2]; float bias[4];
#pragma unroll
                for (int m = 0; m < 4; ++m) { const int i = 64 * wr + 16 * m + fr; bias[m] = RC[512 + 128 * h + i];
#pragma unroll
                    for (int n = 0; n < 2; ++n) ur[m][n] = *(const v2u*)(PROJ + (size_t)(t0 + i) * INW + 128 * h + 32 * wc + 16 * n + 4 * fq); }
                p3_mma(lds, true, acc, wr, wc, fr, fq);
#pragma unroll
                for (int m = 0; m < 4; ++m) { const int i = 64 * wr + 16 * m + fr;
#pragma unroll
                    for (int n = 0; n < 2; ++n) { const int c = 128 * h + 32 * wc + 16 * n + 4 * fq; const v2u u2 = ur[m][n]; const float bi = bias[m];
                        const f32x4 z = acc[m][n]; v2u w; w.x = pk2(bf_lo(u2.x) * (z[0] + bi), bf_hi(u2.x) * (z[1] + bi)); w.y = pk2(bf_lo(u2.y) * (z[2] + bi), bf_hi(u2.y) * (z[3] + bi));
                        *(v2u*)(MIXIN + (size_t)(t0 + i) * D + c) = w; } }
                __syncthreads();
            } else { const int g = item - 4, w = 2 << g;
#pragma unroll
                for (int it = 0; it < 4; ++it) { const int idx = tid + 512 * it, row = idx >> 4, ch = idx & 15; *(LAS v4u*)(lds + P3_RB + row * P3_PA + ch * 16) = P3_RA_(R, it); }
#pragma unroll
                for (int it = 0; it < 5; ++it) { const int idx = tid + 512 * it, row = idx >> 4, ch = idx & 15; if (row < 144) *(LAS v4u*)(lds + P3_RP + row * P3_PA + ch * 16) = P3_RB_(R, it); }
                __syncthreads();
                if (item + 2 < 8) p3_prefetch(R, item + 2, t0, s0, tid, PROJ, WSP, WPOOL);
                switch (g) { case 0: p3_pool<2>(lds, tid, s0); break; case 1: p3_pool<4>(lds, tid, s0); break; case 2: p3_pool<8>(lds, tid, s0); break; default: p3_pool<16>(lds, tid, s0); break; }
                __syncthreads();
                p3_mma(lds, false, acc, wr, wc, fr, fq);
#pragma unroll
                for (int m = 0; m < 4; ++m) { const int t = 64 * wr + 16 * m + fr;
#pragma unroll
                    for (int n = 0; n < 2; ++n) { const int d = 128 * g + 32 * wc + 16 * n + 4 * fq; const f32x4 ps = *(const LAS f32x4*)(RC + 1024 + d); const f32x4 y = acc[m][n] * ps;
                        v2u wv; wv.x = pk2(y[0], y[1]); wv.y = pk2(y[2], y[3]); *(v2u*)(MIXIN + (size_t)(t0 + t) * D + AW + d) = wv; } }
                __syncthreads();
            }
}
__device__ __forceinline__ void p3_mixers(const Args& a, LAS unsigned char* lds, int tid0) {
    const int lane = tid0 & 63, wave = tid0 >> 6, wr = wave >> 2, wc = wave & 3, fr = lane & 15, fq = lane >> 4;
    const bf16* PROJ = (const bf16*)(a.ws + WS_PROJ); bf16* MIXIN = (bf16*)(a.ws + WS_MIXIN);
    const bf16* WSP = (const bf16*)(a.ws + WS_WSP); const bf16* WPOOL = (const bf16*)(a.ws + WS_WPOOL);
    const float* sgug = a.in[I_SGUG]; const float* bsp = a.in[I_BSP]; const float* pscale = a.in[I_PSCALE];
    { LAS float* rc = (LAS float*)(lds + P3_RC); rc[tid0] = sgug[tid0]; rc[512 + tid0] = bsp[tid0]; rc[1024 + tid0] = pscale[tid0]; }
    __syncthreads();
    const LAS float* RC = (const LAS float*)(lds + P3_RC);
    for (int tb = blockIdx.x; tb < M / 128; tb += gridDim.x) { const int t0 = tb * 128, s0 = t0 % SEQ;
        P3Regs R;
        p3_prefetch(R, 0, t0, s0, tid0, PROJ, WSP, WPOOL);
        P3Regs Rb;
        p3_prefetch(Rb, 1, t0, s0, tid0, PROJ, WSP, WPOOL);
        for (int it2 = 0; it2 < 4; ++it2) {
            p3_item(R, 2 * it2, t0, s0, tid0, lds, RC, PROJ, MIXIN, WSP, WPOOL, wr, wc, fr, fq);
            p3_item(Rb, 2 * it2 + 1, t0, s0, tid0, lds, RC, PROJ, MIXIN, WSP, WPOOL, wr, wc, fr, fq); } }
}

__device__ __forceinline__ void p4b_mid(const Args& a, int gw, int NGW, int lane) {
    const float* MOD = (const float*)(a.ws + OFF_MOD); const float* SS1 = (const float*)(a.ws + OFF_SS1); const bf16* MIXED = (const bf16*)(a.ws + WS_MIXED); bf16* XN = (bf16*)(a.ws + WS_XN);
    const float* x = a.in[I_X]; const float* pg = a.in[I_POSTMIXG]; const float* fg = a.in[I_PREFFNG]; bf16* X1B = (bf16*)(a.ws + WS_X1B);
    const int rpw = M / NGW;
    for (int r0 = gw * rpw; r0 < M; r0 += NGW * rpw) { const int b = r0 / SEQ; const float* mb = MOD + (size_t)b * NMOD;
        f32x4 A1[4], A2[4], A3[4];
#pragma unroll
        for (int j = 0; j < 4; ++j) { const int col = 4 * lane + 256 * j; A1[j] = *(const f32x4*)(mb + 2 * D + col) * *(const f32x4*)(pg + col);
            A2[j] = *(const f32x4*)(fg + col) * (1.0f + *(const f32x4*)(mb + 4 * D + col)); A3[j] = *(const f32x4*)(mb + 3 * D + col); }
        f32x4 nx[4]; v2u nm[4];
        { const f32x4* xr = (const f32x4*)(x + (size_t)r0 * D) + lane; const v2u* mr = (const v2u*)(MIXED + (size_t)r0 * D) + lane;
#pragma unroll
            for (int j = 0; j < 4; ++j) { nx[j] = __builtin_nontemporal_load(xr + 64 * j); nm[j] = __builtin_nontemporal_load(mr + 64 * j); } }
        const float ssv = (lane < rpw) ? SS1[r0 + lane] : 0.f;
        for (int r = r0; r < r0 + rpw; ++r) {
            const float rs1 = __builtin_amdgcn_rsqf(__builtin_bit_cast(float, __builtin_amdgcn_readlane(__builtin_bit_cast(int, ssv), r - r0)) * (1.0f / D) + EPS); f32x4 v[4]; float s = 0.f;
#pragma unroll
            for (int j = 0; j < 4; ++j) { const v2u mw = nm[j]; const f32x4 mx = {bf_lo(mw.x), bf_hi(mw.x), bf_lo(mw.y), bf_hi(mw.y)};
                v[j] = nx[j] + mx * rs1 * A1[j]; s += (v[j].x * v[j].x + v[j].y * v[j].y) + (v[j].z * v[j].z + v[j].w * v[j].w); }
            if (r + 1 < r0 + rpw) { const f32x4* xr = (const f32x4*)(x + (size_t)(r + 1) * D) + lane; const v2u* mr = (const v2u*)(MIXED + (size_t)(r + 1) * D) + lane;
#pragma unroll
                for (int j = 0; j < 4; ++j) { nx[j] = __builtin_nontemporal_load(xr + 64 * j); nm[j] = __builtin_nontemporal_load(mr + 64 * j); } }
            v2u* xrow = (v2u*)(X1B + (size_t)r * D) + lane;
#pragma unroll
            for (int j = 0; j < 4; ++j) { v2u w; w.x = pk2(v[j].x, v[j].y); w.y = pk2(v[j].z, v[j].w); __builtin_nontemporal_store(w, xrow + 64 * j); }
            const float rs = __builtin_amdgcn_rsqf(wave_sum(s) * (1.0f / D) + EPS);
            v2u* o = (v2u*)(XN + (size_t)r * D) + lane;
#pragma unroll
            for (int j = 0; j < 4; ++j) { const f32x4 h = v[j] * rs * A2[j] + A3[j]; const unsigned long long w = (unsigned long long)pk2(h.x, h.y) | ((unsigned long long)pk2(h.z, h.w) << 32);
                __hip_atomic_store((unsigned long long*)(o + 64 * j), w, __ATOMIC_RELAXED, __HIP_MEMORY_SCOPE_AGENT); } } }
}

__device__ __forceinline__ void p6b_fixup(const Args& a, int gw, int NGW, int lane) {
    const bf16* RAW = (const bf16*)(a.ws + WS_RAW); bf16* ACT = (bf16*)(a.ws + WS_ACT); const float* cw = a.in[I_CONVW]; const float* cb = a.in[I_CONVB];
    for (int it = gw; it < (M / 64) * 2 * 4; it += NGW) { const int q = it & 3, rr = (it >> 2) & 1, B = it >> 3; const int t = 64 * B + rr, s = t % SEQ;
        const bf16* cur = RAW + (size_t)(B * 4 + rr) * FF2;
        const bf16* p1 = (rr == 1) ? RAW + (size_t)(B * 4 + 0) * FF2 : (s == 0 ? nullptr : RAW + (size_t)((B - 1) * 4 + 3) * FF2);
        const bf16* p2 = (rr == 1) ? (s == 1 ? nullptr : RAW + (size_t)((B - 1) * 4 + 3) * FF2) : (s == 0 ? nullptr : RAW + (size_t)((B - 1) * 4 + 2) * FF2);
        for (int f = q * 704 + 4 * lane; f < q * 704 + 704; f += 256) { f32x4 y[2];
#pragma unroll
            for (int hv = 0; hv < 2; ++hv) { const int col = hv * FF + f; const f32x4 z = {0.f, 0.f, 0.f, 0.f};
                const v2u zz = {0u, 0u}; const v2u r0 = *(const v2u*)(cur + col), r1 = p1 ? *(const v2u*)(p1 + col) : zz, r2 = p2 ? *(const v2u*)(p2 + col) : zz; (void)z;
                const f32x4 u0 = {bf_lo(r0.x), bf_hi(r0.x), bf_lo(r0.y), bf_hi(r0.y)}, u1 = {bf_lo(r1.x), bf_hi(r1.x), bf_lo(r1.y), bf_hi(r1.y)}, u2 = {bf_lo(r2.x), bf_hi(r2.x), bf_lo(r2.y), bf_hi(r2.y)};
                y[hv] = *(const f32x4*)(cb + col) + *(const f32x4*)(cw + col) * u2 + *(const f32x4*)(cw + FF2 + col) * u1 + *(const f32x4*)(cw + 2 * FF2 + col) * u0; }
            v2u w; w.x = pk2(pg8::silu_f(y[0][0]) * y[1][0], pg8::silu_f(y[0][1]) * y[1][1]); w.y = pk2(pg8::silu_f(y[0][2]) * y[1][2], pg8::silu_f(y[0][3]) * y[1][3]);
            *(v2u*)(ACT + (size_t)t * FF + f) = w; } }
}

#define XB_TMO      128
#define XB_XCNT(j)  (256  + 64 * (j))
#define XB_XSUB(j)  (1280 + 64 * (j))
#define XB_XGEN(j)  (2304 + 64 * (j))
#define XB_TOP      3328
#define XB_TOPGEN   3392
#define XCD_BAR_WORDS 3456
#define XB_SPIN_CAP (1u << 18)

__device__ __forceinline__ unsigned xb_ld(unsigned* p)              { return __hip_atomic_load(p, __ATOMIC_RELAXED, __HIP_MEMORY_SCOPE_AGENT); }
__device__ __forceinline__ unsigned xb_add(unsigned* p, unsigned v) { return __hip_atomic_fetch_add(p, v, __ATOMIC_RELAXED, __HIP_MEMORY_SCOPE_AGENT); }
__device__ __forceinline__ unsigned xb_xcc_id() { return (unsigned)__builtin_amdgcn_s_getreg((3 << 11) | 20) & 0xFu; }
#define XB_SPIN(cond, bar) do { unsigned _sp = 0; while (cond) { __builtin_amdgcn_s_sleep(1); \
    if ((++_sp & 255u) == 0u) { if (xb_ld(&(bar)[XB_TMO])) break; if (_sp > XB_SPIN_CAP) { atomicAdd(&(bar)[XB_TMO], 1u); break; } } } } while (0)

struct XcdBarrier {
    unsigned* bar; unsigned x;
    volatile LAS unsigned* st;
};

__device__ __forceinline__ XcdBarrier xcd_barrier_post(unsigned* bar, volatile LAS unsigned* st) {
    XcdBarrier b; b.bar = bar; b.x = xb_xcc_id(); b.st = st;
    if (threadIdx.x == 0) st[2] = xb_add(&bar[XB_XCNT(b.x)], 1u);
    return b;
}
__device__ __forceinline__ void xcd_barrier_complete(unsigned* bar, unsigned x, unsigned& nloc, unsigned& nx) {
    const unsigned G = gridDim.x * gridDim.y * gridDim.z;
    unsigned sum, cnt, mine, sp = 0u;
    for (;;) {
        sum = 0u; cnt = 0u; mine = 0u;
#pragma unroll
        for (unsigned j = 0; j < 16; ++j) { const unsigned c = xb_ld(&bar[XB_XCNT(j)]); sum += c; cnt += (c > 0u) ? 1u : 0u; mine = (j == x) ? c : mine; }
        if (sum == G) break;
        __builtin_amdgcn_s_sleep(1);
        if ((++sp & 255u) == 0u) { if (xb_ld(&bar[XB_TMO])) break; if (sp > XB_SPIN_CAP) { atomicAdd(&bar[XB_TMO], 1u); break; } }
    }
    nloc = mine > 0u ? mine : 1u; nx = cnt > 0u ? cnt : 1u;
}

__device__ __forceinline__ void xcd_barrier(const XcdBarrier& b) {
    asm volatile("s_waitcnt vmcnt(0)" ::: "memory");
    __syncthreads();
    if (threadIdx.x == 0) {
        unsigned* bar = b.bar;
        __builtin_amdgcn_s_waitcnt(0);
        unsigned nloc = b.st[0], nx = b.st[1];
        if (nloc == 0u) { xcd_barrier_complete(bar, b.x, nloc, nx); b.st[0] = nloc; b.st[1] = nx; }
        const unsigned old = xb_add(&bar[XB_XSUB(b.x)], 1u);
        const unsigned gen = old / nloc;
        if (old + 1u == (gen + 1u) * nloc) {
            __builtin_amdgcn_fence(__ATOMIC_RELEASE, "agent");
            asm volatile("s_waitcnt vmcnt(0)" ::: "memory");
            const unsigned og = xb_add(&bar[XB_TOP], 1u);
            const unsigned tg = og / nx;
            if (og + 1u == (tg + 1u) * nx) xb_add(&bar[XB_TOPGEN], 1u);
            else XB_SPIN(xb_ld(&bar[XB_TOPGEN]) == tg, bar);
            __builtin_amdgcn_fence(__ATOMIC_ACQUIRE, "agent");
            xb_add(&bar[XB_XGEN(b.x)], 1u);
            asm volatile("s_waitcnt vmcnt(0)" ::: "memory");
        } else {
            XB_SPIN(xb_ld(&bar[XB_XGEN(b.x)]) == gen, bar);
            __builtin_amdgcn_fence(__ATOMIC_ACQUIRE, "agent");
            asm volatile("s_waitcnt vmcnt(0)" ::: "memory");
        }
    }
    __syncthreads();
}
__global__ void __launch_bounds__(NWAVES * 64, 2) mk_fwd(Args args) {
    extern __shared__ __attribute__((aligned(16))) unsigned char lds_raw[];
    LAS unsigned char* lds = (LAS unsigned char*)lds_raw;
    const int tid = threadIdx.x, lane = tid & 63, wave = __builtin_amdgcn_readfirstlane(tid >> 6);
    const int G = gridDim.x, gw = blockIdx.x * NWAVES + wave, NGW = G * NWAVES;
    const int lo = args.ph_lo, hi = args.ph_hi;
    unsigned char* ws = args.ws;
    if (tid < 64) ((LAS unsigned*)(lds + LDSCTL_OFF))[tid] = 0u;
    __syncthreads();
    XcdBarrier bar = xcd_barrier_post((unsigned*)(ws + OFF_BAR), (volatile LAS unsigned*)(lds + LDSCTL_OFF) + 8);
#define IN(k) (lo <= (k) && (k) < hi)
#define NREP(k) ((MK_REPEAT == (k) || ((k) == 4 && (MK_REPEAT == 41 || MK_REPEAT == 42))) ? 2 : 1)
#define SEAM(k) do { if (IN(k) && IN((k) + 1)) xcd_barrier(bar); } while (0)
    if (lo < 0) cg::this_grid().sync();
    if (IN(0)) { p0_prologue(args, lds, gw, NGW, lane, wave, true, false); }
    SEAM(0);
    if (IN(1)) { for (int rep = 0; rep < NREP(1); ++rep) { if (rep) xcd_barrier(bar); p0_prologue(args, lds, gw, NGW, lane, wave, false, true); p1_norm(args, gw, NGW, lane); } }
    SEAM(1);
    int cvirt = (int)blockIdx.x;
    if (lo == 0 && hi > 2 && (G & 7) == 0) { bool even = true;
#pragma unroll
        for (int j = 0; j < 16; ++j) { const unsigned cj = xb_ld(&bar.bar[XB_XCNT(j)]); even = even && (cj == (j < 8 ? (unsigned)(G >> 3) : 0u)); }
        if (even && bar.x < 8u) cvirt = (int)(bar.st[2] * 8u + bar.x); }
    cvirt = __builtin_amdgcn_readfirstlane(cvirt);
    if (IN(2)) { pg8::Gemm g{(const bf16*)(ws + WS_XN), (const bf16*)(ws + WS_WIN), M, INW, D}; pg8::StaticOrder S; S.init(M, INW, G, cvirt);
        pg8::EpiProj E{(bf16*)(ws + WS_PROJ), INW};
        for (int rep = 0; rep < NREP(2); ++rep) { if (rep) xcd_barrier(bar); pg8::gemm_phase<pg8::EpiProj, pg8::StaticOrder, true, true>(lds, g, S, E); } }
    SEAM(2);
    if (IN(3)) { for (int rep = 0; rep < NREP(3); ++rep) { if (rep) xcd_barrier(bar); __syncthreads(); p3_mixers(args, lds, tid); } }
    SEAM(3);
    if (IN(4)) { pg8::Gemm g{(const bf16*)(ws + WS_MIXIN), (const bf16*)(ws + WS_WOUT), M, D, D}; pg8::StaticOrder S; S.init(M, D, G, cvirt);
        pg8::EpiBf16SS E{(bf16*)(ws + WS_MIXED), D, (float*)(ws + OFF_SS1)};
        pg8::gemm_phase<pg8::EpiBf16SS, pg8::StaticOrder, true, true>(lds, g, S, E);
        xcd_barrier(bar);
        p4b_mid(args, gw, NGW, lane); }
    SEAM(4);
    if (IN(5)) { pg8::Gemm g{(const bf16*)(ws + WS_XN), (const bf16*)(ws + WS_WUP), M, FF2, D}; pg8::StaticOrder S; S.init(M, FF2, G, cvirt);
        pg8::EpiConv E{(bf16*)(ws + WS_ACT), (bf16*)(ws + WS_RAW), args.in[I_CONVW], args.in[I_CONVB], FF, lds + LDSCTL_OFF + 4096};
        for (int rep = 0; rep < NREP(5); ++rep) { if (rep) xcd_barrier(bar); pg8::gemm_phase<pg8::EpiConv, pg8::StaticOrder, true, true>(lds, g, S, E); } }
    SEAM(5);
    if (IN(6)) { p6b_fixup(args, gw, NGW, lane); }
    SEAM(6);
    if (IN(7)) { pg8::Gemm g{(const bf16*)(ws + WS_ACT), (const bf16*)(ws + WS_WDOWN), M, D, FF}; pg8::StaticOrder S; S.init(M, D, G, cvirt);
        for (int rep = 0; rep < NREP(7); ++rep) { if (rep) xcd_barrier(bar);
        pg8::RowStat st{(float*)(ws + (rep ? 736 * 1024 : OFF_SS4)), (unsigned*)(ws + (rep ? 640 * 1024 : OFF_CNT + 32768)), 32u, 1.0f / D, EPS};
        pg8::EpiFinal E{(const bf16*)(ws + WS_X1B), rep ? (float*)(ws + WS_F) : args.out, (const float*)(ws + OFF_MOD), args.in[I_POSTFFNG], st, D, SEQ / 256};
        pg8::gemm_phase<pg8::EpiFinal, pg8::StaticOrder, true, true>(lds, g, S, E); } }
    if (MK_REPEAT == 17 && IN(7)) { xcd_barrier(bar); pg8::Gemm g{(const bf16*)(ws + WS_ACT), (const bf16*)(ws + WS_WDOWN), M, D, FF}; pg8::StaticOrder S; S.init(M, D, G, (int)blockIdx.x);
        pg8::EpiSink E{(float*)(ws + WS_F)}; pg8::gemm_phase<pg8::EpiSink, pg8::StaticOrder, true, true>(lds, g, S, E); }
#undef IN
#undef SEAM
}

constexpr int N_PHASES = 8;
extern "C" void kernel_launch(void* const* d_in, const int* in_sizes, int n_in, void* d_out, int out_size, void* d_ws, size_t ws_size, hipStream_t stream) {
    static int grid = 0;
    if (grid == 0) {
        if (n_in != 19 || in_sizes[0] != M * D || out_size != M * D || ws_size < WS_END) { fprintf(stderr, "kernel_launch: unexpected shapes (n_in %d, in0 %d, out %d, ws %zu)\n", n_in, n_in > 0 ? in_sizes[0] : -1, out_size, ws_size); grid = -1; return; }
        int dev = 0, cus = 0, per_cu = 0;
        (void)hipGetDevice(&dev); (void)hipDeviceGetAttribute(&cus, hipDeviceAttributeMultiprocessorCount, dev);
        if (hipFuncSetAttribute((const void*)mk_fwd, hipFuncAttributeMaxDynamicSharedMemorySize, LDS_BYTES) != hipSuccess) { fprintf(stderr, "kernel_launch: hipFuncSetAttribute failed\n"); grid = -1; return; }
        if (hipOccupancyMaxActiveBlocksPerMultiprocessor(&per_cu, (const void*)mk_fwd, NWAVES * 64, LDS_BYTES) != hipSuccess || per_cu < 1) { fprintf(stderr, "kernel_launch: occupancy query says %d blocks per CU\n", per_cu); per_cu = 1; }
        (void)hipGetLastError();
        grid = cus > 0 ? cus : 256;
    }
    if (grid < 0) return;
    (void)hipMemsetAsync((char*)d_ws + WS_CTL, 0, CTL_ZERO_BYTES, stream);
    Args a{};
    for (int i = 0; i < 19; ++i) a.in[i] = (const float*)d_in[i];
    a.out = (float*)d_out; a.ws = (unsigned char*)d_ws;
#if MK_N_LAUNCHES == 1
    a.ph_lo = 0; a.ph_hi = N_PHASES;
    void* kargs[] = {&a};
    hipError_t e = hipLaunchCooperativeKernel((const void*)mk_fwd, dim3(grid), dim3(NWAVES * 64), kargs, LDS_BYTES, stream);
    if (e != hipSuccess) fprintf(stderr, "kernel_launch: cooperative launch failed: %s (grid %d)\n", hipGetErrorString(e), grid);
#else
    for (int p = 0; p < N_PHASES; ++p) { a.ph_lo = p; a.ph_hi = p + 1; hipLaunchKernelGGL(mk_fwd, dim3(grid), dim3(NWAVES * 64), LDS_BYTES, stream, a); }
#endif
}
```

```cpp
#include <hip/hip_runtime.h>
#include <hip/hip_cooperative_groups.h>
#include <cstdio>
#include <cstdint>
namespace cg = cooperative_groups;
#ifndef MK_N_LAUNCHES
#define MK_N_LAUNCHES 1
#endif
#ifndef MK_REPEAT
#define MK_REPEAT -1
#endif
namespace pg8 {
#define PG8_LAS __attribute__((address_space(3)))
typedef unsigned short bf16_t;
typedef short bf16x8 __attribute__((ext_vector_type(8)));
typedef float f32x4 __attribute__((ext_vector_type(4)));
typedef unsigned u32x4 __attribute__((ext_vector_type(4)));
constexpr int BM = 256, BK = 64, HALF = 128, HTB = HALF * BK * 2  , STAGE_BYTES = 8 * HTB, NXCD = 8, WGM = 8;

__host__ __device__ __forceinline__ int lds_byte(int r, int c) { const int st = (r >> 4) * 2 + (c >> 5), rr = r & 15, cc = c & 31, ob = rr * 64 + cc * 2; return st * 1024 + (ob ^ (((ob >> 9) & 1) << 5)); }
__host__ __device__ __forceinline__ void stage_rc(int b, int& R, int& C) { const int st = b / 1024, sb = b % 1024, swz = sb ^ (((sb >> 9) & 1) << 5); R = (st >> 1) * 16 + swz / 64; C = (st & 1) * 32 + (swz % 64) / 2; }
__host__ __device__ __forceinline__ int perm32(int rho) { const int n = rho >> 4, i = rho & 15; return 8 * (i >> 2) + 4 * n + (i & 3); }

struct Unit { int pm, pn; };
struct Gemm { const bf16_t* A; const bf16_t* Bt; int M, N, K; };

struct StaticOrder {
    int nM, nN, nwg, G, c;
    __host__ __device__ void init(int M, int N, int G_, int c_) { nM = M / BM; nN = N / BM; nwg = nM * nN; G = G_; c = c_; }
    __host__ __device__ bool next(int i, Unit& u) const {
        const long L = (long)i * G + c; if (L >= nwg) return false;
        int wgid = (int)L; { const int q = nwg / NXCD, r = nwg % NXCD, xcd = wgid % NXCD, off = wgid / NXCD; wgid = (xcd < r ? xcd * (q + 1) : r * (q + 1) + (xcd - r) * q) + off; }
        const int nig = WGM * nN, gid = wgid / nig, fm = gid * WGM, gsz = (nM - fm) < WGM ? (nM - fm) : WGM;
        u.pm = fm + ((wgid % nig) % gsz); u.pn = (wgid % nig) / gsz; return true;
    }
    __device__ __forceinline__ void a_ready(const Unit&) const {}
    __device__ __forceinline__ void done(const Unit&) const {}
};

__device__ __forceinline__ unsigned cvt_pk_bf16(float lo, float hi) { unsigned r; asm volatile("v_cvt_pk_bf16_f32 %0, %1, %2" : "=v"(r) : "v"(lo), "v"(hi)); return r; }
typedef float f32x2 __attribute__((ext_vector_type(2)));
typedef unsigned u32x2 __attribute__((ext_vector_type(2)));
__device__ __forceinline__ float fast_sigmoid_arg2(float p) { return __builtin_amdgcn_rcpf(1.0f + __builtin_amdgcn_exp2f(p)); }
__device__ __forceinline__ float gelu_tanh(float x) {
    const float t = x * x; const float p = x * (-2.302208198f + (-0.1029432397f) * t); return x * fast_sigmoid_arg2(p);
}
__device__ __forceinline__ float silu_f(float x) { return x * fast_sigmoid_arg2(x * (-1.4426950409f)); }
__device__ __forceinline__ float dpp_ror1(float x) { return __builtin_bit_cast(float, __builtin_amdgcn_update_dpp(0, __builtin_bit_cast(int, x), 0x121, 0xf, 0xf, false)); }
__device__ __forceinline__ float dpp_ror2(float x) { return __builtin_bit_cast(float, __builtin_amdgcn_update_dpp(0, __builtin_bit_cast(int, x), 0x122, 0xf, 0xf, false)); }

struct EpiProj {
    static constexpr bool PERM = true, AFTER_DRAIN = false, PERMA = false, HAS_PRE = false;
    bf16_t* O; int ldc;
    __device__ __forceinline__ void operator()(const f32x4 (&acc)[2][2][4][2], const Unit& u, int wr, int wc, int fr, int fq) const {
        const int row0 = u.pm * BM + wr * 64 + fr, col0 = u.pn * BM + wc * 32 + 8 * fq; const bool act = u.pn < 4;
#pragma unroll
        for (int ai = 0; ai < 2; ++ai)
#pragma unroll
            for (int m = 0; m < 4; ++m) { bf16_t* rowp = O + (size_t)(row0 + ai * HALF + m * 16) * ldc + col0;
#pragma unroll
                for (int bj = 0; bj < 2; ++bj) { f32x4 v0 = acc[ai][bj][m][0], v1 = acc[ai][bj][m][1];
                    if (act) {
#pragma unroll
                        for (int j = 0; j < 4; ++j) { v0[j] = gelu_tanh(v0[j]); v1[j] = gelu_tanh(v1[j]); } }
                    u32x4 w; w.x = cvt_pk_bf16(v0[0], v0[1]); w.y = cvt_pk_bf16(v0[2], v0[3]); w.z = cvt_pk_bf16(v1[0], v1[1]); w.w = cvt_pk_bf16(v1[2], v1[3]);
                    *(u32x4*)(rowp + bj * HALF) = w; } }
    }
};

struct EpiF32SS {
    static constexpr bool PERM = false, AFTER_DRAIN = false, PERMA = false, HAS_PRE = false;
    float* O; int ldc; float* ss;
    __device__ __forceinline__ void operator()(const f32x4 (&acc)[2][2][4][2], const Unit& u, int wr, int wc, int fr, int fq) const {
        const int row0 = u.pm * BM + wr * 64 + fr, col0 = u.pn * BM + wc * 32 + 4 * fq;
#pragma unroll
        for (int ai = 0; ai < 2; ++ai)
#pragma unroll
            for (int m = 0; m < 4; ++m) { const int row = row0 + ai * HALF + m * 16; float* rowp = O + (size_t)row * ldc + col0; float s = 0.f;
#pragma unroll
                for (int bj = 0; bj < 2; ++bj)
#pragma unroll
                    for (int n = 0; n < 2; ++n) { const f32x4 x = acc[ai][bj][m][n]; s += (x[0] * x[0] + x[1] * x[1]) + (x[2] * x[2] + x[3] * x[3]); *(f32x4*)(rowp + bj * HALF + n * 16) = x; }
                s += __shfl_xor(s, 16); s += __shfl_xor(s, 32);
                if (fq == 0) atomicAdd(ss + row, s); }
    }
};

struct EpiBf16SS {
    static constexpr bool PERM = true, AFTER_DRAIN = false, PERMA = false, HAS_PRE = false;
    bf16_t* O; int ldc; float* ss;
    __device__ __forceinline__ void operator()(const f32x4 (&acc)[2][2][4][2], const Unit& u, int wr, int wc, int fr, int fq) const {
        const int row0 = u.pm * BM + wr * 64 + fr, col0 = u.pn * BM + wc * 32 + 8 * fq;
#pragma unroll
        for (int ai = 0; ai < 2; ++ai)
#pragma unroll
            for (int m = 0; m < 4; ++m) { const int row = row0 + ai * HALF + m * 16; bf16_t* rowp = O + (size_t)row * ldc + col0; float s = 0.f;
#pragma unroll
                for (int bj = 0; bj < 2; ++bj) { const f32x4 v0 = acc[ai][bj][m][0], v1 = acc[ai][bj][m][1];
                    s += ((v0[0] * v0[0] + v0[1] * v0[1]) + (v0[2] * v0[2] + v0[3] * v0[3])) + ((v1[0] * v1[0] + v1[1] * v1[1]) + (v1[2] * v1[2] + v1[3] * v1[3]));
                    u32x4 w; w.x = cvt_pk_bf16(v0[0], v0[1]); w.y = cvt_pk_bf16(v0[2], v0[3]); w.z = cvt_pk_bf16(v1[0], v1[1]); w.w = cvt_pk_bf16(v1[2], v1[3]);
                    *(u32x4*)(rowp + bj * HALF) = w; }
                s += __shfl_xor(s, 16); s += __shfl_xor(s, 32);
                if (fq == 0) atomicAdd(ss + row, s); }
    }
};

__device__ __forceinline__ float dpp_shr1(float x) { return __builtin_bit_cast(float, __builtin_amdgcn_update_dpp(0, __builtin_bit_cast(int, x), 0x111, 0xf, 0xf, true)); }
struct EpiConv {
    static constexpr bool PERM = true, AFTER_DRAIN = false, PERMA = true, HAS_PRE = true;
    bf16_t* ACT; bf16_t* RAW; const float* cw; const float* cb; int FF; PG8_LAS unsigned char* CB;
    __device__ __forceinline__ void pre(const Unit& u, int par) const {
        const int tid = threadIdx.x, w = __builtin_amdgcn_readfirstlane(tid >> 6), l = tid & 63;
        if (w < 4) { const int vec = 2 * w + (l >> 5), k = vec & 3, hv = vec >> 2; const float* src = (k < 3 ? cw + (size_t)k * 2 * FF : cb) + hv * FF + u.pn * HALF + (l & 31) * 4;
            __builtin_amdgcn_global_load_lds((const unsigned*)src, (PG8_LAS unsigned*)(CB + par * 4096 + w * 1024), 16, 0, 0); }
    }
    __device__ __forceinline__ void run(const f32x4 (&acc)[2][2][4][2], const Unit& u, int wr, int wc, int fr, int fq, int par) const {
        const int f0 = u.pn * HALF + wc * 32 + 8 * fq; const int rowt = u.pm * BM + wr * 64 + 4 * fr; const int FF2 = 2 * FF;
        const PG8_LAS float* cbuf = (const PG8_LAS float*)(CB + par * 4096) + wc * 32 + 8 * fq;
        unsigned stash[2][4][2];
#pragma unroll
        for (int n = 0; n < 2; ++n) { const int f = f0 + 4 * n; const PG8_LAS float* cn = cbuf + 4 * n;
            const f32x4 w0g = *(const PG8_LAS f32x4*)(cn), w1g = *(const PG8_LAS f32x4*)(cn + 128), w2g = *(const PG8_LAS f32x4*)(cn + 256), bg = *(const PG8_LAS f32x4*)(cn + 384);
            const f32x4 w0v = *(const PG8_LAS f32x4*)(cn + 512), w1v = *(const PG8_LAS f32x4*)(cn + 640), w2v = *(const PG8_LAS f32x4*)(cn + 768), bv = *(const PG8_LAS f32x4*)(cn + 896);
#pragma unroll
            for (int ai = 0; ai < 2; ++ai) {
                f32x4 gm1, gm2, vm1, vm2;
#pragma unroll
                for (int j = 0; j < 4; ++j) { gm1[j] = dpp_shr1(acc[ai][0][3][n][j]); gm2[j] = dpp_shr1(acc[ai][0][2][n][j]); vm1[j] = dpp_shr1(acc[ai][1][3][n][j]); vm2[j] = dpp_shr1(acc[ai][1][2][n][j]); }
#pragma unroll
                for (int m = 0; m < 4; ++m) { const f32x4 g = acc[ai][0][m][n], v = acc[ai][1][m][n];
                    const f32x4 pg1 = (m == 0) ? gm1 : acc[ai][0][m > 0 ? m - 1 : 0][n], pg2 = (m == 0) ? gm2 : (m == 1 ? gm1 : acc[ai][0][m > 1 ? m - 2 : 0][n]);
                    const f32x4 pv1 = (m == 0) ? vm1 : acc[ai][1][m > 0 ? m - 1 : 0][n], pv2 = (m == 0) ? vm2 : (m == 1 ? vm1 : acc[ai][1][m > 1 ? m - 2 : 0][n]);
                    const f32x4 yg = bg + w0g * pg2 + w1g * pg1 + w2g * g, yv = bv + w0v * pv2 + w1v * pv1 + w2v * v; f32x4 a;
#pragma unroll
                    for (int j = 0; j < 4; ++j) a[j] = silu_f(yg[j]) * yv[j];
                    const unsigned lo = cvt_pk_bf16(a[0], a[1]), hi = cvt_pk_bf16(a[2], a[3]);
                    if (n == 0) { stash[ai][m][0] = lo; stash[ai][m][1] = hi; }
                    else if (!(m < 2 && fr == 0)) { u32x4 w; w.x = stash[ai][m][0]; w.y = stash[ai][m][1]; w.z = lo; w.w = hi; __builtin_nontemporal_store(w, (u32x4*)(ACT + (size_t)(rowt + ai * HALF + m) * FF + f0)); }
                    if ((m < 2 && fr == 0) || (m >= 2 && fr == 15)) { bf16_t* rp = RAW + ((size_t)((u.pm * 4 + ai * 2 + wr) * 4 + m)) * FF2 + f;
                        u32x2 gw, vw; gw.x = cvt_pk_bf16(g[0], g[1]); gw.y = cvt_pk_bf16(g[2], g[3]); vw.x = cvt_pk_bf16(v[0], v[1]); vw.y = cvt_pk_bf16(v[2], v[3]);
                        *(u32x2*)rp = gw; *(u32x2*)(rp + FF) = vw; } } } }
    }
};

struct RowStat {
    float* ss; unsigned* cnt; unsigned want; float inv_n, eps;
    __device__ __forceinline__ void run(const float (&part)[2][4], float (&rs)[2][4], const Unit& u, int wr, int fr, int fq) const {
        const int row0 = u.pm * BM + wr * 64 + fr; const int lane = fq * 16 + fr;
#pragma unroll
        for (int ai = 0; ai < 2; ++ai)
#pragma unroll
            for (int m = 0; m < 4; ++m) { float s = part[ai][m]; s += __shfl_xor(s, 16); s += __shfl_xor(s, 32); if (fq == 0) atomicAdd(ss + row0 + ai * HALF + m * 16, s); }
        asm volatile("s_waitcnt vmcnt(0)" ::: "memory");
        unsigned* c = cnt + 64 * u.pm;
        if (lane == 0) __hip_atomic_fetch_add(c, 1u, __ATOMIC_RELAXED, __HIP_MEMORY_SCOPE_AGENT);
        if (threadIdx.x < 64) { unsigned sp = 0;
            while ((unsigned)__builtin_amdgcn_readfirstlane(__hip_atomic_load(c, __ATOMIC_RELAXED, __HIP_MEMORY_SCOPE_AGENT)) < want) { __builtin_amdgcn_s_sleep(1); if (++sp > (1u << 22)) break; } }
        asm volatile("s_waitcnt vmcnt(0) lgkmcnt(0)" ::: "memory"); __builtin_amdgcn_s_barrier(); asm volatile("" ::: "memory");
#pragma unroll
        for (int ai = 0; ai < 2; ++ai)
#pragma unroll
            for (int m = 0; m < 4; ++m) { const float v = __hip_atomic_load(ss + row0 + ai * HALF + m * 16, __ATOMIC_RELAXED, __HIP_MEMORY_SCOPE_AGENT); rs[ai][m] = __builtin_amdgcn_rsqf(v * inv_n + eps); }
    }
};
template <int VAR = 0  > struct EpiMid {
    static constexpr bool PERM = false, AFTER_DRAIN = false, PERMA = false, HAS_PRE = false;
    const float* x; float* x1; bf16_t* xn; const float* mod; const float* post_g; const float* ffn_g; const float* sxx; float* ss1; float* ssxm; float* ssmm; unsigned* cnt; PG8_LAS float* A23; int ld, tiles_per_batch;
    __device__ __forceinline__ void operator()(f32x4 (&acc)[2][2][4][2], const Unit& u, int wr, int wc, int fr, int fq) const {
        const int col0 = u.pn * BM + wc * 32 + 4 * fq; const float* mb = mod + (size_t)(u.pm / tiles_per_batch) * (6 * ld); const int tid = threadIdx.x;
        const unsigned voff = (unsigned)((wr * 64 + fr) * ld + col0) * 4u;
        const size_t pbase = (size_t)u.pm * BM * ld; const int row0 = u.pm * BM + wr * 64 + fr;
        if (tid < 256) { const int c = u.pn * BM + tid; A23[tid] = mb[2 * ld + c] * post_g[c]; A23[256 + tid] = ffn_g[c] * (1.0f + mb[4 * ld + c]); A23[512 + tid] = mb[3 * ld + c]; }
        asm volatile("s_waitcnt vmcnt(0) lgkmcnt(0)" ::: "memory"); __builtin_amdgcn_s_barrier(); asm volatile("" ::: "memory");
        const PG8_LAS float* As = A23 + wc * 32 + 4 * fq;
#pragma unroll
        for (int ai = 0; ai < 2; ++ai)
#pragma unroll
            for (int m = 0; m < 4; ++m) { const char* xb = (const char*)(x + pbase + (size_t)(ai * HALF + m * 16) * ld); f32x4 s1 = {0.f, 0.f, 0.f, 0.f}, sx = s1, sm = s1;
#pragma unroll
                for (int bj = 0; bj < 2; ++bj)
#pragma unroll
                    for (int n = 0; n < 2; ++n) { const unsigned o = voff + (unsigned)(bj * HALF + n * 16) * 4u; const f32x4 xv = (VAR == 1) ? (f32x4){1.f, 1.f, 1.f, 1.f} : *(const f32x4*)(xb + o); const f32x4 mx = acc[ai][bj][m][n], cm = mx * *(const PG8_LAS f32x4*)(As + bj * HALF + n * 16);
                        s1 += mx * mx; sx += xv * cm; sm += cm * cm; }
                float a = (s1[0] + s1[1]) + (s1[2] + s1[3]), b = (sx[0] + sx[1]) + (sx[2] + sx[3]), c = (sm[0] + sm[1]) + (sm[2] + sm[3]);
                a += __shfl_xor(a, 16); a += __shfl_xor(a, 32); b += __shfl_xor(b, 16); b += __shfl_xor(b, 32); c += __shfl_xor(c, 16); c += __shfl_xor(c, 32);
                if (fq == 0) { const int r = row0 + ai * HALF + m * 16; atomicAdd(ss1 + r, a); atomicAdd(ssxm + r, b); atomicAdd(ssmm + r, c); }
                if (m == 3) asm volatile("" ::: "memory"); }
        asm volatile("s_waitcnt vmcnt(0)" ::: "memory");
        unsigned* cw = cnt + 64 * u.pm;
        if ((tid & 63) == 0) __hip_atomic_fetch_add(cw, 1u, __ATOMIC_RELAXED, __HIP_MEMORY_SCOPE_AGENT);
        if (tid < 64) { unsigned sp = 0;
            while ((unsigned)__builtin_amdgcn_readfirstlane(__hip_atomic_load(cw, __ATOMIC_RELAXED, __HIP_MEMORY_SCOPE_AGENT)) < 32u) { __builtin_amdgcn_s_sleep(1); if (++sp > (1u << 22)) break; } }
        asm volatile("s_waitcnt vmcnt(0) lgkmcnt(0)" ::: "memory"); __builtin_amdgcn_s_barrier(); asm volatile("" ::: "memory");
        const float inv_n = 1.0f / (float)ld; float rs1[2][4], rs2[2][4];
#pragma unroll
        for (int ai = 0; ai < 2; ++ai)
#pragma unroll
            for (int m = 0; m < 4; ++m) { const int r = row0 + ai * HALF + m * 16;
                const float S1 = __hip_atomic_load(ss1 + r, __ATOMIC_RELAXED, __HIP_MEMORY_SCOPE_AGENT), Sxm = __hip_atomic_load(ssxm + r, __ATOMIC_RELAXED, __HIP_MEMORY_SCOPE_AGENT), Smm = __hip_atomic_load(ssmm + r, __ATOMIC_RELAXED, __HIP_MEMORY_SCOPE_AGENT);
                const float r1 = __builtin_amdgcn_rsqf(S1 * inv_n + 1e-6f); rs1[ai][m] = r1;
                const float s2 = sxx[r] + 2.0f * r1 * Sxm + r1 * r1 * Smm; rs2[ai][m] = __builtin_amdgcn_rsqf(s2 * inv_n + 1e-6f); }
        if (VAR != 0) { if (rs1[0][0] + rs2[1][3] + rs1[1][2] + rs2[0][1] == 1.2345e33f) x1[row0] = rs1[0][1]; return; }
#pragma unroll
        for (int ai = 0; ai < 2; ++ai)
#pragma unroll
            for (int m = 0; m < 4; ++m) { const size_t gb = pbase + (size_t)(ai * HALF + m * 16) * ld; const char* xb = (const char*)(x + gb); char* ob = (char*)(x1 + gb); char* nb = (char*)(xn + gb);
#pragma unroll
                for (int bj = 0; bj < 2; ++bj)
#pragma unroll
                    for (int n = 0; n < 2; ++n) { const unsigned o = voff + (unsigned)(bj * HALF + n * 16) * 4u; const f32x4 xv = *(const f32x4*)(xb + o);
                        const f32x4 v = xv + acc[ai][bj][m][n] * rs1[ai][m] * *(const PG8_LAS f32x4*)(As + bj * HALF + n * 16);
                        *(f32x4*)(ob + o) = v;
                        const f32x4 a2 = *(const PG8_LAS f32x4*)(As + 256 + bj * HALF + n * 16), a3 = *(const PG8_LAS f32x4*)(As + 512 + bj * HALF + n * 16); const f32x4 h = v * rs2[ai][m] * a2 + a3;
                        u32x2 wv; wv.x = cvt_pk_bf16(h[0], h[1]); wv.y = cvt_pk_bf16(h[2], h[3]); *(u32x2*)(nb + (o >> 1)) = wv; }
                if (m == 3) asm volatile("" ::: "memory"); }
    }
};
struct EpiFinal {
    static constexpr bool PERM = false, AFTER_DRAIN = false, PERMA = false, HAS_PRE = false;
    const bf16_t* src; float* out; const float* mod; const float* post_g; RowStat st; int ld, tiles_per_batch;
    __device__ __forceinline__ void operator()(f32x4 (&acc)[2][2][4][2], const Unit& u, int wr, int wc, int fr, int fq) const {
        const int col0 = u.pn * BM + wc * 32 + 4 * fq; const float* mb = mod + (size_t)(u.pm / tiles_per_batch) * (6 * ld);
        const unsigned voff = (unsigned)((wr * 64 + fr) * ld + col0) * 4u, cvo = (unsigned)col0 * 4u; const size_t pbase = (size_t)u.pm * BM * ld;
        float part[2][4], rs[2][4];
#pragma unroll
        for (int ai = 0; ai < 2; ++ai)
#pragma unroll
            for (int m = 0; m < 4; ++m) { float s = 0.f;
#pragma unroll
                for (int bj = 0; bj < 2; ++bj)
#pragma unroll
                    for (int n = 0; n < 2; ++n) { const f32x4 v = acc[ai][bj][m][n]; s += (v[0] * v[0] + v[1] * v[1]) + (v[2] * v[2] + v[3] * v[3]); }
                part[ai][m] = s; }
        u32x2 xpre[2][4][2][2];
#pragma unroll
        for (int ai = 0; ai < 2; ++ai)
#pragma unroll
            for (int m = 0; m < 4; ++m) { const char* sb = (const char*)(src + pbase + (size_t)(ai * HALF + m * 16) * ld);
#pragma unroll
                for (int bj = 0; bj < 2; ++bj)
#pragma unroll
                    for (int n = 0; n < 2; ++n) xpre[ai][m][bj][n] = *(const u32x2*)(sb + ((voff + (unsigned)(bj * HALF + n * 16) * 4u) >> 1)); }
        st.run(part, rs, u, wr, fr, fq);
        f32x4 A1[2][2];
#pragma unroll
        for (int bj = 0; bj < 2; ++bj)
#pragma unroll
            for (int n = 0; n < 2; ++n) { const unsigned co = cvo + (unsigned)(bj * HALF + n * 16) * 4u; A1[bj][n] = *(const f32x4*)((const char*)(mb + 5 * ld) + co) * *(const f32x4*)((const char*)post_g + co); }
#pragma unroll
        for (int ai = 0; ai < 2; ++ai)
#pragma unroll
            for (int m = 0; m < 4; ++m) { char* ob = (char*)(out + pbase + (size_t)(ai * HALF + m * 16) * ld);
#pragma unroll
                for (int bj = 0; bj < 2; ++bj)
#pragma unroll
                    for (int n = 0; n < 2; ++n) { const unsigned o = voff + (unsigned)(bj * HALF + n * 16) * 4u; const u32x2 xw = xpre[ai][m][bj][n];
                        const f32x4 xv = {__builtin_bit_cast(float, xw.x << 16), __builtin_bit_cast(float, xw.x & 0xffff0000u), __builtin_bit_cast(float, xw.y << 16), __builtin_bit_cast(float, xw.y & 0xffff0000u)};
                        *(f32x4*)(ob + o) = xv + acc[ai][bj][m][n] * rs[ai][m] * A1[bj][n]; }
                if (m == 3) asm volatile("" ::: "memory"); }
    }
};

struct EpiSink {
    static constexpr bool PERM = false, AFTER_DRAIN = false, PERMA = false, HAS_PRE = false;
    float* O;
    __device__ __forceinline__ void operator()(f32x4 (&acc)[2][2][4][2], const Unit& u, int wr, int wc, int fr, int fq) const {
        f32x4 s = {0.f, 0.f, 0.f, 0.f};
#pragma unroll
        for (int ai = 0; ai < 2; ++ai)
#pragma unroll
            for (int bj = 0; bj < 2; ++bj)
#pragma unroll
                for (int m = 0; m < 4; ++m)
#pragma unroll
                    for (int n = 0; n < 2; ++n) s += acc[ai][bj][m][n];
        if (s[0] + s[1] + s[2] + s[3] == 1.2345e33f) O[u.pm * 256 + wr * 64 + fr + wc + fq] = s[0];
    }
};
template <class Epi, class Sched, bool ALIGN_EPI = false, bool SP2 = false>
__device__ __forceinline__ void gemm_phase(PG8_LAS unsigned char* lds, const Gemm g, const Sched& S, const Epi& E) {
    const int tid = threadIdx.x, wid = __builtin_amdgcn_readfirstlane(tid >> 6), lane = tid & 63, wr = wid >> 2, wc = wid & 3, fr = lane & 15, fq = lane >> 4;
    const int K = g.K, nt = K / BK;
    unsigned voffA[2], voffB[2];
#pragma unroll
    for (int i = 0; i < 2; ++i) { int R, C; stage_rc(tid * 16 + i * 8192, R, C); const int Rb = Epi::PERM ? ((R & ~31) + perm32(R & 31)) : R;
        const int Ra = Epi::PERMA ? ((R & ~63) + 4 * (R & 15) + ((R & 63) >> 4)) : R;
        voffA[i] = (unsigned)(Ra * K + C) * 2u; voffB[i] = (unsigned)(Rb * K + C) * 2u; }
    const size_t kstep = (size_t)(BK * 2);
    const size_t hstep = (size_t)HALF * K * 2;
    const size_t tstep = 2 * hstep;
    const unsigned ldsw = (unsigned)wid * 1024u;
    const int aoff = lds_byte(wr * 64 + fr, fq * 8), boff = lds_byte(wc * 32 + fr, fq * 8);
#define PG8_SA(b, h) (((b) * 2 + (h)) * HTB)
#define PG8_SB(b, h) ((4 + (b) * 2 + (h)) * HTB)
#define PG8_STAGE(bufoff, gbase, voff) do { _Pragma("unroll") for (int _i = 0; _i < 2; ++_i) \
        __builtin_amdgcn_global_load_lds((const unsigned*)((const char*)(gbase) + (voff)[_i]), (PG8_LAS unsigned*)(lds + (bufoff) + ldsw + _i * 8192), 16, 0, 0); } while (0)
#define PG8_LDA(dst, b, h) do { _Pragma("unroll") for (int m = 0; m < 4; ++m) _Pragma("unroll") for (int k = 0; k < 2; ++k) dst[m][k] = *(const PG8_LAS bf16x8*)(lds + PG8_SA(b, h) + aoff + m * 2048 + k * 1024); } while (0)
#define PG8_LDB(dst, b, h) do { _Pragma("unroll") for (int n = 0; n < 2; ++n) _Pragma("unroll") for (int k = 0; k < 2; ++k) dst[n][k] = *(const PG8_LAS bf16x8*)(lds + PG8_SB(b, h) + boff + n * 2048 + k * 1024); } while (0)
#define PG8_MMA(ai, bj, At, Bt) do { __builtin_amdgcn_s_setprio(1); _Pragma("unroll") for (int m = 0; m < 4; ++m) _Pragma("unroll") for (int n = 0; n < 2; ++n) _Pragma("unroll") for (int k = 0; k < 2; ++k) \
        acc[ai][bj][m][n] = __builtin_amdgcn_mfma_f32_16x16x32_bf16(Bt[n][k], At[m][k], acc[ai][bj][m][n], 0, 0, 0); __builtin_amdgcn_s_setprio(0); } while (0)
#define PG8_WAIT_V(n) asm volatile("s_waitcnt vmcnt(" #n ")" ::: "memory")
#define PG8_WAIT_L(n) asm volatile("s_waitcnt lgkmcnt(" #n ")" ::: "memory")
#define PG8_BAR __builtin_amdgcn_s_barrier()
#define PG8_SCHED __builtin_amdgcn_sched_barrier(0)
    Unit cur, nxt; int ui = 0;
    if (!S.next(0, cur)) return;
    f32x4 acc[2][2][4][2];
#pragma unroll
    for (int a = 0; a < 2; ++a)
#pragma unroll
        for (int b = 0; b < 2; ++b)
#pragma unroll
            for (int m = 0; m < 4; ++m)
#pragma unroll
                for (int n = 0; n < 2; ++n) acc[a][b][m][n] = (f32x4){0.f, 0.f, 0.f, 0.f};
    bf16x8 At[4][2], B0[2][2], B1[2][2];
    const char* cA = (const char*)g.A + (size_t)cur.pm * tstep; const char* cB = (const char*)g.Bt + (size_t)cur.pn * tstep;
    S.a_ready(cur);
    if constexpr (Epi::HAS_PRE) E.pre(cur, 0);
    if constexpr (SP2) {
        PG8_STAGE(PG8_SB(0, 0), cB, voffB); PG8_STAGE(PG8_SB(0, 1), cB + hstep, voffB); PG8_STAGE(PG8_SA(0, 0), cA, voffA); PG8_STAGE(PG8_SA(0, 1), cA + hstep, voffA);
        if (wr == 1) PG8_BAR;
        PG8_WAIT_V(2); PG8_BAR;
        PG8_STAGE(PG8_SB(1, 0), cB + kstep, voffB); PG8_STAGE(PG8_SA(1, 0), cA + kstep, voffA); PG8_STAGE(PG8_SB(1, 1), cB + hstep + kstep, voffB);
        PG8_WAIT_V(6); PG8_BAR;
    } else {
        PG8_STAGE(PG8_SB(0, 0), cB, voffB); PG8_STAGE(PG8_SA(0, 0), cA, voffA); PG8_STAGE(PG8_SB(0, 1), cB + hstep, voffB); PG8_STAGE(PG8_SA(0, 1), cA + hstep, voffA);
        if (wr == 1) PG8_BAR;
        PG8_WAIT_V(4); PG8_BAR;
        PG8_STAGE(PG8_SB(1, 0), cB + kstep, voffB); PG8_STAGE(PG8_SA(1, 0), cA + kstep, voffA); PG8_STAGE(PG8_SB(1, 1), cB + hstep + kstep, voffB);
        PG8_WAIT_V(6); PG8_BAR;
    }
    for (;;) {
        const bool has_next = S.next(ui + 1, nxt);
        const char* nA = has_next ? (const char*)g.A + (size_t)nxt.pm * tstep : cA; const char* nB = has_next ? (const char*)g.Bt + (size_t)nxt.pn * tstep : cB;
        for (int t = 0; t < nt; t += 2) {
            const bool last = (t == nt - 2);
            const char* a1 = cA + (size_t)(t + 1) * kstep;
            const char* a2 = last ? nA : cA + (size_t)(t + 2) * kstep; const char* b2 = last ? nB : cB + (size_t)(t + 2) * kstep;
            const char* a3 = a2 + kstep; const char* b3 = b2 + kstep;
            if (last && has_next) S.a_ready(nxt);
            if constexpr (SP2) {
            PG8_LDB(B0, 0, 0); PG8_LDB(B1, 0, 1); PG8_SCHED; PG8_LDA(At, 0, 0); PG8_STAGE(PG8_SA(1, 1), a1 + hstep, voffA);
            PG8_WAIT_V(8); PG8_WAIT_L(0); PG8_BAR; PG8_MMA(0, 0, At, B0); PG8_MMA(0, 1, At, B1); PG8_BAR; PG8_SCHED;
            PG8_LDA(At, 0, 1); PG8_STAGE(PG8_SB(0, 0), b2, voffB); PG8_STAGE(PG8_SB(0, 1), b2 + hstep, voffB); PG8_STAGE(PG8_SA(0, 0), a2, voffA);
            PG8_WAIT_V(8); PG8_WAIT_L(0); PG8_BAR; PG8_MMA(1, 0, At, B0); PG8_MMA(1, 1, At, B1); PG8_BAR; PG8_SCHED;
            PG8_LDB(B0, 1, 0); PG8_LDB(B1, 1, 1); PG8_SCHED; PG8_LDA(At, 1, 0); PG8_STAGE(PG8_SA(0, 1), a2 + hstep, voffA);
            PG8_WAIT_V(8); PG8_WAIT_L(0); PG8_BAR; PG8_MMA(0, 0, At, B0); PG8_MMA(0, 1, At, B1); PG8_BAR; PG8_SCHED;
            PG8_LDA(At, 1, 1); PG8_STAGE(PG8_SB(1, 0), b3, voffB); PG8_STAGE(PG8_SB(1, 1), b3 + hstep, voffB); PG8_STAGE(PG8_SA(1, 0), a3, voffA);
            PG8_WAIT_V(8); PG8_WAIT_L(0); PG8_BAR; PG8_MMA(1, 0, At, B0); PG8_MMA(1, 1, At, B1); PG8_BAR; PG8_SCHED;
            } else {
            PG8_LDB(B0, 0, 0); PG8_SCHED; PG8_LDA(At, 0, 0); PG8_STAGE(PG8_SA(1, 1), a1 + hstep, voffA);
            PG8_WAIT_L(8); PG8_BAR; PG8_WAIT_L(0); PG8_MMA(0, 0, At, B0); PG8_BAR; PG8_SCHED;
            PG8_LDB(B1, 0, 1); PG8_STAGE(PG8_SB(0, 0), b2, voffB);
            PG8_BAR; PG8_WAIT_L(0); PG8_MMA(0, 1, At, B1); PG8_BAR;
            PG8_LDA(At, 0, 1); PG8_STAGE(PG8_SA(0, 0), a2, voffA);
            PG8_BAR; PG8_WAIT_L(0); PG8_MMA(1, 0, At, B0); PG8_BAR; PG8_SCHED;
            PG8_STAGE(PG8_SB(0, 1), b2 + hstep, voffB);
            PG8_WAIT_V(6); PG8_BAR; PG8_MMA(1, 1, At, B1); PG8_BAR;
            PG8_LDB(B0, 1, 0); PG8_SCHED; PG8_LDA(At, 1, 0); PG8_STAGE(PG8_SA(0, 1), a2 + hstep, voffA);
            PG8_WAIT_L(8); PG8_BAR; PG8_WAIT_L(0); PG8_MMA(0, 0, At, B0); PG8_BAR; PG8_SCHED;
            PG8_LDB(B1, 1, 1); PG8_STAGE(PG8_SB(1, 0), b3, voffB);
            PG8_BAR; PG8_WAIT_L(0); PG8_MMA(0, 1, At, B1); PG8_BAR;
            PG8_LDA(At, 1, 1); PG8_STAGE(PG8_SA(1, 0), a3, voffA);
            PG8_BAR; PG8_WAIT_L(0); PG8_MMA(1, 0, At, B0); PG8_BAR; PG8_SCHED;
            PG8_STAGE(PG8_SB(1, 1), b3 + hstep, voffB);
            PG8_WAIT_V(6); PG8_BAR; PG8_MMA(1, 1, At, B1); PG8_BAR;
            }
        }
        if constexpr (ALIGN_EPI) { if (wr == 0) PG8_BAR; }
        if constexpr (Epi::HAS_PRE) { if (has_next) E.pre(nxt, (ui + 1) & 1); E.run(acc, cur, wr, wc, fr, fq, ui & 1); S.done(cur); }
        else if constexpr (!Epi::AFTER_DRAIN) { E(acc, cur, wr, wc, fr, fq); S.done(cur); }
        if (!has_next) break;
#pragma unroll
        for (int a = 0; a < 2; ++a)
#pragma unroll
            for (int b = 0; b < 2; ++b)
#pragma unroll
                for (int m = 0; m < 4; ++m)
#pragma unroll
                    for (int n = 0; n < 2; ++n) acc[a][b][m][n] = (f32x4){0.f, 0.f, 0.f, 0.f};
        cur = nxt; cA = nA; cB = nB; ++ui;
        if constexpr (ALIGN_EPI) { if (wr == 1) PG8_BAR; }
    }
    PG8_WAIT_V(0);
    if constexpr (!ALIGN_EPI) { if (wr == 0) PG8_BAR; }
    PG8_BAR;
    if constexpr (Epi::AFTER_DRAIN) { E.fused(acc, cur, wr, wc, fr, fq, lds, wid, lane); S.done(cur); }
#undef PG8_SA
#undef PG8_SB
#undef PG8_STAGE
#undef PG8_LDA
#undef PG8_LDB
#undef PG8_MMA
#undef PG8_WAIT_V
#undef PG8_WAIT_L
#undef PG8_BAR
#undef PG8_SCHED
}
}
constexpr int NWAVES = 8;
constexpr int BATCH = 4, SEQ = 8192, D = 1024, M = BATCH * SEQ;
constexpr int INW = 1536, AW = 512, FF = 2816, FF2 = 2 * FF, NMOD = 6 * D;
constexpr float EPS = 1e-6f;
constexpr size_t MiB = 1u << 20;
constexpr size_t WS_CTL = 0, CTL_ZERO_BYTES = 1 * MiB;
constexpr size_t OFF_MOD = 0, OFF_SS1 = 128 * 1024, OFF_SS2 = 256 * 1024, OFF_SS3 = 384 * 1024, OFF_BAR = 512 * 1024, OFF_CNT = 544 * 1024, OFF_SS4 = 896 * 1024;
constexpr size_t WS_WIN = 1 * MiB, WS_WOUT = 4 * MiB, WS_WUP = 6 * MiB, WS_WDOWN = 17 * MiB, WS_WSP = 23 * MiB, WS_WPOOL = WS_WSP + 256 * 1024;
constexpr size_t WS_SXX = 23 * MiB + 512 * 1024;
constexpr size_t WS_XN = 24 * MiB;
constexpr size_t WS_PROJ = 88 * MiB;
constexpr size_t WS_MIXIN = 184 * MiB;
constexpr size_t WS_MIXED = 248 * MiB;
constexpr size_t WS_ACT = 88 * MiB;
constexpr size_t WS_RAW = 264 * MiB;
constexpr size_t WS_F = 308 * MiB;
constexpr size_t WS_X1B = 372 * MiB;
constexpr size_t WS_END = 436 * MiB;
static_assert(WS_ACT + (size_t)M * FF * 2 <= WS_RAW && WS_RAW + (size_t)(M / 64) * 4 * FF2 * 4 <= WS_F && WS_F + (size_t)M * D * 4 <= WS_END, "d_ws map");
static_assert(WS_WUP + (size_t)FF2 * D * 2 <= WS_WDOWN && WS_WDOWN + (size_t)D * FF * 2 <= WS_WSP && WS_WPOOL + 4 * 128 * 128 * 2 <= WS_XN, "d_ws weights");
constexpr int RING_BYTES = 131072, LDSCTL_OFF = RING_BYTES, LDS_BYTES = 147456;

#define GAS __attribute__((address_space(1)))
#define LAS __attribute__((address_space(3)))
typedef unsigned short bf16;
typedef unsigned v4u __attribute__((ext_vector_type(4)));
typedef unsigned v2u __attribute__((ext_vector_type(2)));
typedef float f32x4 __attribute__((ext_vector_type(4)));
typedef short bf16x8 __attribute__((ext_vector_type(8)));
#define LDS_WAIT() asm volatile("s_waitcnt lgkmcnt(0)" ::: "memory")
__device__ __forceinline__ unsigned f2bf(float f) { unsigned u = __builtin_bit_cast(unsigned, f); return (u + 0x7fffu + ((u >> 16) & 1u)) >> 16; }
__device__ __forceinline__ unsigned pk2(float lo, float hi) { unsigned r; asm("v_cvt_pk_bf16_f32 %0, %1, %2" : "=v"(r) : "v"(lo), "v"(hi)); return r; }
__device__ __forceinline__ float bf_lo(unsigned w) { return __builtin_bit_cast(float, w << 16); }
__device__ __forceinline__ float bf_hi(unsigned w) { return __builtin_bit_cast(float, w & 0xffff0000u); }
__device__ __forceinline__ float wave_sum(float v) {
#pragma unroll
    for (int o = 1; o < 64; o <<= 1) v += __shfl_xor(v, o);
    return v;
}
__device__ __forceinline__ float silu_acc(float x) { return x / (1.0f + __expf(-x)); }

struct Args { const float* in[19]; float* out; unsigned char* ws; int ph_lo, ph_hi; };
enum { I_X = 0, I_C, I_WADA, I_BADA, I_PREMIXG, I_POSTMIXG, I_WIN, I_SGUG, I_WSP, I_BSP, I_WPOOL, I_PSCALE, I_WOUT, I_PREFFNG, I_POSTFFNG, I_WUP, I_CONVW, I_CONVB, I_WDOWN };

__device__ __forceinline__ void transpose_item(const float* W, int K, int N, bf16* WT, int k0, int n0, int drow0, LAS float* scr, int lane) {
#pragma unroll 8
    for (int i = 0; i < 32; ++i) { const int kk = 2 * i + (lane >> 5); scr[kk * 33 + (lane & 31)] = __builtin_nontemporal_load(W + (size_t)(k0 + kk) * N + n0 + (lane & 31)); }
    LDS_WAIT(); asm volatile("" ::: "memory");
    const int c = lane & 7;
#pragma unroll
    for (int j = 0; j < 4; ++j) { const int n = (lane >> 3) + 8 * j; const LAS float* s = scr + (8 * c) * 33 + n;
        v4u o; o.x = pk2(s[0 * 33], s[1 * 33]); o.y = pk2(s[2 * 33], s[3 * 33]); o.z = pk2(s[4 * 33], s[5 * 33]); o.w = pk2(s[6 * 33], s[7 * 33]);
        *(v4u*)(WT + (size_t)(drow0 + n) * K + k0 + 8 * c) = o; }
    LDS_WAIT(); asm volatile("" ::: "memory");
}

__device__ __forceinline__ void p0_prologue(const Args& a, LAS unsigned char* lds, int gw, int NGW, int lane, int wave, bool with_mod, bool with_rest) {
    unsigned char* ws = a.ws;
    float* MOD = (float*)(ws + OFF_MOD);
    const float* c = a.in[I_C]; const float* wada = a.in[I_WADA]; const float* bada = a.in[I_BADA];
    for (int it = with_mod ? gw : 96 * 16; it < 96 * 16; it += NGW) { const int cb = it % 96, ks = it / 96, col = cb * 64 + lane; float a0 = 0.f, a1 = 0.f, a2 = 0.f, a3 = 0.f;
        const float sv0 = silu_acc(c[ks * 64 + lane]), sv1 = silu_acc(c[D + ks * 64 + lane]), sv2 = silu_acc(c[2 * D + ks * 64 + lane]), sv3 = silu_acc(c[3 * D + ks * 64 + lane]);
#pragma unroll 32
        for (int kk = 0; kk < 64; ++kk) { const float w = __builtin_nontemporal_load(wada + (size_t)(ks * 64 + kk) * NMOD + col);
            a0 += __builtin_bit_cast(float, __builtin_amdgcn_readlane(__builtin_bit_cast(int, sv0), kk)) * w; a1 += __builtin_bit_cast(float, __builtin_amdgcn_readlane(__builtin_bit_cast(int, sv1), kk)) * w;
            a2 += __builtin_bit_cast(float, __builtin_amdgcn_readlane(__builtin_bit_cast(int, sv2), kk)) * w; a3 += __builtin_bit_cast(float, __builtin_amdgcn_readlane(__builtin_bit_cast(int, sv3), kk)) * w; }
        if (ks == 0) { const float b = bada[col]; a0 += b; a1 += b; a2 += b; a3 += b; }
        atomicAdd(MOD + col, a0); atomicAdd(MOD + NMOD + col, a1); atomicAdd(MOD + 2 * NMOD + col, a2); atomicAdd(MOD + 3 * NMOD + col, a3); }
    if (!with_rest) return;
    LAS float* scr = (LAS float*)(lds + wave * 16384);
    constexpr int I_IN = (D / 64) * (INW / 32), I_OUT = (D / 64) * (D / 32), I_UP = (D / 64) * (FF2 / 32), I_DOWN = (FF / 64) * (D / 32), I_POOL = 4 * 2 * 4;
    constexpr int NITEMS = I_IN + I_OUT + I_UP + I_DOWN + I_POOL;
    for (int it = gw; it < NITEMS; it += NGW) { int r = it;
        if (r < I_IN) { const int nb = INW / 32, kb = r / nb, n0 = 32 * (r % nb); transpose_item(a.in[I_WIN], D, INW, (bf16*)(ws + WS_WIN), 64 * kb, n0, n0, scr, lane); continue; } r -= I_IN;
        if (r < I_OUT) { const int nb = D / 32, kb = r / nb, n0 = 32 * (r % nb); transpose_item(a.in[I_WOUT], D, D, (bf16*)(ws + WS_WOUT), 64 * kb, n0, n0, scr, lane); continue; } r -= I_OUT;
        if (r < I_UP) { const int nb = FF2 / 32, kb = r / nb, n0 = 32 * (r % nb); const int half = n0 / FF, f = n0 % FF, drow = 256 * (f / 128) + 128 * half + (f % 128);
            transpose_item(a.in[I_WUP], D, FF2, (bf16*)(ws + WS_WUP), 64 * kb, n0, drow, scr, lane); continue; } r -= I_UP;
        if (r < I_DOWN) { const int nb = D / 32, kb = r / nb, n0 = 32 * (r % nb); transpose_item(a.in[I_WDOWN], FF, D, (bf16*)(ws + WS_WDOWN), 64 * kb, n0, n0, scr, lane); continue; } r -= I_DOWN;
        { const int g = r / 8, q = r % 8, kb = q / 4, n0 = 32 * (q % 4); transpose_item(a.in[I_WPOOL] + (size_t)g * 16384, 128, 128, (bf16*)(ws + WS_WPOOL) + (size_t)g * 16384, 64 * kb, n0, n0, scr, lane); } }
    { const float* wsp = a.in[I_WSP]; bf16* o = (bf16*)(ws + WS_WSP);
        for (int e = gw * 64 + lane; e < 4 * 128 * 128; e += NGW * 64) { const int i = (e >> 7) & 127, j = e & 127; const float v = ((j >> 6) <= (i >> 6)) ? wsp[e] : 0.f; o[e] = (bf16)f2bf(v); } }
}

__device__ __forceinline__ void p1_norm(const Args& a, int gw, int NGW, int lane) {
    const float* MOD = (const float*)(a.ws + OFF_MOD); bf16* XN = (bf16*)(a.ws + WS_XN); const float* x = a.in[I_X]; const float* g = a.in[I_PREMIXG]; float* SXX = (float*)(a.ws + WS_SXX);
    const int rpw = M / NGW;
    for (int r0 = gw * rpw; r0 < M; r0 += NGW * rpw) { const int b = r0 / SEQ; const float* mb = MOD + (size_t)b * NMOD;
        f32x4 A[4], B[4];
#pragma unroll
        for (int j = 0; j < 4; ++j) { const int col = 4 * lane + 256 * j; const f32x4 gg = *(const f32x4*)(g + col), sc = *(const f32x4*)(mb + D + col); A[j] = gg * (1.0f + sc); B[j] = *(const f32x4*)(mb + col); }
        f32x4 nx[4];
        { const f32x4* xr = (const f32x4*)(x + (size_t)r0 * D) + lane;
#pragma unroll
            for (int j = 0; j < 4; ++j) nx[j] = __builtin_nontemporal_load(xr + 64 * j); }
        for (int r = r0; r < r0 + rpw; ++r) { f32x4 v[4]; float s = 0.f;
#pragma unroll
            for (int j = 0; j < 4; ++j) { v[j] = nx[j]; s += (v[j].x * v[j].x + v[j].y * v[j].y) + (v[j].z * v[j].z + v[j].w * v[j].w); }
            if (r + 1 < r0 + rpw) { const f32x4* xr = (const f32x4*)(x + (size_t)(r + 1) * D) + lane;
#pragma unroll
                for (int j = 0; j < 4; ++j) nx[j] = __builtin_nontemporal_load(xr + 64 * j); }
            const float st = wave_sum(s);
            const float rs = 1.0f / sqrtf(st * (1.0f / D) + EPS);
            v2u* o = (v2u*)(XN + (size_t)r * D) + lane;
#pragma unroll
            for (int j = 0; j < 4; ++j) { const f32x4 h = v[j] * rs * A[j] + B[j]; const unsigned long long w = (unsigned long long)pk2(h.x, h.y) | ((unsigned long long)pk2(h.z, h.w) << 32);
                __hip_atomic_store((unsigned long long*)(o + 64 * j), w, __ATOMIC_RELAXED, __HIP_MEMORY_SCOPE_AGENT); } } }
}

constexpr int P3_RA = 0, P3_RB = 34816, P3_RP = 69632, P3_RC = 108800, P3_PA = 272, P3_PV = 264;
__device__ __forceinline__ void p3_mma(LAS unsigned char* lds, bool natural_b, f32x4 (&acc)[4][2], int wr, int wc, int fr, int fq) {
#pragma unroll
    for (int m = 0; m < 4; ++m)
#pragma unroll
        for (int n = 0; n < 2; ++n) acc[m][n] = (f32x4){0.f, 0.f, 0.f, 0.f};
#pragma unroll
    for (int kk = 0; kk < 4; ++kk) { bf16x8 af[4], bfr[2];
#pragma unroll
        for (int m = 0; m < 4; ++m) af[m] = *(const LAS bf16x8*)(lds + P3_RA + (64 * wr + 16 * m + fr) * P3_PA + (32 * kk + 8 * fq) * 2);
        if (natural_b) {
            { const unsigned addr = (unsigned)(size_t)(lds + P3_RB) + (unsigned)((32 * kk + 8 * fq + (fr >> 2)) * P3_PV + (32 * wc + 4 * (fr & 3)) * 2);
                v2u l0, h0, l1, h1;
                asm volatile("ds_read_b64_tr_b16 %0, %4\n\tds_read_b64_tr_b16 %1, %4 offset:%5\n\tds_read_b64_tr_b16 %2, %4 offset:32\n\tds_read_b64_tr_b16 %3, %4 offset:%6\n\ts_waitcnt lgkmcnt(0)"
                             : "=&v"(l0), "=&v"(h0), "=&v"(l1), "=&v"(h1) : "v"(addr), "n"(4 * P3_PV), "n"(4 * P3_PV + 32) : "memory");
                v4u w0, w1; w0.x = l0.x; w0.y = l0.y; w0.z = h0.x; w0.w = h0.y; w1.x = l1.x; w1.y = l1.y; w1.z = h1.x; w1.w = h1.y;
                bfr[0] = __builtin_bit_cast(bf16x8, w0); bfr[1] = __builtin_bit_cast(bf16x8, w1); }
        } else {
#pragma unroll
            for (int n = 0; n < 2; ++n) bfr[n] = *(const LAS bf16x8*)(lds + P3_RB + (32 * wc + 16 * n + fr) * P3_PA + (32 * kk + 8 * fq) * 2);
        }
#pragma unroll
        for (int m = 0; m < 4; ++m)
#pragma unroll
            for (int n = 0; n < 2; ++n) acc[m][n] = __builtin_amdgcn_mfma_f32_16x16x32_bf16(bfr[n], af[m], acc[m][n], 0, 0, 0); }
}
template <int W> __device__ __forceinline__ void p3_pool(LAS unsigned char* lds, int tid, int s0) {
    const int ch = tid & 15, tq = 4 * (tid >> 4); const LAS unsigned char* rp = lds + P3_RP + ch * 16; float sum[8];
#pragma unroll
    for (int e = 0; e < 8; ++e) sum[e] = 0.f;
#pragma unroll 3
    for (int k = 1; k < W; ++k) { const v4u r = *(const LAS v4u*)(rp + (16 + tq - k) * P3_PA);
        sum[0] += bf_lo(r.x); sum[1] += bf_hi(r.x); sum[2] += bf_lo(r.y); sum[3] += bf_hi(r.y); sum[4] += bf_lo(r.z); sum[5] += bf_hi(r.z); sum[6] += bf_lo(r.w); sum[7] += bf_hi(r.w); }
#pragma unroll
    for (int rr = 0; rr < 4; ++rr) { const int t = tq + rr; const v4u cur = *(const LAS v4u*)(rp + (16 + t) * P3_PA);
        sum[0] += bf_lo(cur.x); sum[1] += bf_hi(cur.x); sum[2] += bf_lo(cur.y); sum[3] += bf_hi(cur.y); sum[4] += bf_lo(cur.z); sum[5] += bf_hi(cur.z); sum[6] += bf_lo(cur.w); sum[7] += bf_hi(cur.w);
        const int cnt = (s0 + t + 1) < W ? (s0 + t + 1) : W; const float inv = 1.0f / (float)cnt;
        v4u o; o.x = pk2(sum[0] * inv - bf_lo(cur.x), sum[1] * inv - bf_hi(cur.x)); o.y = pk2(sum[2] * inv - bf_lo(cur.y), sum[3] * inv - bf_hi(cur.y));
        o.z = pk2(sum[4] * inv - bf_lo(cur.z), sum[5] * inv - bf_hi(cur.z)); o.w = pk2(sum[6] * inv - bf_lo(cur.w), sum[7] * inv - bf_hi(cur.w));
        *(LAS v4u*)(lds + P3_RA + t * P3_PA + ch * 16) = o;
        if (rr < 3) { const v4u old = *(const LAS v4u*)(rp + (16 + t - (W - 1)) * P3_PA);
            sum[0] -= bf_lo(old.x); sum[1] -= bf_hi(old.x); sum[2] -= bf_lo(old.y); sum[3] -= bf_hi(old.y); sum[4] -= bf_lo(old.z); sum[5] -= bf_hi(old.z); sum[6] -= bf_lo(old.w); sum[7] -= bf_hi(old.w); } }
}
struct P3Regs { v4u a0, a1, a2, a3, b0, b1, b2, b3, b4; };
#define P3_RA_(R, it) ((it) == 0 ? (R).a0 : (it) == 1 ? (R).a1 : (it) == 2 ? (R).a2 : (R).a3)
#define P3_RB_(R, it) ((it) == 0 ? (R).b0 : (it) == 1 ? (R).b1 : (it) == 2 ? (R).b2 : (it) == 3 ? (R).b3 : (R).b4)
__device__ __forceinline__ void p3_prefetch(P3Regs& R, int item, int t0, int s0, int tid, const bf16* PROJ, const bf16* WSP, const bf16* WPOOL) {
    if (item < 4) { const int h = item;
#pragma unroll
        for (int it = 0; it < 4; ++it) { const int idx = tid + 512 * it, row = idx >> 4, ch = idx & 15;
            const v4u va = *(const v4u*)(WSP + (size_t)h * 16384 + row * 128 + ch * 8), vb = __builtin_nontemporal_load((const v4u*)(PROJ + (size_t)(t0 + row) * INW + AW + 128 * h + 8 * ch));
            if (it == 0) { R.a0 = va; R.b0 = vb; } else if (it == 1) { R.a1 = va; R.b1 = vb; } else if (it == 2) { R.a2 = va; R.b2 = vb; } else { R.a3 = va; R.b3 = vb; } }
    } else { const int g = item - 4;
#pragma unroll
        for (int it = 0; it < 4; ++it) { const int idx = tid + 512 * it, row = idx >> 4, ch = idx & 15; const v4u va = *(const v4u*)(WPOOL + (size_t)g * 16384 + row * 128 + ch * 8);
            if (it == 0) R.a0 = va; else if (it == 1) R.a1 = va; else if (it == 2) R.a2 = va; else R.a3 = va; }
#pragma unroll
        for (int it = 0; it < 5; ++it) { const int idx = tid + 512 * it, row = idx >> 4, ch = idx & 15; v4u raw = {0u, 0u, 0u, 0u};
            if (row < 144 && s0 + row >= 16) raw = __builtin_nontemporal_load((const v4u*)(PROJ + (size_t)(t0 + row - 16) * INW + 2 * AW + 128 * g + 8 * ch));
            if (it == 0) R.b0 = raw; else if (it == 1) R.b1 = raw; else if (it == 2) R.b2 = raw; else if (it == 3) R.b3 = raw; else R.b4 = raw; } }
}
__device__ __forceinline__ void p3_item(P3Regs& R, const int item, const int t0, const int s0, const int tid0, LAS unsigned char* lds, const LAS float* RC, const bf16* PROJ, bf16* MIXIN, const bf16* WSP, const bf16* WPOOL,
                                        const int wr, const int wc, const int fr, const int fq) {
    f32x4 acc[4][2];
            int tl = tid0; asm volatile("" : "+v"(tl));
            const int tid = tl;
            if (item < 4) { const int h = item;
#pragma unroll
                for (int it = 0; it < 4; ++it) { const int idx = tid + 512 * it, row = idx >> 4, ch = idx & 15;
                    *(LAS v4u*)(lds + P3_RA + row * P3_PA + ch * 16) = P3_RA_(R, it);
                    const v4u raw = P3_RB_(R, it);
                    float v[8]; v[0] = bf_lo(raw.x); v[1] = bf_hi(raw.x); v[2] = bf_lo(raw.y); v[3] = bf_hi(raw.y); v[4] = bf_lo(raw.z); v[5] = bf_hi(raw.z); v[6] = bf_lo(raw.w); v[7] = bf_hi(raw.w);
                    float s = 0.f;
#pragma unroll
                    for (int e = 0; e < 8; ++e) s += v[e] * v[e];
                    s += __shfl_xor(s, 1); s += __shfl_xor(s, 2); s += __shfl_xor(s, 4); s += __shfl_xor(s, 8);
                    const float rs = __builtin_amdgcn_rsqf(s * (1.0f / 128.0f) + EPS);
                    const f32x4 g0 = *(const LAS f32x4*)(RC + 128 * h + 8 * ch), g1 = *(const LAS f32x4*)(RC + 128 * h + 8 * ch + 4);
                    v2u w0, w1; w0.x = pk2(v[0] * rs * g0.x, v[1] * rs * g0.y); w0.y = pk2(v[2] * rs * g0.z, v[3] * rs * g0.w); w1.x = pk2(v[4] * rs * g1.x, v[5] * rs * g1.y); w1.y = pk2(v[6] * rs * g1.z, v[7] * rs * g1.w);
                    *(LAS v2u*)(lds + P3_RB + row * P3_PV + ch * 16) = w0; *(LAS v2u*)(lds + P3_RB + row * P3_PV + ch * 16 + 8) = w1; }
                __syncthreads();
                if (item + 2 < 8) p3_prefetch(R, item + 2, t0, s0, tid, PROJ, WSP, WPOOL);
                v2u ur[4][2]; float bias[4];
#pragma unroll
                for (int m = 0; m < 4; ++m) { const int i = 64 * wr + 16 * m + fr; bias[m] = RC[512 + 128 * h + i];
#pragma unroll
                    for (int n = 0; n < 2; ++n) ur[m][n] = *(const v2u*)(PROJ + (size_t)(t0 + i) * INW + 128 * h + 32 * wc + 16 * n + 4 * fq); }
                p3_mma(lds, true, acc, wr, wc, fr, fq);
#pragma unroll
                for (int m = 0; m < 4; ++m) { const int i = 64 * wr + 16 * m + fr;
#pragma unroll
                    for (int n = 0; n < 2; ++n) { const int c = 128 * h + 32 * wc + 16 * n + 4 * fq; const v2u u2 = ur[m][n]; const float bi = bias[m];
                        const f32x4 z = acc[m][n]; v2u w; w.x = pk2(bf_lo(u2.x) * (z[0] + bi), bf_hi(u2.x) * (z[1] + bi)); w.y = pk2(bf_lo(u2.y) * (z[2] + bi), bf_hi(u2.y) * (z[3] + bi));
                        *(v2u*)(MIXIN + (size_t)(t0 + i) * D + c) = w; } }
                __syncthreads();
            } else { const int g = item - 4, w = 2 << g;
#pragma unroll
                for (int it = 0; it < 4; ++it) { const int idx = tid + 512 * it, row = idx >> 4, ch = idx & 15; *(LAS v4u*)(lds + P3_RB + row * P3_PA + ch * 16) = P3_RA_(R, it); }
#pragma unroll
                for (int it = 0; it < 5; ++it) { const int idx = tid + 512 * it, row = idx >> 4, ch = idx & 15; if (row < 144) *(LAS v4u*)(lds + P3_RP + row * P3_PA + ch * 16) = P3_RB_(R, it); }
                __syncthreads();
                if (item + 2 < 8) p3_prefetch(R, item + 2, t0, s0, tid, PROJ, WSP, WPOOL);
                switch (g) { case 0: p3_pool<2>(lds, tid, s0); break; case 1: p3_pool<4>(lds, tid, s0); break; case 2: p3_pool<8>(lds, tid, s0); break; default: p3_pool<16>(lds, tid, s0); break; }
                __syncthreads();
                p3_mma(lds, false, acc, wr, wc, fr, fq);
#pragma unroll
                for (int m = 0; m < 4; ++m) { const int t = 64 * wr + 16 * m + fr;
#pragma unroll
                    for (int n = 0; n < 2; ++n) { const int d = 128 * g + 32 * wc + 16 * n + 4 * fq; const f32x4 ps = *(const LAS f32x4*)(RC + 1024 + d); const f32x4 y = acc[m][n] * ps;
                        v2u wv; wv.x = pk2(y[0], y[1]); wv.y = pk2(y[2], y[3]); *(v2u*)(MIXIN + (size_t)(t0 + t) * D + AW + d) = wv; } }
                __syncthreads();
            }
}
__device__ __forceinline__ void p3_mixers(const Args& a, LAS unsigned char* lds, int tid0, int rb) {
    const int lane = tid0 & 63, wave = tid0 >> 6, wr = wave >> 2, wc = wave & 3, fr = lane & 15, fq = lane >> 4;
    const bf16* PROJ = (const bf16*)(a.ws + WS_PROJ); bf16* MIXIN = (bf16*)(a.ws + WS_MIXIN);
    const bf16* WSP = (const bf16*)(a.ws + WS_WSP); const bf16* WPOOL = (const bf16*)(a.ws + WS_WPOOL);
    const float* sgug = a.in[I_SGUG]; const float* bsp = a.in[I_BSP]; const float* pscale = a.in[I_PSCALE];
    { LAS float* rc = (LAS float*)(lds + P3_RC); rc[tid0] = sgug[tid0]; rc[512 + tid0] = bsp[tid0]; rc[1024 + tid0] = pscale[tid0]; }
    __syncthreads();
    const LAS float* RC = (const LAS float*)(lds + P3_RC);
    for (int tb = rb; tb < M / 128; tb += gridDim.x) { const int t0 = tb * 128, s0 = t0 % SEQ;
        P3Regs R;
        p3_prefetch(R, 0, t0, s0, tid0, PROJ, WSP, WPOOL);
        P3Regs Rb;
        p3_prefetch(Rb, 1, t0, s0, tid0, PROJ, WSP, WPOOL);
        for (int it2 = 0; it2 < 4; ++it2) {
            p3_item(R, 2 * it2, t0, s0, tid0, lds, RC, PROJ, MIXIN, WSP, WPOOL, wr, wc, fr, fq);
            p3_item(Rb, 2 * it2 + 1, t0, s0, tid0, lds, RC, PROJ, MIXIN, WSP, WPOOL, wr, wc, fr, fq); } }
}

__device__ __forceinline__ void p4b_mid(const Args& a, int gw, int NGW, int lane) {
    const float* MOD = (const float*)(a.ws + OFF_MOD); const float* SS1 = (const float*)(a.ws + OFF_SS1); const bf16* MIXED = (const bf16*)(a.ws + WS_MIXED); bf16* XN = (bf16*)(a.ws + WS_XN);
    const float* x = a.in[I_X]; const float* pg = a.in[I_POSTMIXG]; const float* fg = a.in[I_PREFFNG]; bf16* X1B = (bf16*)(a.ws + WS_X1B);
    const int rpw = M / NGW;
    for (int r0 = gw * rpw; r0 < M; r0 += NGW * rpw) { const int b = r0 / SEQ; const float* mb = MOD + (size_t)b * NMOD;
        f32x4 A1[4], A2[4], A3[4];
#pragma unroll
        for (int j = 0; j < 4; ++j) { const int col = 4 * lane + 256 * j; A1[j] = *(const f32x4*)(mb + 2 * D + col) * *(const f32x4*)(pg + col);
            A2[j] = *(const f32x4*)(fg + col) * (1.0f + *(const f32x4*)(mb + 4 * D + col)); A3[j] = *(const f32x4*)(mb + 3 * D + col); }
        f32x4 nx[4]; v2u nm[4];
        { const f32x4* xr = (const f32x4*)(x + (size_t)r0 * D) + lane; const v2u* mr = (const v2u*)(MIXED + (size_t)r0 * D) + lane;
#pragma unroll
            for (int j = 0; j < 4; ++j) { nx[j] = __builtin_nontemporal_load(xr + 64 * j); nm[j] = __builtin_nontemporal_load(mr + 64 * j); } }
        const float ssv = (lane < rpw) ? SS1[r0 + lane] : 0.f;
        for (int r = r0; r < r0 + rpw; ++r) {
            const float rs1 = __builtin_amdgcn_rsqf(__builtin_bit_cast(float, __builtin_amdgcn_readlane(__builtin_bit_cast(int, ssv), r - r0)) * (1.0f / D) + EPS); f32x4 v[4]; float s = 0.f;
#pragma unroll
            for (int j = 0; j < 4; ++j) { const v2u mw = nm[j]; const f32x4 mx = {bf_lo(mw.x), bf_hi(mw.x), bf_lo(mw.y), bf_hi(mw.y)};
                v[j] = nx[j] + mx * rs1 * A1[j]; s += (v[j].x * v[j].x + v[j].y * v[j].y) + (v[j].z * v[j].z + v[j].w * v[j].w); }
            if (r + 1 < r0 + rpw) { const f32x4* xr = (const f32x4*)(x + (size_t)(r + 1) * D) + lane; const v2u* mr = (const v2u*)(MIXED + (size_t)(r + 1) * D) + lane;
#pragma unroll
                for (int j = 0; j < 4; ++j) { nx[j] = __builtin_nontemporal_load(xr + 64 * j); nm[j] = __builtin_nontemporal_load(mr + 64 * j); } }
            v2u* xrow = (v2u*)(X1B + (size_t)r * D) + lane;
#pragma unroll
            for (int j = 0; j < 4; ++j) { v2u w; w.x = pk2(v[j].x, v[j].y); w.y = pk2(v[j].z, v[j].w); __builtin_nontemporal_store(w, xrow + 64 * j); }
            const float rs = __builtin_amdgcn_rsqf(wave_sum(s) * (1.0f / D) + EPS);
            v2u* o = (v2u*)(XN + (size_t)r * D) + lane;
#pragma unroll
            for (int j = 0; j < 4; ++j) { const f32x4 h = v[j] * rs * A2[j] + A3[j]; const unsigned long long w = (unsigned long long)pk2(h.x, h.y) | ((unsigned long long)pk2(h.z, h.w) << 32);
                __hip_atomic_store((unsigned long long*)(o + 64 * j), w, __ATOMIC_RELAXED, __HIP_MEMORY_SCOPE_AGENT); } } }
}

__device__ __forceinline__ void p6b_fixup(const Args& a, int gw, int NGW, int lane) {
    const bf16* RAW = (const bf16*)(a.ws + WS_RAW); bf16* ACT = (bf16*)(a.ws + WS_ACT); const float* cw = a.in[I_CONVW]; const float* cb = a.in[I_CONVB];
    for (int it = 2 * gw; it < 2 * gw + 2; ++it) { const int q = it & 3, rr = (it >> 2) & 1, B = it >> 3; const int t = 64 * B + rr, s = t % SEQ;
        const bf16* cur = RAW + (size_t)(B * 4 + rr) * FF2;
        const bf16* p1 = (rr == 1) ? RAW + (size_t)(B * 4 + 0) * FF2 : (s == 0 ? nullptr : RAW + (size_t)((B - 1) * 4 + 3) * FF2);
        const bf16* p2 = (rr == 1) ? (s == 1 ? nullptr : RAW + (size_t)((B - 1) * 4 + 3) * FF2) : (s == 0 ? nullptr : RAW + (size_t)((B - 1) * 4 + 2) * FF2);
        for (int f = q * 704 + 4 * lane; f < q * 704 + 704; f += 256) { f32x4 y[2];
#pragma unroll
            for (int hv = 0; hv < 2; ++hv) { const int col = hv * FF + f; const f32x4 z = {0.f, 0.f, 0.f, 0.f};
                const v2u zz = {0u, 0u}; const v2u r0 = *(const v2u*)(cur + col), r1 = p1 ? *(const v2u*)(p1 + col) : zz, r2 = p2 ? *(const v2u*)(p2 + col) : zz; (void)z;
                const f32x4 u0 = {bf_lo(r0.x), bf_hi(r0.x), bf_lo(r0.y), bf_hi(r0.y)}, u1 = {bf_lo(r1.x), bf_hi(r1.x), bf_lo(r1.y), bf_hi(r1.y)}, u2 = {bf_lo(r2.x), bf_hi(r2.x), bf_lo(r2.y), bf_hi(r2.y)};
                y[hv] = *(const f32x4*)(cb + col) + *(const f32x4*)(cw + col) * u2 + *(const f32x4*)(cw + FF2 + col) * u1 + *(const f32x4*)(cw + 2 * FF2 + col) * u0; }
            v2u w; w.x = pk2(pg8::silu_f(y[0][0]) * y[1][0], pg8::silu_f(y[0][1]) * y[1][1]); w.y = pk2(pg8::silu_f(y[0][2]) * y[1][2], pg8::silu_f(y[0][3]) * y[1][3]);
            *(v2u*)(ACT + (size_t)t * FF + f) = w; } }
}

#define XB_TMO      128
#define XB_XCNT(j)  (256  + 64 * (j))
#define XB_XSUB(j)  (1280 + 64 * (j))
#define XB_XGEN(j)  (2304 + 64 * (j))
#define XB_TOP      3328
#define XB_TOPGEN   3392
#define XCD_BAR_WORDS 3456
#define XB_SPIN_CAP (1u << 18)

__device__ __forceinline__ unsigned xb_ld(unsigned* p)              { return __hip_atomic_load(p, __ATOMIC_RELAXED, __HIP_MEMORY_SCOPE_AGENT); }
__device__ __forceinline__ unsigned xb_add(unsigned* p, unsigned v) { return __hip_atomic_fetch_add(p, v, __ATOMIC_RELAXED, __HIP_MEMORY_SCOPE_AGENT); }
__device__ __forceinline__ unsigned xb_xcc_id() { return (unsigned)__builtin_amdgcn_s_getreg((3 << 11) | 20) & 0xFu; }
#define XB_SPIN(cond, bar) do { unsigned _sp = 0; while (cond) { __builtin_amdgcn_s_sleep(1); \
    if ((++_sp & 255u) == 0u) { if (xb_ld(&(bar)[XB_TMO])) break; if (_sp > XB_SPIN_CAP) { atomicAdd(&(bar)[XB_TMO], 1u); break; } } } } while (0)

struct XcdBarrier {
    unsigned* bar; unsigned x;
    volatile LAS unsigned* st;
};

__device__ __forceinline__ XcdBarrier xcd_barrier_post(unsigned* bar, volatile LAS unsigned* st) {
    XcdBarrier b; b.bar = bar; b.x = xb_xcc_id(); b.st = st;
    if (threadIdx.x == 0) st[2] = xb_add(&bar[XB_XCNT(b.x)], 1u);
    return b;
}
__device__ __forceinline__ void xcd_barrier_complete(unsigned* bar, unsigned x, unsigned& nloc, unsigned& nx) {
    const unsigned G = gridDim.x * gridDim.y * gridDim.z;
    unsigned sum, cnt, mine, sp = 0u;
    for (;;) {
        sum = 0u; cnt = 0u; mine = 0u;
#pragma unroll
        for (unsigned j = 0; j < 16; ++j) { const unsigned c = xb_ld(&bar[XB_XCNT(j)]); sum += c; cnt += (c > 0u) ? 1u : 0u; mine = (j == x) ? c : mine; }
        if (sum == G) break;
        __builtin_amdgcn_s_sleep(1);
        if ((++sp & 255u) == 0u) { if (xb_ld(&bar[XB_TMO])) break; if (sp > XB_SPIN_CAP) { atomicAdd(&bar[XB_TMO], 1u); break; } }
    }
    nloc = mine > 0u ? mine : 1u; nx = cnt > 0u ? cnt : 1u;
}

__device__ __forceinline__ void xcd_barrier(const XcdBarrier& b) {
    asm volatile("s_waitcnt vmcnt(0)" ::: "memory");
    __syncthreads();
    if (threadIdx.x == 0) {
        unsigned* bar = b.bar;
        __builtin_amdgcn_s_waitcnt(0);
        unsigned nloc = b.st[0], nx = b.st[1];
        if (nloc == 0u) { xcd_barrier_complete(bar, b.x, nloc, nx); b.st[0] = nloc; b.st[1] = nx; }
        const unsigned old = xb_add(&bar[XB_XSUB(b.x)], 1u);
        const unsigned gen = old / nloc;
        if (old + 1u == (gen + 1u) * nloc) {
            __builtin_amdgcn_fence(__ATOMIC_RELEASE, "agent");
            asm volatile("s_waitcnt vmcnt(0)" ::: "memory");
            const unsigned og = xb_add(&bar[XB_TOP], 1u);
            const unsigned tg = og / nx;
            if (og + 1u == (tg + 1u) * nx) xb_add(&bar[XB_TOPGEN], 1u);
            else XB_SPIN(xb_ld(&bar[XB_TOPGEN]) == tg, bar);
            __builtin_amdgcn_fence(__ATOMIC_ACQUIRE, "agent");
            xb_add(&bar[XB_XGEN(b.x)], 1u);
            asm volatile("s_waitcnt vmcnt(0)" ::: "memory");
        } else {
            XB_SPIN(xb_ld(&bar[XB_XGEN(b.x)]) == gen, bar);
            __builtin_amdgcn_fence(__ATOMIC_ACQUIRE, "agent");
            asm volatile("s_waitcnt vmcnt(0)" ::: "memory");
        }
    }
    __syncthreads();
}
#define XL_SUB(j)  (4096 + 64 * (j))
#define XL_GEN(j)  (5120 + 64 * (j))
__device__ __forceinline__ void xcd_local_barrier(const XcdBarrier& b) {
    asm volatile("s_waitcnt vmcnt(0)" ::: "memory");
    __syncthreads();
    if (threadIdx.x == 0) { unsigned* bar = b.bar; const unsigned nloc = b.st[0];
        const unsigned old = xb_add(&bar[XL_SUB(b.x)], 1u); const unsigned gen = old / nloc;
        if (old + 1u == (gen + 1u) * nloc) xb_add(&bar[XL_GEN(b.x)], 1u);
        else XB_SPIN(xb_ld(&bar[XL_GEN(b.x)]) == gen, bar);
        __builtin_amdgcn_fence(__ATOMIC_ACQUIRE, "agent");
        asm volatile("s_waitcnt vmcnt(0)" ::: "memory"); }
    __syncthreads();
}
__global__ void __launch_bounds__(NWAVES * 64, 2) mk_fwd(Args args) {
    extern __shared__ __attribute__((aligned(16))) unsigned char lds_raw[];
    LAS unsigned char* lds = (LAS unsigned char*)lds_raw;
    const int tid = threadIdx.x, lane = tid & 63, wave = __builtin_amdgcn_readfirstlane(tid >> 6);
    const int G = gridDim.x, gw = blockIdx.x * NWAVES + wave, NGW = G * NWAVES;
    const int lo = args.ph_lo, hi = args.ph_hi;
    unsigned char* ws = args.ws;
    if (tid < 64) ((LAS unsigned*)(lds + LDSCTL_OFF))[tid] = 0u;
    __syncthreads();
    XcdBarrier bar = xcd_barrier_post((unsigned*)(ws + OFF_BAR), (volatile LAS unsigned*)(lds + LDSCTL_OFF) + 8);
#define IN(k) (lo <= (k) && (k) < hi)
#define NREP(k) ((MK_REPEAT == (k) || ((k) == 4 && (MK_REPEAT == 41 || MK_REPEAT == 42))) ? 2 : 1)
#define SEAM(k) do { if (IN(k) && IN((k) + 1)) xcd_barrier(bar); } while (0)
    if (lo < 0) cg::this_grid().sync();
    if (IN(0)) { p0_prologue(args, lds, gw, NGW, lane, wave, true, false); }
    SEAM(0);
    if (IN(1)) { for (int rep = 0; rep < NREP(1); ++rep) { if (rep) xcd_barrier(bar); p0_prologue(args, lds, gw, NGW, lane, wave, false, true); p1_norm(args, gw, NGW, lane); } }
    SEAM(1);
    int cvirt = (int)blockIdx.x; bool xlocal = false;
    if (lo == 0 && hi > 2 && (G & 7) == 0) { bool even = true;
#pragma unroll
        for (int j = 0; j < 16; ++j) { const unsigned cj = xb_ld(&bar.bar[XB_XCNT(j)]); even = even && (cj == (j < 8 ? (unsigned)(G >> 3) : 0u)); }
        if (even && bar.x < 8u) { cvirt = (int)(bar.st[2] * 8u + bar.x); xlocal = true; } }
    cvirt = __builtin_amdgcn_readfirstlane(cvirt);
    const int rb = xlocal ? (cvirt & 7) * (G >> 3) + (cvirt >> 3) : (int)blockIdx.x;
#define LSEAM() do { if (xlocal) xcd_local_barrier(bar); else xcd_barrier(bar); } while (0)
    if (IN(2)) { pg8::Gemm g{(const bf16*)(ws + WS_XN), (const bf16*)(ws + WS_WIN), M, INW, D}; pg8::StaticOrder S; S.init(M, INW, G, cvirt);
        pg8::EpiProj E{(bf16*)(ws + WS_PROJ), INW};
        for (int rep = 0; rep < NREP(2); ++rep) { if (rep) xcd_barrier(bar); pg8::gemm_phase<pg8::EpiProj, pg8::StaticOrder, true, true>(lds, g, S, E); } }
    SEAM(2);
    if (IN(3)) { for (int rep = 0; rep < NREP(3); ++rep) { if (rep) xcd_barrier(bar); __syncthreads(); p3_mixers(args, lds, tid, rb); } }
    if (IN(3) && IN(4)) LSEAM();
    if (IN(4)) { pg8::Gemm g{(const bf16*)(ws + WS_MIXIN), (const bf16*)(ws + WS_WOUT), M, D, D}; pg8::StaticOrder S; S.init(M, D, G, cvirt);
        pg8::EpiBf16SS E{(bf16*)(ws + WS_MIXED), D, (float*)(ws + OFF_SS1)};
        pg8::gemm_phase<pg8::EpiBf16SS, pg8::StaticOrder, true, true>(lds, g, S, E);
        LSEAM();
        p4b_mid(args, rb * NWAVES + wave, NGW, lane); }
    if (IN(4) && IN(5)) LSEAM();
    if (IN(5)) { pg8::Gemm g{(const bf16*)(ws + WS_XN), (const bf16*)(ws + WS_WUP), M, FF2, D}; pg8::StaticOrder S; S.init(M, FF2, G, cvirt);
        pg8::EpiConv E{(bf16*)(ws + WS_ACT), (bf16*)(ws + WS_RAW), args.in[I_CONVW], args.in[I_CONVB], FF, lds + LDSCTL_OFF + 4096};
        for (int rep = 0; rep < NREP(5); ++rep) { if (rep) xcd_barrier(bar); pg8::gemm_phase<pg8::EpiConv, pg8::StaticOrder, true, true>(lds, g, S, E); } }
    SEAM(5);
    if (IN(6)) { p6b_fixup(args, rb * NWAVES + wave, NGW, lane); }
    if (IN(6) && IN(7)) LSEAM();
    if (IN(7)) { pg8::Gemm g{(const bf16*)(ws + WS_ACT), (const bf16*)(ws + WS_WDOWN), M, D, FF}; pg8::StaticOrder S; S.init(M, D, G, cvirt);
        for (int rep = 0; rep < NREP(7); ++rep) { if (rep) xcd_barrier(bar);
        pg8::RowStat st{(float*)(ws + (rep ? 736 * 1024 : OFF_SS4)), (unsigned*)(ws + (rep ? 640 * 1024 : OFF_CNT + 32768)), 32u, 1.0f / D, EPS};
        pg8::EpiFinal E{(const bf16*)(ws + WS_X1B), rep ? (float*)(ws + WS_F) : args.out, (const float*)(ws + OFF_MOD), args.in[I_POSTFFNG], st, D, SEQ / 256};
        pg8::gemm_phase<pg8::EpiFinal, pg8::StaticOrder, true, true>(lds, g, S, E); } }
    if (MK_REPEAT == 17 && IN(7)) { xcd_barrier(bar); pg8::Gemm g{(const bf16*)(ws + WS_ACT), (const bf16*)(ws + WS_WDOWN), M, D, FF}; pg8::StaticOrder S; S.init(M, D, G, (int)blockIdx.x);
        pg8::EpiSink E{(float*)(ws + WS_F)}; pg8::gemm_phase<pg8::EpiSink, pg8::StaticOrder, true, true>(lds, g, S, E); }
#undef IN
#undef SEAM
}

constexpr int N_PHASES = 8;
extern "C" void kernel_launch(void* const* d_in, const int* in_sizes, int n_in, void* d_out, int out_size, void* d_ws, size_t ws_size, hipStream_t stream) {
    static int grid = 0;
    if (grid == 0) {
        if (n_in != 19 || in_sizes[0] != M * D || out_size != M * D || ws_size < WS_END) { fprintf(stderr, "kernel_launch: unexpected shapes (n_in %d, in0 %d, out %d, ws %zu)\n", n_in, n_in > 0 ? in_sizes[0] : -1, out_size, ws_size); grid = -1; return; }
        int dev = 0, cus = 0, per_cu = 0;
        (void)hipGetDevice(&dev); (void)hipDeviceGetAttribute(&cus, hipDeviceAttributeMultiprocessorCount, dev);
        if (hipFuncSetAttribute((const void*)mk_fwd, hipFuncAttributeMaxDynamicSharedMemorySize, LDS_BYTES) != hipSuccess) { fprintf(stderr, "kernel_launch: hipFuncSetAttribute failed\n"); grid = -1; return; }
        if (hipOccupancyMaxActiveBlocksPerMultiprocessor(&per_cu, (const void*)mk_fwd, NWAVES * 64, LDS_BYTES) != hipSuccess || per_cu < 1) { fprintf(stderr, "kernel_launch: occupancy query says %d blocks per CU\n", per_cu); per_cu = 1; }
        (void)hipGetLastError();
        grid = cus > 0 ? cus : 256;
    }
    if (grid < 0) return;
    (void)hipMemsetAsync((char*)d_ws + WS_CTL, 0, CTL_ZERO_BYTES, stream);
    Args a{};
    for (int i = 0; i < 19; ++i) a.in[i] = (const float*)d_in[i];
    a.out = (float*)d_out; a.ws = (unsigned char*)d_ws;
#if MK_N_LAUNCHES == 1
    a.ph_lo = 0; a.ph_hi = N_PHASES;
    void* kargs[] = {&a};
    hipError_t e = hipLaunchCooperativeKernel((const void*)mk_fwd, dim3(grid), dim3(NWAVES * 64), kargs, LDS_BYTES, stream);
    if (e != hipSuccess) fprintf(stderr, "kernel_launch: cooperative launch failed: %s (grid %d)\n", hipGetErrorString(e), grid);
#else
    for (int p = 0; p < N_PHASES; ++p) { a.ph_lo = p; a.ph_hi = p + 1; hipLaunchKernelGGL(mk_fwd, dim3(grid), dim3(NWAVES * 64), LDS_BYTES, stream, a); }
#endif
}
```

```cpp
#include <hip/hip_runtime.h>
#include <hip/hip_cooperative_groups.h>
#include <cstdio>
#include <cstdint>
namespace cg = cooperative_groups;
#ifndef MK_N_LAUNCHES
#define MK_N_LAUNCHES 1
#endif
#ifndef MK_REPEAT
#define MK_REPEAT -1
#endif
namespace pg8 {
#define PG8_LAS __attribute__((address_space(3)))
typedef unsigned short bf16_t;
typedef short bf16x8 __attribute__((ext_vector_type(8)));
typedef float f32x4 __attribute__((ext_vector_type(4)));
typedef unsigned u32x4 __attribute__((ext_vector_type(4)));
constexpr int BM = 256, BK = 64, HALF = 128, HTB = HALF * BK * 2  , STAGE_BYTES = 8 * HTB, NXCD = 8, WGM = 8;

__host__ __device__ __forceinline__ int lds_byte(int r, int c) { const int st = (r >> 4) * 2 + (c >> 5), rr = r & 15, cc = c & 31, ob = rr * 64 + cc * 2; return st * 1024 + (ob ^ (((ob >> 9) & 1) << 5)); }
__host__ __device__ __forceinline__ void stage_rc(int b, int& R, int& C) { const int st = b / 1024, sb = b % 1024, swz = sb ^ (((sb >> 9) & 1) << 5); R = (st >> 1) * 16 + swz / 64; C = (st & 1) * 32 + (swz % 64) / 2; }
__host__ __device__ __forceinline__ int perm32(int rho) { const int n = rho >> 4, i = rho & 15; return 8 * (i >> 2) + 4 * n + (i & 3); }

struct Unit { int pm, pn; };
struct Gemm { const bf16_t* A; const bf16_t* Bt; int M, N, K; };

struct StaticOrder {
    int nM, nN, nwg, G, c;
    __host__ __device__ void init(int M, int N, int G_, int c_) { nM = M / BM; nN = N / BM; nwg = nM * nN; G = G_; c = c_; }
    __host__ __device__ bool next(int i, Unit& u) const {
        const long L = (long)i * G + c; if (L >= nwg) return false;
        int wgid = (int)L; { const int q = nwg / NXCD, r = nwg % NXCD, xcd = wgid % NXCD, off = wgid / NXCD; wgid = (xcd < r ? xcd * (q + 1) : r * (q + 1) + (xcd - r) * q) + off; }
        const int nig = WGM * nN, gid = wgid / nig, fm = gid * WGM, gsz = (nM - fm) < WGM ? (nM - fm) : WGM;
        u.pm = fm + ((wgid % nig) % gsz); u.pn = (wgid % nig) / gsz; return true;
    }
    __device__ __forceinline__ void a_ready(const Unit&) const {}
    __device__ __forceinline__ void done(const Unit&) const {}
};

__device__ __forceinline__ unsigned cvt_pk_bf16(float lo, float hi) { unsigned r; asm volatile("v_cvt_pk_bf16_f32 %0, %1, %2" : "=v"(r) : "v"(lo), "v"(hi)); return r; }
typedef float f32x2 __attribute__((ext_vector_type(2)));
typedef unsigned u32x2 __attribute__((ext_vector_type(2)));
__device__ __forceinline__ float fast_sigmoid_arg2(float p) { return __builtin_amdgcn_rcpf(1.0f + __builtin_amdgcn_exp2f(p)); }
__device__ __forceinline__ float gelu_tanh(float x) {
    const float t = x * x; const float p = x * (-2.302208198f + (-0.1029432397f) * t); return x * fast_sigmoid_arg2(p);
}
__device__ __forceinline__ float silu_f(float x) { return x * fast_sigmoid_arg2(x * (-1.4426950409f)); }
__device__ __forceinline__ float dpp_ror1(float x) { return __builtin_bit_cast(float, __builtin_amdgcn_update_dpp(0, __builtin_bit_cast(int, x), 0x121, 0xf, 0xf, false)); }
__device__ __forceinline__ float dpp_ror2(float x) { return __builtin_bit_cast(float, __builtin_amdgcn_update_dpp(0, __builtin_bit_cast(int, x), 0x122, 0xf, 0xf, false)); }

struct EpiProj {
    static constexpr bool PERM = true, AFTER_DRAIN = false, PERMA = false, HAS_PRE = false;
    bf16_t* O; int ldc;
    __device__ __forceinline__ void operator()(const f32x4 (&acc)[2][2][4][2], const Unit& u, int wr, int wc, int fr, int fq) const {
        const int row0 = u.pm * BM + wr * 64 + fr, col0 = u.pn * BM + wc * 32 + 8 * fq; const bool act = u.pn < 4;
#pragma unroll
        for (int ai = 0; ai < 2; ++ai)
#pragma unroll
            for (int m = 0; m < 4; ++m) { bf16_t* rowp = O + (size_t)(row0 + ai * HALF + m * 16) * ldc + col0;
#pragma unroll
                for (int bj = 0; bj < 2; ++bj) { f32x4 v0 = acc[ai][bj][m][0], v1 = acc[ai][bj][m][1];
                    if (act) {
#pragma unroll
                        for (int j = 0; j < 4; ++j) { v0[j] = gelu_tanh(v0[j]); v1[j] = gelu_tanh(v1[j]); } }
                    u32x4 w; w.x = cvt_pk_bf16(v0[0], v0[1]); w.y = cvt_pk_bf16(v0[2], v0[3]); w.z = cvt_pk_bf16(v1[0], v1[1]); w.w = cvt_pk_bf16(v1[2], v1[3]);
                    *(u32x4*)(rowp + bj * HALF) = w; } }
    }
};

struct EpiF32SS {
    static constexpr bool PERM = false, AFTER_DRAIN = false, PERMA = false, HAS_PRE = false;
    float* O; int ldc; float* ss;
    __device__ __forceinline__ void operator()(const f32x4 (&acc)[2][2][4][2], const Unit& u, int wr, int wc, int fr, int fq) const {
        const int row0 = u.pm * BM + wr * 64 + fr, col0 = u.pn * BM + wc * 32 + 4 * fq;
#pragma unroll
        for (int ai = 0; ai < 2; ++ai)
#pragma unroll
            for (int m = 0; m < 4; ++m) { const int row = row0 + ai * HALF + m * 16; float* rowp = O + (size_t)row * ldc + col0; float s = 0.f;
#pragma unroll
                for (int bj = 0; bj < 2; ++bj)
#pragma unroll
                    for (int n = 0; n < 2; ++n) { const f32x4 x = acc[ai][bj][m][n]; s += (x[0] * x[0] + x[1] * x[1]) + (x[2] * x[2] + x[3] * x[3]); *(f32x4*)(rowp + bj * HALF + n * 16) = x; }
                s += __shfl_xor(s, 16); s += __shfl_xor(s, 32);
                if (fq == 0) atomicAdd(ss + row, s); }
    }
};

struct EpiBf16SS {
    static constexpr bool PERM = true, AFTER_DRAIN = false, PERMA = false, HAS_PRE = false;
    bf16_t* O; int ldc; float* ss;
    __device__ __forceinline__ void operator()(const f32x4 (&acc)[2][2][4][2], const Unit& u, int wr, int wc, int fr, int fq) const {
        const int row0 = u.pm * BM + wr * 64 + fr, col0 = u.pn * BM + wc * 32 + 8 * fq;
#pragma unroll
        for (int ai = 0; ai < 2; ++ai)
#pragma unroll
            for (int m = 0; m < 4; ++m) { const int row = row0 + ai * HALF + m * 16; bf16_t* rowp = O + (size_t)row * ldc + col0; float s = 0.f;
#pragma unroll
                for (int bj = 0; bj < 2; ++bj) { const f32x4 v0 = acc[ai][bj][m][0], v1 = acc[ai][bj][m][1];
                    s += ((v0[0] * v0[0] + v0[1] * v0[1]) + (v0[2] * v0[2] + v0[3] * v0[3])) + ((v1[0] * v1[0] + v1[1] * v1[1]) + (v1[2] * v1[2] + v1[3] * v1[3]));
                    u32x4 w; w.x = cvt_pk_bf16(v0[0], v0[1]); w.y = cvt_pk_bf16(v0[2], v0[3]); w.z = cvt_pk_bf16(v1[0], v1[1]); w.w = cvt_pk_bf16(v1[2], v1[3]);
                    *(u32x4*)(rowp + bj * HALF) = w; }
                s += __shfl_xor(s, 16); s += __shfl_xor(s, 32);
                if (fq == 0) atomicAdd(ss + row, s); }
    }
};

__device__ __forceinline__ float dpp_shr1(float x) { return __builtin_bit_cast(float, __builtin_amdgcn_update_dpp(0, __builtin_bit_cast(int, x), 0x111, 0xf, 0xf, true)); }
struct EpiConv {
    static constexpr bool PERM = true, AFTER_DRAIN = false, PERMA = true, HAS_PRE = true;
    bf16_t* ACT; bf16_t* RAW; const float* cw; const float* cb; int FF; PG8_LAS unsigned char* CB;
    __device__ __forceinline__ void pre(const Unit& u, int par) const {
        const int tid = threadIdx.x, w = __builtin_amdgcn_readfirstlane(tid >> 6), l = tid & 63;
        if (w < 4) { const int vec = 2 * w + (l >> 5), k = vec & 3, hv = vec >> 2; const float* src = (k < 3 ? cw + (size_t)k * 2 * FF : cb) + hv * FF + u.pn * HALF + (l & 31) * 4;
            __builtin_amdgcn_global_load_lds((const unsigned*)src, (PG8_LAS unsigned*)(CB + par * 4096 + w * 1024), 16, 0, 0); }
    }
    __device__ __forceinline__ void run(const f32x4 (&acc)[2][2][4][2], const Unit& u, int wr, int wc, int fr, int fq, int par) const {
        const int f0 = u.pn * HALF + wc * 32 + 8 * fq; const int rowt = u.pm * BM + wr * 64 + 4 * fr; const int FF2 = 2 * FF;
        const PG8_LAS float* cbuf = (const PG8_LAS float*)(CB + par * 4096) + wc * 32 + 8 * fq;
        unsigned stash[2][4][2];
#pragma unroll
        for (int n = 0; n < 2; ++n) { const int f = f0 + 4 * n; const PG8_LAS float* cn = cbuf + 4 * n;
            const f32x4 w0g = *(const PG8_LAS f32x4*)(cn), w1g = *(const PG8_LAS f32x4*)(cn + 128), w2g = *(const PG8_LAS f32x4*)(cn + 256), bg = *(const PG8_LAS f32x4*)(cn + 384);
            const f32x4 w0v = *(const PG8_LAS f32x4*)(cn + 512), w1v = *(const PG8_LAS f32x4*)(cn + 640), w2v = *(const PG8_LAS f32x4*)(cn + 768), bv = *(const PG8_LAS f32x4*)(cn + 896);
#pragma unroll
            for (int ai = 0; ai < 2; ++ai) {
                f32x4 gm1, gm2, vm1, vm2;
#pragma unroll
                for (int j = 0; j < 4; ++j) { gm1[j] = dpp_shr1(acc[ai][0][3][n][j]); gm2[j] = dpp_shr1(acc[ai][0][2][n][j]); vm1[j] = dpp_shr1(acc[ai][1][3][n][j]); vm2[j] = dpp_shr1(acc[ai][1][2][n][j]); }
#pragma unroll
                for (int m = 0; m < 4; ++m) { const f32x4 g = acc[ai][0][m][n], v = acc[ai][1][m][n];
                    const f32x4 pg1 = (m == 0) ? gm1 : acc[ai][0][m > 0 ? m - 1 : 0][n], pg2 = (m == 0) ? gm2 : (m == 1 ? gm1 : acc[ai][0][m > 1 ? m - 2 : 0][n]);
                    const f32x4 pv1 = (m == 0) ? vm1 : acc[ai][1][m > 0 ? m - 1 : 0][n], pv2 = (m == 0) ? vm2 : (m == 1 ? vm1 : acc[ai][1][m > 1 ? m - 2 : 0][n]);
                    const f32x4 yg = bg + w0g * pg2 + w1g * pg1 + w2g * g, yv = bv + w0v * pv2 + w1v * pv1 + w2v * v; f32x4 a;
#pragma unroll
                    for (int j = 0; j < 4; ++j) a[j] = silu_f(yg[j]) * yv[j];
                    const unsigned lo = cvt_pk_bf16(a[0], a[1]), hi = cvt_pk_bf16(a[2], a[3]);
                    if (n == 0) { stash[ai][m][0] = lo; stash[ai][m][1] = hi; }
                    else if (!(m < 2 && fr == 0)) { u32x4 w; w.x = stash[ai][m][0]; w.y = stash[ai][m][1]; w.z = lo; w.w = hi; __builtin_nontemporal_store(w, (u32x4*)(ACT + (size_t)(rowt + ai * HALF + m) * FF + f0)); }
                    if ((m < 2 && fr == 0) || (m >= 2 && fr == 15)) { bf16_t* rp = RAW + ((size_t)((u.pm * 4 + ai * 2 + wr) * 4 + m)) * FF2 + f;
                        u32x2 gw, vw; gw.x = cvt_pk_bf16(g[0], g[1]); gw.y = cvt_pk_bf16(g[2], g[3]); vw.x = cvt_pk_bf16(v[0], v[1]); vw.y = cvt_pk_bf16(v[2], v[3]);
                        *(u32x2*)rp = gw; *(u32x2*)(rp + FF) = vw; } } } }
    }
};

struct RowStat {
    float* ss; unsigned* cnt; unsigned want; float inv_n, eps;
    __device__ __forceinline__ void run(const float (&part)[2][4], float (&rs)[2][4], const Unit& u, int wr, int fr, int fq) const {
        const int row0 = u.pm * BM + wr * 64 + fr; const int lane = fq * 16 + fr;
#pragma unroll
        for (int ai = 0; ai < 2; ++ai)
#pragma unroll
            for (int m = 0; m < 4; ++m) { float s = part[ai][m]; s += __shfl_xor(s, 16); s += __shfl_xor(s, 32); if (fq == 0) atomicAdd(ss + row0 + ai * HALF + m * 16, s); }
        asm volatile("s_waitcnt vmcnt(0)" ::: "memory");
        unsigned* c = cnt + 64 * u.pm;
        if (lane == 0) __hip_atomic_fetch_add(c, 1u, __ATOMIC_RELAXED, __HIP_MEMORY_SCOPE_AGENT);
        if (threadIdx.x < 64) { unsigned sp = 0;
            while ((unsigned)__builtin_amdgcn_readfirstlane(__hip_atomic_load(c, __ATOMIC_RELAXED, __HIP_MEMORY_SCOPE_AGENT)) < want) { __builtin_amdgcn_s_sleep(1); if (++sp > (1u << 22)) break; } }
        asm volatile("s_waitcnt vmcnt(0) lgkmcnt(0)" ::: "memory"); __builtin_amdgcn_s_barrier(); asm volatile("" ::: "memory");
#pragma unroll
        for (int ai = 0; ai < 2; ++ai)
#pragma unroll
            for (int m = 0; m < 4; ++m) { const float v = __hip_atomic_load(ss + row0 + ai * HALF + m * 16, __ATOMIC_RELAXED, __HIP_MEMORY_SCOPE_AGENT); rs[ai][m] = __builtin_amdgcn_rsqf(v * inv_n + eps); }
    }
};
template <int VAR = 0  > struct EpiMid {
    static constexpr bool PERM = false, AFTER_DRAIN = false, PERMA = false, HAS_PRE = false;
    const float* x; float* x1; bf16_t* xn; const float* mod; const float* post_g; const float* ffn_g; const float* sxx; float* ss1; float* ssxm; float* ssmm; unsigned* cnt; PG8_LAS float* A23; int ld, tiles_per_batch;
    __device__ __forceinline__ void operator()(f32x4 (&acc)[2][2][4][2], const Unit& u, int wr, int wc, int fr, int fq) const {
        const int col0 = u.pn * BM + wc * 32 + 4 * fq; const float* mb = mod + (size_t)(u.pm / tiles_per_batch) * (6 * ld); const int tid = threadIdx.x;
        const unsigned voff = (unsigned)((wr * 64 + fr) * ld + col0) * 4u;
        const size_t pbase = (size_t)u.pm * BM * ld; const int row0 = u.pm * BM + wr * 64 + fr;
        if (tid < 256) { const int c = u.pn * BM + tid; A23[tid] = mb[2 * ld + c] * post_g[c]; A23[256 + tid] = ffn_g[c] * (1.0f + mb[4 * ld + c]); A23[512 + tid] = mb[3 * ld + c]; }
        asm volatile("s_waitcnt vmcnt(0) lgkmcnt(0)" ::: "memory"); __builtin_amdgcn_s_barrier(); asm volatile("" ::: "memory");
        const PG8_LAS float* As = A23 + wc * 32 + 4 * fq;
#pragma unroll
        for (int ai = 0; ai < 2; ++ai)
#pragma unroll
            for (int m = 0; m < 4; ++m) { const char* xb = (const char*)(x + pbase + (size_t)(ai * HALF + m * 16) * ld); f32x4 s1 = {0.f, 0.f, 0.f, 0.f}, sx = s1, sm = s1;
#pragma unroll
                for (int bj = 0; bj < 2; ++bj)
#pragma unroll
                    for (int n = 0; n < 2; ++n) { const unsigned o = voff + (unsigned)(bj * HALF + n * 16) * 4u; const f32x4 xv = (VAR == 1) ? (f32x4){1.f, 1.f, 1.f, 1.f} : *(const f32x4*)(xb + o); const f32x4 mx = acc[ai][bj][m][n], cm = mx * *(const PG8_LAS f32x4*)(As + bj * HALF + n * 16);
                        s1 += mx * mx; sx += xv * cm; sm += cm * cm; }
                float a = (s1[0] + s1[1]) + (s1[2] + s1[3]), b = (sx[0] + sx[1]) + (sx[2] + sx[3]), c = (sm[0] + sm[1]) + (sm[2] + sm[3]);
                a += __shfl_xor(a, 16); a += __shfl_xor(a, 32); b += __shfl_xor(b, 16); b += __shfl_xor(b, 32); c += __shfl_xor(c, 16); c += __shfl_xor(c, 32);
                if (fq == 0) { const int r = row0 + ai * HALF + m * 16; atomicAdd(ss1 + r, a); atomicAdd(ssxm + r, b); atomicAdd(ssmm + r, c); }
                if (m == 3) asm volatile("" ::: "memory"); }
        asm volatile("s_waitcnt vmcnt(0)" ::: "memory");
        unsigned* cw = cnt + 64 * u.pm;
        if ((tid & 63) == 0) __hip_atomic_fetch_add(cw, 1u, __ATOMIC_RELAXED, __HIP_MEMORY_SCOPE_AGENT);
        if (tid < 64) { unsigned sp = 0;
            while ((unsigned)__builtin_amdgcn_readfirstlane(__hip_atomic_load(cw, __ATOMIC_RELAXED, __HIP_MEMORY_SCOPE_AGENT)) < 32u) { __builtin_amdgcn_s_sleep(1); if (++sp > (1u << 22)) break; } }
        asm volatile("s_waitcnt vmcnt(0) lgkmcnt(0)" ::: "memory"); __builtin_amdgcn_s_barrier(); asm volatile("" ::: "memory");
        const float inv_n = 1.0f / (float)ld; float rs1[2][4], rs2[2][4];
#pragma unroll
        for (int ai = 0; ai < 2; ++ai)
#pragma unroll
            for (int m = 0; m < 4; ++m) { const int r = row0 + ai * HALF + m * 16;
                const float S1 = __hip_atomic_load(ss1 + r, __ATOMIC_RELAXED, __HIP_MEMORY_SCOPE_AGENT), Sxm = __hip_atomic_load(ssxm + r, __ATOMIC_RELAXED, __HIP_MEMORY_SCOPE_AGENT), Smm = __hip_atomic_load(ssmm + r, __ATOMIC_RELAXED, __HIP_MEMORY_SCOPE_AGENT);
                const float r1 = __builtin_amdgcn_rsqf(S1 * inv_n + 1e-6f); rs1[ai][m] = r1;
                const float s2 = sxx[r] + 2.0f * r1 * Sxm + r1 * r1 * Smm; rs2[ai][m] = __builtin_amdgcn_rsqf(s2 * inv_n + 1e-6f); }
        if (VAR != 0) { if (rs1[0][0] + rs2[1][3] + rs1[1][2] + rs2[0][1] == 1.2345e33f) x1[row0] = rs1[0][1]; return; }
#pragma unroll
        for (int ai = 0; ai < 2; ++ai)
#pragma unroll
            for (int m = 0; m < 4; ++m) { const size_t gb = pbase + (size_t)(ai * HALF + m * 16) * ld; const char* xb = (const char*)(x + gb); char* ob = (char*)(x1 + gb); char* nb = (char*)(xn + gb);
#pragma unroll
                for (int bj = 0; bj < 2; ++bj)
#pragma unroll
                    for (int n = 0; n < 2; ++n) { const unsigned o = voff + (unsigned)(bj * HALF + n * 16) * 4u; const f32x4 xv = *(const f32x4*)(xb + o);
                        const f32x4 v = xv + acc[ai][bj][m][n] * rs1[ai][m] * *(const PG8_LAS f32x4*)(As + bj * HALF + n * 16);
                        *(f32x4*)(ob + o) = v;
                        const f32x4 a2 = *(const PG8_LAS f32x4*)(As + 256 + bj * HALF + n * 16), a3 = *(const PG8_LAS f32x4*)(As + 512 + bj * HALF + n * 16); const f32x4 h = v * rs2[ai][m] * a2 + a3;
                        u32x2 wv; wv.x = cvt_pk_bf16(h[0], h[1]); wv.y = cvt_pk_bf16(h[2], h[3]); *(u32x2*)(nb + (o >> 1)) = wv; }
                if (m == 3) asm volatile("" ::: "memory"); }
    }
};
struct EpiFinal {
    static constexpr bool PERM = false, AFTER_DRAIN = false, PERMA = false, HAS_PRE = false;
    const bf16_t* src; float* out; const float* mod; const float* post_g; RowStat st; int ld, tiles_per_batch;
    __device__ __forceinline__ void operator()(f32x4 (&acc)[2][2][4][2], const Unit& u, int wr, int wc, int fr, int fq) const {
        const int col0 = u.pn * BM + wc * 32 + 4 * fq; const float* mb = mod + (size_t)(u.pm / tiles_per_batch) * (6 * ld);
        const unsigned voff = (unsigned)((wr * 64 + fr) * ld + col0) * 4u, cvo = (unsigned)col0 * 4u; const size_t pbase = (size_t)u.pm * BM * ld;
        float part[2][4], rs[2][4];
#pragma unroll
        for (int ai = 0; ai < 2; ++ai)
#pragma unroll
            for (int m = 0; m < 4; ++m) { float s = 0.f;
#pragma unroll
                for (int bj = 0; bj < 2; ++bj)
#pragma unroll
                    for (int n = 0; n < 2; ++n) { const f32x4 v = acc[ai][bj][m][n]; s += (v[0] * v[0] + v[1] * v[1]) + (v[2] * v[2] + v[3] * v[3]); }
                part[ai][m] = s; }
        u32x2 xpre[2][4][2][2];
#pragma unroll
        for (int ai = 0; ai < 2; ++ai)
#pragma unroll
            for (int m = 0; m < 4; ++m) { const char* sb = (const char*)(src + pbase + (size_t)(ai * HALF + m * 16) * ld);
#pragma unroll
                for (int bj = 0; bj < 2; ++bj)
#pragma unroll
                    for (int n = 0; n < 2; ++n) xpre[ai][m][bj][n] = *(const u32x2*)(sb + ((voff + (unsigned)(bj * HALF + n * 16) * 4u) >> 1)); }
        st.run(part, rs, u, wr, fr, fq);
        f32x4 A1[2][2];
#pragma unroll
        for (int bj = 0; bj < 2; ++bj)
#pragma unroll
            for (int n = 0; n < 2; ++n) { const unsigned co = cvo + (unsigned)(bj * HALF + n * 16) * 4u; A1[bj][n] = *(const f32x4*)((const char*)(mb + 5 * ld) + co) * *(const f32x4*)((const char*)post_g + co); }
#pragma unroll
        for (int ai = 0; ai < 2; ++ai)
#pragma unroll
            for (int m = 0; m < 4; ++m) { char* ob = (char*)(out + pbase + (size_t)(ai * HALF + m * 16) * ld);
#pragma unroll
                for (int bj = 0; bj < 2; ++bj)
#pragma unroll
                    for (int n = 0; n < 2; ++n) { const unsigned o = voff + (unsigned)(bj * HALF + n * 16) * 4u; const u32x2 xw = xpre[ai][m][bj][n];
                        const f32x4 xv = {__builtin_bit_cast(float, xw.x << 16), __builtin_bit_cast(float, xw.x & 0xffff0000u), __builtin_bit_cast(float, xw.y << 16), __builtin_bit_cast(float, xw.y & 0xffff0000u)};
                        *(f32x4*)(ob + o) = xv + acc[ai][bj][m][n] * rs[ai][m] * A1[bj][n]; }
                if (m == 3) asm volatile("" ::: "memory"); }
    }
};

struct EpiSink {
    static constexpr bool PERM = false, AFTER_DRAIN = false, PERMA = false, HAS_PRE = false;
    float* O;
    __device__ __forceinline__ void operator()(f32x4 (&acc)[2][2][4][2], const Unit& u, int wr, int wc, int fr, int fq) const {
        f32x4 s = {0.f, 0.f, 0.f, 0.f};
#pragma unroll
        for (int ai = 0; ai < 2; ++ai)
#pragma unroll
            for (int bj = 0; bj < 2; ++bj)
#pragma unroll
                for (int m = 0; m < 4; ++m)
#pragma unroll
                    for (int n = 0; n < 2; ++n) s += acc[ai][bj][m][n];
        if (s[0] + s[1] + s[2] + s[3] == 1.2345e33f) O[u.pm * 256 + wr * 64 + fr + wc + fq] = s[0];
    }
};
template <class Epi, class Sched, bool ALIGN_EPI = false, bool SP2 = false>
__device__ __forceinline__ void gemm_phase(PG8_LAS unsigned char* lds, const Gemm g, const Sched& S, const Epi& E) {
    const int tid = threadIdx.x, wid = __builtin_amdgcn_readfirstlane(tid >> 6), lane = tid & 63, wr = wid >> 2, wc = wid & 3, fr = lane & 15, fq = lane >> 4;
    const int K = g.K, nt = K / BK;
    unsigned voffA[2], voffB[2];
#pragma unroll
    for (int i = 0; i < 2; ++i) { int R, C; stage_rc(tid * 16 + i * 8192, R, C); const int Rb = Epi::PERM ? ((R & ~31) + perm32(R & 31)) : R;
        const int Ra = Epi::PERMA ? ((R & ~63) + 4 * (R & 15) + ((R & 63) >> 4)) : R;
        voffA[i] = (unsigned)(Ra * K + C) * 2u; voffB[i] = (unsigned)(Rb * K + C) * 2u; }
    const size_t kstep = (size_t)(BK * 2);
    const size_t hstep = (size_t)HALF * K * 2;
    const size_t tstep = 2 * hstep;
    const unsigned ldsw = (unsigned)wid * 1024u;
    const int aoff = lds_byte(wr * 64 + fr, fq * 8), boff = lds_byte(wc * 32 + fr, fq * 8);
#define PG8_SA(b, h) (((b) * 2 + (h)) * HTB)
#define PG8_SB(b, h) ((4 + (b) * 2 + (h)) * HTB)
#define PG8_STAGE(bufoff, gbase, voff) do { _Pragma("unroll") for (int _i = 0; _i < 2; ++_i) \
        __builtin_amdgcn_global_load_lds((const unsigned*)((const char*)(gbase) + (voff)[_i]), (PG8_LAS unsigned*)(lds + (bufoff) + ldsw + _i * 8192), 16, 0, 0); } while (0)
#define PG8_LDA(dst, b, h) do { _Pragma("unroll") for (int m = 0; m < 4; ++m) _Pragma("unroll") for (int k = 0; k < 2; ++k) dst[m][k] = *(const PG8_LAS bf16x8*)(lds + PG8_SA(b, h) + aoff + m * 2048 + k * 1024); } while (0)
#define PG8_LDB(dst, b, h) do { _Pragma("unroll") for (int n = 0; n < 2; ++n) _Pragma("unroll") for (int k = 0; k < 2; ++k) dst[n][k] = *(const PG8_LAS bf16x8*)(lds + PG8_SB(b, h) + boff + n * 2048 + k * 1024); } while (0)
#define PG8_MMA(ai, bj, At, Bt) do { __builtin_amdgcn_s_setprio(1); _Pragma("unroll") for (int m = 0; m < 4; ++m) _Pragma("unroll") for (int n = 0; n < 2; ++n) _Pragma("unroll") for (int k = 0; k < 2; ++k) \
        acc[ai][bj][m][n] = __builtin_amdgcn_mfma_f32_16x16x32_bf16(Bt[n][k], At[m][k], acc[ai][bj][m][n], 0, 0, 0); __builtin_amdgcn_s_setprio(0); } while (0)
#define PG8_WAIT_V(n) asm volatile("s_waitcnt vmcnt(" #n ")" ::: "memory")
#define PG8_WAIT_L(n) asm volatile("s_waitcnt lgkmcnt(" #n ")" ::: "memory")
#define PG8_BAR __builtin_amdgcn_s_barrier()
#define PG8_SCHED __builtin_amdgcn_sched_barrier(0)
    Unit cur, nxt; int ui = 0;
    if (!S.next(0, cur)) return;
    f32x4 acc[2][2][4][2];
#pragma unroll
    for (int a = 0; a < 2; ++a)
#pragma unroll
        for (int b = 0; b < 2; ++b)
#pragma unroll
            for (int m = 0; m < 4; ++m)
#pragma unroll
                for (int n = 0; n < 2; ++n) acc[a][b][m][n] = (f32x4){0.f, 0.f, 0.f, 0.f};
    bf16x8 At[4][2], B0[2][2], B1[2][2];
    const char* cA = (const char*)g.A + (size_t)cur.pm * tstep; const char* cB = (const char*)g.Bt + (size_t)cur.pn * tstep;
    S.a_ready(cur);
    if constexpr (Epi::HAS_PRE) E.pre(cur, 0);
    if constexpr (SP2) {
        PG8_STAGE(PG8_SB(0, 0), cB, voffB); PG8_STAGE(PG8_SB(0, 1), cB + hstep, voffB); PG8_STAGE(PG8_SA(0, 0), cA, voffA); PG8_STAGE(PG8_SA(0, 1), cA + hstep, voffA);
        if (wr == 1) PG8_BAR;
        PG8_WAIT_V(2); PG8_BAR;
        PG8_STAGE(PG8_SB(1, 0), cB + kstep, voffB); PG8_STAGE(PG8_SA(1, 0), cA + kstep, voffA); PG8_STAGE(PG8_SB(1, 1), cB + hstep + kstep, voffB);
        PG8_WAIT_V(6); PG8_BAR;
    } else {
        PG8_STAGE(PG8_SB(0, 0), cB, voffB); PG8_STAGE(PG8_SA(0, 0), cA, voffA); PG8_STAGE(PG8_SB(0, 1), cB + hstep, voffB); PG8_STAGE(PG8_SA(0, 1), cA + hstep, voffA);
        if (wr == 1) PG8_BAR;
        PG8_WAIT_V(4); PG8_BAR;
        PG8_STAGE(PG8_SB(1, 0), cB + kstep, voffB); PG8_STAGE(PG8_SA(1, 0), cA + kstep, voffA); PG8_STAGE(PG8_SB(1, 1), cB + hstep + kstep, voffB);
        PG8_WAIT_V(6); PG8_BAR;
    }
    for (;;) {
        const bool has_next = S.next(ui + 1, nxt);
        const char* nA = has_next ? (const char*)g.A + (size_t)nxt.pm * tstep : cA; const char* nB = has_next ? (const char*)g.Bt + (size_t)nxt.pn * tstep : cB;
        for (int t = 0; t < nt; t += 2) {
            const bool last = (t == nt - 2);
            const char* a1 = cA + (size_t)(t + 1) * kstep;
            const char* a2 = last ? nA : cA + (size_t)(t + 2) * kstep; const char* b2 = last ? nB : cB + (size_t)(t + 2) * kstep;
            const char* a3 = a2 + kstep; const char* b3 = b2 + kstep;
            if (last && has_next) S.a_ready(nxt);
            if constexpr (SP2) {
            PG8_LDB(B0, 0, 0); PG8_LDB(B1, 0, 1); PG8_SCHED; PG8_LDA(At, 0, 0); PG8_STAGE(PG8_SA(1, 1), a1 + hstep, voffA);
            PG8_WAIT_V(8); PG8_WAIT_L(0); PG8_BAR; PG8_MMA(0, 0, At, B0); PG8_MMA(0, 1, At, B1); PG8_BAR; PG8_SCHED;
            PG8_LDA(At, 0, 1); PG8_STAGE(PG8_SB(0, 0), b2, voffB); PG8_STAGE(PG8_SB(0, 1), b2 + hstep, voffB); PG8_STAGE(PG8_SA(0, 0), a2, voffA);
            PG8_WAIT_V(8); PG8_WAIT_L(0); PG8_BAR; PG8_MMA(1, 0, At, B0); PG8_MMA(1, 1, At, B1); PG8_BAR; PG8_SCHED;
            PG8_LDB(B0, 1, 0); PG8_LDB(B1, 1, 1); PG8_SCHED; PG8_LDA(At, 1, 0); PG8_STAGE(PG8_SA(0, 1), a2 + hstep, voffA);
            PG8_WAIT_V(8); PG8_WAIT_L(0); PG8_BAR; PG8_MMA(0, 0, At, B0); PG8_MMA(0, 1, At, B1); PG8_BAR; PG8_SCHED;
            PG8_LDA(At, 1, 1); PG8_STAGE(PG8_SB(1, 0), b3, voffB); PG8_STAGE(PG8_SB(1, 1), b3 + hstep, voffB); PG8_STAGE(PG8_SA(1, 0), a3, voffA);
            PG8_WAIT_V(8); PG8_WAIT_L(0); PG8_BAR; PG8_MMA(1, 0, At, B0); PG8_MMA(1, 1, At, B1); PG8_BAR; PG8_SCHED;
            } else {
            PG8_LDB(B0, 0, 0); PG8_SCHED; PG8_LDA(At, 0, 0); PG8_STAGE(PG8_SA(1, 1), a1 + hstep, voffA);
            PG8_WAIT_L(8); PG8_BAR; PG8_WAIT_L(0); PG8_MMA(0, 0, At, B0); PG8_BAR; PG8_SCHED;
            PG8_LDB(B1, 0, 1); PG8_STAGE(PG8_SB(0, 0), b2, voffB);
            PG8_BAR; PG8_WAIT_L(0); PG8_MMA(0, 1, At, B1); PG8_BAR;
            PG8_LDA(At, 0, 1); PG8_STAGE(PG8_SA(0, 0), a2, voffA);
            PG8_BAR; PG8_WAIT_L(0); PG8_MMA(1, 0, At, B0); PG8_BAR; PG8_SCHED;
            PG8_STAGE(PG8_SB(0, 1), b2 + hstep, voffB);
            PG8_WAIT_V(6); PG8_BAR; PG8_MMA(1, 1, At, B1); PG8_BAR;
            PG8_LDB(B0, 1, 0); PG8_SCHED; PG8_LDA(At, 1, 0); PG8_STAGE(PG8_SA(0, 1), a2 + hstep, voffA);
            PG8_WAIT_L(8); PG8_BAR; PG8_WAIT_L(0); PG8_MMA(0, 0, At, B0); PG8_BAR; PG8_SCHED;
            PG8_LDB(B1, 1, 1); PG8_STAGE(PG8_SB(1, 0), b3, voffB);
            PG8_BAR; PG8_WAIT_L(0); PG8_MMA(0, 1, At, B1); PG8_BAR;
            PG8_LDA(At, 1, 1); PG8_STAGE(PG8_SA(1, 0), a3, voffA);
            PG8_BAR; PG8_WAIT_L(0); PG8_MMA(1, 0, At, B0); PG8_BAR; PG8_SCHED;
            PG8_STAGE(PG8_SB(1, 1), b3 + hstep, voffB);
            PG8_WAIT_V(6); PG8_BAR; PG8_MMA(1, 1, At, B1); PG8_BAR;
            }
        }
        if constexpr (ALIGN_EPI) { if (wr == 0) PG8_BAR; }
        if constexpr (Epi::HAS_PRE) { if (has_next) E.pre(nxt, (ui + 1) & 1); E.run(acc, cur, wr, wc, fr, fq, ui & 1); S.done(cur); }
        else if constexpr (!Epi::AFTER_DRAIN) { E(acc, cur, wr, wc, fr, fq); S.done(cur); }
        if (!has_next) break;
#pragma unroll
        for (int a = 0; a < 2; ++a)
#pragma unroll
            for (int b = 0; b < 2; ++b)
#pragma unroll
                for (int m = 0; m < 4; ++m)
#pragma unroll
                    for (int n = 0; n < 2; ++n) acc[a][b][m][n] = (f32x4){0.f, 0.f, 0.f, 0.f};
        cur = nxt; cA = nA; cB = nB; ++ui;
        if constexpr (ALIGN_EPI) { if (wr == 1) PG8_BAR; }
    }
    PG8_WAIT_V(0);
    if constexpr (!ALIGN_EPI) { if (wr == 0) PG8_BAR; }
    PG8_BAR;
    if constexpr (Epi::AFTER_DRAIN) { E.fused(acc, cur, wr, wc, fr, fq, lds, wid, lane); S.done(cur); }
#undef PG8_SA
#undef PG8_SB
#undef PG8_STAGE
#undef PG8_LDA
#undef PG8_LDB
#undef PG8_MMA
#undef PG8_WAIT_V
#undef PG8_WAIT_L
#undef PG8_BAR
#undef PG8_SCHED
}
}
constexpr int NWAVES = 8;
constexpr int BATCH = 4, SEQ = 8192, D = 1024, M = BATCH * SEQ;
constexpr int INW = 1536, AW = 512, FF = 2816, FF2 = 2 * FF, NMOD = 6 * D;
constexpr float EPS = 1e-6f;
constexpr size_t MiB = 1u << 20;
constexpr size_t WS_CTL = 0, CTL_ZERO_BYTES = 1 * MiB;
constexpr size_t OFF_MOD = 0, OFF_SS1 = 128 * 1024, OFF_SS2 = 256 * 1024, OFF_SS3 = 384 * 1024, OFF_BAR = 512 * 1024, OFF_CNT = 544 * 1024, OFF_SS4 = 896 * 1024;
constexpr size_t WS_WIN = 1 * MiB, WS_WOUT = 4 * MiB, WS_WUP = 6 * MiB, WS_WDOWN = 17 * MiB, WS_WSP = 23 * MiB, WS_WPOOL = WS_WSP + 256 * 1024;
constexpr size_t WS_SXX = 23 * MiB + 512 * 1024;
constexpr size_t WS_XN = 24 * MiB;
constexpr size_t WS_PROJ = 88 * MiB;
constexpr size_t WS_MIXIN = 184 * MiB;
constexpr size_t WS_MIXED = 248 * MiB;
constexpr size_t WS_ACT = 88 * MiB;
constexpr size_t WS_RAW = 264 * MiB;
constexpr size_t WS_F = 308 * MiB;
constexpr size_t WS_X1B = 372 * MiB;
constexpr size_t WS_END = 436 * MiB;
static_assert(WS_ACT + (size_t)M * FF * 2 <= WS_RAW && WS_RAW + (size_t)(M / 64) * 4 * FF2 * 4 <= WS_F && WS_F + (size_t)M * D * 4 <= WS_END, "d_ws map");
static_assert(WS_WUP + (size_t)FF2 * D * 2 <= WS_WDOWN && WS_WDOWN + (size_t)D * FF * 2 <= WS_WSP && WS_WPOOL + 4 * 128 * 128 * 2 <= WS_XN, "d_ws weights");
constexpr int RING_BYTES = 131072, LDSCTL_OFF = RING_BYTES, LDS_BYTES = 147456;

#define GAS __attribute__((address_space(1)))
#define LAS __attribute__((address_space(3)))
typedef unsigned short bf16;
typedef unsigned v4u __attribute__((ext_vector_type(4)));
typedef unsigned v2u __attribute__((ext_vector_type(2)));
typedef float f32x4 __attribute__((ext_vector_type(4)));
typedef short bf16x8 __attribute__((ext_vector_type(8)));
#define LDS_WAIT() asm volatile("s_waitcnt lgkmcnt(0)" ::: "memory")
__device__ __forceinline__ unsigned f2bf(float f) { unsigned u = __builtin_bit_cast(unsigned, f); return (u + 0x7fffu + ((u >> 16) & 1u)) >> 16; }
__device__ __forceinline__ unsigned pk2(float lo, float hi) { unsigned r; asm("v_cvt_pk_bf16_f32 %0, %1, %2" : "=v"(r) : "v"(lo), "v"(hi)); return r; }
__device__ __forceinline__ float bf_lo(unsigned w) { return __builtin_bit_cast(float, w << 16); }
__device__ __forceinline__ float bf_hi(unsigned w) { return __builtin_bit_cast(float, w & 0xffff0000u); }
__device__ __forceinline__ float wave_sum(float v) {
#pragma unroll
    for (int o = 1; o < 64; o <<= 1) v += __shfl_xor(v, o);
    return v;
}
__device__ __forceinline__ float silu_acc(float x) { return x / (1.0f + __expf(-x)); }

struct Args { const float* in[19]; float* out; unsigned char* ws; int ph_lo, ph_hi; };
enum { I_X = 0, I_C, I_WADA, I_BADA, I_PREMIXG, I_POSTMIXG, I_WIN, I_SGUG, I_WSP, I_BSP, I_WPOOL, I_PSCALE, I_WOUT, I_PREFFNG, I_POSTFFNG, I_WUP, I_CONVW, I_CONVB, I_WDOWN };

__device__ __forceinline__ void transpose_item(const float* W, int K, int N, bf16* WT, int k0, int n0, int drow0, LAS float* scr, int lane) {
    { f32x4 v[8];
#pragma unroll
        for (int i = 0; i < 8; ++i) v[i] = __builtin_nontemporal_load((const f32x4*)(W + (size_t)(k0 + 8 * i + (lane >> 3)) * N + n0 + 4 * (lane & 7)));
#pragma unroll
        for (int i = 0; i < 8; ++i) { LAS float* d = scr + (8 * i + (lane >> 3)) * 33 + 4 * (lane & 7); d[0] = v[i].x; d[1] = v[i].y; d[2] = v[i].z; d[3] = v[i].w; } }
    LDS_WAIT(); asm volatile("" ::: "memory");
    const int c = lane & 7;
#pragma unroll
    for (int j = 0; j < 4; ++j) { const int n = (lane >> 3) + 8 * j; const LAS float* s = scr + (8 * c) * 33 + n;
        v4u o; o.x = pk2(s[0 * 33], s[1 * 33]); o.y = pk2(s[2 * 33], s[3 * 33]); o.z = pk2(s[4 * 33], s[5 * 33]); o.w = pk2(s[6 * 33], s[7 * 33]);
        *(v4u*)(WT + (size_t)(drow0 + n) * K + k0 + 8 * c) = o; }
    LDS_WAIT(); asm volatile("" ::: "memory");
}

__device__ __forceinline__ void p0_prologue(const Args& a, LAS unsigned char* lds, int gw, int NGW, int lane, int wave, bool with_mod, bool with_rest) {
    unsigned char* ws = a.ws;
    float* MOD = (float*)(ws + OFF_MOD);
    const float* c = a.in[I_C]; const float* wada = a.in[I_WADA]; const float* bada = a.in[I_BADA];
    for (int it = with_mod ? gw : 96 * 16; it < 96 * 16; it += NGW) { const int cb = it % 96, ks = it / 96, col = cb * 64 + lane; float a0 = 0.f, a1 = 0.f, a2 = 0.f, a3 = 0.f;
        const float sv0 = silu_acc(c[ks * 64 + lane]), sv1 = silu_acc(c[D + ks * 64 + lane]), sv2 = silu_acc(c[2 * D + ks * 64 + lane]), sv3 = silu_acc(c[3 * D + ks * 64 + lane]);
#pragma unroll 32
        for (int kk = 0; kk < 64; ++kk) { const float w = __builtin_nontemporal_load(wada + (size_t)(ks * 64 + kk) * NMOD + col);
            a0 += __builtin_bit_cast(float, __builtin_amdgcn_readlane(__builtin_bit_cast(int, sv0), kk)) * w; a1 += __builtin_bit_cast(float, __builtin_amdgcn_readlane(__builtin_bit_cast(int, sv1), kk)) * w;
            a2 += __builtin_bit_cast(float, __builtin_amdgcn_readlane(__builtin_bit_cast(int, sv2), kk)) * w; a3 += __builtin_bit_cast(float, __builtin_amdgcn_readlane(__builtin_bit_cast(int, sv3), kk)) * w; }
        if (ks == 0) { const float b = bada[col]; a0 += b; a1 += b; a2 += b; a3 += b; }
        atomicAdd(MOD + col, a0); atomicAdd(MOD + NMOD + col, a1); atomicAdd(MOD + 2 * NMOD + col, a2); atomicAdd(MOD + 3 * NMOD + col, a3); }
    if (!with_rest) return;
    LAS float* scr = (LAS float*)(lds + wave * 16384);
    constexpr int I_IN = (D / 64) * (INW / 32), I_OUT = (D / 64) * (D / 32), I_UP = (D / 64) * (FF2 / 32), I_DOWN = (FF / 64) * (D / 32), I_POOL = 4 * 2 * 4;
    constexpr int NITEMS = I_IN + I_OUT + I_UP + I_DOWN + I_POOL;
    for (int it = gw; it < NITEMS; it += NGW) { int r = it;
        if (r < I_IN) { const int nb = INW / 32, kb = r / nb, n0 = 32 * (r % nb); transpose_item(a.in[I_WIN], D, INW, (bf16*)(ws + WS_WIN), 64 * kb, n0, n0, scr, lane); continue; } r -= I_IN;
        if (r < I_OUT) { const int nb = D / 32, kb = r / nb, n0 = 32 * (r % nb); transpose_item(a.in[I_WOUT], D, D, (bf16*)(ws + WS_WOUT), 64 * kb, n0, n0, scr, lane); continue; } r -= I_OUT;
        if (r < I_UP) { const int nb = FF2 / 32, kb = r / nb, n0 = 32 * (r % nb); const int half = n0 / FF, f = n0 % FF, drow = 256 * (f / 128) + 128 * half + (f % 128);
            transpose_item(a.in[I_WUP], D, FF2, (bf16*)(ws + WS_WUP), 64 * kb, n0, drow, scr, lane); continue; } r -= I_UP;
        if (r < I_DOWN) { const int nb = D / 32, kb = r / nb, n0 = 32 * (r % nb); transpose_item(a.in[I_WDOWN], FF, D, (bf16*)(ws + WS_WDOWN), 64 * kb, n0, n0, scr, lane); continue; } r -= I_DOWN;
        { const int g = r / 8, q = r % 8, kb = q / 4, n0 = 32 * (q % 4); transpose_item(a.in[I_WPOOL] + (size_t)g * 16384, 128, 128, (bf16*)(ws + WS_WPOOL) + (size_t)g * 16384, 64 * kb, n0, n0, scr, lane); } }
    { const float* wsp = a.in[I_WSP]; bf16* o = (bf16*)(ws + WS_WSP);
        for (int e = gw * 64 + lane; e < 4 * 128 * 128; e += NGW * 64) { const int i = (e >> 7) & 127, j = e & 127; const float v = ((j >> 6) <= (i >> 6)) ? wsp[e] : 0.f; o[e] = (bf16)f2bf(v); } }
}

__device__ __forceinline__ void p1_norm(const Args& a, int gw, int NGW, int lane) {
    const float* MOD = (const float*)(a.ws + OFF_MOD); bf16* XN = (bf16*)(a.ws + WS_XN); const float* x = a.in[I_X]; const float* g = a.in[I_PREMIXG]; float* SXX = (float*)(a.ws + WS_SXX);
    const int rpw = M / NGW;
    for (int r0 = gw * rpw; r0 < M; r0 += NGW * rpw) { const int b = r0 / SEQ; const float* mb = MOD + (size_t)b * NMOD;
        f32x4 A[4], B[4];
#pragma unroll
        for (int j = 0; j < 4; ++j) { const int col = 4 * lane + 256 * j; const f32x4 gg = *(const f32x4*)(g + col), sc = *(const f32x4*)(mb + D + col); A[j] = gg * (1.0f + sc); B[j] = *(const f32x4*)(mb + col); }
        f32x4 nx[4];
        { const f32x4* xr = (const f32x4*)(x + (size_t)r0 * D) + lane;
#pragma unroll
            for (int j = 0; j < 4; ++j) nx[j] = __builtin_nontemporal_load(xr + 64 * j); }
        for (int r = r0; r < r0 + rpw; ++r) { f32x4 v[4]; float s = 0.f;
#pragma unroll
            for (int j = 0; j < 4; ++j) { v[j] = nx[j]; s += (v[j].x * v[j].x + v[j].y * v[j].y) + (v[j].z * v[j].z + v[j].w * v[j].w); }
            if (r + 1 < r0 + rpw) { const f32x4* xr = (const f32x4*)(x + (size_t)(r + 1) * D) + lane;
#pragma unroll
                for (int j = 0; j < 4; ++j) nx[j] = __builtin_nontemporal_load(xr + 64 * j); }
            const float st = wave_sum(s);
            const float rs = 1.0f / sqrtf(st * (1.0f / D) + EPS);
            v2u* o = (v2u*)(XN + (size_t)r * D) + lane;
#pragma unroll
            for (int j = 0; j < 4; ++j) { const f32x4 h = v[j] * rs * A[j] + B[j]; const unsigned long long w = (unsigned long long)pk2(h.x, h.y) | ((unsigned long long)pk2(h.z, h.w) << 32);
                __hip_atomic_store((unsigned long long*)(o + 64 * j), w, __ATOMIC_RELAXED, __HIP_MEMORY_SCOPE_AGENT); } } }
}

constexpr int P3_RA = 0, P3_RB = 34816, P3_RP = 69632, P3_RC = 108800, P3_PA = 272, P3_PV = 264;
__device__ __forceinline__ void p3_mma(LAS unsigned char* lds, bool natural_b, f32x4 (&acc)[4][2], int wr, int wc, int fr, int fq) {
#pragma unroll
    for (int m = 0; m < 4; ++m)
#pragma unroll
        for (int n = 0; n < 2; ++n) acc[m][n] = (f32x4){0.f, 0.f, 0.f, 0.f};
#pragma unroll
    for (int kk = 0; kk < 4; ++kk) { bf16x8 af[4], bfr[2];
#pragma unroll
        for (int m = 0; m < 4; ++m) af[m] = *(const LAS bf16x8*)(lds + P3_RA + (64 * wr + 16 * m + fr) * P3_PA + (32 * kk + 8 * fq) * 2);
        if (natural_b) {
            { const unsigned addr = (unsigned)(size_t)(lds + P3_RB) + (unsigned)((32 * kk + 8 * fq + (fr >> 2)) * P3_PV + (32 * wc + 4 * (fr & 3)) * 2);
                v2u l0, h0, l1, h1;
                asm volatile("ds_read_b64_tr_b16 %0, %4\n\tds_read_b64_tr_b16 %1, %4 offset:%5\n\tds_read_b64_tr_b16 %2, %4 offset:32\n\tds_read_b64_tr_b16 %3, %4 offset:%6\n\ts_waitcnt lgkmcnt(0)"
                             : "=&v"(l0), "=&v"(h0), "=&v"(l1), "=&v"(h1) : "v"(addr), "n"(4 * P3_PV), "n"(4 * P3_PV + 32) : "memory");
                v4u w0, w1; w0.x = l0.x; w0.y = l0.y; w0.z = h0.x; w0.w = h0.y; w1.x = l1.x; w1.y = l1.y; w1.z = h1.x; w1.w = h1.y;
                bfr[0] = __builtin_bit_cast(bf16x8, w0); bfr[1] = __builtin_bit_cast(bf16x8, w1); }
        } else {
#pragma unroll
            for (int n = 0; n < 2; ++n) bfr[n] = *(const LAS bf16x8*)(lds + P3_RB + (32 * wc + 16 * n + fr) * P3_PA + (32 * kk + 8 * fq) * 2);
        }
#pragma unroll
        for (int m = 0; m < 4; ++m)
#pragma unroll
            for (int n = 0; n < 2; ++n) acc[m][n] = __builtin_amdgcn_mfma_f32_16x16x32_bf16(bfr[n], af[m], acc[m][n], 0, 0, 0); }
}
template <int W> __device__ __forceinline__ void p3_pool(LAS unsigned char* lds, int tid, int s0) {
    const int ch = tid & 15, tq = 4 * (tid >> 4); const LAS unsigned char* rp = lds + P3_RP + ch * 16; float sum[8];
#pragma unroll
    for (int e = 0; e < 8; ++e) sum[e] = 0.f;
#pragma unroll 3
    for (int k = 1; k < W; ++k) { const v4u r = *(const LAS v4u*)(rp + (16 + tq - k) * P3_PA);
        sum[0] += bf_lo(r.x); sum[1] += bf_hi(r.x); sum[2] += bf_lo(r.y); sum[3] += bf_hi(r.y); sum[4] += bf_lo(r.z); sum[5] += bf_hi(r.z); sum[6] += bf_lo(r.w); sum[7] += bf_hi(r.w); }
#pragma unroll
    for (int rr = 0; rr < 4; ++rr) { const int t = tq + rr; const v4u cur = *(const LAS v4u*)(rp + (16 + t) * P3_PA);
        sum[0] += bf_lo(cur.x); sum[1] += bf_hi(cur.x); sum[2] += bf_lo(cur.y); sum[3] += bf_hi(cur.y); sum[4] += bf_lo(cur.z); sum[5] += bf_hi(cur.z); sum[6] += bf_lo(cur.w); sum[7] += bf_hi(cur.w);
        const int cnt = (s0 + t + 1) < W ? (s0 + t + 1) : W; const float inv = 1.0f / (float)cnt;
        v4u o; o.x = pk2(sum[0] * inv - bf_lo(cur.x), sum[1] * inv - bf_hi(cur.x)); o.y = pk2(sum[2] * inv - bf_lo(cur.y), sum[3] * inv - bf_hi(cur.y));
        o.z = pk2(sum[4] * inv - bf_lo(cur.z), sum[5] * inv - bf_hi(cur.z)); o.w = pk2(sum[6] * inv - bf_lo(cur.w), sum[7] * inv - bf_hi(cur.w));
        *(LAS v4u*)(lds + P3_RA + t * P3_PA + ch * 16) = o;
        if (rr < 3) { const v4u old = *(const LAS v4u*)(rp + (16 + t - (W - 1)) * P3_PA);
            sum[0] -= bf_lo(old.x); sum[1] -= bf_hi(old.x); sum[2] -= bf_lo(old.y); sum[3] -= bf_hi(old.y); sum[4] -= bf_lo(old.z); sum[5] -= bf_hi(old.z); sum[6] -= bf_lo(old.w); sum[7] -= bf_hi(old.w); } }
}
struct P3Regs { v4u a0, a1, a2, a3, b0, b1, b2, b3, b4; };
#define P3_RA_(R, it) ((it) == 0 ? (R).a0 : (it) == 1 ? (R).a1 : (it) == 2 ? (R).a2 : (R).a3)
#define P3_RB_(R, it) ((it) == 0 ? (R).b0 : (it) == 1 ? (R).b1 : (it) == 2 ? (R).b2 : (it) == 3 ? (R).b3 : (R).b4)
__device__ __forceinline__ void p3_prefetch(P3Regs& R, int item, int t0, int s0, int tid, const bf16* PROJ, const bf16* WSP, const bf16* WPOOL) {
    if (item < 4) { const int h = item;
#pragma unroll
        for (int it = 0; it < 4; ++it) { const int idx = tid + 512 * it, row = idx >> 4, ch = idx & 15;
            const v4u va = *(const v4u*)(WSP + (size_t)h * 16384 + row * 128 + ch * 8), vb = __builtin_nontemporal_load((const v4u*)(PROJ + (size_t)(t0 + row) * INW + AW + 128 * h + 8 * ch));
            if (it == 0) { R.a0 = va; R.b0 = vb; } else if (it == 1) { R.a1 = va; R.b1 = vb; } else if (it == 2) { R.a2 = va; R.b2 = vb; } else { R.a3 = va; R.b3 = vb; } }
    } else { const int g = item - 4;
#pragma unroll
        for (int it = 0; it < 4; ++it) { const int idx = tid + 512 * it, row = idx >> 4, ch = idx & 15; const v4u va = *(const v4u*)(WPOOL + (size_t)g * 16384 + row * 128 + ch * 8);
            if (it == 0) R.a0 = va; else if (it == 1) R.a1 = va; else if (it == 2) R.a2 = va; else R.a3 = va; }
#pragma unroll
        for (int it = 0; it < 5; ++it) { const int idx = tid + 512 * it, row = idx >> 4, ch = idx & 15; v4u raw = {0u, 0u, 0u, 0u};
            if (row < 144 && s0 + row >= 16) raw = __builtin_nontemporal_load((const v4u*)(PROJ + (size_t)(t0 + row - 16) * INW + 2 * AW + 128 * g + 8 * ch));
            if (it == 0) R.b0 = raw; else if (it == 1) R.b1 = raw; else if (it == 2) R.b2 = raw; else if (it == 3) R.b3 = raw; else R.b4 = raw; } }
}
__device__ __forceinline__ void p3_item(P3Regs& R, const int item, const int t0, const int s0, const int tid0, LAS unsigned char* lds, const LAS float* RC, const bf16* PROJ, bf16* MIXIN, const bf16* WSP, const bf16* WPOOL,
                                        const int wr, const int wc, const int fr, const int fq) {
    f32x4 acc[4][2];
            int tl = tid0; asm volatile("" : "+v"(tl));
            const int tid = tl;
            if (item < 4) { const int h = item;
#pragma unroll
                for (int it = 0; it < 4; ++it) { const int idx = tid + 512 * it, row = idx >> 4, ch = idx & 15;
                    *(LAS v4u*)(lds + P3_RA + row * P3_PA + ch * 16) = P3_RA_(R, it);
                    const v4u raw = P3_RB_(R, it);
                    float v[8]; v[0] = bf_lo(raw.x); v[1] = bf_hi(raw.x); v[2] = bf_lo(raw.y); v[3] = bf_hi(raw.y); v[4] = bf_lo(raw.z); v[5] = bf_hi(raw.z); v[6] = bf_lo(raw.w); v[7] = bf_hi(raw.w);
                    float s = 0.f;
#pragma unroll
                    for (int e = 0; e < 8; ++e) s += v[e] * v[e];
                    s += __shfl_xor(s, 1); s += __shfl_xor(s, 2); s += __shfl_xor(s, 4); s += __shfl_xor(s, 8);
                    const float rs = __builtin_amdgcn_rsqf(s * (1.0f / 128.0f) + EPS);
                    const f32x4 g0 = *(const LAS f32x4*)(RC + 128 * h + 8 * ch), g1 = *(const LAS f32x4*)(RC + 128 * h + 8 * ch + 4);
                    v2u w0, w1; w0.x = pk2(v[0] * rs * g0.x, v[1] * rs * g0.y); w0.y = pk2(v[2] * rs * g0.z, v[3] * rs * g0.w); w1.x = pk2(v[4] * rs * g1.x, v[5] * rs * g1.y); w1.y = pk2(v[6] * rs * g1.z, v[7] * rs * g1.w);
                    *(LAS v2u*)(lds + P3_RB + row * P3_PV + ch * 16) = w0; *(LAS v2u*)(lds + P3_RB + row * P3_PV + ch * 16 + 8) = w1; }
                __syncthreads();
                if (item + 2 < 8) p3_prefetch(R, item + 2, t0, s0, tid, PROJ, WSP, WPOOL);
                v2u ur[4][2]; float bias[4];
#pragma unroll
                for (int m = 0; m < 4; ++m) { const int i = 64 * wr + 16 * m + fr; bias[m] = RC[512 + 128 * h + i];
#pragma unroll
                    for (int n = 0; n < 2; ++n) ur[m][n] = *(const v2u*)(PROJ + (size_t)(t0 + i) * INW + 128 * h + 32 * wc + 16 * n + 4 * fq); }
                p3_mma(lds, true, acc, wr, wc, fr, fq);
#pragma unroll
                for (int m = 0; m < 4; ++m) { const int i = 64 * wr + 16 * m + fr;
#pragma unroll
                    for (int n = 0; n < 2; ++n) { const int c = 128 * h + 32 * wc + 16 * n + 4 * fq; const v2u u2 = ur[m][n]; const float bi = bias[m];
                        const f32x4 z = acc[m][n]; v2u w; w.x = pk2(bf_lo(u2.x) * (z[0] + bi), bf_hi(u2.x) * (z[1] + bi)); w.y = pk2(bf_lo(u2.y) * (z[2] + bi), bf_hi(u2.y) * (z[3] + bi));
                        *(v2u*)(MIXIN + (size_t)(t0 + i) * D + c) = w; } }
                __syncthreads();
            } else { const int g = item - 4, w = 2 << g;
#pragma unroll
                for (int it = 0; it < 4; ++it) { const int idx = tid + 512 * it, row = idx >> 4, ch = idx & 15; *(LAS v4u*)(lds + P3_RB + row * P3_PA + ch * 16) = P3_RA_(R, it); }
#pragma unroll
                for (int it = 0; it < 5; ++it) { const int idx = tid + 512 * it, row = idx >> 4, ch = idx & 15; if (row < 144) *(LAS v4u*)(lds + P3_RP + row * P3_PA + ch * 16) = P3_RB_(R, it); }
                __syncthreads();
                if (item + 2 < 8) p3_prefetch(R, item + 2, t0, s0, tid, PROJ, WSP, WPOOL);
                switch (g) { case 0: p3_pool<2>(lds, tid, s0); break; case 1: p3_pool<4>(lds, tid, s0); break; case 2: p3_pool<8>(lds, tid, s0); break; default: p3_pool<16>(lds, tid, s0); break; }
                __syncthreads();
                p3_mma(lds, false, acc, wr, wc, fr, fq);
#pragma unroll
                for (int m = 0; m < 4; ++m) { const int t = 64 * wr + 16 * m + fr;
#pragma unroll
                    for (int n = 0; n < 2; ++n) { const int d = 128 * g + 32 * wc + 16 * n + 4 * fq; const f32x4 ps = *(const LAS f32x4*)(RC + 1024 + d); const f32x4 y = acc[m][n] * ps;
                        v2u wv; wv.x = pk2(y[0], y[1]); wv.y = pk2(y[2], y[3]); *(v2u*)(MIXIN + (size_t)(t0 + t) * D + AW + d) = wv; } }
                __syncthreads();
            }
}
__device__ __forceinline__ void p3_mixers(const Args& a, LAS unsigned char* lds, int tid0, int rb) {
    const int lane = tid0 & 63, wave = tid0 >> 6, wr = wave >> 2, wc = wave & 3, fr = lane & 15, fq = lane >> 4;
    const bf16* PROJ = (const bf16*)(a.ws + WS_PROJ); bf16* MIXIN = (bf16*)(a.ws + WS_MIXIN);
    const bf16* WSP = (const bf16*)(a.ws + WS_WSP); const bf16* WPOOL = (const bf16*)(a.ws + WS_WPOOL);
    const float* sgug = a.in[I_SGUG]; const float* bsp = a.in[I_BSP]; const float* pscale = a.in[I_PSCALE];
    { LAS float* rc = (LAS float*)(lds + P3_RC); rc[tid0] = sgug[tid0]; rc[512 + tid0] = bsp[tid0]; rc[1024 + tid0] = pscale[tid0]; }
    __syncthreads();
    const LAS float* RC = (const LAS float*)(lds + P3_RC);
    for (int tb = rb; tb < M / 128; tb += gridDim.x) { const int t0 = tb * 128, s0 = t0 % SEQ;
        P3Regs R;
        p3_prefetch(R, 0, t0, s0, tid0, PROJ, WSP, WPOOL);
        P3Regs Rb;
        p3_prefetch(Rb, 1, t0, s0, tid0, PROJ, WSP, WPOOL);
        for (int it2 = 0; it2 < 4; ++it2) {
            p3_item(R, 2 * it2, t0, s0, tid0, lds, RC, PROJ, MIXIN, WSP, WPOOL, wr, wc, fr, fq);
            p3_item(Rb, 2 * it2 + 1, t0, s0, tid0, lds, RC, PROJ, MIXIN, WSP, WPOOL, wr, wc, fr, fq); } }
}

__device__ __forceinline__ void p4b_mid(const Args& a, int gw, int NGW, int lane) {
    const float* MOD = (const float*)(a.ws + OFF_MOD); const float* SS1 = (const float*)(a.ws + OFF_SS1); const bf16* MIXED = (const bf16*)(a.ws + WS_MIXED); bf16* XN = (bf16*)(a.ws + WS_XN);
    const float* x = a.in[I_X]; const float* pg = a.in[I_POSTMIXG]; const float* fg = a.in[I_PREFFNG]; bf16* X1B = (bf16*)(a.ws + WS_X1B);
    const int rpw = M / NGW;
    for (int r0 = gw * rpw; r0 < M; r0 += NGW * rpw) { const int b = r0 / SEQ; const float* mb = MOD + (size_t)b * NMOD;
        f32x4 A1[4], A2[4], A3[4];
#pragma unroll
        for (int j = 0; j < 4; ++j) { const int col = 4 * lane + 256 * j; A1[j] = *(const f32x4*)(mb + 2 * D + col) * *(const f32x4*)(pg + col);
            A2[j] = *(const f32x4*)(fg + col) * (1.0f + *(const f32x4*)(mb + 4 * D + col)); A3[j] = *(const f32x4*)(mb + 3 * D + col); }
        f32x4 nx[4]; v2u nm[4];
        { const f32x4* xr = (const f32x4*)(x + (size_t)r0 * D) + lane; const v2u* mr = (const v2u*)(MIXED + (size_t)r0 * D) + lane;
#pragma unroll
            for (int j = 0; j < 4; ++j) { nx[j] = __builtin_nontemporal_load(xr + 64 * j); nm[j] = __builtin_nontemporal_load(mr + 64 * j); } }
        const float ssv = (lane < rpw) ? SS1[r0 + lane] : 0.f;
        for (int r = r0; r < r0 + rpw; ++r) {
            const float rs1 = __builtin_amdgcn_rsqf(__builtin_bit_cast(float, __builtin_amdgcn_readlane(__builtin_bit_cast(int, ssv), r - r0)) * (1.0f / D) + EPS); f32x4 v[4]; float s = 0.f;
#pragma unroll
            for (int j = 0; j < 4; ++j) { const v2u mw = nm[j]; const f32x4 mx = {bf_lo(mw.x), bf_hi(mw.x), bf_lo(mw.y), bf_hi(mw.y)};
                v[j] = nx[j] + mx * rs1 * A1[j]; s += (v[j].x * v[j].x + v[j].y * v[j].y) + (v[j].z * v[j].z + v[j].w * v[j].w); }
            if (r + 1 < r0 + rpw) { const f32x4* xr = (const f32x4*)(x + (size_t)(r + 1) * D) + lane; const v2u* mr = (const v2u*)(MIXED + (size_t)(r + 1) * D) + lane;
#pragma unroll
                for (int j = 0; j < 4; ++j) { nx[j] = __builtin_nontemporal_load(xr + 64 * j); nm[j] = __builtin_nontemporal_load(mr + 64 * j); } }
            v2u* xrow = (v2u*)(X1B + (size_t)r * D) + lane;
#pragma unroll
            for (int j = 0; j < 4; ++j) { v2u w; w.x = pk2(v[j].x, v[j].y); w.y = pk2(v[j].z, v[j].w); __builtin_nontemporal_store(w, xrow + 64 * j); }
            const float rs = __builtin_amdgcn_rsqf(wave_sum(s) * (1.0f / D) + EPS);
            v2u* o = (v2u*)(XN + (size_t)r * D) + lane;
#pragma unroll
            for (int j = 0; j < 4; ++j) { const f32x4 h = v[j] * rs * A2[j] + A3[j]; const unsigned long long w = (unsigned long long)pk2(h.x, h.y) | ((unsigned long long)pk2(h.z, h.w) << 32);
                __hip_atomic_store((unsigned long long*)(o + 64 * j), w, __ATOMIC_RELAXED, __HIP_MEMORY_SCOPE_AGENT); } } }
}

__device__ __forceinline__ void p6b_fixup(const Args& a, int gw, int NGW, int lane) {
    const bf16* RAW = (const bf16*)(a.ws + WS_RAW); bf16* ACT = (bf16*)(a.ws + WS_ACT); const float* cw = a.in[I_CONVW]; const float* cb = a.in[I_CONVB];
    for (int it = 2 * gw; it < 2 * gw + 2; ++it) { const int q = it & 3, rr = (it >> 2) & 1, B = it >> 3; const int t = 64 * B + rr, s = t % SEQ;
        const bf16* cur = RAW + (size_t)(B * 4 + rr) * FF2;
        const bf16* p1 = (rr == 1) ? RAW + (size_t)(B * 4 + 0) * FF2 : (s == 0 ? nullptr : RAW + (size_t)((B - 1) * 4 + 3) * FF2);
        const bf16* p2 = (rr == 1) ? (s == 1 ? nullptr : RAW + (size_t)((B - 1) * 4 + 3) * FF2) : (s == 0 ? nullptr : RAW + (size_t)((B - 1) * 4 + 2) * FF2);
        for (int f = q * 704 + 4 * lane; f < q * 704 + 704; f += 256) { f32x4 y[2];
#pragma unroll
            for (int hv = 0; hv < 2; ++hv) { const int col = hv * FF + f; const f32x4 z = {0.f, 0.f, 0.f, 0.f};
                const v2u zz = {0u, 0u}; const v2u r0 = *(const v2u*)(cur + col), r1 = p1 ? *(const v2u*)(p1 + col) : zz, r2 = p2 ? *(const v2u*)(p2 + col) : zz; (void)z;
                const f32x4 u0 = {bf_lo(r0.x), bf_hi(r0.x), bf_lo(r0.y), bf_hi(r0.y)}, u1 = {bf_lo(r1.x), bf_hi(r1.x), bf_lo(r1.y), bf_hi(r1.y)}, u2 = {bf_lo(r2.x), bf_hi(r2.x), bf_lo(r2.y), bf_hi(r2.y)};
                y[hv] = *(const f32x4*)(cb + col) + *(const f32x4*)(cw + col) * u2 + *(const f32x4*)(cw + FF2 + col) * u1 + *(const f32x4*)(cw + 2 * FF2 + col) * u0; }
            v2u w; w.x = pk2(pg8::silu_f(y[0][0]) * y[1][0], pg8::silu_f(y[0][1]) * y[1][1]); w.y = pk2(pg8::silu_f(y[0][2]) * y[1][2], pg8::silu_f(y[0][3]) * y[1][3]);
            *(v2u*)(ACT + (size_t)t * FF + f) = w; } }
}

#define XB_TMO      128
#define XB_XCNT(j)  (256  + 64 * (j))
#define XB_XSUB(j)  (1280 + 64 * (j))
#define XB_XGEN(j)  (2304 + 64 * (j))
#define XB_TOP      3328
#define XB_TOPGEN   3392
#define XCD_BAR_WORDS 3456
#define XB_SPIN_CAP (1u << 18)

__device__ __forceinline__ unsigned xb_ld(unsigned* p)              { return __hip_atomic_load(p, __ATOMIC_RELAXED, __HIP_MEMORY_SCOPE_AGENT); }
__device__ __forceinline__ unsigned xb_add(unsigned* p, unsigned v) { return __hip_atomic_fetch_add(p, v, __ATOMIC_RELAXED, __HIP_MEMORY_SCOPE_AGENT); }
__device__ __forceinline__ unsigned xb_xcc_id() { return (unsigned)__builtin_amdgcn_s_getreg((3 << 11) | 20) & 0xFu; }
#define XB_SPIN(cond, bar) do { unsigned _sp = 0; while (cond) { __builtin_amdgcn_s_sleep(1); \
    if ((++_sp & 255u) == 0u) { if (xb_ld(&(bar)[XB_TMO])) break; if (_sp > XB_SPIN_CAP) { atomicAdd(&(bar)[XB_TMO], 1u); break; } } } } while (0)

struct XcdBarrier {
    unsigned* bar; unsigned x;
    volatile LAS unsigned* st;
};

__device__ __forceinline__ XcdBarrier xcd_barrier_post(unsigned* bar, volatile LAS unsigned* st) {
    XcdBarrier b; b.bar = bar; b.x = xb_xcc_id(); b.st = st;
    if (threadIdx.x == 0) st[2] = xb_add(&bar[XB_XCNT(b.x)], 1u);
    return b;
}
__device__ __forceinline__ void xcd_barrier_complete(unsigned* bar, unsigned x, unsigned& nloc, unsigned& nx) {
    const unsigned G = gridDim.x * gridDim.y * gridDim.z;
    unsigned sum, cnt, mine, sp = 0u;
    for (;;) {
        sum = 0u; cnt = 0u; mine = 0u;
#pragma unroll
        for (unsigned j = 0; j < 16; ++j) { const unsigned c = xb_ld(&bar[XB_XCNT(j)]); sum += c; cnt += (c > 0u) ? 1u : 0u; mine = (j == x) ? c : mine; }
        if (sum == G) break;
        __builtin_amdgcn_s_sleep(1);
        if ((++sp & 255u) == 0u) { if (xb_ld(&bar[XB_TMO])) break; if (sp > XB_SPIN_CAP) { atomicAdd(&bar[XB_TMO], 1u); break; } }
    }
    nloc = mine > 0u ? mine : 1u; nx = cnt > 0u ? cnt : 1u;
}

__device__ __forceinline__ void xcd_barrier(const XcdBarrier& b) {
    asm volatile("s_waitcnt vmcnt(0)" ::: "memory");
    __syncthreads();
    if (threadIdx.x == 0) {
        unsigned* bar = b.bar;
        __builtin_amdgcn_s_waitcnt(0);
        unsigned nloc = b.st[0], nx = b.st[1];
        if (nloc == 0u) { xcd_barrier_complete(bar, b.x, nloc, nx); b.st[0] = nloc; b.st[1] = nx; }
        const unsigned old = xb_add(&bar[XB_XSUB(b.x)], 1u);
        const unsigned gen = old / nloc;
        if (old + 1u == (gen + 1u) * nloc) {
            __builtin_amdgcn_fence(__ATOMIC_RELEASE, "agent");
            asm volatile("s_waitcnt vmcnt(0)" ::: "memory");
            const unsigned og = xb_add(&bar[XB_TOP], 1u);
            const unsigned tg = og / nx;
            if (og + 1u == (tg + 1u) * nx) xb_add(&bar[XB_TOPGEN], 1u);
            else XB_SPIN(xb_ld(&bar[XB_TOPGEN]) == tg, bar);
            __builtin_amdgcn_fence(__ATOMIC_ACQUIRE, "agent");
            xb_add(&bar[XB_XGEN(b.x)], 1u);
            asm volatile("s_waitcnt vmcnt(0)" ::: "memory");
        } else {
            XB_SPIN(xb_ld(&bar[XB_XGEN(b.x)]) == gen, bar);
            __builtin_amdgcn_fence(__ATOMIC_ACQUIRE, "agent");
            asm volatile("s_waitcnt vmcnt(0)" ::: "memory");
        }
    }
    __syncthreads();
}
#define XL_SUB(j)  (4096 + 64 * (j))
#define XL_GEN(j)  (5120 + 64 * (j))
__device__ __forceinline__ void xcd_local_barrier(const XcdBarrier& b) {
    asm volatile("s_waitcnt vmcnt(0)" ::: "memory");
    __syncthreads();
    if (threadIdx.x == 0) { unsigned* bar = b.bar; const unsigned nloc = b.st[0];
        const unsigned old = xb_add(&bar[XL_SUB(b.x)], 1u); const unsigned gen = old / nloc;
        if (old + 1u == (gen + 1u) * nloc) xb_add(&bar[XL_GEN(b.x)], 1u);
        else XB_SPIN(xb_ld(&bar[XL_GEN(b.x)]) == gen, bar);
        __builtin_amdgcn_fence(__ATOMIC_ACQUIRE, "agent");
        asm volatile("s_waitcnt vmcnt(0)" ::: "memory"); }
    __syncthreads();
}
__global__ void __launch_bounds__(NWAVES * 64, 2) mk_fwd(Args args) {
    extern __shared__ __attribute__((aligned(16))) unsigned char lds_raw[];
    LAS unsigned char* lds = (LAS unsigned char*)lds_raw;
    const int tid = threadIdx.x, lane = tid & 63, wave = __builtin_amdgcn_readfirstlane(tid >> 6);
    const int G = gridDim.x, gw = blockIdx.x * NWAVES + wave, NGW = G * NWAVES;
    const int lo = args.ph_lo, hi = args.ph_hi;
    unsigned char* ws = args.ws;
    if (tid < 64) ((LAS unsigned*)(lds + LDSCTL_OFF))[tid] = 0u;
    __syncthreads();
    XcdBarrier bar = xcd_barrier_post((unsigned*)(ws + OFF_BAR), (volatile LAS unsigned*)(lds + LDSCTL_OFF) + 8);
#define IN(k) (lo <= (k) && (k) < hi)
#define NREP(k) ((MK_REPEAT == (k) || ((k) == 4 && (MK_REPEAT == 41 || MK_REPEAT == 42))) ? 2 : 1)
#define SEAM(k) do { if (IN(k) && IN((k) + 1)) xcd_barrier(bar); } while (0)
    if (lo < 0) cg::this_grid().sync();
    if (IN(0)) { p0_prologue(args, lds, gw, NGW, lane, wave, true, true); }
    SEAM(0);
    int cvirt = (int)blockIdx.x; bool xlocal = false;
    if (lo == 0 && hi > 2 && (G & 7) == 0) { bool even = true;
#pragma unroll
        for (int j = 0; j < 16; ++j) { const unsigned cj = xb_ld(&bar.bar[XB_XCNT(j)]); even = even && (cj == (j < 8 ? (unsigned)(G >> 3) : 0u)); }
        if (even && bar.x < 8u) { cvirt = (int)(bar.st[2] * 8u + bar.x); xlocal = true; } }
    cvirt = __builtin_amdgcn_readfirstlane(cvirt);
    const int rb = xlocal ? (cvirt & 7) * (G >> 3) + (cvirt >> 3) : (int)blockIdx.x;
#define LSEAM() do { if (xlocal) xcd_local_barrier(bar); else xcd_barrier(bar); } while (0)
    if (IN(1)) { for (int rep = 0; rep < NREP(1); ++rep) { if (rep) xcd_barrier(bar); p1_norm(args, rb * NWAVES + wave, NGW, lane); } }
    if (IN(1) && IN(2)) LSEAM();
    if (IN(2)) { pg8::Gemm g{(const bf16*)(ws + WS_XN), (const bf16*)(ws + WS_WIN), M, INW, D}; pg8::StaticOrder S; S.init(M, INW, G, cvirt);
        pg8::EpiProj E{(bf16*)(ws + WS_PROJ), INW};
        for (int rep = 0; rep < NREP(2); ++rep) { if (rep) xcd_barrier(bar); pg8::gemm_phase<pg8::EpiProj, pg8::StaticOrder, true, true>(lds, g, S, E); } }
    SEAM(2);
    if (IN(3)) { for (int rep = 0; rep < NREP(3); ++rep) { if (rep) xcd_barrier(bar); __syncthreads(); p3_mixers(args, lds, tid, rb); } }
    if (IN(3) && IN(4)) LSEAM();
    if (IN(4)) { pg8::Gemm g{(const bf16*)(ws + WS_MIXIN), (const bf16*)(ws + WS_WOUT), M, D, D}; pg8::StaticOrder S; S.init(M, D, G, cvirt);
        pg8::EpiBf16SS E{(bf16*)(ws + WS_MIXED), D, (float*)(ws + OFF_SS1)};
        pg8::gemm_phase<pg8::EpiBf16SS, pg8::StaticOrder, true, true>(lds, g, S, E);
        LSEAM();
        p4b_mid(args, rb * NWAVES + wave, NGW, lane); }
    if (IN(4) && IN(5)) LSEAM();
    if (IN(5)) { pg8::Gemm g{(const bf16*)(ws + WS_XN), (const bf16*)(ws + WS_WUP), M, FF2, D}; pg8::StaticOrder S; S.init(M, FF2, G, cvirt);
        pg8::EpiConv E{(bf16*)(ws + WS_ACT), (bf16*)(ws + WS_RAW), args.in[I_CONVW], args.in[I_CONVB], FF, lds + LDSCTL_OFF + 4096};
        for (int rep = 0; rep < NREP(5); ++rep) { if (rep) xcd_barrier(bar); pg8::gemm_phase<pg8::EpiConv, pg8::StaticOrder, true, true>(lds, g, S, E); } }
    SEAM(5);
    if (IN(6)) { p6b_fixup(args, rb * NWAVES + wave, NGW, lane); }
    if (IN(6) && IN(7)) LSEAM();
    if (IN(7)) { pg8::Gemm g{(const bf16*)(ws + WS_ACT), (const bf16*)(ws + WS_WDOWN), M, D, FF}; pg8::StaticOrder S; S.init(M, D, G, cvirt);
        for (int rep = 0; rep < NREP(7); ++rep) { if (rep) xcd_barrier(bar);
        pg8::RowStat st{(float*)(ws + (rep ? 736 * 1024 : OFF_SS4)), (unsigned*)(ws + (rep ? 640 * 1024 : OFF_CNT + 32768)), 32u, 1.0f / D, EPS};
        pg8::EpiFinal E{(const bf16*)(ws + WS_X1B), rep ? (float*)(ws + WS_F) : args.out, (const float*)(ws + OFF_MOD), args.in[I_POSTFFNG], st, D, SEQ / 256};
        pg8::gemm_phase<pg8::EpiFinal, pg8::StaticOrder, true, true>(lds, g, S, E); } }
    if (MK_REPEAT == 17 && IN(7)) { xcd_barrier(bar); pg8::Gemm g{(const bf16*)(ws + WS_ACT), (const bf16*)(ws + WS_WDOWN), M, D, FF}; pg8::StaticOrder S; S.init(M, D, G, (int)blockIdx.x);
        pg8::EpiSink E{(float*)(ws + WS_F)}; pg8::gemm_phase<pg8::EpiSink, pg8::StaticOrder, true, true>(lds, g, S, E); }
#undef IN
#undef SEAM
}

constexpr int N_PHASES = 8;
extern "C" void kernel_launch(void* const* d_in, const int* in_sizes, int n_in, void* d_out, int out_size, void* d_ws, size_t ws_size, hipStream_t stream) {
    static int grid = 0;
    if (grid == 0) {
        if (n_in != 19 || in_sizes[0] != M * D || out_size != M * D || ws_size < WS_END) { fprintf(stderr, "kernel_launch: unexpected shapes (n_in %d, in0 %d, out %d, ws %zu)\n", n_in, n_in > 0 ? in_sizes[0] : -1, out_size, ws_size); grid = -1; return; }
        int dev = 0, cus = 0, per_cu = 0;
        (void)hipGetDevice(&dev); (void)hipDeviceGetAttribute(&cus, hipDeviceAttributeMultiprocessorCount, dev);
        if (hipFuncSetAttribute((const void*)mk_fwd, hipFuncAttributeMaxDynamicSharedMemorySize, LDS_BYTES) != hipSuccess) { fprintf(stderr, "kernel_launch: hipFuncSetAttribute failed\n"); grid = -1; return; }
        if (hipOccupancyMaxActiveBlocksPerMultiprocessor(&per_cu, (const void*)mk_fwd, NWAVES * 64, LDS_BYTES) != hipSuccess || per_cu < 1) { fprintf(stderr, "kernel_launch: occupancy query says %d blocks per CU\n", per_cu); per_cu = 1; }
        (void)hipGetLastError();
        grid = cus > 0 ? cus : 256;
    }
    if (grid < 0) return;
    (void)hipMemsetAsync((char*)d_ws + WS_CTL, 0, CTL_ZERO_BYTES, stream);
    Args a{};
    for (int i = 0; i < 19; ++i) a.in[i] = (const float*)d_in[i];
    a.out = (float*)d_out; a.ws = (unsigned char*)d_ws;
#if MK_N_LAUNCHES == 1
    a.ph_lo = 0; a.ph_hi = N_PHASES;
    void* kargs[] = {&a};
    hipError_t e = hipLaunchCooperativeKernel((const void*)mk_fwd, dim3(grid), dim3(NWAVES * 64), kargs, LDS_BYTES, stream);
    if (e != hipSuccess) fprintf(stderr, "kernel_launch: cooperative launch failed: %s (grid %d)\n", hipGetErrorString(e), grid);
#else
    for (int p = 0; p < N_PHASES; ++p) { a.ph_lo = p; a.ph_hi = p + 1; hipLaunchKernelGGL(mk_fwd, dim3(grid), dim3(NWAVES * 64), LDS_BYTES, stream, a); }
#endif
}
```

```cpp
#include <hip/hip_runtime.h>
#include <hip/hip_cooperative_groups.h>
#include <cstdio>
#include <cstdint>
namespace cg = cooperative_groups;
#ifndef MK_N_LAUNCHES
#define MK_N_LAUNCHES 1
#endif
#ifndef MK_REPEAT
#define MK_REPEAT -1
#endif
namespace pg8 {
#define PG8_LAS __attribute__((address_space(3)))
typedef unsigned short bf16_t;
typedef short bf16x8 __attribute__((ext_vector_type(8)));
typedef float f32x4 __attribute__((ext_vector_type(4)));
typedef unsigned u32x4 __attribute__((ext_vector_type(4)));
constexpr int BM = 256, BK = 64, HALF = 128, HTB = HALF * BK * 2  , STAGE_BYTES = 8 * HTB, NXCD = 8, WGM = 8;

__host__ __device__ __forceinline__ int lds_byte(int r, int c) { const int st = (r >> 4) * 2 + (c >> 5), rr = r & 15, cc = c & 31, ob = rr * 64 + cc * 2; return st * 1024 + (ob ^ (((ob >> 9) & 1) << 5)); }
__host__ __device__ __forceinline__ void stage_rc(int b, int& R, int& C) { const int st = b / 1024, sb = b % 1024, swz = sb ^ (((sb >> 9) & 1) << 5); R = (st >> 1) * 16 + swz / 64; C = (st & 1) * 32 + (swz % 64) / 2; }
__host__ __device__ __forceinline__ int perm32(int rho) { const int n = rho >> 4, i = rho & 15; return 8 * (i >> 2) + 4 * n + (i & 3); }

struct Unit { int pm, pn; };
struct Gemm { const bf16_t* A; const bf16_t* Bt; int M, N, K; };

struct StaticOrder {
    int nM, nN, nwg, G, c;
    __host__ __device__ void init(int M, int N, int G_, int c_) { nM = M / BM; nN = N / BM; nwg = nM * nN; G = G_; c = c_; }
    __host__ __device__ bool next(int i, Unit& u) const {
        const long L = (long)i * G + c; if (L >= nwg) return false;
        int wgid = (int)L; { const int q = nwg / NXCD, r = nwg % NXCD, xcd = wgid % NXCD, off = wgid / NXCD; wgid = (xcd < r ? xcd * (q + 1) : r * (q + 1) + (xcd - r) * q) + off; }
        const int nig = WGM * nN, gid = wgid / nig, fm = gid * WGM, gsz = (nM - fm) < WGM ? (nM - fm) : WGM;
        u.pm = fm + ((wgid % nig) % gsz); u.pn = (wgid % nig) / gsz; return true;
    }
    __device__ __forceinline__ void a_ready(const Unit&) const {}
    __device__ __forceinline__ void done(const Unit&) const {}
};

__device__ __forceinline__ unsigned cvt_pk_bf16(float lo, float hi) { unsigned r; asm volatile("v_cvt_pk_bf16_f32 %0, %1, %2" : "=v"(r) : "v"(lo), "v"(hi)); return r; }
typedef float f32x2 __attribute__((ext_vector_type(2)));
typedef unsigned u32x2 __attribute__((ext_vector_type(2)));
__device__ __forceinline__ float fast_sigmoid_arg2(float p) { return __builtin_amdgcn_rcpf(1.0f + __builtin_amdgcn_exp2f(p)); }
__device__ __forceinline__ float gelu_tanh(float x) {
    const float t = x * x; const float p = x * (-2.302208198f + (-0.1029432397f) * t); return x * fast_sigmoid_arg2(p);
}
__device__ __forceinline__ float silu_f(float x) { return x * fast_sigmoid_arg2(x * (-1.4426950409f)); }
__device__ __forceinline__ float dpp_ror1(float x) { return __builtin_bit_cast(float, __builtin_amdgcn_update_dpp(0, __builtin_bit_cast(int, x), 0x121, 0xf, 0xf, false)); }
__device__ __forceinline__ float dpp_ror2(float x) { return __builtin_bit_cast(float, __builtin_amdgcn_update_dpp(0, __builtin_bit_cast(int, x), 0x122, 0xf, 0xf, false)); }

struct EpiProj {
    static constexpr bool PERM = true, AFTER_DRAIN = false, PERMA = false, HAS_PRE = false;
    bf16_t* O; int ldc;
    __device__ __forceinline__ void operator()(const f32x4 (&acc)[2][2][4][2], const Unit& u, int wr, int wc, int fr, int fq) const {
        const int row0 = u.pm * BM + wr * 64 + fr, col0 = u.pn * BM + wc * 32 + 8 * fq; const bool act = u.pn < 4; const bool edge = !act && (u.pm & 15) == 15 && wr == 1;
#pragma unroll
        for (int ai = 0; ai < 2; ++ai)
#pragma unroll
            for (int m = 0; m < 4; ++m) { bf16_t* rowp = O + (size_t)(row0 + ai * HALF + m * 16) * ldc + col0;
#pragma unroll
                for (int bj = 0; bj < 2; ++bj) { f32x4 v0 = acc[ai][bj][m][0], v1 = acc[ai][bj][m][1];
                    if (act) {
#pragma unroll
                        for (int j = 0; j < 4; ++j) { v0[j] = gelu_tanh(v0[j]); v1[j] = gelu_tanh(v1[j]); } }
                    u32x4 w; w.x = cvt_pk_bf16(v0[0], v0[1]); w.y = cvt_pk_bf16(v0[2], v0[3]); w.z = cvt_pk_bf16(v1[0], v1[1]); w.w = cvt_pk_bf16(v1[2], v1[3]);
                    if (edge && ai == 1 && m == 3) {
                        __hip_atomic_store((unsigned long long*)(rowp + bj * HALF), (unsigned long long)w.x | ((unsigned long long)w.y << 32), __ATOMIC_RELAXED, __HIP_MEMORY_SCOPE_AGENT);
                        __hip_atomic_store((unsigned long long*)(rowp + bj * HALF + 4), (unsigned long long)w.z | ((unsigned long long)w.w << 32), __ATOMIC_RELAXED, __HIP_MEMORY_SCOPE_AGENT); }
                    else *(u32x4*)(rowp + bj * HALF) = w; } }
    }
};

struct EpiF32SS {
    static constexpr bool PERM = false, AFTER_DRAIN = false, PERMA = false, HAS_PRE = false;
    float* O; int ldc; float* ss;
    __device__ __forceinline__ void operator()(const f32x4 (&acc)[2][2][4][2], const Unit& u, int wr, int wc, int fr, int fq) const {
        const int row0 = u.pm * BM + wr * 64 + fr, col0 = u.pn * BM + wc * 32 + 4 * fq;
#pragma unroll
        for (int ai = 0; ai < 2; ++ai)
#pragma unroll
            for (int m = 0; m < 4; ++m) { const int row = row0 + ai * HALF + m * 16; float* rowp = O + (size_t)row * ldc + col0; float s = 0.f;
#pragma unroll
                for (int bj = 0; bj < 2; ++bj)
#pragma unroll
                    for (int n = 0; n < 2; ++n) { const f32x4 x = acc[ai][bj][m][n]; s += (x[0] * x[0] + x[1] * x[1]) + (x[2] * x[2] + x[3] * x[3]); *(f32x4*)(rowp + bj * HALF + n * 16) = x; }
                s += __shfl_xor(s, 16); s += __shfl_xor(s, 32);
                if (fq == 0) atomicAdd(ss + row, s); }
    }
};

struct EpiBf16SS {
    static constexpr bool PERM = true, AFTER_DRAIN = false, PERMA = false, HAS_PRE = false;
    bf16_t* O; int ldc; float* ss;
    __device__ __forceinline__ void operator()(const f32x4 (&acc)[2][2][4][2], const Unit& u, int wr, int wc, int fr, int fq) const {
        const int row0 = u.pm * BM + wr * 64 + fr, col0 = u.pn * BM + wc * 32 + 8 * fq;
#pragma unroll
        for (int ai = 0; ai < 2; ++ai)
#pragma unroll
            for (int m = 0; m < 4; ++m) { const int row = row0 + ai * HALF + m * 16; bf16_t* rowp = O + (size_t)row * ldc + col0; float s = 0.f;
#pragma unroll
                for (int bj = 0; bj < 2; ++bj) { const f32x4 v0 = acc[ai][bj][m][0], v1 = acc[ai][bj][m][1];
                    s += ((v0[0] * v0[0] + v0[1] * v0[1]) + (v0[2] * v0[2] + v0[3] * v0[3])) + ((v1[0] * v1[0] + v1[1] * v1[1]) + (v1[2] * v1[2] + v1[3] * v1[3]));
                    u32x4 w; w.x = cvt_pk_bf16(v0[0], v0[1]); w.y = cvt_pk_bf16(v0[2], v0[3]); w.z = cvt_pk_bf16(v1[0], v1[1]); w.w = cvt_pk_bf16(v1[2], v1[3]);
                    *(u32x4*)(rowp + bj * HALF) = w; }
                s += __shfl_xor(s, 16); s += __shfl_xor(s, 32);
                if (fq == 0) atomicAdd(ss + row, s); }
    }
};

__device__ __forceinline__ float dpp_shr1(float x) { return __builtin_bit_cast(float, __builtin_amdgcn_update_dpp(0, __builtin_bit_cast(int, x), 0x111, 0xf, 0xf, true)); }
struct EpiConv {
    static constexpr bool PERM = true, AFTER_DRAIN = false, PERMA = true, HAS_PRE = true;
    bf16_t* ACT; bf16_t* RAW; const float* cw; const float* cb; int FF; PG8_LAS unsigned char* CB;
    __device__ __forceinline__ void pre(const Unit& u, int par) const {
        const int tid = threadIdx.x, w = __builtin_amdgcn_readfirstlane(tid >> 6), l = tid & 63;
        if (w < 4) { const int vec = 2 * w + (l >> 5), k = vec & 3, hv = vec >> 2; const float* src = (k < 3 ? cw + (size_t)k * 2 * FF : cb) + hv * FF + u.pn * HALF + (l & 31) * 4;
            __builtin_amdgcn_global_load_lds((const unsigned*)src, (PG8_LAS unsigned*)(CB + par * 4096 + w * 1024), 16, 0, 0); }
    }
    __device__ __forceinline__ void run(const f32x4 (&acc)[2][2][4][2], const Unit& u, int wr, int wc, int fr, int fq, int par) const {
        const int f0 = u.pn * HALF + wc * 32 + 8 * fq; const int rowt = u.pm * BM + wr * 64 + 4 * fr; const int FF2 = 2 * FF;
        const PG8_LAS float* cbuf = (const PG8_LAS float*)(CB + par * 4096) + wc * 32 + 8 * fq;
        unsigned stash[2][4][2];
#pragma unroll
        for (int n = 0; n < 2; ++n) { const int f = f0 + 4 * n; const PG8_LAS float* cn = cbuf + 4 * n;
            const f32x4 w0g = *(const PG8_LAS f32x4*)(cn), w1g = *(const PG8_LAS f32x4*)(cn + 128), w2g = *(const PG8_LAS f32x4*)(cn + 256), bg = *(const PG8_LAS f32x4*)(cn + 384);
            const f32x4 w0v = *(const PG8_LAS f32x4*)(cn + 512), w1v = *(const PG8_LAS f32x4*)(cn + 640), w2v = *(const PG8_LAS f32x4*)(cn + 768), bv = *(const PG8_LAS f32x4*)(cn + 896);
#pragma unroll
            for (int ai = 0; ai < 2; ++ai) {
                f32x4 gm1, gm2, vm1, vm2;
#pragma unroll
                for (int j = 0; j < 4; ++j) { gm1[j] = dpp_shr1(acc[ai][0][3][n][j]); gm2[j] = dpp_shr1(acc[ai][0][2][n][j]); vm1[j] = dpp_shr1(acc[ai][1][3][n][j]); vm2[j] = dpp_shr1(acc[ai][1][2][n][j]); }
#pragma unroll
                for (int m = 0; m < 4; ++m) { const f32x4 g = acc[ai][0][m][n], v = acc[ai][1][m][n];
                    const f32x4 pg1 = (m == 0) ? gm1 : acc[ai][0][m > 0 ? m - 1 : 0][n], pg2 = (m == 0) ? gm2 : (m == 1 ? gm1 : acc[ai][0][m > 1 ? m - 2 : 0][n]);
                    const f32x4 pv1 = (m == 0) ? vm1 : acc[ai][1][m > 0 ? m - 1 : 0][n], pv2 = (m == 0) ? vm2 : (m == 1 ? vm1 : acc[ai][1][m > 1 ? m - 2 : 0][n]);
                    const f32x4 yg = bg + w0g * pg2 + w1g * pg1 + w2g * g, yv = bv + w0v * pv2 + w1v * pv1 + w2v * v; f32x4 a;
#pragma unroll
                    for (int j = 0; j < 4; ++j) a[j] = silu_f(yg[j]) * yv[j];
                    const unsigned lo = cvt_pk_bf16(a[0], a[1]), hi = cvt_pk_bf16(a[2], a[3]);
                    if (n == 0) { stash[ai][m][0] = lo; stash[ai][m][1] = hi; }
                    else if (!(m < 2 && fr == 0)) { u32x4 w; w.x = stash[ai][m][0]; w.y = stash[ai][m][1]; w.z = lo; w.w = hi; __builtin_nontemporal_store(w, (u32x4*)(ACT + (size_t)(rowt + ai * HALF + m) * FF + f0)); }
                    if ((m < 2 && fr == 0) || (m >= 2 && fr == 15)) { bf16_t* rp = RAW + ((size_t)((u.pm * 4 + ai * 2 + wr) * 4 + m)) * FF2 + f;
                        u32x2 gw, vw; gw.x = cvt_pk_bf16(g[0], g[1]); gw.y = cvt_pk_bf16(g[2], g[3]); vw.x = cvt_pk_bf16(v[0], v[1]); vw.y = cvt_pk_bf16(v[2], v[3]);
                        *(u32x2*)rp = gw; *(u32x2*)(rp + FF) = vw; } } } }
    }
};

struct RowStat {
    float* ss; unsigned* cnt; unsigned want; float inv_n, eps;
    __device__ __forceinline__ void run(const float (&part)[2][4], float (&rs)[2][4], const Unit& u, int wr, int fr, int fq) const {
        const int row0 = u.pm * BM + wr * 64 + fr; const int lane = fq * 16 + fr;
#pragma unroll
        for (int ai = 0; ai < 2; ++ai)
#pragma unroll
            for (int m = 0; m < 4; ++m) { float s = part[ai][m]; s += __shfl_xor(s, 16); s += __shfl_xor(s, 32); if (fq == 0) atomicAdd(ss + row0 + ai * HALF + m * 16, s); }
        asm volatile("s_waitcnt vmcnt(0)" ::: "memory");
        unsigned* c = cnt + 64 * u.pm;
        if (lane == 0) __hip_atomic_fetch_add(c, 1u, __ATOMIC_RELAXED, __HIP_MEMORY_SCOPE_AGENT);
        if (threadIdx.x < 64) { unsigned sp = 0;
            while ((unsigned)__builtin_amdgcn_readfirstlane(__hip_atomic_load(c, __ATOMIC_RELAXED, __HIP_MEMORY_SCOPE_AGENT)) < want) { __builtin_amdgcn_s_sleep(1); if (++sp > (1u << 22)) break; } }
        asm volatile("s_waitcnt vmcnt(0) lgkmcnt(0)" ::: "memory"); __builtin_amdgcn_s_barrier(); asm volatile("" ::: "memory");
#pragma unroll
        for (int ai = 0; ai < 2; ++ai)
#pragma unroll
            for (int m = 0; m < 4; ++m) { const float v = __hip_atomic_load(ss + row0 + ai * HALF + m * 16, __ATOMIC_RELAXED, __HIP_MEMORY_SCOPE_AGENT); rs[ai][m] = __builtin_amdgcn_rsqf(v * inv_n + eps); }
    }
};
template <int VAR = 0  > struct EpiMid {
    static constexpr bool PERM = false, AFTER_DRAIN = false, PERMA = false, HAS_PRE = false;
    const float* x; float* x1; bf16_t* xn; const float* mod; const float* post_g; const float* ffn_g; const float* sxx; float* ss1; float* ssxm; float* ssmm; unsigned* cnt; PG8_LAS float* A23; int ld, tiles_per_batch;
    __device__ __forceinline__ void operator()(f32x4 (&acc)[2][2][4][2], const Unit& u, int wr, int wc, int fr, int fq) const {
        const int col0 = u.pn * BM + wc * 32 + 4 * fq; const float* mb = mod + (size_t)(u.pm / tiles_per_batch) * (6 * ld); const int tid = threadIdx.x;
        const unsigned voff = (unsigned)((wr * 64 + fr) * ld + col0) * 4u;
        const size_t pbase = (size_t)u.pm * BM * ld; const int row0 = u.pm * BM + wr * 64 + fr;
        if (tid < 256) { const int c = u.pn * BM + tid; A23[tid] = mb[2 * ld + c] * post_g[c]; A23[256 + tid] = ffn_g[c] * (1.0f + mb[4 * ld + c]); A23[512 + tid] = mb[3 * ld + c]; }
        asm volatile("s_waitcnt vmcnt(0) lgkmcnt(0)" ::: "memory"); __builtin_amdgcn_s_barrier(); asm volatile("" ::: "memory");
        const PG8_LAS float* As = A23 + wc * 32 + 4 * fq;
#pragma unroll
        for (int ai = 0; ai < 2; ++ai)
#pragma unroll
            for (int m = 0; m < 4; ++m) { const char* xb = (const char*)(x + pbase + (size_t)(ai * HALF + m * 16) * ld); f32x4 s1 = {0.f, 0.f, 0.f, 0.f}, sx = s1, sm = s1;
#pragma unroll
                for (int bj = 0; bj < 2; ++bj)
#pragma unroll
                    for (int n = 0; n < 2; ++n) { const unsigned o = voff + (unsigned)(bj * HALF + n * 16) * 4u; const f32x4 xv = (VAR == 1) ? (f32x4){1.f, 1.f, 1.f, 1.f} : *(const f32x4*)(xb + o); const f32x4 mx = acc[ai][bj][m][n], cm = mx * *(const PG8_LAS f32x4*)(As + bj * HALF + n * 16);
                        s1 += mx * mx; sx += xv * cm; sm += cm * cm; }
                float a = (s1[0] + s1[1]) + (s1[2] + s1[3]), b = (sx[0] + sx[1]) + (sx[2] + sx[3]), c = (sm[0] + sm[1]) + (sm[2] + sm[3]);
                a += __shfl_xor(a, 16); a += __shfl_xor(a, 32); b += __shfl_xor(b, 16); b += __shfl_xor(b, 32); c += __shfl_xor(c, 16); c += __shfl_xor(c, 32);
                if (fq == 0) { const int r = row0 + ai * HALF + m * 16; atomicAdd(ss1 + r, a); atomicAdd(ssxm + r, b); atomicAdd(ssmm + r, c); }
                if (m == 3) asm volatile("" ::: "memory"); }
        asm volatile("s_waitcnt vmcnt(0)" ::: "memory");
        unsigned* cw = cnt + 64 * u.pm;
        if ((tid & 63) == 0) __hip_atomic_fetch_add(cw, 1u, __ATOMIC_RELAXED, __HIP_MEMORY_SCOPE_AGENT);
        if (tid < 64) { unsigned sp = 0;
            while ((unsigned)__builtin_amdgcn_readfirstlane(__hip_atomic_load(cw, __ATOMIC_RELAXED, __HIP_MEMORY_SCOPE_AGENT)) < 32u) { __builtin_amdgcn_s_sleep(1); if (++sp > (1u << 22)) break; } }
        asm volatile("s_waitcnt vmcnt(0) lgkmcnt(0)" ::: "memory"); __builtin_amdgcn_s_barrier(); asm volatile("" ::: "memory");
        const float inv_n = 1.0f / (float)ld; float rs1[2][4], rs2[2][4];
#pragma unroll
        for (int ai = 0; ai < 2; ++ai)
#pragma unroll
            for (int m = 0; m < 4; ++m) { const int r = row0 + ai * HALF + m * 16;
                const float S1 = __hip_atomic_load(ss1 + r, __ATOMIC_RELAXED, __HIP_MEMORY_SCOPE_AGENT), Sxm = __hip_atomic_load(ssxm + r, __ATOMIC_RELAXED, __HIP_MEMORY_SCOPE_AGENT), Smm = __hip_atomic_load(ssmm + r, __ATOMIC_RELAXED, __HIP_MEMORY_SCOPE_AGENT);
                const float r1 = __builtin_amdgcn_rsqf(S1 * inv_n + 1e-6f); rs1[ai][m] = r1;
                const float s2 = sxx[r] + 2.0f * r1 * Sxm + r1 * r1 * Smm; rs2[ai][m] = __builtin_amdgcn_rsqf(s2 * inv_n + 1e-6f); }
        if (VAR != 0) { if (rs1[0][0] + rs2[1][3] + rs1[1][2] + rs2[0][1] == 1.2345e33f) x1[row0] = rs1[0][1]; return; }
#pragma unroll
        for (int ai = 0; ai < 2; ++ai)
#pragma unroll
            for (int m = 0; m < 4; ++m) { const size_t gb = pbase + (size_t)(ai * HALF + m * 16) * ld; const char* xb = (const char*)(x + gb); char* ob = (char*)(x1 + gb); char* nb = (char*)(xn + gb);
#pragma unroll
                for (int bj = 0; bj < 2; ++bj)
#pragma unroll
                    for (int n = 0; n < 2; ++n) { const unsigned o = voff + (unsigned)(bj * HALF + n * 16) * 4u; const f32x4 xv = *(const f32x4*)(xb + o);
                        const f32x4 v = xv + acc[ai][bj][m][n] * rs1[ai][m] * *(const PG8_LAS f32x4*)(As + bj * HALF + n * 16);
                        *(f32x4*)(ob + o) = v;
                        const f32x4 a2 = *(const PG8_LAS f32x4*)(As + 256 + bj * HALF + n * 16), a3 = *(const PG8_LAS f32x4*)(As + 512 + bj * HALF + n * 16); const f32x4 h = v * rs2[ai][m] * a2 + a3;
                        u32x2 wv; wv.x = cvt_pk_bf16(h[0], h[1]); wv.y = cvt_pk_bf16(h[2], h[3]); *(u32x2*)(nb + (o >> 1)) = wv; }
                if (m == 3) asm volatile("" ::: "memory"); }
    }
};
struct EpiFinal {
    static constexpr bool PERM = false, AFTER_DRAIN = false, PERMA = false, HAS_PRE = false;
    const bf16_t* src; float* out; const float* mod; const float* post_g; RowStat st; int ld, tiles_per_batch;
    __device__ __forceinline__ void operator()(f32x4 (&acc)[2][2][4][2], const Unit& u, int wr, int wc, int fr, int fq) const {
        const int col0 = u.pn * BM + wc * 32 + 4 * fq; const float* mb = mod + (size_t)(u.pm / tiles_per_batch) * (6 * ld);
        const unsigned voff = (unsigned)((wr * 64 + fr) * ld + col0) * 4u, cvo = (unsigned)col0 * 4u; const size_t pbase = (size_t)u.pm * BM * ld;
        float part[2][4], rs[2][4];
#pragma unroll
        for (int ai = 0; ai < 2; ++ai)
#pragma unroll
            for (int m = 0; m < 4; ++m) { float s = 0.f;
#pragma unroll
                for (int bj = 0; bj < 2; ++bj)
#pragma unroll
                    for (int n = 0; n < 2; ++n) { const f32x4 v = acc[ai][bj][m][n]; s += (v[0] * v[0] + v[1] * v[1]) + (v[2] * v[2] + v[3] * v[3]); }
                part[ai][m] = s; }
        u32x2 xpre[2][4][2][2];
#pragma unroll
        for (int ai = 0; ai < 2; ++ai)
#pragma unroll
            for (int m = 0; m < 4; ++m) { const char* sb = (const char*)(src + pbase + (size_t)(ai * HALF + m * 16) * ld);
#pragma unroll
                for (int bj = 0; bj < 2; ++bj)
#pragma unroll
                    for (int n = 0; n < 2; ++n) xpre[ai][m][bj][n] = *(const u32x2*)(sb + ((voff + (unsigned)(bj * HALF + n * 16) * 4u) >> 1)); }
        st.run(part, rs, u, wr, fr, fq);
        f32x4 A1[2][2];
#pragma unroll
        for (int bj = 0; bj < 2; ++bj)
#pragma unroll
            for (int n = 0; n < 2; ++n) { const unsigned co = cvo + (unsigned)(bj * HALF + n * 16) * 4u; A1[bj][n] = *(const f32x4*)((const char*)(mb + 5 * ld) + co) * *(const f32x4*)((const char*)post_g + co); }
#pragma unroll
        for (int ai = 0; ai < 2; ++ai)
#pragma unroll
            for (int m = 0; m < 4; ++m) { char* ob = (char*)(out + pbase + (size_t)(ai * HALF + m * 16) * ld);
#pragma unroll
                for (int bj = 0; bj < 2; ++bj)
#pragma unroll
                    for (int n = 0; n < 2; ++n) { const unsigned o = voff + (unsigned)(bj * HALF + n * 16) * 4u; const u32x2 xw = xpre[ai][m][bj][n];
                        const f32x4 xv = {__builtin_bit_cast(float, xw.x << 16), __builtin_bit_cast(float, xw.x & 0xffff0000u), __builtin_bit_cast(float, xw.y << 16), __builtin_bit_cast(float, xw.y & 0xffff0000u)};
                        *(f32x4*)(ob + o) = xv + acc[ai][bj][m][n] * rs[ai][m] * A1[bj][n]; }
                if (m == 3) asm volatile("" ::: "memory"); }
    }
};

struct EpiSink {
    static constexpr bool PERM = false, AFTER_DRAIN = false, PERMA = false, HAS_PRE = false;
    float* O;
    __device__ __forceinline__ void operator()(f32x4 (&acc)[2][2][4][2], const Unit& u, int wr, int wc, int fr, int fq) const {
        f32x4 s = {0.f, 0.f, 0.f, 0.f};
#pragma unroll
        for (int ai = 0; ai < 2; ++ai)
#pragma unroll
            for (int bj = 0; bj < 2; ++bj)
#pragma unroll
                for (int m = 0; m < 4; ++m)
#pragma unroll
                    for (int n = 0; n < 2; ++n) s += acc[ai][bj][m][n];
        if (s[0] + s[1] + s[2] + s[3] == 1.2345e33f) O[u.pm * 256 + wr * 64 + fr + wc + fq] = s[0];
    }
};
template <class Epi, class Sched, bool ALIGN_EPI = false, bool SP2 = false>
__device__ __forceinline__ void gemm_phase(PG8_LAS unsigned char* lds, const Gemm g, const Sched& S, const Epi& E) {
    const int tid = threadIdx.x, wid = __builtin_amdgcn_readfirstlane(tid >> 6), lane = tid & 63, wr = wid >> 2, wc = wid & 3, fr = lane & 15, fq = lane >> 4;
    const int K = g.K, nt = K / BK;
    unsigned voffA[2], voffB[2];
#pragma unroll
    for (int i = 0; i < 2; ++i) { int R, C; stage_rc(tid * 16 + i * 8192, R, C); const int Rb = Epi::PERM ? ((R & ~31) + perm32(R & 31)) : R;
        const int Ra = Epi::PERMA ? ((R & ~63) + 4 * (R & 15) + ((R & 63) >> 4)) : R;
        voffA[i] = (unsigned)(Ra * K + C) * 2u; voffB[i] = (unsigned)(Rb * K + C) * 2u; }
    const size_t kstep = (size_t)(BK * 2);
    const size_t hstep = (size_t)HALF * K * 2;
    const size_t tstep = 2 * hstep;
    const unsigned ldsw = (unsigned)wid * 1024u;
    const int aoff = lds_byte(wr * 64 + fr, fq * 8), boff = lds_byte(wc * 32 + fr, fq * 8);
#define PG8_SA(b, h) (((b) * 2 + (h)) * HTB)
#define PG8_SB(b, h) ((4 + (b) * 2 + (h)) * HTB)
#define PG8_STAGE(bufoff, gbase, voff) do { _Pragma("unroll") for (int _i = 0; _i < 2; ++_i) \
        __builtin_amdgcn_global_load_lds((const unsigned*)((const char*)(gbase) + (voff)[_i]), (PG8_LAS unsigned*)(lds + (bufoff) + ldsw + _i * 8192), 16, 0, 0); } while (0)
#define PG8_LDA(dst, b, h) do { _Pragma("unroll") for (int m = 0; m < 4; ++m) _Pragma("unroll") for (int k = 0; k < 2; ++k) dst[m][k] = *(const PG8_LAS bf16x8*)(lds + PG8_SA(b, h) + aoff + m * 2048 + k * 1024); } while (0)
#define PG8_LDB(dst, b, h) do { _Pragma("unroll") for (int n = 0; n < 2; ++n) _Pragma("unroll") for (int k = 0; k < 2; ++k) dst[n][k] = *(const PG8_LAS bf16x8*)(lds + PG8_SB(b, h) + boff + n * 2048 + k * 1024); } while (0)
#define PG8_MMA(ai, bj, At, Bt) do { __builtin_amdgcn_s_setprio(1); _Pragma("unroll") for (int m = 0; m < 4; ++m) _Pragma("unroll") for (int n = 0; n < 2; ++n) _Pragma("unroll") for (int k = 0; k < 2; ++k) \
        acc[ai][bj][m][n] = __builtin_amdgcn_mfma_f32_16x16x32_bf16(Bt[n][k], At[m][k], acc[ai][bj][m][n], 0, 0, 0); __builtin_amdgcn_s_setprio(0); } while (0)
#define PG8_WAIT_V(n) asm volatile("s_waitcnt vmcnt(" #n ")" ::: "memory")
#define PG8_WAIT_L(n) asm volatile("s_waitcnt lgkmcnt(" #n ")" ::: "memory")
#define PG8_BAR __builtin_amdgcn_s_barrier()
#define PG8_SCHED __builtin_amdgcn_sched_barrier(0)
    Unit cur, nxt; int ui = 0;
    if (!S.next(0, cur)) return;
    f32x4 acc[2][2][4][2];
#pragma unroll
    for (int a = 0; a < 2; ++a)
#pragma unroll
        for (int b = 0; b < 2; ++b)
#pragma unroll
            for (int m = 0; m < 4; ++m)
#pragma unroll
                for (int n = 0; n < 2; ++n) acc[a][b][m][n] = (f32x4){0.f, 0.f, 0.f, 0.f};
    bf16x8 At[4][2], B0[2][2], B1[2][2];
    const char* cA = (const char*)g.A + (size_t)cur.pm * tstep; const char* cB = (const char*)g.Bt + (size_t)cur.pn * tstep;
    S.a_ready(cur);
    if constexpr (Epi::HAS_PRE) E.pre(cur, 0);
    if constexpr (SP2) {
        PG8_STAGE(PG8_SB(0, 0), cB, voffB); PG8_STAGE(PG8_SB(0, 1), cB + hstep, voffB); PG8_STAGE(PG8_SA(0, 0), cA, voffA); PG8_STAGE(PG8_SA(0, 1), cA + hstep, voffA);
        if (wr == 1) PG8_BAR;
        PG8_WAIT_V(2); PG8_BAR;
        PG8_STAGE(PG8_SB(1, 0), cB + kstep, voffB); PG8_STAGE(PG8_SA(1, 0), cA + kstep, voffA); PG8_STAGE(PG8_SB(1, 1), cB + hstep + kstep, voffB);
        PG8_WAIT_V(6); PG8_BAR;
    } else {
        PG8_STAGE(PG8_SB(0, 0), cB, voffB); PG8_STAGE(PG8_SA(0, 0), cA, voffA); PG8_STAGE(PG8_SB(0, 1), cB + hstep, voffB); PG8_STAGE(PG8_SA(0, 1), cA + hstep, voffA);
        if (wr == 1) PG8_BAR;
        PG8_WAIT_V(4); PG8_BAR;
        PG8_STAGE(PG8_SB(1, 0), cB + kstep, voffB); PG8_STAGE(PG8_SA(1, 0), cA + kstep, voffA); PG8_STAGE(PG8_SB(1, 1), cB + hstep + kstep, voffB);
        PG8_WAIT_V(6); PG8_BAR;
    }
    for (;;) {
        const bool has_next = S.next(ui + 1, nxt);
        const char* nA = has_next ? (const char*)g.A + (size_t)nxt.pm * tstep : cA; const char* nB = has_next ? (const char*)g.Bt + (size_t)nxt.pn * tstep : cB;
        for (int t = 0; t < nt; t += 2) {
            const bool last = (t == nt - 2);
            const char* a1 = cA + (size_t)(t + 1) * kstep;
            const char* a2 = last ? nA : cA + (size_t)(t + 2) * kstep; const char* b2 = last ? nB : cB + (size_t)(t + 2) * kstep;
            const char* a3 = a2 + kstep; const char* b3 = b2 + kstep;
            if (last && has_next) S.a_ready(nxt);
            if constexpr (SP2) {
            PG8_LDB(B0, 0, 0); PG8_LDB(B1, 0, 1); PG8_SCHED; PG8_LDA(At, 0, 0); PG8_STAGE(PG8_SA(1, 1), a1 + hstep, voffA);
            PG8_WAIT_V(8); PG8_WAIT_L(0); PG8_BAR; PG8_MMA(0, 0, At, B0); PG8_MMA(0, 1, At, B1); PG8_BAR; PG8_SCHED;
            PG8_LDA(At, 0, 1); PG8_STAGE(PG8_SB(0, 0), b2, voffB); PG8_STAGE(PG8_SB(0, 1), b2 + hstep, voffB); PG8_STAGE(PG8_SA(0, 0), a2, voffA);
            PG8_WAIT_V(8); PG8_WAIT_L(0); PG8_BAR; PG8_MMA(1, 0, At, B0); PG8_MMA(1, 1, At, B1); PG8_BAR; PG8_SCHED;
            PG8_LDB(B0, 1, 0); PG8_LDB(B1, 1, 1); PG8_SCHED; PG8_LDA(At, 1, 0); PG8_STAGE(PG8_SA(0, 1), a2 + hstep, voffA);
            PG8_WAIT_V(8); PG8_WAIT_L(0); PG8_BAR; PG8_MMA(0, 0, At, B0); PG8_MMA(0, 1, At, B1); PG8_BAR; PG8_SCHED;
            PG8_LDA(At, 1, 1); PG8_STAGE(PG8_SB(1, 0), b3, voffB); PG8_STAGE(PG8_SB(1, 1), b3 + hstep, voffB); PG8_STAGE(PG8_SA(1, 0), a3, voffA);
            PG8_WAIT_V(8); PG8_WAIT_L(0); PG8_BAR; PG8_MMA(1, 0, At, B0); PG8_MMA(1, 1, At, B1); PG8_BAR; PG8_SCHED;
            } else {
            PG8_LDB(B0, 0, 0); PG8_SCHED; PG8_LDA(At, 0, 0); PG8_STAGE(PG8_SA(1, 1), a1 + hstep, voffA);
            PG8_WAIT_L(8); PG8_BAR; PG8_WAIT_L(0); PG8_MMA(0, 0, At, B0); PG8_BAR; PG8_SCHED;
            PG8_LDB(B1, 0, 1); PG8_STAGE(PG8_SB(0, 0), b2, voffB);
            PG8_BAR; PG8_WAIT_L(0); PG8_MMA(0, 1, At, B1); PG8_BAR;
            PG8_LDA(At, 0, 1); PG8_STAGE(PG8_SA(0, 0), a2, voffA);
            PG8_BAR; PG8_WAIT_L(0); PG8_MMA(1, 0, At, B0); PG8_BAR; PG8_SCHED;
            PG8_STAGE(PG8_SB(0, 1), b2 + hstep, voffB);
            PG8_WAIT_V(6); PG8_BAR; PG8_MMA(1, 1, At, B1); PG8_BAR;
            PG8_LDB(B0, 1, 0); PG8_SCHED; PG8_LDA(At, 1, 0); PG8_STAGE(PG8_SA(0, 1), a2 + hstep, voffA);
            PG8_WAIT_L(8); PG8_BAR; PG8_WAIT_L(0); PG8_MMA(0, 0, At, B0); PG8_BAR; PG8_SCHED;
            PG8_LDB(B1, 1, 1); PG8_STAGE(PG8_SB(1, 0), b3, voffB);
            PG8_BAR; PG8_WAIT_L(0); PG8_MMA(0, 1, At, B1); PG8_BAR;
            PG8_LDA(At, 1, 1); PG8_STAGE(PG8_SA(1, 0), a3, voffA);
            PG8_BAR; PG8_WAIT_L(0); PG8_MMA(1, 0, At, B0); PG8_BAR; PG8_SCHED;
            PG8_STAGE(PG8_SB(1, 1), b3 + hstep, voffB);
            PG8_WAIT_V(6); PG8_BAR; PG8_MMA(1, 1, At, B1); PG8_BAR;
            }
        }
        if constexpr (ALIGN_EPI) { if (wr == 0) PG8_BAR; }
        if constexpr (Epi::HAS_PRE) { if (has_next) E.pre(nxt, (ui + 1) & 1); E.run(acc, cur, wr, wc, fr, fq, ui & 1); S.done(cur); }
        else if constexpr (!Epi::AFTER_DRAIN) { E(acc, cur, wr, wc, fr, fq); S.done(cur); }
        if (!has_next) break;
#pragma unroll
        for (int a = 0; a < 2; ++a)
#pragma unroll
            for (int b = 0; b < 2; ++b)
#pragma unroll
                for (int m = 0; m < 4; ++m)
#pragma unroll
                    for (int n = 0; n < 2; ++n) acc[a][b][m][n] = (f32x4){0.f, 0.f, 0.f, 0.f};
        cur = nxt; cA = nA; cB = nB; ++ui;
        if constexpr (ALIGN_EPI) { if (wr == 1) PG8_BAR; }
    }
    PG8_WAIT_V(0);
    if constexpr (!ALIGN_EPI) { if (wr == 0) PG8_BAR; }
    PG8_BAR;
    if constexpr (Epi::AFTER_DRAIN) { E.fused(acc, cur, wr, wc, fr, fq, lds, wid, lane); S.done(cur); }
#undef PG8_SA
#undef PG8_SB
#undef PG8_STAGE
#undef PG8_LDA
#undef PG8_LDB
#undef PG8_MMA
#undef PG8_WAIT_V
#undef PG8_WAIT_L
#undef PG8_BAR
#undef PG8_SCHED
}
}
constexpr int NWAVES = 8;
constexpr int BATCH = 4, SEQ = 8192, D = 1024, M = BATCH * SEQ;
constexpr int INW = 1536, AW = 512, FF = 2816, FF2 = 2 * FF, NMOD = 6 * D;
constexpr float EPS = 1e-6f;
constexpr size_t MiB = 1u << 20;
constexpr size_t WS_CTL = 0, CTL_ZERO_BYTES = 1 * MiB;
constexpr size_t OFF_MOD = 0, OFF_SS1 = 128 * 1024, OFF_SS2 = 256 * 1024, OFF_SS3 = 384 * 1024, OFF_BAR = 512 * 1024, OFF_CNT = 544 * 1024, OFF_SS4 = 896 * 1024;
constexpr size_t WS_WIN = 1 * MiB, WS_WOUT = 4 * MiB, WS_WUP = 6 * MiB, WS_WDOWN = 17 * MiB, WS_WSP = 23 * MiB, WS_WPOOL = WS_WSP + 256 * 1024;
constexpr size_t WS_SXX = 23 * MiB + 512 * 1024;
constexpr size_t WS_XN = 24 * MiB;
constexpr size_t WS_PROJ = 88 * MiB;
constexpr size_t WS_MIXIN = 184 * MiB;
constexpr size_t WS_MIXED = 248 * MiB;
constexpr size_t WS_ACT = 88 * MiB;
constexpr size_t WS_RAW = 264 * MiB;
constexpr size_t WS_F = 308 * MiB;
constexpr size_t WS_X1B = 372 * MiB;
constexpr size_t WS_END = 436 * MiB;
static_assert(WS_ACT + (size_t)M * FF * 2 <= WS_RAW && WS_RAW + (size_t)(M / 64) * 4 * FF2 * 4 <= WS_F && WS_F + (size_t)M * D * 4 <= WS_END, "d_ws map");
static_assert(WS_WUP + (size_t)FF2 * D * 2 <= WS_WDOWN && WS_WDOWN + (size_t)D * FF * 2 <= WS_WSP && WS_WPOOL + 4 * 128 * 128 * 2 <= WS_XN, "d_ws weights");
constexpr int RING_BYTES = 131072, LDSCTL_OFF = RING_BYTES, LDS_BYTES = 147456;

#define GAS __attribute__((address_space(1)))
#define LAS __attribute__((address_space(3)))
typedef unsigned short bf16;
typedef unsigned v4u __attribute__((ext_vector_type(4)));
typedef unsigned v2u __attribute__((ext_vector_type(2)));
typedef float f32x4 __attribute__((ext_vector_type(4)));
typedef short bf16x8 __attribute__((ext_vector_type(8)));
#define LDS_WAIT() asm volatile("s_waitcnt lgkmcnt(0)" ::: "memory")
__device__ __forceinline__ unsigned f2bf(float f) { unsigned u = __builtin_bit_cast(unsigned, f); return (u + 0x7fffu + ((u >> 16) & 1u)) >> 16; }
__device__ __forceinline__ unsigned pk2(float lo, float hi) { unsigned r; asm("v_cvt_pk_bf16_f32 %0, %1, %2" : "=v"(r) : "v"(lo), "v"(hi)); return r; }
__device__ __forceinline__ float bf_lo(unsigned w) { return __builtin_bit_cast(float, w << 16); }
__device__ __forceinline__ float bf_hi(unsigned w) { return __builtin_bit_cast(float, w & 0xffff0000u); }
__device__ __forceinline__ float wave_sum(float v) {
#pragma unroll
    for (int o = 1; o < 64; o <<= 1) v += __shfl_xor(v, o);
    return v;
}
__device__ __forceinline__ float silu_acc(float x) { return x / (1.0f + __expf(-x)); }

struct Args { const float* in[19]; float* out; unsigned char* ws; int ph_lo, ph_hi; };
enum { I_X = 0, I_C, I_WADA, I_BADA, I_PREMIXG, I_POSTMIXG, I_WIN, I_SGUG, I_WSP, I_BSP, I_WPOOL, I_PSCALE, I_WOUT, I_PREFFNG, I_POSTFFNG, I_WUP, I_CONVW, I_CONVB, I_WDOWN };

__device__ __forceinline__ void transpose_item(const float* W, int K, int N, bf16* WT, int k0, int n0, int drow0, LAS float* scr, int lane) {
    { f32x4 v[8];
#pragma unroll
        for (int i = 0; i < 8; ++i) v[i] = __builtin_nontemporal_load((const f32x4*)(W + (size_t)(k0 + 8 * i + (lane >> 3)) * N + n0 + 4 * (lane & 7)));
#pragma unroll
        for (int i = 0; i < 8; ++i) { LAS float* d = scr + (8 * i + (lane >> 3)) * 33 + 4 * (lane & 7); d[0] = v[i].x; d[1] = v[i].y; d[2] = v[i].z; d[3] = v[i].w; } }
    LDS_WAIT(); asm volatile("" ::: "memory");
    const int c = lane & 7;
#pragma unroll
    for (int j = 0; j < 4; ++j) { const int n = (lane >> 3) + 8 * j; const LAS float* s = scr + (8 * c) * 33 + n;
        v4u o; o.x = pk2(s[0 * 33], s[1 * 33]); o.y = pk2(s[2 * 33], s[3 * 33]); o.z = pk2(s[4 * 33], s[5 * 33]); o.w = pk2(s[6 * 33], s[7 * 33]);
        *(v4u*)(WT + (size_t)(drow0 + n) * K + k0 + 8 * c) = o; }
    LDS_WAIT(); asm volatile("" ::: "memory");
}

__device__ __forceinline__ void p0_prologue(const Args& a, LAS unsigned char* lds, int gw, int NGW, int lane, int wave, bool with_mod, bool with_rest) {
    unsigned char* ws = a.ws;
    float* MOD = (float*)(ws + OFF_MOD);
    const float* c = a.in[I_C]; const float* wada = a.in[I_WADA]; const float* bada = a.in[I_BADA];
    for (int it = with_mod ? gw : 96 * 16; it < 96 * 16; it += NGW) { const int cb = it % 96, ks = it / 96, col = cb * 64 + lane; float a0 = 0.f, a1 = 0.f, a2 = 0.f, a3 = 0.f;
        const float sv0 = silu_acc(c[ks * 64 + lane]), sv1 = silu_acc(c[D + ks * 64 + lane]), sv2 = silu_acc(c[2 * D + ks * 64 + lane]), sv3 = silu_acc(c[3 * D + ks * 64 + lane]);
#pragma unroll 32
        for (int kk = 0; kk < 64; ++kk) { const float w = __builtin_nontemporal_load(wada + (size_t)(ks * 64 + kk) * NMOD + col);
            a0 += __builtin_bit_cast(float, __builtin_amdgcn_readlane(__builtin_bit_cast(int, sv0), kk)) * w; a1 += __builtin_bit_cast(float, __builtin_amdgcn_readlane(__builtin_bit_cast(int, sv1), kk)) * w;
            a2 += __builtin_bit_cast(float, __builtin_amdgcn_readlane(__builtin_bit_cast(int, sv2), kk)) * w; a3 += __builtin_bit_cast(float, __builtin_amdgcn_readlane(__builtin_bit_cast(int, sv3), kk)) * w; }
        if (ks == 0) { const float b = bada[col]; a0 += b; a1 += b; a2 += b; a3 += b; }
        atomicAdd(MOD + col, a0); atomicAdd(MOD + NMOD + col, a1); atomicAdd(MOD + 2 * NMOD + col, a2); atomicAdd(MOD + 3 * NMOD + col, a3); }
    if (!with_rest) return;
    LAS float* scr = (LAS float*)(lds + wave * 16384);
    constexpr int I_IN = (D / 64) * (INW / 32), I_OUT = (D / 64) * (D / 32), I_UP = (D / 64) * (FF2 / 32), I_DOWN = (FF / 64) * (D / 32), I_POOL = 4 * 2 * 4;
    constexpr int NITEMS = I_IN + I_OUT + I_UP + I_DOWN + I_POOL;
    for (int it = gw; it < NITEMS; it += NGW) { int r = it;
        if (r < I_IN) { const int nb = INW / 32, kb = r / nb, n0 = 32 * (r % nb); transpose_item(a.in[I_WIN], D, INW, (bf16*)(ws + WS_WIN), 64 * kb, n0, n0, scr, lane); continue; } r -= I_IN;
        if (r < I_OUT) { const int nb = D / 32, kb = r / nb, n0 = 32 * (r % nb); transpose_item(a.in[I_WOUT], D, D, (bf16*)(ws + WS_WOUT), 64 * kb, n0, n0, scr, lane); continue; } r -= I_OUT;
        if (r < I_UP) { const int nb = FF2 / 32, kb = r / nb, n0 = 32 * (r % nb); const int half = n0 / FF, f = n0 % FF, drow = 256 * (f / 128) + 128 * half + (f % 128);
            transpose_item(a.in[I_WUP], D, FF2, (bf16*)(ws + WS_WUP), 64 * kb, n0, drow, scr, lane); continue; } r -= I_UP;
        if (r < I_DOWN) { const int nb = D / 32, kb = r / nb, n0 = 32 * (r % nb); transpose_item(a.in[I_WDOWN], FF, D, (bf16*)(ws + WS_WDOWN), 64 * kb, n0, n0, scr, lane); continue; } r -= I_DOWN;
        { const int g = r / 8, q = r % 8, kb = q / 4, n0 = 32 * (q % 4); transpose_item(a.in[I_WPOOL] + (size_t)g * 16384, 128, 128, (bf16*)(ws + WS_WPOOL) + (size_t)g * 16384, 64 * kb, n0, n0, scr, lane); } }
    { const float* wsp = a.in[I_WSP]; bf16* o = (bf16*)(ws + WS_WSP);
        for (int e = gw * 64 + lane; e < 4 * 128 * 128; e += NGW * 64) { const int i = (e >> 7) & 127, j = e & 127; const float v = ((j >> 6) <= (i >> 6)) ? wsp[e] : 0.f; o[e] = (bf16)f2bf(v); } }
}

__device__ __forceinline__ void p1_norm(const Args& a, int gw, int NGW, int lane) {
    const float* MOD = (const float*)(a.ws + OFF_MOD); bf16* XN = (bf16*)(a.ws + WS_XN); const float* x = a.in[I_X]; const float* g = a.in[I_PREMIXG]; float* SXX = (float*)(a.ws + WS_SXX);
    const int rpw = M / NGW;
    for (int r0 = gw * rpw; r0 < M; r0 += NGW * rpw) { const int b = r0 / SEQ; const float* mb = MOD + (size_t)b * NMOD;
        f32x4 A[4], B[4];
#pragma unroll
        for (int j = 0; j < 4; ++j) { const int col = 4 * lane + 256 * j; const f32x4 gg = *(const f32x4*)(g + col), sc = *(const f32x4*)(mb + D + col); A[j] = gg * (1.0f + sc); B[j] = *(const f32x4*)(mb + col); }
        f32x4 nx[4];
        { const f32x4* xr = (const f32x4*)(x + (size_t)r0 * D) + lane;
#pragma unroll
            for (int j = 0; j < 4; ++j) nx[j] = __builtin_nontemporal_load(xr + 64 * j); }
        for (int r = r0; r < r0 + rpw; ++r) { f32x4 v[4]; float s = 0.f;
#pragma unroll
            for (int j = 0; j < 4; ++j) { v[j] = nx[j]; s += (v[j].x * v[j].x + v[j].y * v[j].y) + (v[j].z * v[j].z + v[j].w * v[j].w); }
            if (r + 1 < r0 + rpw) { const f32x4* xr = (const f32x4*)(x + (size_t)(r + 1) * D) + lane;
#pragma unroll
                for (int j = 0; j < 4; ++j) nx[j] = __builtin_nontemporal_load(xr + 64 * j); }
            const float st = wave_sum(s);
            const float rs = 1.0f / sqrtf(st * (1.0f / D) + EPS);
            v2u* o = (v2u*)(XN + (size_t)r * D) + lane;
#pragma unroll
            for (int j = 0; j < 4; ++j) { const f32x4 h = v[j] * rs * A[j] + B[j]; const unsigned long long w = (unsigned long long)pk2(h.x, h.y) | ((unsigned long long)pk2(h.z, h.w) << 32);
                __hip_atomic_store((unsigned long long*)(o + 64 * j), w, __ATOMIC_RELAXED, __HIP_MEMORY_SCOPE_AGENT); } } }
}

constexpr int P3_RA = 0, P3_RB = 34816, P3_RP = 69632, P3_RC = 108800, P3_PA = 272, P3_PV = 264;
__device__ __forceinline__ void p3_mma(LAS unsigned char* lds, bool natural_b, f32x4 (&acc)[4][2], int wr, int wc, int fr, int fq) {
#pragma unroll
    for (int m = 0; m < 4; ++m)
#pragma unroll
        for (int n = 0; n < 2; ++n) acc[m][n] = (f32x4){0.f, 0.f, 0.f, 0.f};
#pragma unroll
    for (int kk = 0; kk < 4; ++kk) { bf16x8 af[4], bfr[2];
#pragma unroll
        for (int m = 0; m < 4; ++m) af[m] = *(const LAS bf16x8*)(lds + P3_RA + (64 * wr + 16 * m + fr) * P3_PA + (32 * kk + 8 * fq) * 2);
        if (natural_b) {
            { const unsigned addr = (unsigned)(size_t)(lds + P3_RB) + (unsigned)((32 * kk + 8 * fq + (fr >> 2)) * P3_PV + (32 * wc + 4 * (fr & 3)) * 2);
                v2u l0, h0, l1, h1;
                asm volatile("ds_read_b64_tr_b16 %0, %4\n\tds_read_b64_tr_b16 %1, %4 offset:%5\n\tds_read_b64_tr_b16 %2, %4 offset:32\n\tds_read_b64_tr_b16 %3, %4 offset:%6\n\ts_waitcnt lgkmcnt(0)"
                             : "=&v"(l0), "=&v"(h0), "=&v"(l1), "=&v"(h1) : "v"(addr), "n"(4 * P3_PV), "n"(4 * P3_PV + 32) : "memory");
                v4u w0, w1; w0.x = l0.x; w0.y = l0.y; w0.z = h0.x; w0.w = h0.y; w1.x = l1.x; w1.y = l1.y; w1.z = h1.x; w1.w = h1.y;
                bfr[0] = __builtin_bit_cast(bf16x8, w0); bfr[1] = __builtin_bit_cast(bf16x8, w1); }
        } else {
#pragma unroll
            for (int n = 0; n < 2; ++n) bfr[n] = *(const LAS bf16x8*)(lds + P3_RB + (32 * wc + 16 * n + fr) * P3_PA + (32 * kk + 8 * fq) * 2);
        }
#pragma unroll
        for (int m = 0; m < 4; ++m)
#pragma unroll
            for (int n = 0; n < 2; ++n) acc[m][n] = __builtin_amdgcn_mfma_f32_16x16x32_bf16(bfr[n], af[m], acc[m][n], 0, 0, 0); }
}
template <int W> __device__ __forceinline__ void p3_pool(LAS unsigned char* lds, int tid, int s0) {
    const int ch = tid & 15, tq = 4 * (tid >> 4); const LAS unsigned char* rp = lds + P3_RP + ch * 16; float sum[8];
#pragma unroll
    for (int e = 0; e < 8; ++e) sum[e] = 0.f;
#pragma unroll 3
    for (int k = 1; k < W; ++k) { const v4u r = *(const LAS v4u*)(rp + (16 + tq - k) * P3_PA);
        sum[0] += bf_lo(r.x); sum[1] += bf_hi(r.x); sum[2] += bf_lo(r.y); sum[3] += bf_hi(r.y); sum[4] += bf_lo(r.z); sum[5] += bf_hi(r.z); sum[6] += bf_lo(r.w); sum[7] += bf_hi(r.w); }
#pragma unroll
    for (int rr = 0; rr < 4; ++rr) { const int t = tq + rr; const v4u cur = *(const LAS v4u*)(rp + (16 + t) * P3_PA);
        sum[0] += bf_lo(cur.x); sum[1] += bf_hi(cur.x); sum[2] += bf_lo(cur.y); sum[3] += bf_hi(cur.y); sum[4] += bf_lo(cur.z); sum[5] += bf_hi(cur.z); sum[6] += bf_lo(cur.w); sum[7] += bf_hi(cur.w);
        const int cnt = (s0 + t + 1) < W ? (s0 + t + 1) : W; const float inv = 1.0f / (float)cnt;
        v4u o; o.x = pk2(sum[0] * inv - bf_lo(cur.x), sum[1] * inv - bf_hi(cur.x)); o.y = pk2(sum[2] * inv - bf_lo(cur.y), sum[3] * inv - bf_hi(cur.y));
        o.z = pk2(sum[4] * inv - bf_lo(cur.z), sum[5] * inv - bf_hi(cur.z)); o.w = pk2(sum[6] * inv - bf_lo(cur.w), sum[7] * inv - bf_hi(cur.w));
        *(LAS v4u*)(lds + P3_RA + t * P3_PA + ch * 16) = o;
        if (rr < 3) { const v4u old = *(const LAS v4u*)(rp + (16 + t - (W - 1)) * P3_PA);
            sum[0] -= bf_lo(old.x); sum[1] -= bf_hi(old.x); sum[2] -= bf_lo(old.y); sum[3] -= bf_hi(old.y); sum[4] -= bf_lo(old.z); sum[5] -= bf_hi(old.z); sum[6] -= bf_lo(old.w); sum[7] -= bf_hi(old.w); } }
}
struct P3Regs { v4u a0, a1, a2, a3, b0, b1, b2, b3, b4; };
#define P3_RA_(R, it) ((it) == 0 ? (R).a0 : (it) == 1 ? (R).a1 : (it) == 2 ? (R).a2 : (R).a3)
#define P3_RB_(R, it) ((it) == 0 ? (R).b0 : (it) == 1 ? (R).b1 : (it) == 2 ? (R).b2 : (it) == 3 ? (R).b3 : (R).b4)
__device__ __forceinline__ void p3_prefetch(P3Regs& R, int item, int t0, int s0, int tid, const bf16* PROJ, const bf16* WSP, const bf16* WPOOL, bool xhalo = false) {
    if (item < 4) { const int h = item;
#pragma unroll
        for (int it = 0; it < 4; ++it) { const int idx = tid + 512 * it, row = idx >> 4, ch = idx & 15;
            const v4u va = *(const v4u*)(WSP + (size_t)h * 16384 + row * 128 + ch * 8), vb = __builtin_nontemporal_load((const v4u*)(PROJ + (size_t)(t0 + row) * INW + AW + 128 * h + 8 * ch));
            if (it == 0) { R.a0 = va; R.b0 = vb; } else if (it == 1) { R.a1 = va; R.b1 = vb; } else if (it == 2) { R.a2 = va; R.b2 = vb; } else { R.a3 = va; R.b3 = vb; } }
    } else { const int g = item - 4;
#pragma unroll
        for (int it = 0; it < 4; ++it) { const int idx = tid + 512 * it, row = idx >> 4, ch = idx & 15; const v4u va = *(const v4u*)(WPOOL + (size_t)g * 16384 + row * 128 + ch * 8);
            if (it == 0) R.a0 = va; else if (it == 1) R.a1 = va; else if (it == 2) R.a2 = va; else R.a3 = va; }
#pragma unroll
        for (int it = 0; it < 5; ++it) { const int idx = tid + 512 * it, row = idx >> 4, ch = idx & 15; v4u raw = {0u, 0u, 0u, 0u};
            if (row < 144 && s0 + row >= 16) { const bf16* src = PROJ + (size_t)(t0 + row - 16) * INW + 2 * AW + 128 * g + 8 * ch;
                if (xhalo && row < 16) { const unsigned long long w0 = __hip_atomic_load((const unsigned long long*)src, __ATOMIC_RELAXED, __HIP_MEMORY_SCOPE_AGENT), w1 = __hip_atomic_load((const unsigned long long*)src + 1, __ATOMIC_RELAXED, __HIP_MEMORY_SCOPE_AGENT);
                    raw.x = (unsigned)w0; raw.y = (unsigned)(w0 >> 32); raw.z = (unsigned)w1; raw.w = (unsigned)(w1 >> 32); }
                else raw = __builtin_nontemporal_load((const v4u*)src); }
            if (it == 0) R.b0 = raw; else if (it == 1) R.b1 = raw; else if (it == 2) R.b2 = raw; else if (it == 3) R.b3 = raw; else R.b4 = raw; } }
}
__device__ __forceinline__ void p3_item(P3Regs& R, const int item, const int t0, const int s0, const int tid0, LAS unsigned char* lds, const LAS float* RC, const bf16* PROJ, bf16* MIXIN, const bf16* WSP, const bf16* WPOOL,
                                        const int wr, const int wc, const int fr, const int fq, const bool xhalo) {
    f32x4 acc[4][2];
            int tl = tid0; asm volatile("" : "+v"(tl));
            const int tid = tl;
            if (item < 4) { const int h = item;
#pragma unroll
                for (int it = 0; it < 4; ++it) { const int idx = tid + 512 * it, row = idx >> 4, ch = idx & 15;
                    *(LAS v4u*)(lds + P3_RA + row * P3_PA + ch * 16) = P3_RA_(R, it);
                    const v4u raw = P3_RB_(R, it);
                    float v[8]; v[0] = bf_lo(raw.x); v[1] = bf_hi(raw.x); v[2] = bf_lo(raw.y); v[3] = bf_hi(raw.y); v[4] = bf_lo(raw.z); v[5] = bf_hi(raw.z); v[6] = bf_lo(raw.w); v[7] = bf_hi(raw.w);
                    float s = 0.f;
#pragma unroll
                    for (int e = 0; e < 8; ++e) s += v[e] * v[e];
                    s += __shfl_xor(s, 1); s += __shfl_xor(s, 2); s += __shfl_xor(s, 4); s += __shfl_xor(s, 8);
                    const float rs = __builtin_amdgcn_rsqf(s * (1.0f / 128.0f) + EPS);
                    const f32x4 g0 = *(const LAS f32x4*)(RC + 128 * h + 8 * ch), g1 = *(const LAS f32x4*)(RC + 128 * h + 8 * ch + 4);
                    v2u w0, w1; w0.x = pk2(v[0] * rs * g0.x, v[1] * rs * g0.y); w0.y = pk2(v[2] * rs * g0.z, v[3] * rs * g0.w); w1.x = pk2(v[4] * rs * g1.x, v[5] * rs * g1.y); w1.y = pk2(v[6] * rs * g1.z, v[7] * rs * g1.w);
                    *(LAS v2u*)(lds + P3_RB + row * P3_PV + ch * 16) = w0; *(LAS v2u*)(lds + P3_RB + row * P3_PV + ch * 16 + 8) = w1; }
                __syncthreads();
                if (item + 2 < 8) p3_prefetch(R, item + 2, t0, s0, tid, PROJ, WSP, WPOOL, xhalo);
                v2u ur[4][2]; float bias[4];
#pragma unroll
                for (int m = 0; m < 4; ++m) { const int i = 64 * wr + 16 * m + fr; bias[m] = RC[512 + 128 * h + i];
#pragma unroll
                    for (int n = 0; n < 2; ++n) ur[m][n] = *(const v2u*)(PROJ + (size_t)(t0 + i) * INW + 128 * h + 32 * wc + 16 * n + 4 * fq); }
                p3_mma(lds, true, acc, wr, wc, fr, fq);
#pragma unroll
                for (int m = 0; m < 4; ++m) { const int i = 64 * wr + 16 * m + fr;
#pragma unroll
                    for (int n = 0; n < 2; ++n) { const int c = 128 * h + 32 * wc + 16 * n + 4 * fq; const v2u u2 = ur[m][n]; const float bi = bias[m];
                        const f32x4 z = acc[m][n]; v2u w; w.x = pk2(bf_lo(u2.x) * (z[0] + bi), bf_hi(u2.x) * (z[1] + bi)); w.y = pk2(bf_lo(u2.y) * (z[2] + bi), bf_hi(u2.y) * (z[3] + bi));
                        *(v2u*)(MIXIN + (size_t)(t0 + i) * D + c) = w; } }
                __syncthreads();
            } else { const int g = item - 4, w = 2 << g;
#pragma unroll
                for (int it = 0; it < 4; ++it) { const int idx = tid + 512 * it, row = idx >> 4, ch = idx & 15; *(LAS v4u*)(lds + P3_RB + row * P3_PA + ch * 16) = P3_RA_(R, it); }
#pragma unroll
                for (int it = 0; it < 5; ++it) { const int idx = tid + 512 * it, row = idx >> 4, ch = idx & 15; if (row < 144) *(LAS v4u*)(lds + P3_RP + row * P3_PA + ch * 16) = P3_RB_(R, it); }
                __syncthreads();
                if (item + 2 < 8) p3_prefetch(R, item + 2, t0, s0, tid, PROJ, WSP, WPOOL, xhalo);
                switch (g) { case 0: p3_pool<2>(lds, tid, s0); break; case 1: p3_pool<4>(lds, tid, s0); break; case 2: p3_pool<8>(lds, tid, s0); break; default: p3_pool<16>(lds, tid, s0); break; }
                __syncthreads();
                p3_mma(lds, false, acc, wr, wc, fr, fq);
#pragma unroll
                for (int m = 0; m < 4; ++m) { const int t = 64 * wr + 16 * m + fr;
#pragma unroll
                    for (int n = 0; n < 2; ++n) { const int d = 128 * g + 32 * wc + 16 * n + 4 * fq; const f32x4 ps = *(const LAS f32x4*)(RC + 1024 + d); const f32x4 y = acc[m][n] * ps;
                        v2u wv; wv.x = pk2(y[0], y[1]); wv.y = pk2(y[2], y[3]); *(v2u*)(MIXIN + (size_t)(t0 + t) * D + AW + d) = wv; } }
                __syncthreads();
            }
}
__device__ __forceinline__ void p3_mixers(const Args& a, LAS unsigned char* lds, int tid0, int rb, unsigned* xwait, unsigned xgen) {
    const int lane = tid0 & 63, wave = tid0 >> 6, wr = wave >> 2, wc = wave & 3, fr = lane & 15, fq = lane >> 4;
    const bf16* PROJ = (const bf16*)(a.ws + WS_PROJ); bf16* MIXIN = (bf16*)(a.ws + WS_MIXIN);
    const bf16* WSP = (const bf16*)(a.ws + WS_WSP); const bf16* WPOOL = (const bf16*)(a.ws + WS_WPOOL);
    const float* sgug = a.in[I_SGUG]; const float* bsp = a.in[I_BSP]; const float* pscale = a.in[I_PSCALE];
    { LAS float* rc = (LAS float*)(lds + P3_RC); rc[tid0] = sgug[tid0]; rc[512 + tid0] = bsp[tid0]; rc[1024 + tid0] = pscale[tid0]; }
    __syncthreads();
    const LAS float* RC = (const LAS float*)(lds + P3_RC);
    for (int tb = rb; tb < M / 128; tb += gridDim.x) { const int t0 = tb * 128, s0 = t0 % SEQ;
        const bool xhalo = xwait != nullptr && (tb & 31) == 0 && s0 != 0;
        if (xhalo) { unsigned sp = 0; while ((unsigned)__builtin_amdgcn_readfirstlane(__hip_atomic_load(xwait, __ATOMIC_RELAXED, __HIP_MEMORY_SCOPE_AGENT)) < xgen) { __builtin_amdgcn_s_sleep(2); if (++sp > (1u << 22)) break; } }
        P3Regs R;
        p3_prefetch(R, 0, t0, s0, tid0, PROJ, WSP, WPOOL);
        P3Regs Rb;
        p3_prefetch(Rb, 1, t0, s0, tid0, PROJ, WSP, WPOOL);
        for (int it2 = 0; it2 < 4; ++it2) {
            p3_item(R, 2 * it2, t0, s0, tid0, lds, RC, PROJ, MIXIN, WSP, WPOOL, wr, wc, fr, fq, xhalo);
            p3_item(Rb, 2 * it2 + 1, t0, s0, tid0, lds, RC, PROJ, MIXIN, WSP, WPOOL, wr, wc, fr, fq, xhalo); } }
}

__device__ __forceinline__ void p4b_mid(const Args& a, int gw, int NGW, int lane) {
    const float* MOD = (const float*)(a.ws + OFF_MOD); const float* SS1 = (const float*)(a.ws + OFF_SS1); const bf16* MIXED = (const bf16*)(a.ws + WS_MIXED); bf16* XN = (bf16*)(a.ws + WS_XN);
    const float* x = a.in[I_X]; const float* pg = a.in[I_POSTMIXG]; const float* fg = a.in[I_PREFFNG]; bf16* X1B = (bf16*)(a.ws + WS_X1B);
    const int rpw = M / NGW;
    for (int r0 = gw * rpw; r0 < M; r0 += NGW * rpw) { const int b = r0 / SEQ; const float* mb = MOD + (size_t)b * NMOD;
        f32x4 A1[4], A2[4], A3[4];
#pragma unroll
        for (int j = 0; j < 4; ++j) { const int col = 4 * lane + 256 * j; A1[j] = *(const f32x4*)(mb + 2 * D + col) * *(const f32x4*)(pg + col);
            A2[j] = *(const f32x4*)(fg + col) * (1.0f + *(const f32x4*)(mb + 4 * D + col)); A3[j] = *(const f32x4*)(mb + 3 * D + col); }
        f32x4 nx[4]; v2u nm[4];
        { const f32x4* xr = (const f32x4*)(x + (size_t)r0 * D) + lane; const v2u* mr = (const v2u*)(MIXED + (size_t)r0 * D) + lane;
#pragma unroll
            for (int j = 0; j < 4; ++j) { nx[j] = __builtin_nontemporal_load(xr + 64 * j); nm[j] = __builtin_nontemporal_load(mr + 64 * j); } }
        const float ssv = (lane < rpw) ? SS1[r0 + lane] : 0.f;
        for (int r = r0; r < r0 + rpw; ++r) {
            const float rs1 = __builtin_amdgcn_rsqf(__builtin_bit_cast(float, __builtin_amdgcn_readlane(__builtin_bit_cast(int, ssv), r - r0)) * (1.0f / D) + EPS); f32x4 v[4]; float s = 0.f;
#pragma unroll
            for (int j = 0; j < 4; ++j) { const v2u mw = nm[j]; const f32x4 mx = {bf_lo(mw.x), bf_hi(mw.x), bf_lo(mw.y), bf_hi(mw.y)};
                v[j] = nx[j] + mx * rs1 * A1[j]; s += (v[j].x * v[j].x + v[j].y * v[j].y) + (v[j].z * v[j].z + v[j].w * v[j].w); }
            if (r + 1 < r0 + rpw) { const f32x4* xr = (const f32x4*)(x + (size_t)(r + 1) * D) + lane; const v2u* mr = (const v2u*)(MIXED + (size_t)(r + 1) * D) + lane;
#pragma unroll
                for (int j = 0; j < 4; ++j) { nx[j] = __builtin_nontemporal_load(xr + 64 * j); nm[j] = __builtin_nontemporal_load(mr + 64 * j); } }
            v2u* xrow = (v2u*)(X1B + (size_t)r * D) + lane;
#pragma unroll
            for (int j = 0; j < 4; ++j) { v2u w; w.x = pk2(v[j].x, v[j].y); w.y = pk2(v[j].z, v[j].w); __builtin_nontemporal_store(w, xrow + 64 * j); }
            const float rs = __builtin_amdgcn_rsqf(wave_sum(s) * (1.0f / D) + EPS);
            v2u* o = (v2u*)(XN + (size_t)r * D) + lane;
#pragma unroll
            for (int j = 0; j < 4; ++j) { const f32x4 h = v[j] * rs * A2[j] + A3[j]; const unsigned long long w = (unsigned long long)pk2(h.x, h.y) | ((unsigned long long)pk2(h.z, h.w) << 32);
                __hip_atomic_store((unsigned long long*)(o + 64 * j), w, __ATOMIC_RELAXED, __HIP_MEMORY_SCOPE_AGENT); } } }
}

__device__ __forceinline__ void p6b_fixup(const Args& a, int gw, int NGW, int lane) {
    const bf16* RAW = (const bf16*)(a.ws + WS_RAW); bf16* ACT = (bf16*)(a.ws + WS_ACT); const float* cw = a.in[I_CONVW]; const float* cb = a.in[I_CONVB];
    for (int it = 2 * gw; it < 2 * gw + 2; ++it) { const int q = it & 3, rr = (it >> 2) & 1, B = it >> 3; const int t = 64 * B + rr, s = t % SEQ;
        const bf16* cur = RAW + (size_t)(B * 4 + rr) * FF2;
        const bf16* p1 = (rr == 1) ? RAW + (size_t)(B * 4 + 0) * FF2 : (s == 0 ? nullptr : RAW + (size_t)((B - 1) * 4 + 3) * FF2);
        const bf16* p2 = (rr == 1) ? (s == 1 ? nullptr : RAW + (size_t)((B - 1) * 4 + 3) * FF2) : (s == 0 ? nullptr : RAW + (size_t)((B - 1) * 4 + 2) * FF2);
        for (int f = q * 704 + 4 * lane; f < q * 704 + 704; f += 256) { f32x4 y[2];
#pragma unroll
            for (int hv = 0; hv < 2; ++hv) { const int col = hv * FF + f; const f32x4 z = {0.f, 0.f, 0.f, 0.f};
                const v2u zz = {0u, 0u}; const v2u r0 = *(const v2u*)(cur + col), r1 = p1 ? *(const v2u*)(p1 + col) : zz, r2 = p2 ? *(const v2u*)(p2 + col) : zz; (void)z;
                const f32x4 u0 = {bf_lo(r0.x), bf_hi(r0.x), bf_lo(r0.y), bf_hi(r0.y)}, u1 = {bf_lo(r1.x), bf_hi(r1.x), bf_lo(r1.y), bf_hi(r1.y)}, u2 = {bf_lo(r2.x), bf_hi(r2.x), bf_lo(r2.y), bf_hi(r2.y)};
                y[hv] = *(const f32x4*)(cb + col) + *(const f32x4*)(cw + col) * u2 + *(const f32x4*)(cw + FF2 + col) * u1 + *(const f32x4*)(cw + 2 * FF2 + col) * u0; }
            v2u w; w.x = pk2(pg8::silu_f(y[0][0]) * y[1][0], pg8::silu_f(y[0][1]) * y[1][1]); w.y = pk2(pg8::silu_f(y[0][2]) * y[1][2], pg8::silu_f(y[0][3]) * y[1][3]);
            *(v2u*)(ACT + (size_t)t * FF + f) = w; } }
}

#define XB_TMO      128
#define XB_XCNT(j)  (256  + 64 * (j))
#define XB_XSUB(j)  (1280 + 64 * (j))
#define XB_XGEN(j)  (2304 + 64 * (j))
#define XB_TOP      3328
#define XB_TOPGEN   3392
#define XCD_BAR_WORDS 3456
#define XB_SPIN_CAP (1u << 18)

__device__ __forceinline__ unsigned xb_ld(unsigned* p)              { return __hip_atomic_load(p, __ATOMIC_RELAXED, __HIP_MEMORY_SCOPE_AGENT); }
__device__ __forceinline__ unsigned xb_add(unsigned* p, unsigned v) { return __hip_atomic_fetch_add(p, v, __ATOMIC_RELAXED, __HIP_MEMORY_SCOPE_AGENT); }
__device__ __forceinline__ unsigned xb_xcc_id() { return (unsigned)__builtin_amdgcn_s_getreg((3 << 11) | 20) & 0xFu; }
#define XB_SPIN(cond, bar) do { unsigned _sp = 0; while (cond) { __builtin_amdgcn_s_sleep(1); \
    if ((++_sp & 255u) == 0u) { if (xb_ld(&(bar)[XB_TMO])) break; if (_sp > XB_SPIN_CAP) { atomicAdd(&(bar)[XB_TMO], 1u); break; } } } } while (0)

struct XcdBarrier {
    unsigned* bar; unsigned x;
    volatile LAS unsigned* st;
};

__device__ __forceinline__ XcdBarrier xcd_barrier_post(unsigned* bar, volatile LAS unsigned* st) {
    XcdBarrier b; b.bar = bar; b.x = xb_xcc_id(); b.st = st;
    if (threadIdx.x == 0) st[2] = xb_add(&bar[XB_XCNT(b.x)], 1u);
    return b;
}
__device__ __forceinline__ void xcd_barrier_complete(unsigned* bar, unsigned x, unsigned& nloc, unsigned& nx) {
    const unsigned G = gridDim.x * gridDim.y * gridDim.z;
    unsigned sum, cnt, mine, sp = 0u;
    for (;;) {
        sum = 0u; cnt = 0u; mine = 0u;
#pragma unroll
        for (unsigned j = 0; j < 16; ++j) { const unsigned c = xb_ld(&bar[XB_XCNT(j)]); sum += c; cnt += (c > 0u) ? 1u : 0u; mine = (j == x) ? c : mine; }
        if (sum == G) break;
        __builtin_amdgcn_s_sleep(1);
        if ((++sp & 255u) == 0u) { if (xb_ld(&bar[XB_TMO])) break; if (sp > XB_SPIN_CAP) { atomicAdd(&bar[XB_TMO], 1u); break; } }
    }
    nloc = mine > 0u ? mine : 1u; nx = cnt > 0u ? cnt : 1u;
}

__device__ __forceinline__ void xcd_barrier(const XcdBarrier& b) {
    asm volatile("s_waitcnt vmcnt(0)" ::: "memory");
    __syncthreads();
    if (threadIdx.x == 0) {
        unsigned* bar = b.bar;
        __builtin_amdgcn_s_waitcnt(0);
        unsigned nloc = b.st[0], nx = b.st[1];
        if (nloc == 0u) { xcd_barrier_complete(bar, b.x, nloc, nx); b.st[0] = nloc; b.st[1] = nx; }
        const unsigned old = xb_add(&bar[XB_XSUB(b.x)], 1u);
        const unsigned gen = old / nloc;
        if (old + 1u == (gen + 1u) * nloc) {
            __builtin_amdgcn_fence(__ATOMIC_RELEASE, "agent");
            asm volatile("s_waitcnt vmcnt(0)" ::: "memory");
            const unsigned og = xb_add(&bar[XB_TOP], 1u);
            const unsigned tg = og / nx;
            if (og + 1u == (tg + 1u) * nx) xb_add(&bar[XB_TOPGEN], 1u);
            else XB_SPIN(xb_ld(&bar[XB_TOPGEN]) == tg, bar);
            __builtin_amdgcn_fence(__ATOMIC_ACQUIRE, "agent");
            xb_add(&bar[XB_XGEN(b.x)], 1u);
            asm volatile("s_waitcnt vmcnt(0)" ::: "memory");
        } else {
            XB_SPIN(xb_ld(&bar[XB_XGEN(b.x)]) == gen, bar);
            __builtin_amdgcn_fence(__ATOMIC_ACQUIRE, "agent");
            asm volatile("s_waitcnt vmcnt(0)" ::: "memory");
        }
    }
    __syncthreads();
}
#define XL_SUB(j)  (4096 + 64 * (j))
#define XL_GEN(j)  (5120 + 64 * (j))
__device__ __forceinline__ void xcd_local_barrier(const XcdBarrier& b) {
    asm volatile("s_waitcnt vmcnt(0)" ::: "memory");
    __syncthreads();
    if (threadIdx.x == 0) { unsigned* bar = b.bar; const unsigned nloc = b.st[0];
        const unsigned old = xb_add(&bar[XL_SUB(b.x)], 1u); const unsigned gen = old / nloc;
        if (old + 1u == (gen + 1u) * nloc) xb_add(&bar[XL_GEN(b.x)], 1u);
        else XB_SPIN(xb_ld(&bar[XL_GEN(b.x)]) == gen, bar);
        __builtin_amdgcn_fence(__ATOMIC_ACQUIRE, "agent");
        asm volatile("s_waitcnt vmcnt(0)" ::: "memory"); }
    __syncthreads();
}
__global__ void __launch_bounds__(NWAVES * 64, 2) mk_fwd(Args args) {
    extern __shared__ __attribute__((aligned(16))) unsigned char lds_raw[];
    LAS unsigned char* lds = (LAS unsigned char*)lds_raw;
    const int tid = threadIdx.x, lane = tid & 63, wave = __builtin_amdgcn_readfirstlane(tid >> 6);
    const int G = gridDim.x, gw = blockIdx.x * NWAVES + wave, NGW = G * NWAVES;
    const int lo = args.ph_lo, hi = args.ph_hi;
    unsigned char* ws = args.ws;
    if (tid < 64) ((LAS unsigned*)(lds + LDSCTL_OFF))[tid] = 0u;
    __syncthreads();
    XcdBarrier bar = xcd_barrier_post((unsigned*)(ws + OFF_BAR), (volatile LAS unsigned*)(lds + LDSCTL_OFF) + 8);
#define IN(k) (lo <= (k) && (k) < hi)
#define NREP(k) ((MK_REPEAT == (k) || ((k) == 4 && (MK_REPEAT == 41 || MK_REPEAT == 42))) ? 2 : 1)
#define SEAM(k) do { if (IN(k) && IN((k) + 1)) xcd_barrier(bar); } while (0)
    if (lo < 0) cg::this_grid().sync();
    if (IN(0)) { p0_prologue(args, lds, gw, NGW, lane, wave, true, true); }
    SEAM(0);
    int cvirt = (int)blockIdx.x; bool xlocal = false;
    if (lo == 0 && hi > 2 && (G & 7) == 0) { bool even = true;
#pragma unroll
        for (int j = 0; j < 16; ++j) { const unsigned cj = xb_ld(&bar.bar[XB_XCNT(j)]); even = even && (cj == (j < 8 ? (unsigned)(G >> 3) : 0u)); }
        if (even && bar.x < 8u) { cvirt = (int)(bar.st[2] * 8u + bar.x); xlocal = true; } }
    cvirt = __builtin_amdgcn_readfirstlane(cvirt);
    const int rb = xlocal ? (cvirt & 7) * (G >> 3) + (cvirt >> 3) : (int)blockIdx.x;
    unsigned lgen = 0;
#define LSEAM() do { if (xlocal) { xcd_local_barrier(bar); ++lgen; } else xcd_barrier(bar); } while (0)
    if (IN(1)) { for (int rep = 0; rep < NREP(1); ++rep) { if (rep) xcd_barrier(bar); p1_norm(args, rb * NWAVES + wave, NGW, lane); } }
    if (IN(1) && IN(2)) LSEAM();
    if (IN(2)) { pg8::Gemm g{(const bf16*)(ws + WS_XN), (const bf16*)(ws + WS_WIN), M, INW, D}; pg8::StaticOrder S; S.init(M, INW, G, cvirt);
        pg8::EpiProj E{(bf16*)(ws + WS_PROJ), INW};
        for (int rep = 0; rep < NREP(2); ++rep) { if (rep) xcd_barrier(bar); pg8::gemm_phase<pg8::EpiProj, pg8::StaticOrder, true, true>(lds, g, S, E); } }
    if (IN(2) && IN(3)) LSEAM();
    if (IN(3)) { for (int rep = 0; rep < NREP(3); ++rep) { if (rep) xcd_barrier(bar); __syncthreads(); p3_mixers(args, lds, tid, rb, (xlocal && bar.x > 0u) ? &bar.bar[XL_GEN(bar.x - 1u)] : nullptr, lgen); } }
    if (IN(3) && IN(4)) LSEAM();
    if (IN(4)) { pg8::Gemm g{(const bf16*)(ws + WS_MIXIN), (const bf16*)(ws + WS_WOUT), M, D, D}; pg8::StaticOrder S; S.init(M, D, G, cvirt);
        pg8::EpiBf16SS E{(bf16*)(ws + WS_MIXED), D, (float*)(ws + OFF_SS1)};
        pg8::gemm_phase<pg8::EpiBf16SS, pg8::StaticOrder, true, true>(lds, g, S, E);
        LSEAM();
        p4b_mid(args, rb * NWAVES + wave, NGW, lane); }
    if (IN(4) && IN(5)) LSEAM();
    if (IN(5)) { pg8::Gemm g{(const bf16*)(ws + WS_XN), (const bf16*)(ws + WS_WUP), M, FF2, D}; pg8::StaticOrder S; S.init(M, FF2, G, cvirt);
        pg8::EpiConv E{(bf16*)(ws + WS_ACT), (bf16*)(ws + WS_RAW), args.in[I_CONVW], args.in[I_CONVB], FF, lds + LDSCTL_OFF + 4096};
        for (int rep = 0; rep < NREP(5); ++rep) { if (rep) xcd_barrier(bar); pg8::gemm_phase<pg8::EpiConv, pg8::StaticOrder, true, true>(lds, g, S, E); } }
    SEAM(5);
    if (IN(6)) { p6b_fixup(args, rb * NWAVES + wave, NGW, lane); }
    if (IN(6) && IN(7)) LSEAM();
    if (IN(7)) { pg8::Gemm g{(const bf16*)(ws + WS_ACT), (const bf16*)(ws + WS_WDOWN), M, D, FF}; pg8::StaticOrder S; S.init(M, D, G, cvirt);
        for (int rep = 0; rep < NREP(7); ++rep) { if (rep) xcd_barrier(bar);
        pg8::RowStat st{(float*)(ws + (rep ? 736 * 1024 : OFF_SS4)), (unsigned*)(ws + (rep ? 640 * 1024 : OFF_CNT + 32768)), 32u, 1.0f / D, EPS};
        pg8::EpiFinal E{(const bf16*)(ws + WS_X1B), rep ? (float*)(ws + WS_F) : args.out, (const float*)(ws + OFF_MOD), args.in[I_POSTFFNG], st, D, SEQ / 256};
        pg8::gemm_phase<pg8::EpiFinal, pg8::StaticOrder, true, true>(lds, g, S, E); } }
    if (MK_REPEAT == 17 && IN(7)) { xcd_barrier(bar); pg8::Gemm g{(const bf16*)(ws + WS_ACT), (const bf16*)(ws + WS_WDOWN), M, D, FF}; pg8::StaticOrder S; S.init(M, D, G, (int)blockIdx.x);
        pg8::EpiSink E{(float*)(ws + WS_F)}; pg8::gemm_phase<pg8::EpiSink, pg8::StaticOrder, true, true>(lds, g, S, E); }
#undef IN
#undef SEAM
}

constexpr int N_PHASES = 8;
extern "C" void kernel_launch(void* const* d_in, const int* in_sizes, int n_in, void* d_out, int out_size, void* d_ws, size_t ws_size, hipStream_t stream) {
    static int grid = 0;
    if (grid == 0) {
        if (n_in != 19 || in_sizes[0] != M * D || out_size != M * D || ws_size < WS_END) { fprintf(stderr, "kernel_launch: unexpected shapes (n_in %d, in0 %d, out %d, ws %zu)\n", n_in, n_in > 0 ? in_sizes[0] : -1, out_size, ws_size); grid = -1; return; }
        int dev = 0, cus = 0, per_cu = 0;
        (void)hipGetDevice(&dev); (void)hipDeviceGetAttribute(&cus, hipDeviceAttributeMultiprocessorCount, dev);
        if (hipFuncSetAttribute((const void*)mk_fwd, hipFuncAttributeMaxDynamicSharedMemorySize, LDS_BYTES) != hipSuccess) { fprintf(stderr, "kernel_launch: hipFuncSetAttribute failed\n"); grid = -1; return; }
        if (hipOccupancyMaxActiveBlocksPerMultiprocessor(&per_cu, (const void*)mk_fwd, NWAVES * 64, LDS_BYTES) != hipSuccess || per_cu < 1) { fprintf(stderr, "kernel_launch: occupancy query says %d blocks per CU\n", per_cu); per_cu = 1; }
        (void)hipGetLastError();
        grid = cus > 0 ? cus : 256;
    }
    if (grid < 0) return;
    (void)hipMemsetAsync((char*)d_ws + WS_CTL, 0, CTL_ZERO_BYTES, stream);
    Args a{};
    for (int i = 0; i < 19; ++i) a.in[i] = (const float*)d_in[i];
    a.out = (float*)d_out; a.ws = (unsigned char*)d_ws;
#if MK_N_LAUNCHES == 1
    a.ph_lo = 0; a.ph_hi = N_PHASES;
    void* kargs[] = {&a};
    hipError_t e = hipLaunchCooperativeKernel((const void*)mk_fwd, dim3(grid), dim3(NWAVES * 64), kargs, LDS_BYTES, stream);
    if (e != hipSuccess) fprintf(stderr, "kernel_launch: cooperative launch failed: %s (grid %d)\n", hipGetErrorString(e), grid);
#else
    for (int p = 0; p < N_PHASES; ++p) { a.ph_lo = p; a.ph_hi = p + 1; hipLaunchKernelGGL(mk_fwd, dim3(grid), dim3(NWAVES * 64), LDS_BYTES, stream, a); }
#endif
}
```

```cpp
#include <hip/hip_runtime.h>
#include <hip/hip_cooperative_groups.h>
#include <cstdio>
#include <cstdint>
namespace cg = cooperative_groups;
#ifndef MK_N_LAUNCHES
#define MK_N_LAUNCHES 1
#endif
#ifndef MK_REPEAT
#define MK_REPEAT -1
#endif
namespace pg8 {
#define PG8_LAS __attribute__((address_space(3)))
typedef unsigned short bf16_t;
typedef short bf16x8 __attribute__((ext_vector_type(8)));
typedef float f32x4 __attribute__((ext_vector_type(4)));
typedef unsigned u32x4 __attribute__((ext_vector_type(4)));
constexpr int BM = 256, BK = 64, HALF = 128, HTB = HALF * BK * 2  , STAGE_BYTES = 8 * HTB, NXCD = 8, WGM = 8;

__host__ __device__ __forceinline__ int lds_byte(int r, int c) { const int st = (r >> 4) * 2 + (c >> 5), rr = r & 15, cc = c & 31, ob = rr * 64 + cc * 2; return st * 1024 + (ob ^ (((ob >> 9) & 1) << 5)); }
__host__ __device__ __forceinline__ void stage_rc(int b, int& R, int& C) { const int st = b / 1024, sb = b % 1024, swz = sb ^ (((sb >> 9) & 1) << 5); R = (st >> 1) * 16 + swz / 64; C = (st & 1) * 32 + (swz % 64) / 2; }
__host__ __device__ __forceinline__ int perm32(int rho) { const int n = rho >> 4, i = rho & 15; return 8 * (i >> 2) + 4 * n + (i & 3); }

struct Unit { int pm, pn; };
struct Gemm { const bf16_t* A; const bf16_t* Bt; int M, N, K; };

struct StaticOrder {
    int nM, nN, nwg, G, c;
    __host__ __device__ void init(int M, int N, int G_, int c_) { nM = M / BM; nN = N / BM; nwg = nM * nN; G = G_; c = c_; }
    __host__ __device__ bool next(int i, Unit& u) const {
        const long L = (long)i * G + c; if (L >= nwg) return false;
        int wgid = (int)L; { const int q = nwg / NXCD, r = nwg % NXCD, xcd = wgid % NXCD, off = wgid / NXCD; wgid = (xcd < r ? xcd * (q + 1) : r * (q + 1) + (xcd - r) * q) + off; }
        const int nig = WGM * nN, gid = wgid / nig, fm = gid * WGM, gsz = (nM - fm) < WGM ? (nM - fm) : WGM;
        u.pm = fm + ((wgid % nig) % gsz); u.pn = (wgid % nig) / gsz; return true;
    }
    __device__ __forceinline__ void a_ready(const Unit&) const {}
    __device__ __forceinline__ void done(const Unit&) const {}
};

__device__ __forceinline__ unsigned cvt_pk_bf16(float lo, float hi) { unsigned r; asm volatile("v_cvt_pk_bf16_f32 %0, %1, %2" : "=v"(r) : "v"(lo), "v"(hi)); return r; }
typedef float f32x2 __attribute__((ext_vector_type(2)));
typedef unsigned u32x2 __attribute__((ext_vector_type(2)));
__device__ __forceinline__ float fast_sigmoid_arg2(float p) { return __builtin_amdgcn_rcpf(1.0f + __builtin_amdgcn_exp2f(p)); }
__device__ __forceinline__ float gelu_tanh(float x) {
    const float t = x * x; const float p = x * (-2.302208198f + (-0.1029432397f) * t); return x * fast_sigmoid_arg2(p);
}
__device__ __forceinline__ float silu_f(float x) { return x * fast_sigmoid_arg2(x * (-1.4426950409f)); }
__device__ __forceinline__ float dpp_ror1(float x) { return __builtin_bit_cast(float, __builtin_amdgcn_update_dpp(0, __builtin_bit_cast(int, x), 0x121, 0xf, 0xf, false)); }
__device__ __forceinline__ float dpp_ror2(float x) { return __builtin_bit_cast(float, __builtin_amdgcn_update_dpp(0, __builtin_bit_cast(int, x), 0x122, 0xf, 0xf, false)); }

struct EpiProj {
    static constexpr bool PERM = true, AFTER_DRAIN = false, PERMA = false, HAS_PRE = false;
    bf16_t* O; int ldc;
    __device__ __forceinline__ void operator()(const f32x4 (&acc)[2][2][4][2], const Unit& u, int wr, int wc, int fr, int fq) const {
        const int row0 = u.pm * BM + wr * 64 + fr, col0 = u.pn * BM + wc * 32 + 8 * fq; const bool act = u.pn < 4; const bool edge = !act && (u.pm & 15) == 15 && wr == 1;
#pragma unroll
        for (int ai = 0; ai < 2; ++ai)
#pragma unroll
            for (int m = 0; m < 4; ++m) { bf16_t* rowp = O + (size_t)(row0 + ai * HALF + m * 16) * ldc + col0;
#pragma unroll
                for (int bj = 0; bj < 2; ++bj) { f32x4 v0 = acc[ai][bj][m][0], v1 = acc[ai][bj][m][1];
                    if (act) {
#pragma unroll
                        for (int j = 0; j < 4; ++j) { v0[j] = gelu_tanh(v0[j]); v1[j] = gelu_tanh(v1[j]); } }
                    u32x4 w; w.x = cvt_pk_bf16(v0[0], v0[1]); w.y = cvt_pk_bf16(v0[2], v0[3]); w.z = cvt_pk_bf16(v1[0], v1[1]); w.w = cvt_pk_bf16(v1[2], v1[3]);
                    if (edge && ai == 1 && m == 3) {
                        __hip_atomic_store((unsigned long long*)(rowp + bj * HALF), (unsigned long long)w.x | ((unsigned long long)w.y << 32), __ATOMIC_RELAXED, __HIP_MEMORY_SCOPE_AGENT);
                        __hip_atomic_store((unsigned long long*)(rowp + bj * HALF + 4), (unsigned long long)w.z | ((unsigned long long)w.w << 32), __ATOMIC_RELAXED, __HIP_MEMORY_SCOPE_AGENT); }
                    else *(u32x4*)(rowp + bj * HALF) = w; } }
    }
};

struct EpiF32SS {
    static constexpr bool PERM = false, AFTER_DRAIN = false, PERMA = false, HAS_PRE = false;
    float* O; int ldc; float* ss;
    __device__ __forceinline__ void operator()(const f32x4 (&acc)[2][2][4][2], const Unit& u, int wr, int wc, int fr, int fq) const {
        const int row0 = u.pm * BM + wr * 64 + fr, col0 = u.pn * BM + wc * 32 + 4 * fq;
#pragma unroll
        for (int ai = 0; ai < 2; ++ai)
#pragma unroll
            for (int m = 0; m < 4; ++m) { const int row = row0 + ai * HALF + m * 16; float* rowp = O + (size_t)row * ldc + col0; float s = 0.f;
#pragma unroll
                for (int bj = 0; bj < 2; ++bj)
#pragma unroll
                    for (int n = 0; n < 2; ++n) { const f32x4 x = acc[ai][bj][m][n]; s += (x[0] * x[0] + x[1] * x[1]) + (x[2] * x[2] + x[3] * x[3]); *(f32x4*)(rowp + bj * HALF + n * 16) = x; }
                s += __shfl_xor(s, 16); s += __shfl_xor(s, 32);
                if (fq == 0) atomicAdd(ss + row, s); }
    }
};

struct EpiBf16SS {
    static constexpr bool PERM = true, AFTER_DRAIN = false, PERMA = false, HAS_PRE = false;
    bf16_t* O; int ldc; float* ss;
    __device__ __forceinline__ void operator()(const f32x4 (&acc)[2][2][4][2], const Unit& u, int wr, int wc, int fr, int fq) const {
        const int row0 = u.pm * BM + wr * 64 + fr, col0 = u.pn * BM + wc * 32 + 8 * fq;
#pragma unroll
        for (int ai = 0; ai < 2; ++ai)
#pragma unroll
            for (int m = 0; m < 4; ++m) { const int row = row0 + ai * HALF + m * 16; bf16_t* rowp = O + (size_t)row * ldc + col0; float s = 0.f;
#pragma unroll
                for (int bj = 0; bj < 2; ++bj) { const f32x4 v0 = acc[ai][bj][m][0], v1 = acc[ai][bj][m][1];
                    s += ((v0[0] * v0[0] + v0[1] * v0[1]) + (v0[2] * v0[2] + v0[3] * v0[3])) + ((v1[0] * v1[0] + v1[1] * v1[1]) + (v1[2] * v1[2] + v1[3] * v1[3]));
                    u32x4 w; w.x = cvt_pk_bf16(v0[0], v0[1]); w.y = cvt_pk_bf16(v0[2], v0[3]); w.z = cvt_pk_bf16(v1[0], v1[1]); w.w = cvt_pk_bf16(v1[2], v1[3]);
                    *(u32x4*)(rowp + bj * HALF) = w; }
                s += __shfl_xor(s, 16); s += __shfl_xor(s, 32);
                if (fq == 0) atomicAdd(ss + row, s); }
    }
};

__device__ __forceinline__ float dpp_shr1(float x) { return __builtin_bit_cast(float, __builtin_amdgcn_update_dpp(0, __builtin_bit_cast(int, x), 0x111, 0xf, 0xf, true)); }
struct EpiConv {
    static constexpr bool PERM = true, AFTER_DRAIN = false, PERMA = true, HAS_PRE = true;
    bf16_t* ACT; bf16_t* RAW; const float* cw; const float* cb; int FF; PG8_LAS unsigned char* CB;
    __device__ __forceinline__ void pre(const Unit& u, int par) const {
        const int tid = threadIdx.x, w = __builtin_amdgcn_readfirstlane(tid >> 6), l = tid & 63;
        if (w < 4) { const int vec = 2 * w + (l >> 5), k = vec & 3, hv = vec >> 2; const float* src = (k < 3 ? cw + (size_t)k * 2 * FF : cb) + hv * FF + u.pn * HALF + (l & 31) * 4;
            __builtin_amdgcn_global_load_lds((const unsigned*)src, (PG8_LAS unsigned*)(CB + par * 4096 + w * 1024), 16, 0, 0); }
    }
    __device__ __forceinline__ void run(const f32x4 (&acc)[2][2][4][2], const Unit& u, int wr, int wc, int fr, int fq, int par) const {
        const int f0 = u.pn * HALF + wc * 32 + 8 * fq; const int rowt = u.pm * BM + wr * 64 + 4 * fr; const int FF2 = 2 * FF;
        const PG8_LAS float* cbuf = (const PG8_LAS float*)(CB + par * 4096) + wc * 32 + 8 * fq;
        unsigned stash[2][4][2];
#pragma unroll
        for (int n = 0; n < 2; ++n) { const int f = f0 + 4 * n; const PG8_LAS float* cn = cbuf + 4 * n;
            const f32x4 w0g = *(const PG8_LAS f32x4*)(cn), w1g = *(const PG8_LAS f32x4*)(cn + 128), w2g = *(const PG8_LAS f32x4*)(cn + 256), bg = *(const PG8_LAS f32x4*)(cn + 384);
            const f32x4 w0v = *(const PG8_LAS f32x4*)(cn + 512), w1v = *(const PG8_LAS f32x4*)(cn + 640), w2v = *(const PG8_LAS f32x4*)(cn + 768), bv = *(const PG8_LAS f32x4*)(cn + 896);
#pragma unroll
            for (int ai = 0; ai < 2; ++ai) {
                f32x4 gm1, gm2, vm1, vm2;
#pragma unroll
                for (int j = 0; j < 4; ++j) { gm1[j] = dpp_shr1(acc[ai][0][3][n][j]); gm2[j] = dpp_shr1(acc[ai][0][2][n][j]); vm1[j] = dpp_shr1(acc[ai][1][3][n][j]); vm2[j] = dpp_shr1(acc[ai][1][2][n][j]); }
#pragma unroll
                for (int m = 0; m < 4; ++m) { const f32x4 g = acc[ai][0][m][n], v = acc[ai][1][m][n];
                    const f32x4 pg1 = (m == 0) ? gm1 : acc[ai][0][m > 0 ? m - 1 : 0][n], pg2 = (m == 0) ? gm2 : (m == 1 ? gm1 : acc[ai][0][m > 1 ? m - 2 : 0][n]);
                    const f32x4 pv1 = (m == 0) ? vm1 : acc[ai][1][m > 0 ? m - 1 : 0][n], pv2 = (m == 0) ? vm2 : (m == 1 ? vm1 : acc[ai][1][m > 1 ? m - 2 : 0][n]);
                    const f32x4 yg = bg + w0g * pg2 + w1g * pg1 + w2g * g, yv = bv + w0v * pv2 + w1v * pv1 + w2v * v; f32x4 a;
#pragma unroll
                    for (int j = 0; j < 4; ++j) a[j] = silu_f(yg[j]) * yv[j];
                    const unsigned lo = cvt_pk_bf16(a[0], a[1]), hi = cvt_pk_bf16(a[2], a[3]);
                    if (n == 0) { stash[ai][m][0] = lo; stash[ai][m][1] = hi; }
                    else if (!(m < 2 && fr == 0)) { u32x4 w; w.x = stash[ai][m][0]; w.y = stash[ai][m][1]; w.z = lo; w.w = hi; __builtin_nontemporal_store(w, (u32x4*)(ACT + (size_t)(rowt + ai * HALF + m) * FF + f0)); }
                    if ((m < 2 && fr == 0) || (m >= 2 && fr == 15)) { bf16_t* rp = RAW + ((size_t)((u.pm * 4 + ai * 2 + wr) * 4 + m)) * FF2 + f;
                        u32x2 gw, vw; gw.x = cvt_pk_bf16(g[0], g[1]); gw.y = cvt_pk_bf16(g[2], g[3]); vw.x = cvt_pk_bf16(v[0], v[1]); vw.y = cvt_pk_bf16(v[2], v[3]);
                        *(u32x2*)rp = gw; *(u32x2*)(rp + FF) = vw; } } } }
    }
};

struct RowStat {
    float* ss; unsigned* cnt; unsigned want; float inv_n, eps;
    __device__ __forceinline__ void run(const float (&part)[2][4], float (&rs)[2][4], const Unit& u, int wr, int fr, int fq) const {
        const int row0 = u.pm * BM + wr * 64 + fr; const int lane = fq * 16 + fr;
#pragma unroll
        for (int ai = 0; ai < 2; ++ai)
#pragma unroll
            for (int m = 0; m < 4; ++m) { float s = part[ai][m]; s += __shfl_xor(s, 16); s += __shfl_xor(s, 32); if (fq == 0) atomicAdd(ss + row0 + ai * HALF + m * 16, s); }
        asm volatile("s_waitcnt vmcnt(0)" ::: "memory");
        unsigned* c = cnt + 64 * u.pm;
        if (lane == 0) __hip_atomic_fetch_add(c, 1u, __ATOMIC_RELAXED, __HIP_MEMORY_SCOPE_AGENT);
        if (threadIdx.x < 64) { unsigned sp = 0;
            while ((unsigned)__builtin_amdgcn_readfirstlane(__hip_atomic_load(c, __ATOMIC_RELAXED, __HIP_MEMORY_SCOPE_AGENT)) < want) { __builtin_amdgcn_s_sleep(1); if (++sp > (1u << 22)) break; } }
        asm volatile("s_waitcnt vmcnt(0) lgkmcnt(0)" ::: "memory"); __builtin_amdgcn_s_barrier(); asm volatile("" ::: "memory");
#pragma unroll
        for (int ai = 0; ai < 2; ++ai)
#pragma unroll
            for (int m = 0; m < 4; ++m) { const float v = __hip_atomic_load(ss + row0 + ai * HALF + m * 16, __ATOMIC_RELAXED, __HIP_MEMORY_SCOPE_AGENT); rs[ai][m] = __builtin_amdgcn_rsqf(v * inv_n + eps); }
    }
};
template <int VAR = 0  > struct EpiMid {
    static constexpr bool PERM = false, AFTER_DRAIN = false, PERMA = false, HAS_PRE = false;
    const float* x; float* x1; bf16_t* xn; const float* mod; const float* post_g; const float* ffn_g; const float* sxx; float* ss1; float* ssxm; float* ssmm; unsigned* cnt; PG8_LAS float* A23; int ld, tiles_per_batch;
    __device__ __forceinline__ void operator()(f32x4 (&acc)[2][2][4][2], const Unit& u, int wr, int wc, int fr, int fq) const {
        const int col0 = u.pn * BM + wc * 32 + 4 * fq; const float* mb = mod + (size_t)(u.pm / tiles_per_batch) * (6 * ld); const int tid = threadIdx.x;
        const unsigned voff = (unsigned)((wr * 64 + fr) * ld + col0) * 4u;
        const size_t pbase = (size_t)u.pm * BM * ld; const int row0 = u.pm * BM + wr * 64 + fr;
        if (tid < 256) { const int c = u.pn * BM + tid; A23[tid] = mb[2 * ld + c] * post_g[c]; A23[256 + tid] = ffn_g[c] * (1.0f + mb[4 * ld + c]); A23[512 + tid] = mb[3 * ld + c]; }
        asm volatile("s_waitcnt vmcnt(0) lgkmcnt(0)" ::: "memory"); __builtin_amdgcn_s_barrier(); asm volatile("" ::: "memory");
        const PG8_LAS float* As = A23 + wc * 32 + 4 * fq;
#pragma unroll
        for (int ai = 0; ai < 2; ++ai)
#pragma unroll
            for (int m = 0; m < 4; ++m) { const char* xb = (const char*)(x + pbase + (size_t)(ai * HALF + m * 16) * ld); f32x4 s1 = {0.f, 0.f, 0.f, 0.f}, sx = s1, sm = s1;
#pragma unroll
                for (int bj = 0; bj < 2; ++bj)
#pragma unroll
                    for (int n = 0; n < 2; ++n) { const unsigned o = voff + (unsigned)(bj * HALF + n * 16) * 4u; const f32x4 xv = (VAR == 1) ? (f32x4){1.f, 1.f, 1.f, 1.f} : *(const f32x4*)(xb + o); const f32x4 mx = acc[ai][bj][m][n], cm = mx * *(const PG8_LAS f32x4*)(As + bj * HALF + n * 16);
                        s1 += mx * mx; sx += xv * cm; sm += cm * cm; }
                float a = (s1[0] + s1[1]) + (s1[2] + s1[3]), b = (sx[0] + sx[1]) + (sx[2] + sx[3]), c = (sm[0] + sm[1]) + (sm[2] + sm[3]);
                a += __shfl_xor(a, 16); a += __shfl_xor(a, 32); b += __shfl_xor(b, 16); b += __shfl_xor(b, 32); c += __shfl_xor(c, 16); c += __shfl_xor(c, 32);
                if (fq == 0) { const int r = row0 + ai * HALF + m * 16; atomicAdd(ss1 + r, a); atomicAdd(ssxm + r, b); atomicAdd(ssmm + r, c); }
                if (m == 3) asm volatile("" ::: "memory"); }
        asm volatile("s_waitcnt vmcnt(0)" ::: "memory");
        unsigned* cw = cnt + 64 * u.pm;
        if ((tid & 63) == 0) __hip_atomic_fetch_add(cw, 1u, __ATOMIC_RELAXED, __HIP_MEMORY_SCOPE_AGENT);
        if (tid < 64) { unsigned sp = 0;
            while ((unsigned)__builtin_amdgcn_readfirstlane(__hip_atomic_load(cw, __ATOMIC_RELAXED, __HIP_MEMORY_SCOPE_AGENT)) < 32u) { __builtin_amdgcn_s_sleep(1); if (++sp > (1u << 22)) break; } }
        asm volatile("s_waitcnt vmcnt(0) lgkmcnt(0)" ::: "memory"); __builtin_amdgcn_s_barrier(); asm volatile("" ::: "memory");
        const float inv_n = 1.0f / (float)ld; float rs1[2][4], rs2[2][4];
#pragma unroll
        for (int ai = 0; ai < 2; ++ai)
#pragma unroll
            for (int m = 0; m < 4; ++m) { const int r = row0 + ai * HALF + m * 16;
                const float S1 = __hip_atomic_load(ss1 + r, __ATOMIC_RELAXED, __HIP_MEMORY_SCOPE_AGENT), Sxm = __hip_atomic_load(ssxm + r, __ATOMIC_RELAXED, __HIP_MEMORY_SCOPE_AGENT), Smm = __hip_atomic_load(ssmm + r, __ATOMIC_RELAXED, __HIP_MEMORY_SCOPE_AGENT);
                const float r1 = __builtin_amdgcn_rsqf(S1 * inv_n + 1e-6f); rs1[ai][m] = r1;
                const float s2 = sxx[r] + 2.0f * r1 * Sxm + r1 * r1 * Smm; rs2[ai][m] = __builtin_amdgcn_rsqf(s2 * inv_n + 1e-6f); }
        if (VAR != 0) { if (rs1[0][0] + rs2[1][3] + rs1[1][2] + rs2[0][1] == 1.2345e33f) x1[row0] = rs1[0][1]; return; }
#pragma unroll
        for (int ai = 0; ai < 2; ++ai)
#pragma unroll
            for (int m = 0; m < 4; ++m) { const size_t gb = pbase + (size_t)(ai * HALF + m * 16) * ld; const char* xb = (const char*)(x + gb); char* ob = (char*)(x1 + gb); char* nb = (char*)(xn + gb);
#pragma unroll
                for (int bj = 0; bj < 2; ++bj)
#pragma unroll
                    for (int n = 0; n < 2; ++n) { const unsigned o = voff + (unsigned)(bj * HALF + n * 16) * 4u; const f32x4 xv = *(const f32x4*)(xb + o);
                        const f32x4 v = xv + acc[ai][bj][m][n] * rs1[ai][m] * *(const PG8_LAS f32x4*)(As + bj * HALF + n * 16);
                        *(f32x4*)(ob + o) = v;
                        const f32x4 a2 = *(const PG8_LAS f32x4*)(As + 256 + bj * HALF + n * 16), a3 = *(const PG8_LAS f32x4*)(As + 512 + bj * HALF + n * 16); const f32x4 h = v * rs2[ai][m] * a2 + a3;
                        u32x2 wv; wv.x = cvt_pk_bf16(h[0], h[1]); wv.y = cvt_pk_bf16(h[2], h[3]); *(u32x2*)(nb + (o >> 1)) = wv; }
                if (m == 3) asm volatile("" ::: "memory"); }
    }
};
struct EpiFinal {
    static constexpr bool PERM = false, AFTER_DRAIN = false, PERMA = false, HAS_PRE = false;
    const bf16_t* src; float* out; const float* mod; const float* post_g; RowStat st; int ld, tiles_per_batch;
    __device__ __forceinline__ void operator()(f32x4 (&acc)[2][2][4][2], const Unit& u, int wr, int wc, int fr, int fq) const {
        const int col0 = u.pn * BM + wc * 32 + 4 * fq; const float* mb = mod + (size_t)(u.pm / tiles_per_batch) * (6 * ld);
        const unsigned voff = (unsigned)((wr * 64 + fr) * ld + col0) * 4u, cvo = (unsigned)col0 * 4u; const size_t pbase = (size_t)u.pm * BM * ld;
        float part[2][4], rs[2][4];
#pragma unroll
        for (int ai = 0; ai < 2; ++ai)
#pragma unroll
            for (int m = 0; m < 4; ++m) { float s = 0.f;
#pragma unroll
                for (int bj = 0; bj < 2; ++bj)
#pragma unroll
                    for (int n = 0; n < 2; ++n) { const f32x4 v = acc[ai][bj][m][n]; s += (v[0] * v[0] + v[1] * v[1]) + (v[2] * v[2] + v[3] * v[3]); }
                part[ai][m] = s; }
        u32x2 xpre[2][4][2][2];
#pragma unroll
        for (int ai = 0; ai < 2; ++ai)
#pragma unroll
            for (int m = 0; m < 4; ++m) { const char* sb = (const char*)(src + pbase + (size_t)(ai * HALF + m * 16) * ld);
#pragma unroll
                for (int bj = 0; bj < 2; ++bj)
#pragma unroll
                    for (int n = 0; n < 2; ++n) xpre[ai][m][bj][n] = *(const u32x2*)(sb + ((voff + (unsigned)(bj * HALF + n * 16) * 4u) >> 1)); }
        st.run(part, rs, u, wr, fr, fq);
        f32x4 A1[2][2];
#pragma unroll
        for (int bj = 0; bj < 2; ++bj)
#pragma unroll
            for (int n = 0; n < 2; ++n) { const unsigned co = cvo + (unsigned)(bj * HALF + n * 16) * 4u; A1[bj][n] = *(const f32x4*)((const char*)(mb + 5 * ld) + co) * *(const f32x4*)((const char*)post_g + co); }
#pragma unroll
        for (int ai = 0; ai < 2; ++ai)
#pragma unroll
            for (int m = 0; m < 4; ++m) { char* ob = (char*)(out + pbase + (size_t)(ai * HALF + m * 16) * ld);
#pragma unroll
                for (int bj = 0; bj < 2; ++bj)
#pragma unroll
                    for (int n = 0; n < 2; ++n) { const unsigned o = voff + (unsigned)(bj * HALF + n * 16) * 4u; const u32x2 xw = xpre[ai][m][bj][n];
                        const f32x4 xv = {__builtin_bit_cast(float, xw.x << 16), __builtin_bit_cast(float, xw.x & 0xffff0000u), __builtin_bit_cast(float, xw.y << 16), __builtin_bit_cast(float, xw.y & 0xffff0000u)};
                        *(f32x4*)(ob + o) = xv + acc[ai][bj][m][n] * rs[ai][m] * A1[bj][n]; }
                if (m == 3) asm volatile("" ::: "memory"); }
    }
};

struct EpiSink {
    static constexpr bool PERM = false, AFTER_DRAIN = false, PERMA = false, HAS_PRE = false;
    float* O;
    __device__ __forceinline__ void operator()(f32x4 (&acc)[2][2][4][2], const Unit& u, int wr, int wc, int fr, int fq) const {
        f32x4 s = {0.f, 0.f, 0.f, 0.f};
#pragma unroll
        for (int ai = 0; ai < 2; ++ai)
#pragma unroll
            for (int bj = 0; bj < 2; ++bj)
#pragma unroll
                for (int m = 0; m < 4; ++m)
#pragma unroll
                    for (int n = 0; n < 2; ++n) s += acc[ai][bj][m][n];
        if (s[0] + s[1] + s[2] + s[3] == 1.2345e33f) O[u.pm * 256 + wr * 64 + fr + wc + fq] = s[0];
    }
};
template <class Epi, class Sched, bool ALIGN_EPI = false, bool SP2 = false>
__device__ __forceinline__ void gemm_phase(PG8_LAS unsigned char* lds, const Gemm g, const Sched& S, const Epi& E) {
    const int tid = threadIdx.x, wid = __builtin_amdgcn_readfirstlane(tid >> 6), lane = tid & 63, wr = wid >> 2, wc = wid & 3, fr = lane & 15, fq = lane >> 4;
    const int K = g.K, nt = K / BK;
    unsigned voffA[2], voffB[2];
#pragma unroll
    for (int i = 0; i < 2; ++i) { int R, C; stage_rc(tid * 16 + i * 8192, R, C); const int Rb = Epi::PERM ? ((R & ~31) + perm32(R & 31)) : R;
        const int Ra = Epi::PERMA ? ((R & ~63) + 4 * (R & 15) + ((R & 63) >> 4)) : R;
        voffA[i] = (unsigned)(Ra * K + C) * 2u; voffB[i] = (unsigned)(Rb * K + C) * 2u; }
    const size_t kstep = (size_t)(BK * 2);
    const size_t hstep = (size_t)HALF * K * 2;
    const size_t tstep = 2 * hstep;
    const unsigned ldsw = (unsigned)wid * 1024u;
    const int aoff = lds_byte(wr * 64 + fr, fq * 8), boff = lds_byte(wc * 32 + fr, fq * 8);
#define PG8_SA(b, h) (((b) * 2 + (h)) * HTB)
#define PG8_SB(b, h) ((4 + (b) * 2 + (h)) * HTB)
#define PG8_STAGE(bufoff, gbase, voff) do { _Pragma("unroll") for (int _i = 0; _i < 2; ++_i) \
        __builtin_amdgcn_global_load_lds((const unsigned*)((const char*)(gbase) + (voff)[_i]), (PG8_LAS unsigned*)(lds + (bufoff) + ldsw + _i * 8192), 16, 0, 0); } while (0)
#define PG8_LDA(dst, b, h) do { _Pragma("unroll") for (int m = 0; m < 4; ++m) _Pragma("unroll") for (int k = 0; k < 2; ++k) dst[m][k] = *(const PG8_LAS bf16x8*)(lds + PG8_SA(b, h) + aoff + m * 2048 + k * 1024); } while (0)
#define PG8_LDB(dst, b, h) do { _Pragma("unroll") for (int n = 0; n < 2; ++n) _Pragma("unroll") for (int k = 0; k < 2; ++k) dst[n][k] = *(const PG8_LAS bf16x8*)(lds + PG8_SB(b, h) + boff + n * 2048 + k * 1024); } while (0)
#define PG8_MMA(ai, bj, At, Bt) do { __builtin_amdgcn_s_setprio(1); _Pragma("unroll") for (int m = 0; m < 4; ++m) _Pragma("unroll") for (int n = 0; n < 2; ++n) _Pragma("unroll") for (int k = 0; k < 2; ++k) \
        acc[ai][bj][m][n] = __builtin_amdgcn_mfma_f32_16x16x32_bf16(Bt[n][k], At[m][k], acc[ai][bj][m][n], 0, 0, 0); __builtin_amdgcn_s_setprio(0); } while (0)
#define PG8_WAIT_V(n) asm volatile("s_waitcnt vmcnt(" #n ")" ::: "memory")
#define PG8_WAIT_L(n) asm volatile("s_waitcnt lgkmcnt(" #n ")" ::: "memory")
#define PG8_BAR __builtin_amdgcn_s_barrier()
#define PG8_SCHED __builtin_amdgcn_sched_barrier(0)
    Unit cur, nxt; int ui = 0;
    if (!S.next(0, cur)) return;
    f32x4 acc[2][2][4][2];
#pragma unroll
    for (int a = 0; a < 2; ++a)
#pragma unroll
        for (int b = 0; b < 2; ++b)
#pragma unroll
            for (int m = 0; m < 4; ++m)
#pragma unroll
                for (int n = 0; n < 2; ++n) acc[a][b][m][n] = (f32x4){0.f, 0.f, 0.f, 0.f};
    bf16x8 At[4][2], B0[2][2], B1[2][2];
    const char* cA = (const char*)g.A + (size_t)cur.pm * tstep; const char* cB = (const char*)g.Bt + (size_t)cur.pn * tstep;
    S.a_ready(cur);
    if constexpr (Epi::HAS_PRE) E.pre(cur, 0);
    if constexpr (SP2) {
        PG8_STAGE(PG8_SB(0, 0), cB, voffB); PG8_STAGE(PG8_SB(0, 1), cB + hstep, voffB); PG8_STAGE(PG8_SA(0, 0), cA, voffA); PG8_STAGE(PG8_SA(0, 1), cA + hstep, voffA);
        if (wr == 1) PG8_BAR;
        PG8_WAIT_V(2); PG8_BAR;
        PG8_STAGE(PG8_SB(1, 0), cB + kstep, voffB); PG8_STAGE(PG8_SA(1, 0), cA + kstep, voffA); PG8_STAGE(PG8_SB(1, 1), cB + hstep + kstep, voffB);
        PG8_WAIT_V(6); PG8_BAR;
    } else {
        PG8_STAGE(PG8_SB(0, 0), cB, voffB); PG8_STAGE(PG8_SA(0, 0), cA, voffA); PG8_STAGE(PG8_SB(0, 1), cB + hstep, voffB); PG8_STAGE(PG8_SA(0, 1), cA + hstep, voffA);
        if (wr == 1) PG8_BAR;
        PG8_WAIT_V(4); PG8_BAR;
        PG8_STAGE(PG8_SB(1, 0), cB + kstep, voffB); PG8_STAGE(PG8_SA(1, 0), cA + kstep, voffA); PG8_STAGE(PG8_SB(1, 1), cB + hstep + kstep, voffB);
        PG8_WAIT_V(6); PG8_BAR;
    }
    for (;;) {
        const bool has_next = S.next(ui + 1, nxt);
        const char* nA = has_next ? (const char*)g.A + (size_t)nxt.pm * tstep : cA; const char* nB = has_next ? (const char*)g.Bt + (size_t)nxt.pn * tstep : cB;
        for (int t = 0; t < nt; t += 2) {
            const bool last = (t == nt - 2);
            const char* a1 = cA + (size_t)(t + 1) * kstep;
            const char* a2 = last ? nA : cA + (size_t)(t + 2) * kstep; const char* b2 = last ? nB : cB + (size_t)(t + 2) * kstep;
            const char* a3 = a2 + kstep; const char* b3 = b2 + kstep;
            if (last && has_next) S.a_ready(nxt);
            if constexpr (SP2) {
            PG8_LDB(B0, 0, 0); PG8_LDB(B1, 0, 1); PG8_SCHED; PG8_LDA(At, 0, 0); PG8_STAGE(PG8_SA(1, 1), a1 + hstep, voffA);
            PG8_WAIT_V(8); PG8_WAIT_L(0); PG8_BAR; PG8_MMA(0, 0, At, B0); PG8_MMA(0, 1, At, B1); PG8_BAR; PG8_SCHED;
            PG8_LDA(At, 0, 1); PG8_STAGE(PG8_SB(0, 0), b2, voffB); PG8_STAGE(PG8_SB(0, 1), b2 + hstep, voffB); PG8_STAGE(PG8_SA(0, 0), a2, voffA);
            PG8_WAIT_V(8); PG8_WAIT_L(0); PG8_BAR; PG8_MMA(1, 0, At, B0); PG8_MMA(1, 1, At, B1); PG8_BAR; PG8_SCHED;
            PG8_LDB(B0, 1, 0); PG8_LDB(B1, 1, 1); PG8_SCHED; PG8_LDA(At, 1, 0); PG8_STAGE(PG8_SA(0, 1), a2 + hstep, voffA);
            PG8_WAIT_V(8); PG8_WAIT_L(0); PG8_BAR; PG8_MMA(0, 0, At, B0); PG8_MMA(0, 1, At, B1); PG8_BAR; PG8_SCHED;
            PG8_LDA(At, 1, 1); PG8_STAGE(PG8_SB(1, 0), b3, voffB); PG8_STAGE(PG8_SB(1, 1), b3 + hstep, voffB); PG8_STAGE(PG8_SA(1, 0), a3, voffA);
            PG8_WAIT_V(8); PG8_WAIT_L(0); PG8_BAR; PG8_MMA(1, 0, At, B0); PG8_MMA(1, 1, At, B1); PG8_BAR; PG8_SCHED;
            } else {
            PG8_LDB(B0, 0, 0); PG8_SCHED; PG8_LDA(At, 0, 0); PG8_STAGE(PG8_SA(1, 1), a1 + hstep, voffA);
            PG8_WAIT_L(8); PG8_BAR; PG8_WAIT_L(0); PG8_MMA(0, 0, At, B0); PG8_BAR; PG8_SCHED;
            PG8_LDB(B1, 0, 1); PG8_STAGE(PG8_SB(0, 0), b2, voffB);
            PG8_BAR; PG8_WAIT_L(0); PG8_MMA(0, 1, At, B1); PG8_BAR;
            PG8_LDA(At, 0, 1); PG8_STAGE(PG8_SA(0, 0), a2, voffA);
            PG8_BAR; PG8_WAIT_L(0); PG8_MMA(1, 0, At, B0); PG8_BAR; PG8_SCHED;
            PG8_STAGE(PG8_SB(0, 1), b2 + hstep, voffB);
            PG8_WAIT_V(6); PG8_BAR; PG8_MMA(1, 1, At, B1); PG8_BAR;
            PG8_LDB(B0, 1, 0); PG8_SCHED; PG8_LDA(At, 1, 0); PG8_STAGE(PG8_SA(0, 1), a2 + hstep, voffA);
            PG8_WAIT_L(8); PG8_BAR; PG8_WAIT_L(0); PG8_MMA(0, 0, At, B0); PG8_BAR; PG8_SCHED;
            PG8_LDB(B1, 1, 1); PG8_STAGE(PG8_SB(1, 0), b3, voffB);
            PG8_BAR; PG8_WAIT_L(0); PG8_MMA(0, 1, At, B1); PG8_BAR;
            PG8_LDA(At, 1, 1); PG8_STAGE(PG8_SA(1, 0), a3, voffA);
            PG8_BAR; PG8_WAIT_L(0); PG8_MMA(1, 0, At, B0); PG8_BAR; PG8_SCHED;
            PG8_STAGE(PG8_SB(1, 1), b3 + hstep, voffB);
            PG8_WAIT_V(6); PG8_BAR; PG8_MMA(1, 1, At, B1); PG8_BAR;
            }
        }
        if constexpr (ALIGN_EPI) { if (wr == 0) PG8_BAR; }
        if constexpr (Epi::HAS_PRE) { if (has_next) E.pre(nxt, (ui + 1) & 1); E.run(acc, cur, wr, wc, fr, fq, ui & 1); S.done(cur); }
        else if constexpr (!Epi::AFTER_DRAIN) { E(acc, cur, wr, wc, fr, fq); S.done(cur); }
        if (!has_next) break;
#pragma unroll
        for (int a = 0; a < 2; ++a)
#pragma unroll
            for (int b = 0; b < 2; ++b)
#pragma unroll
                for (int m = 0; m < 4; ++m)
#pragma unroll
                    for (int n = 0; n < 2; ++n) acc[a][b][m][n] = (f32x4){0.f, 0.f, 0.f, 0.f};
        cur = nxt; cA = nA; cB = nB; ++ui;
        if constexpr (ALIGN_EPI) { if (wr == 1) PG8_BAR; }
    }
    PG8_WAIT_V(0);
    if constexpr (!ALIGN_EPI) { if (wr == 0) PG8_BAR; }
    PG8_BAR;
    if constexpr (Epi::AFTER_DRAIN) { E.fused(acc, cur, wr, wc, fr, fq, lds, wid, lane); S.done(cur); }
#undef PG8_SA
#undef PG8_SB
#undef PG8_STAGE
#undef PG8_LDA
#undef PG8_LDB
#undef PG8_MMA
#undef PG8_WAIT_V
#undef PG8_WAIT_L
#undef PG8_BAR
#undef PG8_SCHED
}
}
constexpr int NWAVES = 8;
constexpr int BATCH = 4, SEQ = 8192, D = 1024, M = BATCH * SEQ;
constexpr int INW = 1536, AW = 512, FF = 2816, FF2 = 2 * FF, NMOD = 6 * D;
constexpr float EPS = 1e-6f;
constexpr size_t MiB = 1u << 20;
constexpr size_t WS_CTL = 0, CTL_ZERO_BYTES = 1 * MiB;
constexpr size_t OFF_MOD = 0, OFF_SS1 = 128 * 1024, OFF_SS2 = 256 * 1024, OFF_SS3 = 384 * 1024, OFF_BAR = 512 * 1024, OFF_CNT = 544 * 1024, OFF_SS4 = 896 * 1024;
constexpr size_t WS_WIN = 1 * MiB, WS_WOUT = 4 * MiB, WS_WUP = 6 * MiB, WS_WDOWN = 17 * MiB, WS_WSP = 23 * MiB, WS_WPOOL = WS_WSP + 256 * 1024;
constexpr size_t WS_SXX = 23 * MiB + 512 * 1024;
constexpr size_t WS_XN = 24 * MiB;
constexpr size_t WS_PROJ = 88 * MiB;
constexpr size_t WS_MIXIN = 184 * MiB;
constexpr size_t WS_MIXED = WS_PROJ;
constexpr size_t WS_ACT = 248 * MiB;
constexpr size_t WS_RAW = 424 * MiB;
constexpr size_t WS_X1B = 446 * MiB;
constexpr size_t WS_F = WS_ACT;
constexpr size_t WS_END = 510 * MiB;
static_assert(WS_XN + (size_t)M * D * 2 <= WS_PROJ && WS_PROJ + (size_t)M * INW * 2 <= WS_MIXIN && WS_MIXIN + (size_t)M * D * 2 <= WS_ACT && WS_ACT + (size_t)M * FF * 2 <= WS_RAW && WS_RAW + (size_t)(M / 64) * 4 * FF2 * 2 <= WS_X1B && WS_X1B + (size_t)M * D * 2 <= WS_END, "d_ws map");
static_assert(WS_WUP + (size_t)FF2 * D * 2 <= WS_WDOWN && WS_WDOWN + (size_t)D * FF * 2 <= WS_WSP && WS_WPOOL + 4 * 128 * 128 * 2 <= WS_XN, "d_ws weights");
constexpr int RING_BYTES = 131072, LDSCTL_OFF = RING_BYTES, LDS_BYTES = 147456;

#define GAS __attribute__((address_space(1)))
#define LAS __attribute__((address_space(3)))
typedef unsigned short bf16;
typedef unsigned v4u __attribute__((ext_vector_type(4)));
typedef unsigned v2u __attribute__((ext_vector_type(2)));
typedef float f32x4 __attribute__((ext_vector_type(4)));
typedef short bf16x8 __attribute__((ext_vector_type(8)));
#define LDS_WAIT() asm volatile("s_waitcnt lgkmcnt(0)" ::: "memory")
__device__ __forceinline__ unsigned f2bf(float f) { unsigned u = __builtin_bit_cast(unsigned, f); return (u + 0x7fffu + ((u >> 16) & 1u)) >> 16; }
__device__ __forceinline__ unsigned pk2(float lo, float hi) { unsigned r; asm("v_cvt_pk_bf16_f32 %0, %1, %2" : "=v"(r) : "v"(lo), "v"(hi)); return r; }
__device__ __forceinline__ float bf_lo(unsigned w) { return __builtin_bit_cast(float, w << 16); }
__device__ __forceinline__ float bf_hi(unsigned w) { return __builtin_bit_cast(float, w & 0xffff0000u); }
__device__ __forceinline__ float wave_sum(float v) {
#pragma unroll
    for (int o = 1; o < 64; o <<= 1) v += __shfl_xor(v, o);
    return v;
}
__device__ __forceinline__ float silu_acc(float x) { return x / (1.0f + __expf(-x)); }

struct Args { const float* in[19]; float* out; unsigned char* ws; int ph_lo, ph_hi; };
enum { I_X = 0, I_C, I_WADA, I_BADA, I_PREMIXG, I_POSTMIXG, I_WIN, I_SGUG, I_WSP, I_BSP, I_WPOOL, I_PSCALE, I_WOUT, I_PREFFNG, I_POSTFFNG, I_WUP, I_CONVW, I_CONVB, I_WDOWN };

__device__ __forceinline__ void transpose_item(const float* W, int K, int N, bf16* WT, int k0, int n0, int drow0, LAS float* scr, int lane) {
    { f32x4 v[8];
#pragma unroll
        for (int i = 0; i < 8; ++i) v[i] = __builtin_nontemporal_load((const f32x4*)(W + (size_t)(k0 + 8 * i + (lane >> 3)) * N + n0 + 4 * (lane & 7)));
#pragma unroll
        for (int i = 0; i < 8; ++i) { LAS float* d = scr + (8 * i + (lane >> 3)) * 33 + 4 * (lane & 7); d[0] = v[i].x; d[1] = v[i].y; d[2] = v[i].z; d[3] = v[i].w; } }
    LDS_WAIT(); asm volatile("" ::: "memory");
    const int c = lane & 7;
#pragma unroll
    for (int j = 0; j < 4; ++j) { const int n = (lane >> 3) + 8 * j; const LAS float* s = scr + (8 * c) * 33 + n;
        v4u o; o.x = pk2(s[0 * 33], s[1 * 33]); o.y = pk2(s[2 * 33], s[3 * 33]); o.z = pk2(s[4 * 33], s[5 * 33]); o.w = pk2(s[6 * 33], s[7 * 33]);
        *(v4u*)(WT + (size_t)(drow0 + n) * K + k0 + 8 * c) = o; }
    LDS_WAIT(); asm volatile("" ::: "memory");
}

__device__ __forceinline__ void p0_prologue(const Args& a, LAS unsigned char* lds, int gw, int NGW, int lane, int wave, bool with_mod, bool with_rest) {
    unsigned char* ws = a.ws;
    float* MOD = (float*)(ws + OFF_MOD);
    const float* c = a.in[I_C]; const float* wada = a.in[I_WADA]; const float* bada = a.in[I_BADA];
    for (int it = with_mod ? gw : 96 * 16; it < 96 * 16; it += NGW) { const int cb = it % 96, ks = it / 96, col = cb * 64 + lane; float a0 = 0.f, a1 = 0.f, a2 = 0.f, a3 = 0.f;
        const float sv0 = silu_acc(c[ks * 64 + lane]), sv1 = silu_acc(c[D + ks * 64 + lane]), sv2 = silu_acc(c[2 * D + ks * 64 + lane]), sv3 = silu_acc(c[3 * D + ks * 64 + lane]);
#pragma unroll 32
        for (int kk = 0; kk < 64; ++kk) { const float w = __builtin_nontemporal_load(wada + (size_t)(ks * 64 + kk) * NMOD + col);
            a0 += __builtin_bit_cast(float, __builtin_amdgcn_readlane(__builtin_bit_cast(int, sv0), kk)) * w; a1 += __builtin_bit_cast(float, __builtin_amdgcn_readlane(__builtin_bit_cast(int, sv1), kk)) * w;
            a2 += __builtin_bit_cast(float, __builtin_amdgcn_readlane(__builtin_bit_cast(int, sv2), kk)) * w; a3 += __builtin_bit_cast(float, __builtin_amdgcn_readlane(__builtin_bit_cast(int, sv3), kk)) * w; }
        if (ks == 0) { const float b = bada[col]; a0 += b; a1 += b; a2 += b; a3 += b; }
        atomicAdd(MOD + col, a0); atomicAdd(MOD + NMOD + col, a1); atomicAdd(MOD + 2 * NMOD + col, a2); atomicAdd(MOD + 3 * NMOD + col, a3); }
    if (!with_rest) return;
    LAS float* scr = (LAS float*)(lds + wave * 16384);
    constexpr int I_IN = (D / 64) * (INW / 32), I_OUT = (D / 64) * (D / 32), I_UP = (D / 64) * (FF2 / 32), I_DOWN = (FF / 64) * (D / 32), I_POOL = 4 * 2 * 4;
    constexpr int NITEMS = I_IN + I_OUT + I_UP + I_DOWN + I_POOL;
    for (int it = gw; it < NITEMS; it += NGW) { int r = it;
        if (r < I_IN) { const int nb = INW / 32, kb = r / nb, n0 = 32 * (r % nb); transpose_item(a.in[I_WIN], D, INW, (bf16*)(ws + WS_WIN), 64 * kb, n0, n0, scr, lane); continue; } r -= I_IN;
        if (r < I_OUT) { const int nb = D / 32, kb = r / nb, n0 = 32 * (r % nb); transpose_item(a.in[I_WOUT], D, D, (bf16*)(ws + WS_WOUT), 64 * kb, n0, n0, scr, lane); continue; } r -= I_OUT;
        if (r < I_UP) { const int nb = FF2 / 32, kb = r / nb, n0 = 32 * (r % nb); const int half = n0 / FF, f = n0 % FF, drow = 256 * (f / 128) + 128 * half + (f % 128);
            transpose_item(a.in[I_WUP], D, FF2, (bf16*)(ws + WS_WUP), 64 * kb, n0, drow, scr, lane); continue; } r -= I_UP;
        if (r < I_DOWN) { const int nb = D / 32, kb = r / nb, n0 = 32 * (r % nb); transpose_item(a.in[I_WDOWN], FF, D, (bf16*)(ws + WS_WDOWN), 64 * kb, n0, n0, scr, lane); continue; } r -= I_DOWN;
        { const int g = r / 8, q = r % 8, kb = q / 4, n0 = 32 * (q % 4); transpose_item(a.in[I_WPOOL] + (size_t)g * 16384, 128, 128, (bf16*)(ws + WS_WPOOL) + (size_t)g * 16384, 64 * kb, n0, n0, scr, lane); } }
    { const float* wsp = a.in[I_WSP]; bf16* o = (bf16*)(ws + WS_WSP);
        for (int e = gw * 64 + lane; e < 4 * 128 * 128; e += NGW * 64) { const int i = (e >> 7) & 127, j = e & 127; const float v = ((j >> 6) <= (i >> 6)) ? wsp[e] : 0.f; o[e] = (bf16)f2bf(v); } }
}

__device__ __forceinline__ void p1_norm(const Args& a, int gw, int NGW, int lane) {
    const float* MOD = (const float*)(a.ws + OFF_MOD); bf16* XN = (bf16*)(a.ws + WS_XN); const float* x = a.in[I_X]; const float* g = a.in[I_PREMIXG]; float* SXX = (float*)(a.ws + WS_SXX);
    const int rpw = M / NGW;
    for (int r0 = gw * rpw; r0 < M; r0 += NGW * rpw) { const int b = r0 / SEQ; const float* mb = MOD + (size_t)b * NMOD;
        f32x4 A[4], B[4];
#pragma unroll
        for (int j = 0; j < 4; ++j) { const int col = 4 * lane + 256 * j; const f32x4 gg = *(const f32x4*)(g + col), sc = *(const f32x4*)(mb + D + col); A[j] = gg * (1.0f + sc); B[j] = *(const f32x4*)(mb + col); }
        f32x4 nx[4];
        { const f32x4* xr = (const f32x4*)(x + (size_t)r0 * D) + lane;
#pragma unroll
            for (int j = 0; j < 4; ++j) nx[j] = __builtin_nontemporal_load(xr + 64 * j); }
        for (int r = r0; r < r0 + rpw; ++r) { f32x4 v[4]; float s = 0.f;
#pragma unroll
            for (int j = 0; j < 4; ++j) { v[j] = nx[j]; s += (v[j].x * v[j].x + v[j].y * v[j].y) + (v[j].z * v[j].z + v[j].w * v[j].w); }
            if (r + 1 < r0 + rpw) { const f32x4* xr = (const f32x4*)(x + (size_t)(r + 1) * D) + lane;
#pragma unroll
                for (int j = 0; j < 4; ++j) nx[j] = __builtin_nontemporal_load(xr + 64 * j); }
            const float st = wave_sum(s);
            const float rs = 1.0f / sqrtf(st * (1.0f / D) + EPS);
            v2u* o = (v2u*)(XN + (size_t)r * D) + lane;
#pragma unroll
            for (int j = 0; j < 4; ++j) { const f32x4 h = v[j] * rs * A[j] + B[j]; const unsigned long long w = (unsigned long long)pk2(h.x, h.y) | ((unsigned long long)pk2(h.z, h.w) << 32);
                __hip_atomic_store((unsigned long long*)(o + 64 * j), w, __ATOMIC_RELAXED, __HIP_MEMORY_SCOPE_AGENT); } } }
}

constexpr int P3_RA = 0, P3_RB = 34816, P3_RP = 69632, P3_RC = 108800, P3_PA = 272, P3_PV = 264;
__device__ __forceinline__ void p3_mma(LAS unsigned char* lds, bool natural_b, f32x4 (&acc)[4][2], int wr, int wc, int fr, int fq) {
#pragma unroll
    for (int m = 0; m < 4; ++m)
#pragma unroll
        for (int n = 0; n < 2; ++n) acc[m][n] = (f32x4){0.f, 0.f, 0.f, 0.f};
#pragma unroll
    for (int kk = 0; kk < 4; ++kk) { bf16x8 af[4], bfr[2];
#pragma unroll
        for (int m = 0; m < 4; ++m) af[m] = *(const LAS bf16x8*)(lds + P3_RA + (64 * wr + 16 * m + fr) * P3_PA + (32 * kk + 8 * fq) * 2);
        if (natural_b) {
            { const unsigned addr = (unsigned)(size_t)(lds + P3_RB) + (unsigned)((32 * kk + 8 * fq + (fr >> 2)) * P3_PV + (32 * wc + 4 * (fr & 3)) * 2);
                v2u l0, h0, l1, h1;
                asm volatile("ds_read_b64_tr_b16 %0, %4\n\tds_read_b64_tr_b16 %1, %4 offset:%5\n\tds_read_b64_tr_b16 %2, %4 offset:32\n\tds_read_b64_tr_b16 %3, %4 offset:%6\n\ts_waitcnt lgkmcnt(0)"
                             : "=&v"(l0), "=&v"(h0), "=&v"(l1), "=&v"(h1) : "v"(addr), "n"(4 * P3_PV), "n"(4 * P3_PV + 32) : "memory");
                v4u w0, w1; w0.x = l0.x; w0.y = l0.y; w0.z = h0.x; w0.w = h0.y; w1.x = l1.x; w1.y = l1.y; w1.z = h1.x; w1.w = h1.y;
                bfr[0] = __builtin_bit_cast(bf16x8, w0); bfr[1] = __builtin_bit_cast(bf16x8, w1); }
        } else {
#pragma unroll
            for (int n = 0; n < 2; ++n) bfr[n] = *(const LAS bf16x8*)(lds + P3_RB + (32 * wc + 16 * n + fr) * P3_PA + (32 * kk + 8 * fq) * 2);
        }
#pragma unroll
        for (int m = 0; m < 4; ++m)
#pragma unroll
            for (int n = 0; n < 2; ++n) acc[m][n] = __builtin_amdgcn_mfma_f32_16x16x32_bf16(bfr[n], af[m], acc[m][n], 0, 0, 0); }
}
template <int W> __device__ __forceinline__ void p3_pool(LAS unsigned char* lds, int tid, int s0) {
    const int ch = tid & 15, tq = 4 * (tid >> 4); const LAS unsigned char* rp = lds + P3_RP + ch * 16; float sum[8];
#pragma unroll
    for (int e = 0; e < 8; ++e) sum[e] = 0.f;
#pragma unroll 3
    for (int k = 1; k < W; ++k) { const v4u r = *(const LAS v4u*)(rp + (16 + tq - k) * P3_PA);
        sum[0] += bf_lo(r.x); sum[1] += bf_hi(r.x); sum[2] += bf_lo(r.y); sum[3] += bf_hi(r.y); sum[4] += bf_lo(r.z); sum[5] += bf_hi(r.z); sum[6] += bf_lo(r.w); sum[7] += bf_hi(r.w); }
#pragma unroll
    for (int rr = 0; rr < 4; ++rr) { const int t = tq + rr; const v4u cur = *(const LAS v4u*)(rp + (16 + t) * P3_PA);
        sum[0] += bf_lo(cur.x); sum[1] += bf_hi(cur.x); sum[2] += bf_lo(cur.y); sum[3] += bf_hi(cur.y); sum[4] += bf_lo(cur.z); sum[5] += bf_hi(cur.z); sum[6] += bf_lo(cur.w); sum[7] += bf_hi(cur.w);
        const int cnt = (s0 + t + 1) < W ? (s0 + t + 1) : W; const float inv = 1.0f / (float)cnt;
        v4u o; o.x = pk2(sum[0] * inv - bf_lo(cur.x), sum[1] * inv - bf_hi(cur.x)); o.y = pk2(sum[2] * inv - bf_lo(cur.y), sum[3] * inv - bf_hi(cur.y));
        o.z = pk2(sum[4] * inv - bf_lo(cur.z), sum[5] * inv - bf_hi(cur.z)); o.w = pk2(sum[6] * inv - bf_lo(cur.w), sum[7] * inv - bf_hi(cur.w));
        *(LAS v4u*)(lds + P3_RA + t * P3_PA + ch * 16) = o;
        if (rr < 3) { const v4u old = *(const LAS v4u*)(rp + (16 + t - (W - 1)) * P3_PA);
            sum[0] -= bf_lo(old.x); sum[1] -= bf_hi(old.x); sum[2] -= bf_lo(old.y); sum[3] -= bf_hi(old.y); sum[4] -= bf_lo(old.z); sum[5] -= bf_hi(old.z); sum[6] -= bf_lo(old.w); sum[7] -= bf_hi(old.w); } }
}
struct P3Regs { v4u a0, a1, a2, a3, b0, b1, b2, b3, b4; };
#define P3_RA_(R, it) ((it) == 0 ? (R).a0 : (it) == 1 ? (R).a1 : (it) == 2 ? (R).a2 : (R).a3)
#define P3_RB_(R, it) ((it) == 0 ? (R).b0 : (it) == 1 ? (R).b1 : (it) == 2 ? (R).b2 : (it) == 3 ? (R).b3 : (R).b4)
__device__ __forceinline__ void p3_prefetch(P3Regs& R, int item, int t0, int s0, int tid, const bf16* PROJ, const bf16* WSP, const bf16* WPOOL, bool xhalo = false) {
    if (item < 4) { const int h = item;
#pragma unroll
        for (int it = 0; it < 4; ++it) { const int idx = tid + 512 * it, row = idx >> 4, ch = idx & 15;
            const v4u va = *(const v4u*)(WSP + (size_t)h * 16384 + row * 128 + ch * 8), vb = __builtin_nontemporal_load((const v4u*)(PROJ + (size_t)(t0 + row) * INW + AW + 128 * h + 8 * ch));
            if (it == 0) { R.a0 = va; R.b0 = vb; } else if (it == 1) { R.a1 = va; R.b1 = vb; } else if (it == 2) { R.a2 = va; R.b2 = vb; } else { R.a3 = va; R.b3 = vb; } }
    } else { const int g = item - 4;
#pragma unroll
        for (int it = 0; it < 4; ++it) { const int idx = tid + 512 * it, row = idx >> 4, ch = idx & 15; const v4u va = *(const v4u*)(WPOOL + (size_t)g * 16384 + row * 128 + ch * 8);
            if (it == 0) R.a0 = va; else if (it == 1) R.a1 = va; else if (it == 2) R.a2 = va; else R.a3 = va; }
#pragma unroll
        for (int it = 0; it < 5; ++it) { const int idx = tid + 512 * it, row = idx >> 4, ch = idx & 15; v4u raw = {0u, 0u, 0u, 0u};
            if (row < 144 && s0 + row >= 16) { const bf16* src = PROJ + (size_t)(t0 + row - 16) * INW + 2 * AW + 128 * g + 8 * ch;
                if (xhalo && row < 16) { const unsigned long long w0 = __hip_atomic_load((const unsigned long long*)src, __ATOMIC_RELAXED, __HIP_MEMORY_SCOPE_AGENT), w1 = __hip_atomic_load((const unsigned long long*)src + 1, __ATOMIC_RELAXED, __HIP_MEMORY_SCOPE_AGENT);
                    raw.x = (unsigned)w0; raw.y = (unsigned)(w0 >> 32); raw.z = (unsigned)w1; raw.w = (unsigned)(w1 >> 32); }
                else raw = __builtin_nontemporal_load((const v4u*)src); }
            if (it == 0) R.b0 = raw; else if (it == 1) R.b1 = raw; else if (it == 2) R.b2 = raw; else if (it == 3) R.b3 = raw; else R.b4 = raw; } }
}
__device__ __forceinline__ void p3_item(P3Regs& R, const int item, const int t0, const int s0, const int tid0, LAS unsigned char* lds, const LAS float* RC, const bf16* PROJ, bf16* MIXIN, const bf16* WSP, const bf16* WPOOL,
                                        const int wr, const int wc, const int fr, const int fq, const bool xhalo) {
    f32x4 acc[4][2];
            int tl = tid0; asm volatile("" : "+v"(tl));
            const int tid = tl;
            if (item < 4) { const int h = item;
#pragma unroll
                for (int it = 0; it < 4; ++it) { const int idx = tid + 512 * it, row = idx >> 4, ch = idx & 15;
                    *(LAS v4u*)(lds + P3_RA + row * P3_PA + ch * 16) = P3_RA_(R, it);
                    const v4u raw = P3_RB_(R, it);
                    float v[8]; v[0] = bf_lo(raw.x); v[1] = bf_hi(raw.x); v[2] = bf_lo(raw.y); v[3] = bf_hi(raw.y); v[4] = bf_lo(raw.z); v[5] = bf_hi(raw.z); v[6] = bf_lo(raw.w); v[7] = bf_hi(raw.w);
                    float s = 0.f;
#pragma unroll
                    for (int e = 0; e < 8; ++e) s += v[e] * v[e];
                    s += __shfl_xor(s, 1); s += __shfl_xor(s, 2); s += __shfl_xor(s, 4); s += __shfl_xor(s, 8);
                    const float rs = __builtin_amdgcn_rsqf(s * (1.0f / 128.0f) + EPS);
                    const f32x4 g0 = *(const LAS f32x4*)(RC + 128 * h + 8 * ch), g1 = *(const LAS f32x4*)(RC + 128 * h + 8 * ch + 4);
                    v2u w0, w1; w0.x = pk2(v[0] * rs * g0.x, v[1] * rs * g0.y); w0.y = pk2(v[2] * rs * g0.z, v[3] * rs * g0.w); w1.x = pk2(v[4] * rs * g1.x, v[5] * rs * g1.y); w1.y = pk2(v[6] * rs * g1.z, v[7] * rs * g1.w);
                    *(LAS v2u*)(lds + P3_RB + row * P3_PV + ch * 16) = w0; *(LAS v2u*)(lds + P3_RB + row * P3_PV + ch * 16 + 8) = w1; }
                __syncthreads();
                if (item + 2 < 8) p3_prefetch(R, item + 2, t0, s0, tid, PROJ, WSP, WPOOL, xhalo);
                v2u ur[4][2]; float bias[4];
#pragma unroll
                for (int m = 0; m < 4; ++m) { const int i = 64 * wr + 16 * m + fr; bias[m] = RC[512 + 128 * h + i];
#pragma unroll
                    for (int n = 0; n < 2; ++n) ur[m][n] = *(const v2u*)(PROJ + (size_t)(t0 + i) * INW + 128 * h + 32 * wc + 16 * n + 4 * fq); }
                p3_mma(lds, true, acc, wr, wc, fr, fq);
#pragma unroll
                for (int m = 0; m < 4; ++m) { const int i = 64 * wr + 16 * m + fr;
#pragma unroll
                    for (int n = 0; n < 2; ++n) { const int c = 128 * h + 32 * wc + 16 * n + 4 * fq; const v2u u2 = ur[m][n]; const float bi = bias[m];
                        const f32x4 z = acc[m][n]; v2u w; w.x = pk2(bf_lo(u2.x) * (z[0] + bi), bf_hi(u2.x) * (z[1] + bi)); w.y = pk2(bf_lo(u2.y) * (z[2] + bi), bf_hi(u2.y) * (z[3] + bi));
                        *(v2u*)(MIXIN + (size_t)(t0 + i) * D + c) = w; } }
                __syncthreads();
            } else { const int g = item - 4, w = 2 << g;
#pragma unroll
                for (int it = 0; it < 4; ++it) { const int idx = tid + 512 * it, row = idx >> 4, ch = idx & 15; *(LAS v4u*)(lds + P3_RB + row * P3_PA + ch * 16) = P3_RA_(R, it); }
#pragma unroll
                for (int it = 0; it < 5; ++it) { const int idx = tid + 512 * it, row = idx >> 4, ch = idx & 15; if (row < 144) *(LAS v4u*)(lds + P3_RP + row * P3_PA + ch * 16) = P3_RB_(R, it); }
                __syncthreads();
                if (item + 2 < 8) p3_prefetch(R, item + 2, t0, s0, tid, PROJ, WSP, WPOOL, xhalo);
                switch (g) { case 0: p3_pool<2>(lds, tid, s0); break; case 1: p3_pool<4>(lds, tid, s0); break; case 2: p3_pool<8>(lds, tid, s0); break; default: p3_pool<16>(lds, tid, s0); break; }
                __syncthreads();
                p3_mma(lds, false, acc, wr, wc, fr, fq);
#pragma unroll
                for (int m = 0; m < 4; ++m) { const int t = 64 * wr + 16 * m + fr;
#pragma unroll
                    for (int n = 0; n < 2; ++n) { const int d = 128 * g + 32 * wc + 16 * n + 4 * fq; const f32x4 ps = *(const LAS f32x4*)(RC + 1024 + d); const f32x4 y = acc[m][n] * ps;
                        v2u wv; wv.x = pk2(y[0], y[1]); wv.y = pk2(y[2], y[3]); *(v2u*)(MIXIN + (size_t)(t0 + t) * D + AW + d) = wv; } }
                __syncthreads();
            }
}
__device__ __forceinline__ void p3_mixers(const Args& a, LAS unsigned char* lds, int tid0, int rb, unsigned* xwait, unsigned xgen) {
    const int lane = tid0 & 63, wave = tid0 >> 6, wr = wave >> 2, wc = wave & 3, fr = lane & 15, fq = lane >> 4;
    const bf16* PROJ = (const bf16*)(a.ws + WS_PROJ); bf16* MIXIN = (bf16*)(a.ws + WS_MIXIN);
    const bf16* WSP = (const bf16*)(a.ws + WS_WSP); const bf16* WPOOL = (const bf16*)(a.ws + WS_WPOOL);
    const float* sgug = a.in[I_SGUG]; const float* bsp = a.in[I_BSP]; const float* pscale = a.in[I_PSCALE];
    { LAS float* rc = (LAS float*)(lds + P3_RC); rc[tid0] = sgug[tid0]; rc[512 + tid0] = bsp[tid0]; rc[1024 + tid0] = pscale[tid0]; }
    __syncthreads();
    const LAS float* RC = (const LAS float*)(lds + P3_RC);
    for (int tb = rb; tb < M / 128; tb += gridDim.x) { const int t0 = tb * 128, s0 = t0 % SEQ;
        const bool xhalo = xwait != nullptr && (tb & 31) == 0 && s0 != 0;
        if (xhalo) { unsigned sp = 0; while ((unsigned)__builtin_amdgcn_readfirstlane(__hip_atomic_load(xwait, __ATOMIC_RELAXED, __HIP_MEMORY_SCOPE_AGENT)) < xgen) { __builtin_amdgcn_s_sleep(2); if (++sp > (1u << 22)) break; } }
        P3Regs R;
        p3_prefetch(R, 0, t0, s0, tid0, PROJ, WSP, WPOOL);
        P3Regs Rb;
        p3_prefetch(Rb, 1, t0, s0, tid0, PROJ, WSP, WPOOL);
        for (int it2 = 0; it2 < 4; ++it2) {
            p3_item(R, 2 * it2, t0, s0, tid0, lds, RC, PROJ, MIXIN, WSP, WPOOL, wr, wc, fr, fq, xhalo);
            p3_item(Rb, 2 * it2 + 1, t0, s0, tid0, lds, RC, PROJ, MIXIN, WSP, WPOOL, wr, wc, fr, fq, xhalo); } }
}

__device__ __forceinline__ void p4b_mid(const Args& a, int gw, int NGW, int lane) {
    const float* MOD = (const float*)(a.ws + OFF_MOD); const float* SS1 = (const float*)(a.ws + OFF_SS1); const bf16* MIXED = (const bf16*)(a.ws + WS_MIXED); bf16* XN = (bf16*)(a.ws + WS_XN);
    const float* x = a.in[I_X]; const float* pg = a.in[I_POSTMIXG]; const float* fg = a.in[I_PREFFNG]; bf16* X1B = (bf16*)(a.ws + WS_X1B);
    const int rpw = M / NGW;
    for (int r0 = gw * rpw; r0 < M; r0 += NGW * rpw) { const int b = r0 / SEQ; const float* mb = MOD + (size_t)b * NMOD;
        f32x4 A1[4], A2[4], A3[4];
#pragma unroll
        for (int j = 0; j < 4; ++j) { const int col = 4 * lane + 256 * j; A1[j] = *(const f32x4*)(mb + 2 * D + col) * *(const f32x4*)(pg + col);
            A2[j] = *(const f32x4*)(fg + col) * (1.0f + *(const f32x4*)(mb + 4 * D + col)); A3[j] = *(const f32x4*)(mb + 3 * D + col); }
        f32x4 nx[4]; v2u nm[4];
        { const f32x4* xr = (const f32x4*)(x + (size_t)r0 * D) + lane; const v2u* mr = (const v2u*)(MIXED + (size_t)r0 * INW) + lane;
#pragma unroll
            for (int j = 0; j < 4; ++j) { nx[j] = __builtin_nontemporal_load(xr + 64 * j); nm[j] = __builtin_nontemporal_load(mr + 64 * j); } }
        const float ssv = (lane < rpw) ? SS1[r0 + lane] : 0.f;
        for (int r = r0; r < r0 + rpw; ++r) {
            const float rs1 = __builtin_amdgcn_rsqf(__builtin_bit_cast(float, __builtin_amdgcn_readlane(__builtin_bit_cast(int, ssv), r - r0)) * (1.0f / D) + EPS); f32x4 v[4]; float s = 0.f;
#pragma unroll
            for (int j = 0; j < 4; ++j) { const v2u mw = nm[j]; const f32x4 mx = {bf_lo(mw.x), bf_hi(mw.x), bf_lo(mw.y), bf_hi(mw.y)};
                v[j] = nx[j] + mx * rs1 * A1[j]; s += (v[j].x * v[j].x + v[j].y * v[j].y) + (v[j].z * v[j].z + v[j].w * v[j].w); }
            if (r + 1 < r0 + rpw) { const f32x4* xr = (const f32x4*)(x + (size_t)(r + 1) * D) + lane; const v2u* mr = (const v2u*)(MIXED + (size_t)(r + 1) * INW) + lane;
#pragma unroll
                for (int j = 0; j < 4; ++j) { nx[j] = __builtin_nontemporal_load(xr + 64 * j); nm[j] = __builtin_nontemporal_load(mr + 64 * j); } }
            v2u* xrow = (v2u*)(X1B + (size_t)r * D) + lane;
#pragma unroll
            for (int j = 0; j < 4; ++j) { v2u w; w.x = pk2(v[j].x, v[j].y); w.y = pk2(v[j].z, v[j].w); __builtin_nontemporal_store(w, xrow + 64 * j); }
            const float rs = __builtin_amdgcn_rsqf(wave_sum(s) * (1.0f / D) + EPS);
            v2u* o = (v2u*)(XN + (size_t)r * D) + lane;
#pragma unroll
            for (int j = 0; j < 4; ++j) { const f32x4 h = v[j] * rs * A2[j] + A3[j]; const unsigned long long w = (unsigned long long)pk2(h.x, h.y) | ((unsigned long long)pk2(h.z, h.w) << 32);
                __hip_atomic_store((unsigned long long*)(o + 64 * j), w, __ATOMIC_RELAXED, __HIP_MEMORY_SCOPE_AGENT); } } }
}

__device__ __forceinline__ void p6b_fixup(const Args& a, int gw, int NGW, int lane) {
    const bf16* RAW = (const bf16*)(a.ws + WS_RAW); bf16* ACT = (bf16*)(a.ws + WS_ACT); const float* cw = a.in[I_CONVW]; const float* cb = a.in[I_CONVB];
    for (int it = 2 * gw; it < 2 * gw + 2; ++it) { const int q = it & 3, rr = (it >> 2) & 1, B = it >> 3; const int t = 64 * B + rr, s = t % SEQ;
        const bf16* cur = RAW + (size_t)(B * 4 + rr) * FF2;
        const bf16* p1 = (rr == 1) ? RAW + (size_t)(B * 4 + 0) * FF2 : (s == 0 ? nullptr : RAW + (size_t)((B - 1) * 4 + 3) * FF2);
        const bf16* p2 = (rr == 1) ? (s == 1 ? nullptr : RAW + (size_t)((B - 1) * 4 + 3) * FF2) : (s == 0 ? nullptr : RAW + (size_t)((B - 1) * 4 + 2) * FF2);
        for (int f = q * 704 + 4 * lane; f < q * 704 + 704; f += 256) { f32x4 y[2];
#pragma unroll
            for (int hv = 0; hv < 2; ++hv) { const int col = hv * FF + f; const f32x4 z = {0.f, 0.f, 0.f, 0.f};
                const v2u zz = {0u, 0u}; const v2u r0 = *(const v2u*)(cur + col), r1 = p1 ? *(const v2u*)(p1 + col) : zz, r2 = p2 ? *(const v2u*)(p2 + col) : zz; (void)z;
                const f32x4 u0 = {bf_lo(r0.x), bf_hi(r0.x), bf_lo(r0.y), bf_hi(r0.y)}, u1 = {bf_lo(r1.x), bf_hi(r1.x), bf_lo(r1.y), bf_hi(r1.y)}, u2 = {bf_lo(r2.x), bf_hi(r2.x), bf_lo(r2.y), bf_hi(r2.y)};
                y[hv] = *(const f32x4*)(cb + col) + *(const f32x4*)(cw + col) * u2 + *(const f32x4*)(cw + FF2 + col) * u1 + *(const f32x4*)(cw + 2 * FF2 + col) * u0; }
            v2u w; w.x = pk2(pg8::silu_f(y[0][0]) * y[1][0], pg8::silu_f(y[0][1]) * y[1][1]); w.y = pk2(pg8::silu_f(y[0][2]) * y[1][2], pg8::silu_f(y[0][3]) * y[1][3]);
            *(v2u*)(ACT + (size_t)t * FF + f) = w; } }
}

#define XB_TMO      128
#define XB_XCNT(j)  (256  + 64 * (j))
#define XB_XSUB(j)  (1280 + 64 * (j))
#define XB_XGEN(j)  (2304 + 64 * (j))
#define XB_TOP      3328
#define XB_TOPGEN   3392
#define XCD_BAR_WORDS 3456
#define XB_SPIN_CAP (1u << 18)

__device__ __forceinline__ unsigned xb_ld(unsigned* p)              { return __hip_atomic_load(p, __ATOMIC_RELAXED, __HIP_MEMORY_SCOPE_AGENT); }
__device__ __forceinline__ unsigned xb_add(unsigned* p, unsigned v) { return __hip_atomic_fetch_add(p, v, __ATOMIC_RELAXED, __HIP_MEMORY_SCOPE_AGENT); }
__device__ __forceinline__ unsigned xb_xcc_id() { return (unsigned)__builtin_amdgcn_s_getreg((3 << 11) | 20) & 0xFu; }
#define XB_SPIN(cond, bar) do { unsigned _sp = 0; while (cond) { __builtin_amdgcn_s_sleep(1); \
    if ((++_sp & 255u) == 0u) { if (xb_ld(&(bar)[XB_TMO])) break; if (_sp > XB_SPIN_CAP) { atomicAdd(&(bar)[XB_TMO], 1u); break; } } } } while (0)

struct XcdBarrier {
    unsigned* bar; unsigned x;
    volatile LAS unsigned* st;
};

__device__ __forceinline__ XcdBarrier xcd_barrier_post(unsigned* bar, volatile LAS unsigned* st) {
    XcdBarrier b; b.bar = bar; b.x = xb_xcc_id(); b.st = st;
    if (threadIdx.x == 0) st[2] = xb_add(&bar[XB_XCNT(b.x)], 1u);
    return b;
}
__device__ __forceinline__ void xcd_barrier_complete(unsigned* bar, unsigned x, unsigned& nloc, unsigned& nx) {
    const unsigned G = gridDim.x * gridDim.y * gridDim.z;
    unsigned sum, cnt, mine, sp = 0u;
    for (;;) {
        sum = 0u; cnt = 0u; mine = 0u;
#pragma unroll
        for (unsigned j = 0; j < 16; ++j) { const unsigned c = xb_ld(&bar[XB_XCNT(j)]); sum += c; cnt += (c > 0u) ? 1u : 0u; mine = (j == x) ? c : mine; }
        if (sum == G) break;
        __builtin_amdgcn_s_sleep(1);
        if ((++sp & 255u) == 0u) { if (xb_ld(&bar[XB_TMO])) break; if (sp > XB_SPIN_CAP) { atomicAdd(&bar[XB_TMO], 1u); break; } }
    }
    nloc = mine > 0u ? mine : 1u; nx = cnt > 0u ? cnt : 1u;
}

__device__ __forceinline__ void xcd_barrier(const XcdBarrier& b) {
    asm volatile("s_waitcnt vmcnt(0)" ::: "memory");
    __syncthreads();
    if (threadIdx.x == 0) {
        unsigned* bar = b.bar;
        __builtin_amdgcn_s_waitcnt(0);
        unsigned nloc = b.st[0], nx = b.st[1];
        if (nloc == 0u) { xcd_barrier_complete(bar, b.x, nloc, nx); b.st[0] = nloc; b.st[1] = nx; }
        const unsigned old = xb_add(&bar[XB_XSUB(b.x)], 1u);
        const unsigned gen = old / nloc;
        if (old + 1u == (gen + 1u) * nloc) {
            __builtin_amdgcn_fence(__ATOMIC_RELEASE, "agent");
            asm volatile("s_waitcnt vmcnt(0)" ::: "memory");
            const unsigned og = xb_add(&bar[XB_TOP], 1u);
            const unsigned tg = og / nx;
            if (og + 1u == (tg + 1u) * nx) xb_add(&bar[XB_TOPGEN], 1u);
            else XB_SPIN(xb_ld(&bar[XB_TOPGEN]) == tg, bar);
            __builtin_amdgcn_fence(__ATOMIC_ACQUIRE, "agent");
            xb_add(&bar[XB_XGEN(b.x)], 1u);
            asm volatile("s_waitcnt vmcnt(0)" ::: "memory");
        } else {
            XB_SPIN(xb_ld(&bar[XB_XGEN(b.x)]) == gen, bar);
            __builtin_amdgcn_fence(__ATOMIC_ACQUIRE, "agent");
            asm volatile("s_waitcnt vmcnt(0)" ::: "memory");
        }
    }
    __syncthreads();
}
#define XL_SUB(j)  (4096 + 64 * (j))
#define XL_GEN(j)  (5120 + 64 * (j))
__device__ __forceinline__ void xcd_local_barrier(const XcdBarrier& b) {
    asm volatile("s_waitcnt vmcnt(0)" ::: "memory");
    __syncthreads();
    if (threadIdx.x == 0) { unsigned* bar = b.bar; const unsigned nloc = b.st[0];
        const unsigned old = xb_add(&bar[XL_SUB(b.x)], 1u); const unsigned gen = old / nloc;
        if (old + 1u == (gen + 1u) * nloc) xb_add(&bar[XL_GEN(b.x)], 1u);
        else XB_SPIN(xb_ld(&bar[XL_GEN(b.x)]) == gen, bar);
        __builtin_amdgcn_fence(__ATOMIC_ACQUIRE, "agent");
        asm volatile("s_waitcnt vmcnt(0)" ::: "memory"); }
    __syncthreads();
}
__global__ void __launch_bounds__(NWAVES * 64, 2) mk_fwd(Args args) {
    extern __shared__ __attribute__((aligned(16))) unsigned char lds_raw[];
    LAS unsigned char* lds = (LAS unsigned char*)lds_raw;
    const int tid = threadIdx.x, lane = tid & 63, wave = __builtin_amdgcn_readfirstlane(tid >> 6);
    const int G = gridDim.x, gw = blockIdx.x * NWAVES + wave, NGW = G * NWAVES;
    const int lo = args.ph_lo, hi = args.ph_hi;
    unsigned char* ws = args.ws;
    if (tid < 64) ((LAS unsigned*)(lds + LDSCTL_OFF))[tid] = 0u;
    __syncthreads();
    XcdBarrier bar = xcd_barrier_post((unsigned*)(ws + OFF_BAR), (volatile LAS unsigned*)(lds + LDSCTL_OFF) + 8);
#define IN(k) (lo <= (k) && (k) < hi)
#define NREP(k) ((MK_REPEAT == (k) || ((k) == 4 && (MK_REPEAT == 41 || MK_REPEAT == 42))) ? 2 : 1)
#define SEAM(k) do { if (IN(k) && IN((k) + 1)) xcd_barrier(bar); } while (0)
    if (lo < 0) cg::this_grid().sync();
    if (IN(0)) { p0_prologue(args, lds, gw, NGW, lane, wave, true, true); }
    SEAM(0);
    int cvirt = (int)blockIdx.x; bool xlocal = false;
    if (lo == 0 && hi > 2 && (G & 7) == 0) { bool even = true;
#pragma unroll
        for (int j = 0; j < 16; ++j) { const unsigned cj = xb_ld(&bar.bar[XB_XCNT(j)]); even = even && (cj == (j < 8 ? (unsigned)(G >> 3) : 0u)); }
        if (even && bar.x < 8u) { cvirt = (int)(bar.st[2] * 8u + bar.x); xlocal = true; } }
    cvirt = __builtin_amdgcn_readfirstlane(cvirt);
    const int rb = xlocal ? (cvirt & 7) * (G >> 3) + (cvirt >> 3) : (int)blockIdx.x;
    unsigned lgen = 0;
#define LSEAM() do { if (xlocal) { xcd_local_barrier(bar); ++lgen; } else xcd_barrier(bar); } while (0)
    if (IN(1)) { for (int rep = 0; rep < NREP(1); ++rep) { if (rep) xcd_barrier(bar); p1_norm(args, rb * NWAVES + wave, NGW, lane); } }
    if (IN(1) && IN(2)) LSEAM();
    if (IN(2)) { pg8::Gemm g{(const bf16*)(ws + WS_XN), (const bf16*)(ws + WS_WIN), M, INW, D}; pg8::StaticOrder S; S.init(M, INW, G, cvirt);
        pg8::EpiProj E{(bf16*)(ws + WS_PROJ), INW};
        for (int rep = 0; rep < NREP(2); ++rep) { if (rep) xcd_barrier(bar); pg8::gemm_phase<pg8::EpiProj, pg8::StaticOrder, true, true>(lds, g, S, E); } }
    if (IN(2) && IN(3)) LSEAM();
    if (IN(3)) { for (int rep = 0; rep < NREP(3); ++rep) { if (rep) xcd_barrier(bar); __syncthreads(); p3_mixers(args, lds, tid, rb, (xlocal && bar.x > 0u) ? &bar.bar[XL_GEN(bar.x - 1u)] : nullptr, lgen); } }
    if (IN(3) && IN(4)) LSEAM();
    if (IN(4)) { pg8::Gemm g{(const bf16*)(ws + WS_MIXIN), (const bf16*)(ws + WS_WOUT), M, D, D}; pg8::StaticOrder S; S.init(M, D, G, cvirt);
        pg8::EpiBf16SS E{(bf16*)(ws + WS_MIXED), INW, (float*)(ws + OFF_SS1)};
        pg8::gemm_phase<pg8::EpiBf16SS, pg8::StaticOrder, true, true>(lds, g, S, E);
        LSEAM();
        p4b_mid(args, rb * NWAVES + wave, NGW, lane); }
    if (IN(4) && IN(5)) LSEAM();
    if (IN(5)) { pg8::Gemm g{(const bf16*)(ws + WS_XN), (const bf16*)(ws + WS_WUP), M, FF2, D}; pg8::StaticOrder S; S.init(M, FF2, G, cvirt);
        pg8::EpiConv E{(bf16*)(ws + WS_ACT), (bf16*)(ws + WS_RAW), args.in[I_CONVW], args.in[I_CONVB], FF, lds + LDSCTL_OFF + 4096};
        for (int rep = 0; rep < NREP(5); ++rep) { if (rep) xcd_barrier(bar); pg8::gemm_phase<pg8::EpiConv, pg8::StaticOrder, true, true>(lds, g, S, E); } }
    SEAM(5);
    if (IN(6)) { p6b_fixup(args, rb * NWAVES + wave, NGW, lane); }
    if (IN(6) && IN(7)) LSEAM();
    if (IN(7)) { pg8::Gemm g{(const bf16*)(ws + WS_ACT), (const bf16*)(ws + WS_WDOWN), M, D, FF}; pg8::StaticOrder S; S.init(M, D, G, cvirt);
        for (int rep = 0; rep < NREP(7); ++rep) { if (rep) xcd_barrier(bar);
        pg8::RowStat st{(float*)(ws + (rep ? 736 * 1024 : OFF_SS4)), (unsigned*)(ws + (rep ? 640 * 1024 : OFF_CNT + 32768)), 32u, 1.0f / D, EPS};
        pg8::EpiFinal E{(const bf16*)(ws + WS_X1B), rep ? (float*)(ws + WS_F) : args.out, (const float*)(ws + OFF_MOD), args.in[I_POSTFFNG], st, D, SEQ / 256};
        pg8::gemm_phase<pg8::EpiFinal, pg8::StaticOrder, true, true>(lds, g, S, E); } }
    if (MK_REPEAT == 17 && IN(7)) { xcd_barrier(bar); pg8::Gemm g{(const bf16*)(ws + WS_ACT), (const bf16*)(ws + WS_WDOWN), M, D, FF}; pg8::StaticOrder S; S.init(M, D, G, (int)blockIdx.x);
        pg8::EpiSink E{(float*)(ws + WS_F)}; pg8::gemm_phase<pg8::EpiSink, pg8::StaticOrder, true, true>(lds, g, S, E); }
#undef IN
#undef SEAM
}

constexpr int N_PHASES = 8;
extern "C" void kernel_launch(void* const* d_in, const int* in_sizes, int n_in, void* d_out, int out_size, void* d_ws, size_t ws_size, hipStream_t stream) {
    static int grid = 0;
    if (grid == 0) {
        if (n_in != 19 || in_sizes[0] != M * D || out_size != M * D || ws_size < WS_END) { fprintf(stderr, "kernel_launch: unexpected shapes (n_in %d, in0 %d, out %d, ws %zu)\n", n_in, n_in > 0 ? in_sizes[0] : -1, out_size, ws_size); grid = -1; return; }
        int dev = 0, cus = 0, per_cu = 0;
        (void)hipGetDevice(&dev); (void)hipDeviceGetAttribute(&cus, hipDeviceAttributeMultiprocessorCount, dev);
        if (hipFuncSetAttribute((const void*)mk_fwd, hipFuncAttributeMaxDynamicSharedMemorySize, LDS_BYTES) != hipSuccess) { fprintf(stderr, "kernel_launch: hipFuncSetAttribute failed\n"); grid = -1; return; }
        if (hipOccupancyMaxActiveBlocksPerMultiprocessor(&per_cu, (const void*)mk_fwd, NWAVES * 64, LDS_BYTES) != hipSuccess || per_cu < 1) { fprintf(stderr, "kernel_launch: occupancy query says %d blocks per CU\n", per_cu); per_cu = 1; }
        (void)hipGetLastError();
        grid = cus > 0 ? cus : 256;
    }
    if (grid < 0) return;
    (void)hipMemsetAsync((char*)d_ws + WS_CTL, 0, CTL_ZERO_BYTES, stream);
    Args a{};
    for (int i = 0; i < 19; ++i) a.in[i] = (const float*)d_in[i];
    a.out = (float*)d_out; a.ws = (unsigned char*)d_ws;
#if MK_N_LAUNCHES == 1
    a.ph_lo = 0; a.ph_hi = N_PHASES;
    void* kargs[] = {&a};
    hipError_t e = hipLaunchCooperativeKernel((const void*)mk_fwd, dim3(grid), dim3(NWAVES * 64), kargs, LDS_BYTES, stream);
    if (e != hipSuccess) fprintf(stderr, "kernel_launch: cooperative launch failed: %s (grid %d)\n", hipGetErrorString(e), grid);
#else
    for (int p = 0; p < N_PHASES; ++p) { a.ph_lo = p; a.ph_hi = p + 1; hipLaunchKernelGGL(mk_fwd, dim3(grid), dim3(NWAVES * 64), LDS_BYTES, stream, a); }
#endif
}
```

```cpp
#include <hip/hip_runtime.h>
#include <hip/hip_cooperative_groups.h>
#include <cstdio>
#include <cstdint>
namespace cg = cooperative_groups;
#ifndef MK_N_LAUNCHES
#define MK_N_LAUNCHES 1
#endif
#ifndef MK_REPEAT
#define MK_REPEAT -1
#endif
namespace pg8 {
#define PG8_LAS __attribute__((address_space(3)))
typedef unsigned short bf16_t;
typedef short bf16x8 __attribute__((ext_vector_type(8)));
typedef float f32x4 __attribute__((ext_vector_type(4)));
typedef unsigned u32x4 __attribute__((ext_vector_type(4)));
constexpr int BM = 256, BK = 64, HALF = 128, HTB = HALF * BK * 2  , STAGE_BYTES = 8 * HTB, NXCD = 8, WGM = 8;

__host__ __device__ __forceinline__ int lds_byte(int r, int c) { const int st = (r >> 4) * 2 + (c >> 5), rr = r & 15, cc = c & 31, ob = rr * 64 + cc * 2; return st * 1024 + (ob ^ (((ob >> 9) & 1) << 5)); }
__host__ __device__ __forceinline__ void stage_rc(int b, int& R, int& C) { const int st = b / 1024, sb = b % 1024, swz = sb ^ (((sb >> 9) & 1) << 5); R = (st >> 1) * 16 + swz / 64; C = (st & 1) * 32 + (swz % 64) / 2; }
__host__ __device__ __forceinline__ int perm32(int rho) { const int n = rho >> 4, i = rho & 15; return 8 * (i >> 2) + 4 * n + (i & 3); }

struct Unit { int pm, pn; };
struct Gemm { const bf16_t* A; const bf16_t* Bt; int M, N, K; };

struct StaticOrder {
    int nM, nN, nwg, G, c;
    __host__ __device__ void init(int M, int N, int G_, int c_) { nM = M / BM; nN = N / BM; nwg = nM * nN; G = G_; c = c_; }
    __host__ __device__ bool next(int i, Unit& u) const {
        const long L = (long)i * G + c; if (L >= nwg) return false;
        int wgid = (int)L; { const int q = nwg / NXCD, r = nwg % NXCD, xcd = wgid % NXCD, off = wgid / NXCD; wgid = (xcd < r ? xcd * (q + 1) : r * (q + 1) + (xcd - r) * q) + off; }
        const int nig = WGM * nN, gid = wgid / nig, fm = gid * WGM, gsz = (nM - fm) < WGM ? (nM - fm) : WGM;
        u.pm = fm + ((wgid % nig) % gsz); u.pn = (wgid % nig) / gsz; return true;
    }
    __device__ __forceinline__ void a_ready(const Unit&) const {}
    __device__ __forceinline__ void done(const Unit&) const {}
};

__device__ __forceinline__ unsigned cvt_pk_bf16(float lo, float hi) { unsigned r; asm volatile("v_cvt_pk_bf16_f32 %0, %1, %2" : "=v"(r) : "v"(lo), "v"(hi)); return r; }
typedef float f32x2 __attribute__((ext_vector_type(2)));
typedef unsigned u32x2 __attribute__((ext_vector_type(2)));
__device__ __forceinline__ float fast_sigmoid_arg2(float p) { return __builtin_amdgcn_rcpf(1.0f + __builtin_amdgcn_exp2f(p)); }
__device__ __forceinline__ float gelu_tanh(float x) {
    const float t = x * x; const float p = x * (-2.302208198f + (-0.1029432397f) * t); return x * fast_sigmoid_arg2(p);
}
__device__ __forceinline__ float silu_f(float x) { return x * fast_sigmoid_arg2(x * (-1.4426950409f)); }
__device__ __forceinline__ float dpp_ror1(float x) { return __builtin_bit_cast(float, __builtin_amdgcn_update_dpp(0, __builtin_bit_cast(int, x), 0x121, 0xf, 0xf, false)); }
__device__ __forceinline__ float dpp_ror2(float x) { return __builtin_bit_cast(float, __builtin_amdgcn_update_dpp(0, __builtin_bit_cast(int, x), 0x122, 0xf, 0xf, false)); }

struct EpiProj {
    static constexpr bool PERM = true, AFTER_DRAIN = false, PERMA = false, HAS_PRE = false;
    bf16_t* O; int ldc;
    __device__ __forceinline__ void operator()(const f32x4 (&acc)[2][2][4][2], const Unit& u, int wr, int wc, int fr, int fq) const {
        const int row0 = u.pm * BM + wr * 64 + fr, col0 = u.pn * BM + wc * 32 + 8 * fq; const bool act = u.pn < 4; const bool edge = !act && (u.pm & 15) == 15 && wr == 1;
#pragma unroll
        for (int ai = 0; ai < 2; ++ai)
#pragma unroll
            for (int m = 0; m < 4; ++m) { bf16_t* rowp = O + (size_t)(row0 + ai * HALF + m * 16) * ldc + col0;
#pragma unroll
                for (int bj = 0; bj < 2; ++bj) { f32x4 v0 = acc[ai][bj][m][0], v1 = acc[ai][bj][m][1];
                    if (act) {
#pragma unroll
                        for (int j = 0; j < 4; ++j) { v0[j] = gelu_tanh(v0[j]); v1[j] = gelu_tanh(v1[j]); } }
                    u32x4 w; w.x = cvt_pk_bf16(v0[0], v0[1]); w.y = cvt_pk_bf16(v0[2], v0[3]); w.z = cvt_pk_bf16(v1[0], v1[1]); w.w = cvt_pk_bf16(v1[2], v1[3]);
                    if (edge && ai == 1 && m == 3) {
                        __hip_atomic_store((unsigned long long*)(rowp + bj * HALF), (unsigned long long)w.x | ((unsigned long long)w.y << 32), __ATOMIC_RELAXED, __HIP_MEMORY_SCOPE_AGENT);
                        __hip_atomic_store((unsigned long long*)(rowp + bj * HALF + 4), (unsigned long long)w.z | ((unsigned long long)w.w << 32), __ATOMIC_RELAXED, __HIP_MEMORY_SCOPE_AGENT); }
                    else *(u32x4*)(rowp + bj * HALF) = w; } }
    }
};

struct EpiF32SS {
    static constexpr bool PERM = false, AFTER_DRAIN = false, PERMA = false, HAS_PRE = false;
    float* O; int ldc; float* ss;
    __device__ __forceinline__ void operator()(const f32x4 (&acc)[2][2][4][2], const Unit& u, int wr, int wc, int fr, int fq) const {
        const int row0 = u.pm * BM + wr * 64 + fr, col0 = u.pn * BM + wc * 32 + 4 * fq;
#pragma unroll
        for (int ai = 0; ai < 2; ++ai)
#pragma unroll
            for (int m = 0; m < 4; ++m) { const int row = row0 + ai * HALF + m * 16; float* rowp = O + (size_t)row * ldc + col0; float s = 0.f;
#pragma unroll
                for (int bj = 0; bj < 2; ++bj)
#pragma unroll
                    for (int n = 0; n < 2; ++n) { const f32x4 x = acc[ai][bj][m][n]; s += (x[0] * x[0] + x[1] * x[1]) + (x[2] * x[2] + x[3] * x[3]); *(f32x4*)(rowp + bj * HALF + n * 16) = x; }
                s += __shfl_xor(s, 16); s += __shfl_xor(s, 32);
                if (fq == 0) atomicAdd(ss + row, s); }
    }
};

struct EpiBf16SS {
    static constexpr bool PERM = true, AFTER_DRAIN = false, PERMA = false, HAS_PRE = false;
    bf16_t* O; int ldc; float* ss;
    __device__ __forceinline__ void operator()(const f32x4 (&acc)[2][2][4][2], const Unit& u, int wr, int wc, int fr, int fq) const {
        const int row0 = u.pm * BM + wr * 64 + fr, col0 = u.pn * BM + wc * 32 + 8 * fq;
#pragma unroll
        for (int ai = 0; ai < 2; ++ai)
#pragma unroll
            for (int m = 0; m < 4; ++m) { const int row = row0 + ai * HALF + m * 16; bf16_t* rowp = O + (size_t)row * ldc + col0; float s = 0.f;
#pragma unroll
                for (int bj = 0; bj < 2; ++bj) { const f32x4 v0 = acc[ai][bj][m][0], v1 = acc[ai][bj][m][1];
                    s += ((v0[0] * v0[0] + v0[1] * v0[1]) + (v0[2] * v0[2] + v0[3] * v0[3])) + ((v1[0] * v1[0] + v1[1] * v1[1]) + (v1[2] * v1[2] + v1[3] * v1[3]));
                    u32x4 w; w.x = cvt_pk_bf16(v0[0], v0[1]); w.y = cvt_pk_bf16(v0[2], v0[3]); w.z = cvt_pk_bf16(v1[0], v1[1]); w.w = cvt_pk_bf16(v1[2], v1[3]);
                    *(u32x4*)(rowp + bj * HALF) = w; }
                s += __shfl_xor(s, 16); s += __shfl_xor(s, 32);
                if (fq == 0) atomicAdd(ss + row, s); }
    }
};

__device__ __forceinline__ float dpp_shr1(float x) { return __builtin_bit_cast(float, __builtin_amdgcn_update_dpp(0, __builtin_bit_cast(int, x), 0x111, 0xf, 0xf, true)); }
struct EpiConv {
    static constexpr bool PERM = true, AFTER_DRAIN = false, PERMA = true, HAS_PRE = true;
    bf16_t* ACT; bf16_t* RAW; const float* cw; const float* cb; int FF; PG8_LAS unsigned char* CB;
    __device__ __forceinline__ void pre(const Unit& u, int par) const {
        const int tid = threadIdx.x, w = __builtin_amdgcn_readfirstlane(tid >> 6), l = tid & 63;
        if (w < 4) { const int vec = 2 * w + (l >> 5), k = vec & 3, hv = vec >> 2; const float* src = (k < 3 ? cw + (size_t)k * 2 * FF : cb) + hv * FF + u.pn * HALF + (l & 31) * 4;
            __builtin_amdgcn_global_load_lds((const unsigned*)src, (PG8_LAS unsigned*)(CB + par * 4096 + w * 1024), 16, 0, 0); }
    }
    __device__ __forceinline__ void run(const f32x4 (&acc)[2][2][4][2], const Unit& u, int wr, int wc, int fr, int fq, int par) const {
        const int f0 = u.pn * HALF + wc * 32 + 8 * fq; const int rowt = u.pm * BM + wr * 64 + 4 * fr; const int FF2 = 2 * FF;
        const PG8_LAS float* cbuf = (const PG8_LAS float*)(CB + par * 4096) + wc * 32 + 8 * fq;
        unsigned stash[2][4][2];
#pragma unroll
        for (int n = 0; n < 2; ++n) { const int f = f0 + 4 * n; const PG8_LAS float* cn = cbuf + 4 * n;
            const f32x4 w0g = *(const PG8_LAS f32x4*)(cn), w1g = *(const PG8_LAS f32x4*)(cn + 128), w2g = *(const PG8_LAS f32x4*)(cn + 256), bg = *(const PG8_LAS f32x4*)(cn + 384);
            const f32x4 w0v = *(const PG8_LAS f32x4*)(cn + 512), w1v = *(const PG8_LAS f32x4*)(cn + 640), w2v = *(const PG8_LAS f32x4*)(cn + 768), bv = *(const PG8_LAS f32x4*)(cn + 896);
#pragma unroll
            for (int ai = 0; ai < 2; ++ai) {
                f32x4 gm1, gm2, vm1, vm2;
#pragma unroll
                for (int j = 0; j < 4; ++j) { gm1[j] = dpp_shr1(acc[ai][0][3][n][j]); gm2[j] = dpp_shr1(acc[ai][0][2][n][j]); vm1[j] = dpp_shr1(acc[ai][1][3][n][j]); vm2[j] = dpp_shr1(acc[ai][1][2][n][j]); }
#pragma unroll
                for (int m = 0; m < 4; ++m) { const f32x4 g = acc[ai][0][m][n], v = acc[ai][1][m][n];
                    const f32x4 pg1 = (m == 0) ? gm1 : acc[ai][0][m > 0 ? m - 1 : 0][n], pg2 = (m == 0) ? gm2 : (m == 1 ? gm1 : acc[ai][0][m > 1 ? m - 2 : 0][n]);
                    const f32x4 pv1 = (m == 0) ? vm1 : acc[ai][1][m > 0 ? m - 1 : 0][n], pv2 = (m == 0) ? vm2 : (m == 1 ? vm1 : acc[ai][1][m > 1 ? m - 2 : 0][n]);
                    const f32x4 yg = bg + w0g * pg2 + w1g * pg1 + w2g * g, yv = bv + w0v * pv2 + w1v * pv1 + w2v * v; f32x4 a;
#pragma unroll
                    for (int j = 0; j < 4; ++j) a[j] = silu_f(yg[j]) * yv[j];
                    const unsigned lo = cvt_pk_bf16(a[0], a[1]), hi = cvt_pk_bf16(a[2], a[3]);
                    if (n == 0) { stash[ai][m][0] = lo; stash[ai][m][1] = hi; }
                    else if (!(m < 2 && fr == 0)) { u32x4 w; w.x = stash[ai][m][0]; w.y = stash[ai][m][1]; w.z = lo; w.w = hi; __builtin_nontemporal_store(w, (u32x4*)(ACT + (size_t)(rowt + ai * HALF + m) * FF + f0)); }
                    if ((m < 2 && fr == 0) || (m >= 2 && fr == 15)) { bf16_t* rp = RAW + ((size_t)((u.pm * 4 + ai * 2 + wr) * 4 + m)) * FF2 + f;
                        u32x2 gw, vw; gw.x = cvt_pk_bf16(g[0], g[1]); gw.y = cvt_pk_bf16(g[2], g[3]); vw.x = cvt_pk_bf16(v[0], v[1]); vw.y = cvt_pk_bf16(v[2], v[3]);
                        *(u32x2*)rp = gw; *(u32x2*)(rp + FF) = vw; } } } }
    }
};

struct RowStat {
    float* ss; unsigned* cnt; unsigned want; float inv_n, eps;
    __device__ __forceinline__ void run(const float (&part)[2][4], float (&rs)[2][4], const Unit& u, int wr, int fr, int fq) const {
        const int row0 = u.pm * BM + wr * 64 + fr; const int lane = fq * 16 + fr;
#pragma unroll
        for (int ai = 0; ai < 2; ++ai)
#pragma unroll
            for (int m = 0; m < 4; ++m) { float s = part[ai][m]; s += __shfl_xor(s, 16); s += __shfl_xor(s, 32); if (fq == 0) atomicAdd(ss + row0 + ai * HALF + m * 16, s); }
        asm volatile("s_waitcnt vmcnt(0)" ::: "memory");
        unsigned* c = cnt + 64 * u.pm;
        if (lane == 0) __hip_atomic_fetch_add(c, 1u, __ATOMIC_RELAXED, __HIP_MEMORY_SCOPE_AGENT);
        if (threadIdx.x < 64) { unsigned sp = 0;
            while ((unsigned)__builtin_amdgcn_readfirstlane(__hip_atomic_load(c, __ATOMIC_RELAXED, __HIP_MEMORY_SCOPE_AGENT)) < want) { __builtin_amdgcn_s_sleep(1); if (++sp > (1u << 22)) break; } }
        asm volatile("s_waitcnt vmcnt(0) lgkmcnt(0)" ::: "memory"); __builtin_amdgcn_s_barrier(); asm volatile("" ::: "memory");
#pragma unroll
        for (int ai = 0; ai < 2; ++ai)
#pragma unroll
            for (int m = 0; m < 4; ++m) { const float v = __hip_atomic_load(ss + row0 + ai * HALF + m * 16, __ATOMIC_RELAXED, __HIP_MEMORY_SCOPE_AGENT); rs[ai][m] = __builtin_amdgcn_rsqf(v * inv_n + eps); }
    }
};
template <int VAR = 0  > struct EpiMid {
    static constexpr bool PERM = false, AFTER_DRAIN = false, PERMA = false, HAS_PRE = false;
    const float* x; float* x1; bf16_t* xn; const float* mod; const float* post_g; const float* ffn_g; const float* sxx; float* ss1; float* ssxm; float* ssmm; unsigned* cnt; PG8_LAS float* A23; int ld, tiles_per_batch;
    __device__ __forceinline__ void operator()(f32x4 (&acc)[2][2][4][2], const Unit& u, int wr, int wc, int fr, int fq) const {
        const int col0 = u.pn * BM + wc * 32 + 4 * fq; const float* mb = mod + (size_t)(u.pm / tiles_per_batch) * (6 * ld); const int tid = threadIdx.x;
        const unsigned voff = (unsigned)((wr * 64 + fr) * ld + col0) * 4u;
        const size_t pbase = (size_t)u.pm * BM * ld; const int row0 = u.pm * BM + wr * 64 + fr;
        if (tid < 256) { const int c = u.pn * BM + tid; A23[tid] = mb[2 * ld + c] * post_g[c]; A23[256 + tid] = ffn_g[c] * (1.0f + mb[4 * ld + c]); A23[512 + tid] = mb[3 * ld + c]; }
        asm volatile("s_waitcnt vmcnt(0) lgkmcnt(0)" ::: "memory"); __builtin_amdgcn_s_barrier(); asm volatile("" ::: "memory");
        const PG8_LAS float* As = A23 + wc * 32 + 4 * fq;
#pragma unroll
        for (int ai = 0; ai < 2; ++ai)
#pragma unroll
            for (int m = 0; m < 4; ++m) { const char* xb = (const char*)(x + pbase + (size_t)(ai * HALF + m * 16) * ld); f32x4 s1 = {0.f, 0.f, 0.f, 0.f}, sx = s1, sm = s1;
#pragma unroll
                for (int bj = 0; bj < 2; ++bj)
#pragma unroll
                    for (int n = 0; n < 2; ++n) { const unsigned o = voff + (unsigned)(bj * HALF + n * 16) * 4u; const f32x4 xv = (VAR == 1) ? (f32x4){1.f, 1.f, 1.f, 1.f} : *(const f32x4*)(xb + o); const f32x4 mx = acc[ai][bj][m][n], cm = mx * *(const PG8_LAS f32x4*)(As + bj * HALF + n * 16);
                        s1 += mx * mx; sx += xv * cm; sm += cm * cm; }
                float a = (s1[0] + s1[1]) + (s1[2] + s1[3]), b = (sx[0] + sx[1]) + (sx[2] + sx[3]), c = (sm[0] + sm[1]) + (sm[2] + sm[3]);
                a += __shfl_xor(a, 16); a += __shfl_xor(a, 32); b += __shfl_xor(b, 16); b += __shfl_xor(b, 32); c += __shfl_xor(c, 16); c += __shfl_xor(c, 32);
                if (fq == 0) { const int r = row0 + ai * HALF + m * 16; atomicAdd(ss1 + r, a); atomicAdd(ssxm + r, b); atomicAdd(ssmm + r, c); }
                if (m == 3) asm volatile("" ::: "memory"); }
        asm volatile("s_waitcnt vmcnt(0)" ::: "memory");
        unsigned* cw = cnt + 64 * u.pm;
        if ((tid & 63) == 0) __hip_atomic_fetch_add(cw, 1u, __ATOMIC_RELAXED, __HIP_MEMORY_SCOPE_AGENT);
        if (tid < 64) { unsigned sp = 0;
            while ((unsigned)__builtin_amdgcn_readfirstlane(__hip_atomic_load(cw, __ATOMIC_RELAXED, __HIP_MEMORY_SCOPE_AGENT)) < 32u) { __builtin_amdgcn_s_sleep(1); if (++sp > (1u << 22)) break; } }
        asm volatile("s_waitcnt vmcnt(0) lgkmcnt(0)" ::: "memory"); __builtin_amdgcn_s_barrier(); asm volatile("" ::: "memory");
        const float inv_n = 1.0f / (float)ld; float rs1[2][4], rs2[2][4];
#pragma unroll
        for (int ai = 0; ai < 2; ++ai)
#pragma unroll
            for (int m = 0; m < 4; ++m) { const int r = row0 + ai * HALF + m * 16;
                const float S1 = __hip_atomic_load(ss1 + r, __ATOMIC_RELAXED, __HIP_MEMORY_SCOPE_AGENT), Sxm = __hip_atomic_load(ssxm + r, __ATOMIC_RELAXED, __HIP_MEMORY_SCOPE_AGENT), Smm = __hip_atomic_load(ssmm + r, __ATOMIC_RELAXED, __HIP_MEMORY_SCOPE_AGENT);
                const float r1 = __builtin_amdgcn_rsqf(S1 * inv_n + 1e-6f); rs1[ai][m] = r1;
                const float s2 = sxx[r] + 2.0f * r1 * Sxm + r1 * r1 * Smm; rs2[ai][m] = __builtin_amdgcn_rsqf(s2 * inv_n + 1e-6f); }
        if (VAR != 0) { if (rs1[0][0] + rs2[1][3] + rs1[1][2] + rs2[0][1] == 1.2345e33f) x1[row0] = rs1[0][1]; return; }
#pragma unroll
        for (int ai = 0; ai < 2; ++ai)
#pragma unroll
            for (int m = 0; m < 4; ++m) { const size_t gb = pbase + (size_t)(ai * HALF + m * 16) * ld; const char* xb = (const char*)(x + gb); char* ob = (char*)(x1 + gb); char* nb = (char*)(xn + gb);
#pragma unroll
                for (int bj = 0; bj < 2; ++bj)
#pragma unroll
                    for (int n = 0; n < 2; ++n) { const unsigned o = voff + (unsigned)(bj * HALF + n * 16) * 4u; const f32x4 xv = *(const f32x4*)(xb + o);
                        const f32x4 v = xv + acc[ai][bj][m][n] * rs1[ai][m] * *(const PG8_LAS f32x4*)(As + bj * HALF + n * 16);
                        *(f32x4*)(ob + o) = v;
                        const f32x4 a2 = *(const PG8_LAS f32x4*)(As + 256 + bj * HALF + n * 16), a3 = *(const PG8_LAS f32x4*)(As + 512 + bj * HALF + n * 16); const f32x4 h = v * rs2[ai][m] * a2 + a3;
                        u32x2 wv; wv.x = cvt_pk_bf16(h[0], h[1]); wv.y = cvt_pk_bf16(h[2], h[3]); *(u32x2*)(nb + (o >> 1)) = wv; }
                if (m == 3) asm volatile("" ::: "memory"); }
    }
};
struct EpiFinal {
    static constexpr bool PERM = false, AFTER_DRAIN = false, PERMA = false, HAS_PRE = false;
    const bf16_t* src; float* out; const float* mod; const float* post_g; RowStat st; int ld, tiles_per_batch;
    __device__ __forceinline__ void operator()(f32x4 (&acc)[2][2][4][2], const Unit& u, int wr, int wc, int fr, int fq) const {
        const int col0 = u.pn * BM + wc * 32 + 4 * fq; const float* mb = mod + (size_t)(u.pm / tiles_per_batch) * (6 * ld);
        const unsigned voff = (unsigned)((wr * 64 + fr) * ld + col0) * 4u, cvo = (unsigned)col0 * 4u; const size_t pbase = (size_t)u.pm * BM * ld;
        float part[2][4], rs[2][4];
#pragma unroll
        for (int ai = 0; ai < 2; ++ai)
#pragma unroll
            for (int m = 0; m < 4; ++m) { float s = 0.f;
#pragma unroll
                for (int bj = 0; bj < 2; ++bj)
#pragma unroll
                    for (int n = 0; n < 2; ++n) { const f32x4 v = acc[ai][bj][m][n]; s += (v[0] * v[0] + v[1] * v[1]) + (v[2] * v[2] + v[3] * v[3]); }
                part[ai][m] = s; }
        u32x2 xpre[2][4][2][2];
#pragma unroll
        for (int ai = 0; ai < 2; ++ai)
#pragma unroll
            for (int m = 0; m < 4; ++m) { const char* sb = (const char*)(src + pbase + (size_t)(ai * HALF + m * 16) * ld);
#pragma unroll
                for (int bj = 0; bj < 2; ++bj)
#pragma unroll
                    for (int n = 0; n < 2; ++n) xpre[ai][m][bj][n] = *(const u32x2*)(sb + ((voff + (unsigned)(bj * HALF + n * 16) * 4u) >> 1)); }
        st.run(part, rs, u, wr, fr, fq);
        f32x4 A1[2][2];
#pragma unroll
        for (int bj = 0; bj < 2; ++bj)
#pragma unroll
            for (int n = 0; n < 2; ++n) { const unsigned co = cvo + (unsigned)(bj * HALF + n * 16) * 4u; A1[bj][n] = *(const f32x4*)((const char*)(mb + 5 * ld) + co) * *(const f32x4*)((const char*)post_g + co); }
#pragma unroll
        for (int ai = 0; ai < 2; ++ai)
#pragma unroll
            for (int m = 0; m < 4; ++m) { char* ob = (char*)(out + pbase + (size_t)(ai * HALF + m * 16) * ld);
#pragma unroll
                for (int bj = 0; bj < 2; ++bj)
#pragma unroll
                    for (int n = 0; n < 2; ++n) { const unsigned o = voff + (unsigned)(bj * HALF + n * 16) * 4u; const u32x2 xw = xpre[ai][m][bj][n];
                        const f32x4 xv = {__builtin_bit_cast(float, xw.x << 16), __builtin_bit_cast(float, xw.x & 0xffff0000u), __builtin_bit_cast(float, xw.y << 16), __builtin_bit_cast(float, xw.y & 0xffff0000u)};
                        *(f32x4*)(ob + o) = xv + acc[ai][bj][m][n] * rs[ai][m] * A1[bj][n]; }
                if (m == 3) asm volatile("" ::: "memory"); }
    }
};

struct EpiSink {
    static constexpr bool PERM = false, AFTER_DRAIN = false, PERMA = false, HAS_PRE = false;
    float* O;
    __device__ __forceinline__ void operator()(f32x4 (&acc)[2][2][4][2], const Unit& u, int wr, int wc, int fr, int fq) const {
        f32x4 s = {0.f, 0.f, 0.f, 0.f};
#pragma unroll
        for (int ai = 0; ai < 2; ++ai)
#pragma unroll
            for (int bj = 0; bj < 2; ++bj)
#pragma unroll
                for (int m = 0; m < 4; ++m)
#pragma unroll
                    for (int n = 0; n < 2; ++n) s += acc[ai][bj][m][n];
        if (s[0] + s[1] + s[2] + s[3] == 1.2345e33f) O[u.pm * 256 + wr * 64 + fr + wc + fq] = s[0];
    }
};
template <class Epi, class Sched, bool ALIGN_EPI = false, bool SP2 = false>
__device__ __forceinline__ void gemm_phase(PG8_LAS unsigned char* lds, const Gemm g, const Sched& S, const Epi& E) {
    const int tid = threadIdx.x, wid = __builtin_amdgcn_readfirstlane(tid >> 6), lane = tid & 63, wr = wid >> 2, wc = wid & 3, fr = lane & 15, fq = lane >> 4;
    const int K = g.K, nt = K / BK;
    unsigned voffA[2], voffB[2];
#pragma unroll
    for (int i = 0; i < 2; ++i) { int R, C; stage_rc(tid * 16 + i * 8192, R, C); const int Rb = Epi::PERM ? ((R & ~31) + perm32(R & 31)) : R;
        const int Ra = Epi::PERMA ? ((R & ~63) + 4 * (R & 15) + ((R & 63) >> 4)) : R;
        voffA[i] = (unsigned)(Ra * K + C) * 2u; voffB[i] = (unsigned)(Rb * K + C) * 2u; }
    const size_t kstep = (size_t)(BK * 2);
    const size_t hstep = (size_t)HALF * K * 2;
    const size_t tstep = 2 * hstep;
    const unsigned ldsw = (unsigned)wid * 1024u;
    const int aoff = lds_byte(wr * 64 + fr, fq * 8), boff = lds_byte(wc * 32 + fr, fq * 8);
#define PG8_SA(b, h) (((b) * 2 + (h)) * HTB)
#define PG8_SB(b, h) ((4 + (b) * 2 + (h)) * HTB)
#define PG8_STAGE(bufoff, gbase, voff) do { _Pragma("unroll") for (int _i = 0; _i < 2; ++_i) \
        __builtin_amdgcn_global_load_lds((const unsigned*)((const char*)(gbase) + (voff)[_i]), (PG8_LAS unsigned*)(lds + (bufoff) + ldsw + _i * 8192), 16, 0, 0); } while (0)
#define PG8_LDA(dst, b, h) do { _Pragma("unroll") for (int m = 0; m < 4; ++m) _Pragma("unroll") for (int k = 0; k < 2; ++k) dst[m][k] = *(const PG8_LAS bf16x8*)(lds + PG8_SA(b, h) + aoff + m * 2048 + k * 1024); } while (0)
#define PG8_LDB(dst, b, h) do { _Pragma("unroll") for (int n = 0; n < 2; ++n) _Pragma("unroll") for (int k = 0; k < 2; ++k) dst[n][k] = *(const PG8_LAS bf16x8*)(lds + PG8_SB(b, h) + boff + n * 2048 + k * 1024); } while (0)
#define PG8_MMA(ai, bj, At, Bt) do { __builtin_amdgcn_s_setprio(1); _Pragma("unroll") for (int m = 0; m < 4; ++m) _Pragma("unroll") for (int n = 0; n < 2; ++n) _Pragma("unroll") for (int k = 0; k < 2; ++k) \
        acc[ai][bj][m][n] = __builtin_amdgcn_mfma_f32_16x16x32_bf16(Bt[n][k], At[m][k], acc[ai][bj][m][n], 0, 0, 0); __builtin_amdgcn_s_setprio(0); } while (0)
#define PG8_WAIT_V(n) asm volatile("s_waitcnt vmcnt(" #n ")" ::: "memory")
#define PG8_WAIT_L(n) asm volatile("s_waitcnt lgkmcnt(" #n ")" ::: "memory")
#define PG8_BAR __builtin_amdgcn_s_barrier()
#define PG8_SCHED __builtin_amdgcn_sched_barrier(0)
    Unit cur, nxt; int ui = 0;
    if (!S.next(0, cur)) return;
    f32x4 acc[2][2][4][2];
#pragma unroll
    for (int a = 0; a < 2; ++a)
#pragma unroll
        for (int b = 0; b < 2; ++b)
#pragma unroll
            for (int m = 0; m < 4; ++m)
#pragma unroll
                for (int n = 0; n < 2; ++n) acc[a][b][m][n] = (f32x4){0.f, 0.f, 0.f, 0.f};
    bf16x8 At[4][2], B0[2][2], B1[2][2];
    const char* cA = (const char*)g.A + (size_t)cur.pm * tstep; const char* cB = (const char*)g.Bt + (size_t)cur.pn * tstep;
    S.a_ready(cur);
    if constexpr (Epi::HAS_PRE) E.pre(cur, 0);
    if constexpr (SP2) {
        PG8_STAGE(PG8_SB(0, 0), cB, voffB); PG8_STAGE(PG8_SB(0, 1), cB + hstep, voffB); PG8_STAGE(PG8_SA(0, 0), cA, voffA); PG8_STAGE(PG8_SA(0, 1), cA + hstep, voffA);
        if (wr == 1) PG8_BAR;
        PG8_WAIT_V(2); PG8_BAR;
        PG8_STAGE(PG8_SB(1, 0), cB + kstep, voffB); PG8_STAGE(PG8_SA(1, 0), cA + kstep, voffA); PG8_STAGE(PG8_SB(1, 1), cB + hstep + kstep, voffB);
        PG8_WAIT_V(6); PG8_BAR;
    } else {
        PG8_STAGE(PG8_SB(0, 0), cB, voffB); PG8_STAGE(PG8_SA(0, 0), cA, voffA); PG8_STAGE(PG8_SB(0, 1), cB + hstep, voffB); PG8_STAGE(PG8_SA(0, 1), cA + hstep, voffA);
        if (wr == 1) PG8_BAR;
        PG8_WAIT_V(4); PG8_BAR;
        PG8_STAGE(PG8_SB(1, 0), cB + kstep, voffB); PG8_STAGE(PG8_SA(1, 0), cA + kstep, voffA); PG8_STAGE(PG8_SB(1, 1), cB + hstep + kstep, voffB);
        PG8_WAIT_V(6); PG8_BAR;
    }
    for (;;) {
        const bool has_next = S.next(ui + 1, nxt);
        const char* nA = has_next ? (const char*)g.A + (size_t)nxt.pm * tstep : cA; const char* nB = has_next ? (const char*)g.Bt + (size_t)nxt.pn * tstep : cB;
        for (int t = 0; t < nt; t += 2) {
            const bool last = (t == nt - 2);
            const char* a1 = cA + (size_t)(t + 1) * kstep;
            const char* a2 = last ? nA : cA + (size_t)(t + 2) * kstep; const char* b2 = last ? nB : cB + (size_t)(t + 2) * kstep;
            const char* a3 = a2 + kstep; const char* b3 = b2 + kstep;
            if (last && has_next) S.a_ready(nxt);
            if constexpr (SP2) {
            PG8_LDB(B0, 0, 0); PG8_LDB(B1, 0, 1); PG8_SCHED; PG8_LDA(At, 0, 0); PG8_STAGE(PG8_SA(1, 1), a1 + hstep, voffA);
            PG8_WAIT_V(8); PG8_WAIT_L(0); PG8_BAR; PG8_MMA(0, 0, At, B0); PG8_MMA(0, 1, At, B1); PG8_BAR; PG8_SCHED;
            PG8_LDA(At, 0, 1); PG8_STAGE(PG8_SB(0, 0), b2, voffB); PG8_STAGE(PG8_SB(0, 1), b2 + hstep, voffB); PG8_STAGE(PG8_SA(0, 0), a2, voffA);
            PG8_WAIT_V(8); PG8_WAIT_L(0); PG8_BAR; PG8_MMA(1, 0, At, B0); PG8_MMA(1, 1, At, B1); PG8_BAR; PG8_SCHED;
            PG8_LDB(B0, 1, 0); PG8_LDB(B1, 1, 1); PG8_SCHED; PG8_LDA(At, 1, 0); PG8_STAGE(PG8_SA(0, 1), a2 + hstep, voffA);
            PG8_WAIT_V(8); PG8_WAIT_L(0); PG8_BAR; PG8_MMA(0, 0, At, B0); PG8_MMA(0, 1, At, B1); PG8_BAR; PG8_SCHED;
            PG8_LDA(At, 1, 1); PG8_STAGE(PG8_SB(1, 0), b3, voffB); PG8_STAGE(PG8_SB(1, 1), b3 + hstep, voffB); PG8_STAGE(PG8_SA(1, 0), a3, voffA);
            PG8_WAIT_V(8); PG8_WAIT_L(0); PG8_BAR; PG8_MMA(1, 0, At, B0); PG8_MMA(1, 1, At, B1); PG8_BAR; PG8_SCHED;
            } else {
            PG8_LDB(B0, 0, 0); PG8_SCHED; PG8_LDA(At, 0, 0); PG8_STAGE(PG8_SA(1, 1), a1 + hstep, voffA);
            PG8_WAIT_L(8); PG8_BAR; PG8_WAIT_L(0); PG8_MMA(0, 0, At, B0); PG8_BAR; PG8_SCHED;
            PG8_LDB(B1, 0, 1); PG8_STAGE(PG8_SB(0, 0), b2, voffB);
            PG8_BAR; PG8_WAIT_L(0); PG8_MMA(0, 1, At, B1); PG8_BAR;
            PG8_LDA(At, 0, 1); PG8_STAGE(PG8_SA(0, 0), a2, voffA);
            PG8_BAR; PG8_WAIT_L(0); PG8_MMA(1, 0, At, B0); PG8_BAR; PG8_SCHED;
            PG8_STAGE(PG8_SB(0, 1), b2 + hstep, voffB);
            PG8_WAIT_V(6); PG8_BAR; PG8_MMA(1, 1, At, B1); PG8_BAR;
            PG8_LDB(B0, 1, 0); PG8_SCHED; PG8_LDA(At, 1, 0); PG8_STAGE(PG8_SA(0, 1), a2 + hstep, voffA);
            PG8_WAIT_L(8); PG8_BAR; PG8_WAIT_L(0); PG8_MMA(0, 0, At, B0); PG8_BAR; PG8_SCHED;
            PG8_LDB(B1, 1, 1); PG8_STAGE(PG8_SB(1, 0), b3, voffB);
            PG8_BAR; PG8_WAIT_L(0); PG8_MMA(0, 1, At, B1); PG8_BAR;
            PG8_LDA(At, 1, 1); PG8_STAGE(PG8_SA(1, 0), a3, voffA);
            PG8_BAR; PG8_WAIT_L(0); PG8_MMA(1, 0, At, B0); PG8_BAR; PG8_SCHED;
            PG8_STAGE(PG8_SB(1, 1), b3 + hstep, voffB);
            PG8_WAIT_V(6); PG8_BAR; PG8_MMA(1, 1, At, B1); PG8_BAR;
            }
        }
        if constexpr (ALIGN_EPI) { if (wr == 0) PG8_BAR; }
        if constexpr (Epi::HAS_PRE) { if (has_next) E.pre(nxt, (ui + 1) & 1); E.run(acc, cur, wr, wc, fr, fq, ui & 1); S.done(cur); }
        else if constexpr (!Epi::AFTER_DRAIN) { E(acc, cur, wr, wc, fr, fq); S.done(cur); }
        if (!has_next) break;
#pragma unroll
        for (int a = 0; a < 2; ++a)
#pragma unroll
            for (int b = 0; b < 2; ++b)
#pragma unroll
                for (int m = 0; m < 4; ++m)
#pragma unroll
                    for (int n = 0; n < 2; ++n) acc[a][b][m][n] = (f32x4){0.f, 0.f, 0.f, 0.f};
        cur = nxt; cA = nA; cB = nB; ++ui;
        if constexpr (ALIGN_EPI) { if (wr == 1) PG8_BAR; }
    }
    PG8_WAIT_V(0);
    if constexpr (!ALIGN_EPI) { if (wr == 0) PG8_BAR; }
    PG8_BAR;
    if constexpr (Epi::AFTER_DRAIN) { E.fused(acc, cur, wr, wc, fr, fq, lds, wid, lane); S.done(cur); }
#undef PG8_SA
#undef PG8_SB
#undef PG8_STAGE
#undef PG8_LDA
#undef PG8_LDB
#undef PG8_MMA
#undef PG8_WAIT_V
#undef PG8_WAIT_L
#undef PG8_BAR
#undef PG8_SCHED
}
}
constexpr int NWAVES = 8;
constexpr int BATCH = 4, SEQ = 8192, D = 1024, M = BATCH * SEQ;
constexpr int INW = 1536, AW = 512, FF = 2816, FF2 = 2 * FF, NMOD = 6 * D;
constexpr float EPS = 1e-6f;
constexpr size_t MiB = 1u << 20;
constexpr size_t WS_CTL = 0, CTL_ZERO_BYTES = 1 * MiB;
constexpr size_t OFF_MOD = 0, OFF_SS1 = 128 * 1024, OFF_SS2 = 256 * 1024, OFF_SS3 = 384 * 1024, OFF_BAR = 512 * 1024, OFF_CNT = 544 * 1024, OFF_SS4 = 896 * 1024;
constexpr size_t WS_WIN = 1 * MiB, WS_WOUT = 4 * MiB, WS_WUP = 6 * MiB, WS_WDOWN = 17 * MiB, WS_WSP = 23 * MiB, WS_WPOOL = WS_WSP + 256 * 1024;
constexpr size_t WS_SXX = 23 * MiB + 512 * 1024;
constexpr size_t WS_XN = 24 * MiB;
constexpr size_t WS_PROJ = 88 * MiB;
constexpr size_t WS_MIXIN = 184 * MiB;
constexpr size_t WS_MIXED = WS_PROJ;
constexpr size_t WS_ACT = 248 * MiB;
constexpr size_t WS_RAW = 424 * MiB;
constexpr size_t WS_X1B = 446 * MiB;
constexpr size_t WS_F = WS_ACT;
constexpr size_t WS_END = 510 * MiB;
static_assert(WS_XN + (size_t)M * D * 2 <= WS_PROJ && WS_PROJ + (size_t)M * INW * 2 <= WS_MIXIN && WS_MIXIN + (size_t)M * D * 2 <= WS_ACT && WS_ACT + (size_t)M * FF * 2 <= WS_RAW && WS_RAW + (size_t)(M / 64) * 4 * FF2 * 2 <= WS_X1B && WS_X1B + (size_t)M * D * 2 <= WS_END, "d_ws map");
static_assert(WS_WUP + (size_t)FF2 * D * 2 <= WS_WDOWN && WS_WDOWN + (size_t)D * FF * 2 <= WS_WSP && WS_WPOOL + 4 * 128 * 128 * 2 <= WS_XN, "d_ws weights");
constexpr int RING_BYTES = 131072, LDSCTL_OFF = RING_BYTES, LDS_BYTES = 147456;

#define GAS __attribute__((address_space(1)))
#define LAS __attribute__((address_space(3)))
typedef unsigned short bf16;
typedef unsigned v4u __attribute__((ext_vector_type(4)));
typedef unsigned v2u __attribute__((ext_vector_type(2)));
typedef float f32x4 __attribute__((ext_vector_type(4)));
typedef short bf16x8 __attribute__((ext_vector_type(8)));
#define LDS_WAIT() asm volatile("s_waitcnt lgkmcnt(0)" ::: "memory")
__device__ __forceinline__ unsigned f2bf(float f) { unsigned u = __builtin_bit_cast(unsigned, f); return (u + 0x7fffu + ((u >> 16) & 1u)) >> 16; }
__device__ __forceinline__ unsigned pk2(float lo, float hi) { unsigned r; asm("v_cvt_pk_bf16_f32 %0, %1, %2" : "=v"(r) : "v"(lo), "v"(hi)); return r; }
__device__ __forceinline__ float bf_lo(unsigned w) { return __builtin_bit_cast(float, w << 16); }
__device__ __forceinline__ float bf_hi(unsigned w) { return __builtin_bit_cast(float, w & 0xffff0000u); }
__device__ __forceinline__ float wave_sum(float v) {
#pragma unroll
    for (int o = 1; o < 64; o <<= 1) v += __shfl_xor(v, o);
    return v;
}
__device__ __forceinline__ float silu_acc(float x) { return x / (1.0f + __expf(-x)); }

struct Args { const float* in[19]; float* out; unsigned char* ws; int ph_lo, ph_hi; };
enum { I_X = 0, I_C, I_WADA, I_BADA, I_PREMIXG, I_POSTMIXG, I_WIN, I_SGUG, I_WSP, I_BSP, I_WPOOL, I_PSCALE, I_WOUT, I_PREFFNG, I_POSTFFNG, I_WUP, I_CONVW, I_CONVB, I_WDOWN };

__device__ __forceinline__ void transpose_item(const float* W, int K, int N, bf16* WT, int k0, int n0, int drow0, LAS float* scr, int lane) {
    { f32x4 v[8];
#pragma unroll
        for (int i = 0; i < 8; ++i) v[i] = __builtin_nontemporal_load((const f32x4*)(W + (size_t)(k0 + 8 * i + (lane >> 3)) * N + n0 + 4 * (lane & 7)));
#pragma unroll
        for (int i = 0; i < 8; ++i) { LAS float* d = scr + (8 * i + (lane >> 3)) * 33 + 4 * (lane & 7); d[0] = v[i].x; d[1] = v[i].y; d[2] = v[i].z; d[3] = v[i].w; } }
    LDS_WAIT(); asm volatile("" ::: "memory");
    const int c = lane & 7;
#pragma unroll
    for (int j = 0; j < 4; ++j) { const int n = (lane >> 3) + 8 * j; const LAS float* s = scr + (8 * c) * 33 + n;
        v4u o; o.x = pk2(s[0 * 33], s[1 * 33]); o.y = pk2(s[2 * 33], s[3 * 33]); o.z = pk2(s[4 * 33], s[5 * 33]); o.w = pk2(s[6 * 33], s[7 * 33]);
        *(v4u*)(WT + (size_t)(drow0 + n) * K + k0 + 8 * c) = o; }
    LDS_WAIT(); asm volatile("" ::: "memory");
}

__device__ __forceinline__ void p0_prologue(const Args& a, LAS unsigned char* lds, int gw, int NGW, int lane, int wave, bool with_mod, bool with_rest) {
    unsigned char* ws = a.ws;
    float* MOD = (float*)(ws + OFF_MOD);
    const float* c = a.in[I_C]; const float* wada = a.in[I_WADA]; const float* bada = a.in[I_BADA];
    for (int it = with_mod ? gw : 96 * 16; it < 96 * 16; it += NGW) { const int cb = it % 96, ks = it / 96, col = cb * 64 + lane; float a0 = 0.f, a1 = 0.f, a2 = 0.f, a3 = 0.f;
        const float sv0 = silu_acc(c[ks * 64 + lane]), sv1 = silu_acc(c[D + ks * 64 + lane]), sv2 = silu_acc(c[2 * D + ks * 64 + lane]), sv3 = silu_acc(c[3 * D + ks * 64 + lane]);
#pragma unroll 32
        for (int kk = 0; kk < 64; ++kk) { const float w = __builtin_nontemporal_load(wada + (size_t)(ks * 64 + kk) * NMOD + col);
            a0 += __builtin_bit_cast(float, __builtin_amdgcn_readlane(__builtin_bit_cast(int, sv0), kk)) * w; a1 += __builtin_bit_cast(float, __builtin_amdgcn_readlane(__builtin_bit_cast(int, sv1), kk)) * w;
            a2 += __builtin_bit_cast(float, __builtin_amdgcn_readlane(__builtin_bit_cast(int, sv2), kk)) * w; a3 += __builtin_bit_cast(float, __builtin_amdgcn_readlane(__builtin_bit_cast(int, sv3), kk)) * w; }
        if (ks == 0) { const float b = bada[col]; a0 += b; a1 += b; a2 += b; a3 += b; }
        atomicAdd(MOD + col, a0); atomicAdd(MOD + NMOD + col, a1); atomicAdd(MOD + 2 * NMOD + col, a2); atomicAdd(MOD + 3 * NMOD + col, a3); }
    if (!with_rest) return;
    LAS float* scr = (LAS float*)(lds + wave * 16384);
    constexpr int I_IN = (D / 64) * (INW / 32), I_OUT = (D / 64) * (D / 32), I_UP = (D / 64) * (FF2 / 32), I_DOWN = (FF / 64) * (D / 32), I_POOL = 4 * 2 * 4;
    constexpr int NITEMS = I_IN + I_OUT + I_UP + I_DOWN + I_POOL;
    for (int it = gw; it < NITEMS; it += NGW) { int r = it;
        if (r < I_IN) { const int nb = INW / 32, kb = r / nb, n0 = 32 * (r % nb); transpose_item(a.in[I_WIN], D, INW, (bf16*)(ws + WS_WIN), 64 * kb, n0, n0, scr, lane); continue; } r -= I_IN;
        if (r < I_OUT) { const int nb = D / 32, kb = r / nb, n0 = 32 * (r % nb); transpose_item(a.in[I_WOUT], D, D, (bf16*)(ws + WS_WOUT), 64 * kb, n0, n0, scr, lane); continue; } r -= I_OUT;
        if (r < I_UP) { const int nb = FF2 / 32, kb = r / nb, n0 = 32 * (r % nb); const int half = n0 / FF, f = n0 % FF, drow = 256 * (f / 128) + 128 * half + (f % 128);
            transpose_item(a.in[I_WUP], D, FF2, (bf16*)(ws + WS_WUP), 64 * kb, n0, drow, scr, lane); continue; } r -= I_UP;
        if (r < I_DOWN) { const int nb = D / 32, kb = r / nb, n0 = 32 * (r % nb); transpose_item(a.in[I_WDOWN], FF, D, (bf16*)(ws + WS_WDOWN), 64 * kb, n0, n0, scr, lane); continue; } r -= I_DOWN;
        { const int g = r / 8, q = r % 8, kb = q / 4, n0 = 32 * (q % 4); transpose_item(a.in[I_WPOOL] + (size_t)g * 16384, 128, 128, (bf16*)(ws + WS_WPOOL) + (size_t)g * 16384, 64 * kb, n0, n0, scr, lane); } }
    { const float* wsp = a.in[I_WSP]; bf16* o = (bf16*)(ws + WS_WSP);
        for (int e = gw * 64 + lane; e < 4 * 128 * 128; e += NGW * 64) { const int i = (e >> 7) & 127, j = e & 127; const float v = ((j >> 6) <= (i >> 6)) ? wsp[e] : 0.f; o[e] = (bf16)f2bf(v); } }
}

__device__ __forceinline__ void p1_norm(const Args& a, int gw, int NGW, int lane) {
    const float* MOD = (const float*)(a.ws + OFF_MOD); bf16* XN = (bf16*)(a.ws + WS_XN); const float* x = a.in[I_X]; const float* g = a.in[I_PREMIXG]; float* SXX = (float*)(a.ws + WS_SXX);
    const int rpw = M / NGW;
    for (int r0 = gw * rpw; r0 < M; r0 += NGW * rpw) { const int b = r0 / SEQ; const float* mb = MOD + (size_t)b * NMOD;
        f32x4 A[4], B[4];
#pragma unroll
        for (int j = 0; j < 4; ++j) { const int col = 4 * lane + 256 * j; const f32x4 gg = *(const f32x4*)(g + col), sc = *(const f32x4*)(mb + D + col); A[j] = gg * (1.0f + sc); B[j] = *(const f32x4*)(mb + col); }
        f32x4 nx[4];
        { const f32x4* xr = (const f32x4*)(x + (size_t)r0 * D) + lane;
#pragma unroll
            for (int j = 0; j < 4; ++j) nx[j] = __builtin_nontemporal_load(xr + 64 * j); }
        for (int r = r0; r < r0 + rpw; ++r) { f32x4 v[4]; float s = 0.f;
#pragma unroll
            for (int j = 0; j < 4; ++j) { v[j] = nx[j]; s += (v[j].x * v[j].x + v[j].y * v[j].y) + (v[j].z * v[j].z + v[j].w * v[j].w); }
            if (r + 1 < r0 + rpw) { const f32x4* xr = (const f32x4*)(x + (size_t)(r + 1) * D) + lane;
#pragma unroll
                for (int j = 0; j < 4; ++j) nx[j] = __builtin_nontemporal_load(xr + 64 * j); }
            const float st = wave_sum(s);
            const float rs = 1.0f / sqrtf(st * (1.0f / D) + EPS);
            v2u* o = (v2u*)(XN + (size_t)r * D) + lane;
#pragma unroll
            for (int j = 0; j < 4; ++j) { const f32x4 h = v[j] * rs * A[j] + B[j]; const unsigned long long w = (unsigned long long)pk2(h.x, h.y) | ((unsigned long long)pk2(h.z, h.w) << 32);
                __hip_atomic_store((unsigned long long*)(o + 64 * j), w, __ATOMIC_RELAXED, __HIP_MEMORY_SCOPE_AGENT); } } }
}

constexpr int P3_RA = 0, P3_RB = 34816, P3_RP = 69632, P3_RC = 108800, P3_PA = 272, P3_PV = 272;
__device__ __forceinline__ void p3_mma(LAS unsigned char* lds, bool natural_b, f32x4 (&acc)[4][2], int wr, int wc, int fr, int fq) {
#pragma unroll
    for (int m = 0; m < 4; ++m)
#pragma unroll
        for (int n = 0; n < 2; ++n) acc[m][n] = (f32x4){0.f, 0.f, 0.f, 0.f};
#pragma unroll
    for (int kk = 0; kk < 4; ++kk) { bf16x8 af[4], bfr[2];
#pragma unroll
        for (int m = 0; m < 4; ++m) af[m] = *(const LAS bf16x8*)(lds + P3_RA + (64 * wr + 16 * m + fr) * P3_PA + (32 * kk + 8 * fq) * 2);
        if (natural_b) {
            { const unsigned addr = (unsigned)(size_t)(lds + P3_RB) + (unsigned)((32 * kk + 8 * fq + (fr >> 2)) * P3_PV + (32 * wc + 4 * (fr & 3)) * 2);
                v2u l0, h0, l1, h1;
                asm volatile("ds_read_b64_tr_b16 %0, %4\n\tds_read_b64_tr_b16 %1, %4 offset:%5\n\tds_read_b64_tr_b16 %2, %4 offset:32\n\tds_read_b64_tr_b16 %3, %4 offset:%6\n\ts_waitcnt lgkmcnt(0)"
                             : "=&v"(l0), "=&v"(h0), "=&v"(l1), "=&v"(h1) : "v"(addr), "n"(4 * P3_PV), "n"(4 * P3_PV + 32) : "memory");
                v4u w0, w1; w0.x = l0.x; w0.y = l0.y; w0.z = h0.x; w0.w = h0.y; w1.x = l1.x; w1.y = l1.y; w1.z = h1.x; w1.w = h1.y;
                bfr[0] = __builtin_bit_cast(bf16x8, w0); bfr[1] = __builtin_bit_cast(bf16x8, w1); }
        } else {
#pragma unroll
            for (int n = 0; n < 2; ++n) bfr[n] = *(const LAS bf16x8*)(lds + P3_RB + (32 * wc + 16 * n + fr) * P3_PA + (32 * kk + 8 * fq) * 2);
        }
#pragma unroll
        for (int m = 0; m < 4; ++m)
#pragma unroll
            for (int n = 0; n < 2; ++n) acc[m][n] = __builtin_amdgcn_mfma_f32_16x16x32_bf16(bfr[n], af[m], acc[m][n], 0, 0, 0); }
}
template <int W> __device__ __forceinline__ void p3_pool(LAS unsigned char* lds, int tid, int s0) {
    const int ch = tid & 15, tq = 4 * (tid >> 4); const LAS unsigned char* rp = lds + P3_RP + ch * 16; float sum[8];
#pragma unroll
    for (int e = 0; e < 8; ++e) sum[e] = 0.f;
#pragma unroll 3
    for (int k = 1; k < W; ++k) { const v4u r = *(const LAS v4u*)(rp + (16 + tq - k) * P3_PA);
        sum[0] += bf_lo(r.x); sum[1] += bf_hi(r.x); sum[2] += bf_lo(r.y); sum[3] += bf_hi(r.y); sum[4] += bf_lo(r.z); sum[5] += bf_hi(r.z); sum[6] += bf_lo(r.w); sum[7] += bf_hi(r.w); }
#pragma unroll
    for (int rr = 0; rr < 4; ++rr) { const int t = tq + rr; const v4u cur = *(const LAS v4u*)(rp + (16 + t) * P3_PA);
        sum[0] += bf_lo(cur.x); sum[1] += bf_hi(cur.x); sum[2] += bf_lo(cur.y); sum[3] += bf_hi(cur.y); sum[4] += bf_lo(cur.z); sum[5] += bf_hi(cur.z); sum[6] += bf_lo(cur.w); sum[7] += bf_hi(cur.w);
        const int cnt = (s0 + t + 1) < W ? (s0 + t + 1) : W; const float inv = 1.0f / (float)cnt;
        v4u o; o.x = pk2(sum[0] * inv - bf_lo(cur.x), sum[1] * inv - bf_hi(cur.x)); o.y = pk2(sum[2] * inv - bf_lo(cur.y), sum[3] * inv - bf_hi(cur.y));
        o.z = pk2(sum[4] * inv - bf_lo(cur.z), sum[5] * inv - bf_hi(cur.z)); o.w = pk2(sum[6] * inv - bf_lo(cur.w), sum[7] * inv - bf_hi(cur.w));
        *(LAS v4u*)(lds + P3_RA + t * P3_PA + ch * 16) = o;
        if (rr < 3) { const v4u old = *(const LAS v4u*)(rp + (16 + t - (W - 1)) * P3_PA);
            sum[0] -= bf_lo(old.x); sum[1] -= bf_hi(old.x); sum[2] -= bf_lo(old.y); sum[3] -= bf_hi(old.y); sum[4] -= bf_lo(old.z); sum[5] -= bf_hi(old.z); sum[6] -= bf_lo(old.w); sum[7] -= bf_hi(old.w); } }
}
struct P3Regs { v4u a0, a1, a2, a3, b0, b1, b2, b3, b4; };
#define P3_RA_(R, it) ((it) == 0 ? (R).a0 : (it) == 1 ? (R).a1 : (it) == 2 ? (R).a2 : (R).a3)
#define P3_RB_(R, it) ((it) == 0 ? (R).b0 : (it) == 1 ? (R).b1 : (it) == 2 ? (R).b2 : (it) == 3 ? (R).b3 : (R).b4)
__device__ __forceinline__ void p3_prefetch(P3Regs& R, int item, int t0, int s0, int tid, const bf16* PROJ, const bf16* WSP, const bf16* WPOOL, bool xhalo = false) {
    if (item < 4) { const int h = item;
#pragma unroll
        for (int it = 0; it < 4; ++it) { const int idx = tid + 512 * it, row = idx >> 4, ch = idx & 15;
            const v4u va = *(const v4u*)(WSP + (size_t)h * 16384 + row * 128 + ch * 8), vb = __builtin_nontemporal_load((const v4u*)(PROJ + (size_t)(t0 + row) * INW + AW + 128 * h + 8 * ch));
            if (it == 0) { R.a0 = va; R.b0 = vb; } else if (it == 1) { R.a1 = va; R.b1 = vb; } else if (it == 2) { R.a2 = va; R.b2 = vb; } else { R.a3 = va; R.b3 = vb; } }
    } else { const int g = item - 4;
#pragma unroll
        for (int it = 0; it < 4; ++it) { const int idx = tid + 512 * it, row = idx >> 4, ch = idx & 15; const v4u va = *(const v4u*)(WPOOL + (size_t)g * 16384 + row * 128 + ch * 8);
            if (it == 0) R.a0 = va; else if (it == 1) R.a1 = va; else if (it == 2) R.a2 = va; else R.a3 = va; }
#pragma unroll
        for (int it = 0; it < 5; ++it) { const int idx = tid + 512 * it, row = idx >> 4, ch = idx & 15; v4u raw = {0u, 0u, 0u, 0u};
            if (row < 144 && s0 + row >= 16) { const bf16* src = PROJ + (size_t)(t0 + row - 16) * INW + 2 * AW + 128 * g + 8 * ch;
                if (xhalo && row < 16) { const unsigned long long w0 = __hip_atomic_load((const unsigned long long*)src, __ATOMIC_RELAXED, __HIP_MEMORY_SCOPE_AGENT), w1 = __hip_atomic_load((const unsigned long long*)src + 1, __ATOMIC_RELAXED, __HIP_MEMORY_SCOPE_AGENT);
                    raw.x = (unsigned)w0; raw.y = (unsigned)(w0 >> 32); raw.z = (unsigned)w1; raw.w = (unsigned)(w1 >> 32); }
                else raw = __builtin_nontemporal_load((const v4u*)src); }
            if (it == 0) R.b0 = raw; else if (it == 1) R.b1 = raw; else if (it == 2) R.b2 = raw; else if (it == 3) R.b3 = raw; else R.b4 = raw; } }
}
__device__ __forceinline__ void p3_item(P3Regs& R, const int item, const int t0, const int s0, const int tid0, LAS unsigned char* lds, const LAS float* RC, const bf16* PROJ, bf16* MIXIN, const bf16* WSP, const bf16* WPOOL,
                                        const int wr, const int wc, const int fr, const int fq, const bool xhalo) {
    f32x4 acc[4][2];
            int tl = tid0; asm volatile("" : "+v"(tl));
            const int tid = tl;
            if (item < 4) { const int h = item;
#pragma unroll
                for (int it = 0; it < 4; ++it) { const int idx = tid + 512 * it, row = idx >> 4, ch = idx & 15;
                    *(LAS v4u*)(lds + P3_RA + row * P3_PA + ch * 16) = P3_RA_(R, it);
                    const v4u raw = P3_RB_(R, it);
                    float v[8]; v[0] = bf_lo(raw.x); v[1] = bf_hi(raw.x); v[2] = bf_lo(raw.y); v[3] = bf_hi(raw.y); v[4] = bf_lo(raw.z); v[5] = bf_hi(raw.z); v[6] = bf_lo(raw.w); v[7] = bf_hi(raw.w);
                    float s = 0.f;
#pragma unroll
                    for (int e = 0; e < 8; ++e) s += v[e] * v[e];
                    s += __shfl_xor(s, 1); s += __shfl_xor(s, 2); s += __shfl_xor(s, 4); s += __shfl_xor(s, 8);
                    const float rs = __builtin_amdgcn_rsqf(s * (1.0f / 128.0f) + EPS);
                    const f32x4 g0 = *(const LAS f32x4*)(RC + 128 * h + 8 * ch), g1 = *(const LAS f32x4*)(RC + 128 * h + 8 * ch + 4);
                    v2u w0, w1; w0.x = pk2(v[0] * rs * g0.x, v[1] * rs * g0.y); w0.y = pk2(v[2] * rs * g0.z, v[3] * rs * g0.w); w1.x = pk2(v[4] * rs * g1.x, v[5] * rs * g1.y); w1.y = pk2(v[6] * rs * g1.z, v[7] * rs * g1.w);
                    v4u w01; w01.x = w0.x; w01.y = w0.y; w01.z = w1.x; w01.w = w1.y; *(LAS v4u*)(lds + P3_RB + row * P3_PV + ch * 16) = w01; }
                __syncthreads();
                if (item + 2 < 8) p3_prefetch(R, item + 2, t0, s0, tid, PROJ, WSP, WPOOL, xhalo);
                v2u ur[4][2]; float bias[4];
#pragma unroll
                for (int m = 0; m < 4; ++m) { const int i = 64 * wr + 16 * m + fr; bias[m] = RC[512 + 128 * h + i];
#pragma unroll
                    for (int n = 0; n < 2; ++n) ur[m][n] = *(const v2u*)(PROJ + (size_t)(t0 + i) * INW + 128 * h + 32 * wc + 16 * n + 4 * fq); }
                p3_mma(lds, true, acc, wr, wc, fr, fq);
#pragma unroll
                for (int m = 0; m < 4; ++m) { const int i = 64 * wr + 16 * m + fr;
#pragma unroll
                    for (int n = 0; n < 2; ++n) { const int c = 128 * h + 32 * wc + 16 * n + 4 * fq; const v2u u2 = ur[m][n]; const float bi = bias[m];
                        const f32x4 z = acc[m][n]; v2u w; w.x = pk2(bf_lo(u2.x) * (z[0] + bi), bf_hi(u2.x) * (z[1] + bi)); w.y = pk2(bf_lo(u2.y) * (z[2] + bi), bf_hi(u2.y) * (z[3] + bi));
                        *(v2u*)(MIXIN + (size_t)(t0 + i) * D + c) = w; } }
                __syncthreads();
            } else { const int g = item - 4, w = 2 << g;
#pragma unroll
                for (int it = 0; it < 4; ++it) { const int idx = tid + 512 * it, row = idx >> 4, ch = idx & 15; *(LAS v4u*)(lds + P3_RB + row * P3_PA + ch * 16) = P3_RA_(R, it); }
#pragma unroll
                for (int it = 0; it < 5; ++it) { const int idx = tid + 512 * it, row = idx >> 4, ch = idx & 15; if (row < 144) *(LAS v4u*)(lds + P3_RP + row * P3_PA + ch * 16) = P3_RB_(R, it); }
                __syncthreads();
                if (item + 2 < 8) p3_prefetch(R, item + 2, t0, s0, tid, PROJ, WSP, WPOOL, xhalo);
                switch (g) { case 0: p3_pool<2>(lds, tid, s0); break; case 1: p3_pool<4>(lds, tid, s0); break; case 2: p3_pool<8>(lds, tid, s0); break; default: p3_pool<16>(lds, tid, s0); break; }
                __syncthreads();
                p3_mma(lds, false, acc, wr, wc, fr, fq);
#pragma unroll
                for (int m = 0; m < 4; ++m) { const int t = 64 * wr + 16 * m + fr;
#pragma unroll
                    for (int n = 0; n < 2; ++n) { const int d = 128 * g + 32 * wc + 16 * n + 4 * fq; const f32x4 ps = *(const LAS f32x4*)(RC + 1024 + d); const f32x4 y = acc[m][n] * ps;
                        v2u wv; wv.x = pk2(y[0], y[1]); wv.y = pk2(y[2], y[3]); *(v2u*)(MIXIN + (size_t)(t0 + t) * D + AW + d) = wv; } }
                __syncthreads();
            }
}
__device__ __forceinline__ void p3_mixers(const Args& a, LAS unsigned char* lds, int tid0, int rb, unsigned* xwait, unsigned xgen) {
    const int lane = tid0 & 63, wave = tid0 >> 6, wr = wave >> 2, wc = wave & 3, fr = lane & 15, fq = lane >> 4;
    const bf16* PROJ = (const bf16*)(a.ws + WS_PROJ); bf16* MIXIN = (bf16*)(a.ws + WS_MIXIN);
    const bf16* WSP = (const bf16*)(a.ws + WS_WSP); const bf16* WPOOL = (const bf16*)(a.ws + WS_WPOOL);
    const float* sgug = a.in[I_SGUG]; const float* bsp = a.in[I_BSP]; const float* pscale = a.in[I_PSCALE];
    { LAS float* rc = (LAS float*)(lds + P3_RC); rc[tid0] = sgug[tid0]; rc[512 + tid0] = bsp[tid0]; rc[1024 + tid0] = pscale[tid0]; }
    __syncthreads();
    const LAS float* RC = (const LAS float*)(lds + P3_RC);
    for (int tb = rb; tb < M / 128; tb += gridDim.x) { const int t0 = tb * 128, s0 = t0 % SEQ;
        const bool xhalo = xwait != nullptr && (tb & 31) == 0 && s0 != 0;
        if (xhalo) { unsigned sp = 0; while ((unsigned)__builtin_amdgcn_readfirstlane(__hip_atomic_load(xwait, __ATOMIC_RELAXED, __HIP_MEMORY_SCOPE_AGENT)) < xgen) { __builtin_amdgcn_s_sleep(2); if (++sp > (1u << 22)) break; } }
        P3Regs R;
        p3_prefetch(R, 0, t0, s0, tid0, PROJ, WSP, WPOOL);
        P3Regs Rb;
        p3_prefetch(Rb, 1, t0, s0, tid0, PROJ, WSP, WPOOL);
        for (int it2 = 0; it2 < 4; ++it2) {
            p3_item(R, 2 * it2, t0, s0, tid0, lds, RC, PROJ, MIXIN, WSP, WPOOL, wr, wc, fr, fq, xhalo);
            p3_item(Rb, 2 * it2 + 1, t0, s0, tid0, lds, RC, PROJ, MIXIN, WSP, WPOOL, wr, wc, fr, fq, xhalo); } }
}

__device__ __forceinline__ void p4b_mid(const Args& a, int gw, int NGW, int lane) {
    const float* MOD = (const float*)(a.ws + OFF_MOD); const float* SS1 = (const float*)(a.ws + OFF_SS1); const bf16* MIXED = (const bf16*)(a.ws + WS_MIXED); bf16* XN = (bf16*)(a.ws + WS_XN);
    const float* x = a.in[I_X]; const float* pg = a.in[I_POSTMIXG]; const float* fg = a.in[I_PREFFNG]; bf16* X1B = (bf16*)(a.ws + WS_X1B);
    const int rpw = M / NGW;
    for (int r0 = gw * rpw; r0 < M; r0 += NGW * rpw) { const int b = r0 / SEQ; const float* mb = MOD + (size_t)b * NMOD;
        f32x4 A1[4], A2[4], A3[4];
#pragma unroll
        for (int j = 0; j < 4; ++j) { const int col = 4 * lane + 256 * j; A1[j] = *(const f32x4*)(mb + 2 * D + col) * *(const f32x4*)(pg + col);
            A2[j] = *(const f32x4*)(fg + col) * (1.0f + *(const f32x4*)(mb + 4 * D + col)); A3[j] = *(const f32x4*)(mb + 3 * D + col); }
        f32x4 nx[4]; v2u nm[4];
        { const f32x4* xr = (const f32x4*)(x + (size_t)r0 * D) + lane; const v2u* mr = (const v2u*)(MIXED + (size_t)r0 * INW) + lane;
#pragma unroll
            for (int j = 0; j < 4; ++j) { nx[j] = __builtin_nontemporal_load(xr + 64 * j); nm[j] = __builtin_nontemporal_load(mr + 64 * j); } }
        const float ssv = (lane < rpw) ? SS1[r0 + lane] : 0.f;
        for (int r = r0; r < r0 + rpw; ++r) {
            const float rs1 = __builtin_amdgcn_rsqf(__builtin_bit_cast(float, __builtin_amdgcn_readlane(__builtin_bit_cast(int, ssv), r - r0)) * (1.0f / D) + EPS); f32x4 v[4]; float s = 0.f;
#pragma unroll
            for (int j = 0; j < 4; ++j) { const v2u mw = nm[j]; const f32x4 mx = {bf_lo(mw.x), bf_hi(mw.x), bf_lo(mw.y), bf_hi(mw.y)};
                v[j] = nx[j] + mx * rs1 * A1[j]; s += (v[j].x * v[j].x + v[j].y * v[j].y) + (v[j].z * v[j].z + v[j].w * v[j].w); }
            if (r + 1 < r0 + rpw) { const f32x4* xr = (const f32x4*)(x + (size_t)(r + 1) * D) + lane; const v2u* mr = (const v2u*)(MIXED + (size_t)(r + 1) * INW) + lane;
#pragma unroll
                for (int j = 0; j < 4; ++j) { nx[j] = __builtin_nontemporal_load(xr + 64 * j); nm[j] = __builtin_nontemporal_load(mr + 64 * j); } }
            v2u* xrow = (v2u*)(X1B + (size_t)r * D) + lane;
#pragma unroll
            for (int j = 0; j < 4; ++j) { v2u w; w.x = pk2(v[j].x, v[j].y); w.y = pk2(v[j].z, v[j].w); __builtin_nontemporal_store(w, xrow + 64 * j); }
            const float rs = __builtin_amdgcn_rsqf(wave_sum(s) * (1.0f / D) + EPS);
            v2u* o = (v2u*)(XN + (size_t)r * D) + lane;
#pragma unroll
            for (int j = 0; j < 4; ++j) { const f32x4 h = v[j] * rs * A2[j] + A3[j]; const unsigned long long w = (unsigned long long)pk2(h.x, h.y) | ((unsigned long long)pk2(h.z, h.w) << 32);
                __hip_atomic_store((unsigned long long*)(o + 64 * j), w, __ATOMIC_RELAXED, __HIP_MEMORY_SCOPE_AGENT); } } }
}

__device__ __forceinline__ void p6b_fixup(const Args& a, int gw, int NGW, int lane) {
    const bf16* RAW = (const bf16*)(a.ws + WS_RAW); bf16* ACT = (bf16*)(a.ws + WS_ACT); const float* cw = a.in[I_CONVW]; const float* cb = a.in[I_CONVB];
    for (int it = 2 * gw; it < 2 * gw + 2; ++it) { const int q = it & 3, rr = (it >> 2) & 1, B = it >> 3; const int t = 64 * B + rr, s = t % SEQ;
        const bf16* cur = RAW + (size_t)(B * 4 + rr) * FF2;
        const bf16* p1 = (rr == 1) ? RAW + (size_t)(B * 4 + 0) * FF2 : (s == 0 ? nullptr : RAW + (size_t)((B - 1) * 4 + 3) * FF2);
        const bf16* p2 = (rr == 1) ? (s == 1 ? nullptr : RAW + (size_t)((B - 1) * 4 + 3) * FF2) : (s == 0 ? nullptr : RAW + (size_t)((B - 1) * 4 + 2) * FF2);
        for (int f = q * 704 + 4 * lane; f < q * 704 + 704; f += 256) { f32x4 y[2];
#pragma unroll
            for (int hv = 0; hv < 2; ++hv) { const int col = hv * FF + f; const f32x4 z = {0.f, 0.f, 0.f, 0.f};
                const v2u zz = {0u, 0u}; const v2u r0 = *(const v2u*)(cur + col), r1 = p1 ? *(const v2u*)(p1 + col) : zz, r2 = p2 ? *(const v2u*)(p2 + col) : zz; (void)z;
                const f32x4 u0 = {bf_lo(r0.x), bf_hi(r0.x), bf_lo(r0.y), bf_hi(r0.y)}, u1 = {bf_lo(r1.x), bf_hi(r1.x), bf_lo(r1.y), bf_hi(r1.y)}, u2 = {bf_lo(r2.x), bf_hi(r2.x), bf_lo(r2.y), bf_hi(r2.y)};
                y[hv] = *(const f32x4*)(cb + col) + *(const f32x4*)(cw + col) * u2 + *(const f32x4*)(cw + FF2 + col) * u1 + *(const f32x4*)(cw + 2 * FF2 + col) * u0; }
            v2u w; w.x = pk2(pg8::silu_f(y[0][0]) * y[1][0], pg8::silu_f(y[0][1]) * y[1][1]); w.y = pk2(pg8::silu_f(y[0][2]) * y[1][2], pg8::silu_f(y[0][3]) * y[1][3]);
            *(v2u*)(ACT + (size_t)t * FF + f) = w; } }
}

#define XB_TMO      128
#define XB_XCNT(j)  (256  + 64 * (j))
#define XB_XSUB(j)  (1280 + 64 * (j))
#define XB_XGEN(j)  (2304 + 64 * (j))
#define XB_TOP      3328
#define XB_TOPGEN   3392
#define XCD_BAR_WORDS 3456
#define XB_SPIN_CAP (1u << 18)

__device__ __forceinline__ unsigned xb_ld(unsigned* p)              { return __hip_atomic_load(p, __ATOMIC_RELAXED, __HIP_MEMORY_SCOPE_AGENT); }
__device__ __forceinline__ unsigned xb_add(unsigned* p, unsigned v) { return __hip_atomic_fetch_add(p, v, __ATOMIC_RELAXED, __HIP_MEMORY_SCOPE_AGENT); }
__device__ __forceinline__ unsigned xb_xcc_id() { return (unsigned)__builtin_amdgcn_s_getreg((3 << 11) | 20) & 0xFu; }
#define XB_SPIN(cond, bar) do { unsigned _sp = 0; while (cond) { __builtin_amdgcn_s_sleep(1); \
    if ((++_sp & 255u) == 0u) { if (xb_ld(&(bar)[XB_TMO])) break; if (_sp > XB_SPIN_CAP) { atomicAdd(&(bar)[XB_TMO], 1u); break; } } } } while (0)

struct XcdBarrier {
    unsigned* bar; unsigned x;
    volatile LAS unsigned* st;
};

__device__ __forceinline__ XcdBarrier xcd_barrier_post(unsigned* bar, volatile LAS unsigned* st) {
    XcdBarrier b; b.bar = bar; b.x = xb_xcc_id(); b.st = st;
    if (threadIdx.x == 0) st[2] = xb_add(&bar[XB_XCNT(b.x)], 1u);
    return b;
}
__device__ __forceinline__ void xcd_barrier_complete(unsigned* bar, unsigned x, unsigned& nloc, unsigned& nx) {
    const unsigned G = gridDim.x * gridDim.y * gridDim.z;
    unsigned sum, cnt, mine, sp = 0u;
    for (;;) {
        sum = 0u; cnt = 0u; mine = 0u;
#pragma unroll
        for (unsigned j = 0; j < 16; ++j) { const unsigned c = xb_ld(&bar[XB_XCNT(j)]); sum += c; cnt += (c > 0u) ? 1u : 0u; mine = (j == x) ? c : mine; }
        if (sum == G) break;
        __builtin_amdgcn_s_sleep(1);
        if ((++sp & 255u) == 0u) { if (xb_ld(&bar[XB_TMO])) break; if (sp > XB_SPIN_CAP) { atomicAdd(&bar[XB_TMO], 1u); break; } }
    }
    nloc = mine > 0u ? mine : 1u; nx = cnt > 0u ? cnt : 1u;
}

__device__ __forceinline__ void xcd_barrier(const XcdBarrier& b) {
    asm volatile("s_waitcnt vmcnt(0)" ::: "memory");
    __syncthreads();
    if (threadIdx.x == 0) {
        unsigned* bar = b.bar;
        __builtin_amdgcn_s_waitcnt(0);
        unsigned nloc = b.st[0], nx = b.st[1];
        if (nloc == 0u) { xcd_barrier_complete(bar, b.x, nloc, nx); b.st[0] = nloc; b.st[1] = nx; }
        const unsigned old = xb_add(&bar[XB_XSUB(b.x)], 1u);
        const unsigned gen = old / nloc;
        if (old + 1u == (gen + 1u) * nloc) {
            __builtin_amdgcn_fence(__ATOMIC_RELEASE, "agent");
            asm volatile("s_waitcnt vmcnt(0)" ::: "memory");
            const unsigned og = xb_add(&bar[XB_TOP], 1u);
            const unsigned tg = og / nx;
            if (og + 1u == (tg + 1u) * nx) xb_add(&bar[XB_TOPGEN], 1u);
            else XB_SPIN(xb_ld(&bar[XB_TOPGEN]) == tg, bar);
            __builtin_amdgcn_fence(__ATOMIC_ACQUIRE, "agent");
            xb_add(&bar[XB_XGEN(b.x)], 1u);
            asm volatile("s_waitcnt vmcnt(0)" ::: "memory");
        } else {
            XB_SPIN(xb_ld(&bar[XB_XGEN(b.x)]) == gen, bar);
            __builtin_amdgcn_fence(__ATOMIC_ACQUIRE, "agent");
            asm volatile("s_waitcnt vmcnt(0)" ::: "memory");
        }
    }
    __syncthreads();
}
#define XL_SUB(j)  (4096 + 64 * (j))
#define XL_GEN(j)  (5120 + 64 * (j))
__device__ __forceinline__ void xcd_local_barrier(const XcdBarrier& b) {
    asm volatile("s_waitcnt vmcnt(0)" ::: "memory");
    __syncthreads();
    if (threadIdx.x == 0) { unsigned* bar = b.bar; const unsigned nloc = b.st[0];
        const unsigned old = xb_add(&bar[XL_SUB(b.x)], 1u); const unsigned gen = old / nloc;
        if (old + 1u == (gen + 1u) * nloc) xb_add(&bar[XL_GEN(b.x)], 1u);
        else XB_SPIN(xb_ld(&bar[XL_GEN(b.x)]) == gen, bar);
        __builtin_amdgcn_fence(__ATOMIC_ACQUIRE, "agent");
        asm volatile("s_waitcnt vmcnt(0)" ::: "memory"); }
    __syncthreads();
}
__global__ void __launch_bounds__(NWAVES * 64, 2) mk_fwd(Args args) {
    extern __shared__ __attribute__((aligned(16))) unsigned char lds_raw[];
    LAS unsigned char* lds = (LAS unsigned char*)lds_raw;
    const int tid = threadIdx.x, lane = tid & 63, wave = __builtin_amdgcn_readfirstlane(tid >> 6);
    const int G = gridDim.x, gw = blockIdx.x * NWAVES + wave, NGW = G * NWAVES;
    const int lo = args.ph_lo, hi = args.ph_hi;
    unsigned char* ws = args.ws;
    if (tid < 64) ((LAS unsigned*)(lds + LDSCTL_OFF))[tid] = 0u;
    __syncthreads();
    XcdBarrier bar = xcd_barrier_post((unsigned*)(ws + OFF_BAR), (volatile LAS unsigned*)(lds + LDSCTL_OFF) + 8);
#define IN(k) (lo <= (k) && (k) < hi)
#define NREP(k) ((MK_REPEAT == (k) || ((k) == 4 && (MK_REPEAT == 41 || MK_REPEAT == 42))) ? 2 : 1)
#define SEAM(k) do { if (IN(k) && IN((k) + 1)) xcd_barrier(bar); } while (0)
    if (lo < 0) cg::this_grid().sync();
    if (IN(0)) { p0_prologue(args, lds, gw, NGW, lane, wave, true, true); }
    SEAM(0);
    int cvirt = (int)blockIdx.x; bool xlocal = false;
    if (lo == 0 && hi > 2 && (G & 7) == 0) { bool even = true;
#pragma unroll
        for (int j = 0; j < 16; ++j) { const unsigned cj = xb_ld(&bar.bar[XB_XCNT(j)]); even = even && (cj == (j < 8 ? (unsigned)(G >> 3) : 0u)); }
        if (even && bar.x < 8u) { cvirt = (int)(bar.st[2] * 8u + bar.x); xlocal = true; } }
    cvirt = __builtin_amdgcn_readfirstlane(cvirt);
    const int rb = xlocal ? (cvirt & 7) * (G >> 3) + (cvirt >> 3) : (int)blockIdx.x;
    unsigned lgen = 0;
#define LSEAM() do { if (xlocal) { xcd_local_barrier(bar); ++lgen; } else xcd_barrier(bar); } while (0)
    if (IN(1)) { for (int rep = 0; rep < NREP(1); ++rep) { if (rep) xcd_barrier(bar); p1_norm(args, rb * NWAVES + wave, NGW, lane); } }
    if (IN(1) && IN(2)) LSEAM();
    if (IN(2)) { pg8::Gemm g{(const bf16*)(ws + WS_XN), (const bf16*)(ws + WS_WIN), M, INW, D}; pg8::StaticOrder S; S.init(M, INW, G, cvirt);
        pg8::EpiProj E{(bf16*)(ws + WS_PROJ), INW};
        for (int rep = 0; rep < NREP(2); ++rep) { if (rep) xcd_barrier(bar); pg8::gemm_phase<pg8::EpiProj, pg8::StaticOrder, true, true>(lds, g, S, E); } }
    if (IN(2) && IN(3)) LSEAM();
    if (IN(3)) { for (int rep = 0; rep < NREP(3); ++rep) { if (rep) xcd_barrier(bar); __syncthreads(); p3_mixers(args, lds, tid, rb, (xlocal && bar.x > 0u) ? &bar.bar[XL_GEN(bar.x - 1u)] : nullptr, lgen); } }
    if (IN(3) && IN(4)) LSEAM();
    if (IN(4)) { pg8::Gemm g{(const bf16*)(ws + WS_MIXIN), (const bf16*)(ws + WS_WOUT), M, D, D}; pg8::StaticOrder S; S.init(M, D, G, cvirt);
        pg8::EpiBf16SS E{(bf16*)(ws + WS_MIXED), INW, (float*)(ws + OFF_SS1)};
        pg8::gemm_phase<pg8::EpiBf16SS, pg8::StaticOrder, true, true>(lds, g, S, E);
        LSEAM();
        p4b_mid(args, rb * NWAVES + wave, NGW, lane); }
    if (IN(4) && IN(5)) LSEAM();
    if (IN(5)) { pg8::Gemm g{(const bf16*)(ws + WS_XN), (const bf16*)(ws + WS_WUP), M, FF2, D}; pg8::StaticOrder S; S.init(M, FF2, G, cvirt);
        pg8::EpiConv E{(bf16*)(ws + WS_ACT), (bf16*)(ws + WS_RAW), args.in[I_CONVW], args.in[I_CONVB], FF, lds + LDSCTL_OFF + 4096};
        for (int rep = 0; rep < NREP(5); ++rep) { if (rep) xcd_barrier(bar); pg8::gemm_phase<pg8::EpiConv, pg8::StaticOrder, true, true>(lds, g, S, E); } }
    SEAM(5);
    if (IN(6)) { p6b_fixup(args, rb * NWAVES + wave, NGW, lane); }
    if (IN(6) && IN(7)) LSEAM();
    if (IN(7)) { pg8::Gemm g{(const bf16*)(ws + WS_ACT), (const bf16*)(ws + WS_WDOWN), M, D, FF}; pg8::StaticOrder S; S.init(M, D, G, cvirt);
        for (int rep = 0; rep < NREP(7); ++rep) { if (rep) xcd_barrier(bar);
        pg8::RowStat st{(float*)(ws + (rep ? 736 * 1024 : OFF_SS4)), (unsigned*)(ws + (rep ? 640 * 1024 : OFF_CNT + 32768)), 32u, 1.0f / D, EPS};
        pg8::EpiFinal E{(const bf16*)(ws + WS_X1B), rep ? (float*)(ws + WS_F) : args.out, (const float*)(ws + OFF_MOD), args.in[I_POSTFFNG], st, D, SEQ / 256};
        pg8::gemm_phase<pg8::EpiFinal, pg8::StaticOrder, true, true>(lds, g, S, E); } }
    if (MK_REPEAT == 17 && IN(7)) { xcd_barrier(bar); pg8::Gemm g{(const bf16*)(ws + WS_ACT), (const bf16*)(ws + WS_WDOWN), M, D, FF}; pg8::StaticOrder S; S.init(M, D, G, (int)blockIdx.x);
        pg8::EpiSink E{(float*)(ws + WS_F)}; pg8::gemm_phase<pg8::EpiSink, pg8::StaticOrder, true, true>(lds, g, S, E); }
#undef IN
#undef SEAM
}

constexpr int N_PHASES = 8;
extern "C" void kernel_launch(void* const* d_in, const int* in_sizes, int n_in, void* d_out, int out_size, void* d_ws, size_t ws_size, hipStream_t stream) {
    static int grid = 0;
    if (grid == 0) {
        if (n_in != 19 || in_sizes[0] != M * D || out_size != M * D || ws_size < WS_END) { fprintf(stderr, "kernel_launch: unexpected shapes (n_in %d, in0 %d, out %d, ws %zu)\n", n_in, n_in > 0 ? in_sizes[0] : -1, out_size, ws_size); grid = -1; return; }
        int dev = 0, cus = 0, per_cu = 0;
        (void)hipGetDevice(&dev); (void)hipDeviceGetAttribute(&cus, hipDeviceAttributeMultiprocessorCount, dev);
        if (hipFuncSetAttribute((const void*)mk_fwd, hipFuncAttributeMaxDynamicSharedMemorySize, LDS_BYTES) != hipSuccess) { fprintf(stderr, "kernel_launch: hipFuncSetAttribute failed\n"); grid = -1; return; }
        if (hipOccupancyMaxActiveBlocksPerMultiprocessor(&per_cu, (const void*)mk_fwd, NWAVES * 64, LDS_BYTES) != hipSuccess || per_cu < 1) { fprintf(stderr, "kernel_launch: occupancy query says %d blocks per CU\n", per_cu); per_cu = 1; }
        (void)hipGetLastError();
        grid = cus > 0 ? cus : 256;
    }
    if (grid < 0) return;
    (void)hipMemsetAsync((char*)d_ws + WS_CTL, 0, CTL_ZERO_BYTES, stream);
    Args a{};
    for (int i = 0; i < 19; ++i) a.in[i] = (const float*)d_in[i];
    a.out = (float*)d_out; a.ws = (unsigned char*)d_ws;
#if MK_N_LAUNCHES == 1
    a.ph_lo = 0; a.ph_hi = N_PHASES;
    void* kargs[] = {&a};
    hipError_t e = hipLaunchCooperativeKernel((const void*)mk_fwd, dim3(grid), dim3(NWAVES * 64), kargs, LDS_BYTES, stream);
    if (e != hipSuccess) fprintf(stderr, "kernel_launch: cooperative launch failed: %s (grid %d)\n", hipGetErrorString(e), grid);
#else
    for (int p = 0; p < N_PHASES; ++p) { a.ph_lo = p; a.ph_hi = p + 1; hipLaunchKernelGGL(mk_fwd, dim3(grid), dim3(NWAVES * 64), LDS_BYTES, stream, a); }
#endif
}
```

```cpp
#include <hip/hip_runtime.h>
#include <hip/hip_cooperative_groups.h>
#include <cstdio>
#include <cstdint>
namespace cg = cooperative_groups;
#ifndef MK_N_LAUNCHES
#define MK_N_LAUNCHES 1
#endif
#ifndef MK_REPEAT
#define MK_REPEAT -1
#endif
namespace pg8 {
#define PG8_LAS __attribute__((address_space(3)))
typedef unsigned short bf16_t;
typedef short bf16x8 __attribute__((ext_vector_type(8)));
typedef float f32x4 __attribute__((ext_vector_type(4)));
typedef unsigned u32x4 __attribute__((ext_vector_type(4)));
constexpr int BM = 256, BK = 64, HALF = 128, HTB = HALF * BK * 2  , STAGE_BYTES = 8 * HTB, NXCD = 8, WGM = 4;

__host__ __device__ __forceinline__ int lds_byte(int r, int c) { const int st = (r >> 4) * 2 + (c >> 5), rr = r & 15, cc = c & 31, ob = rr * 64 + cc * 2; return st * 1024 + (ob ^ (((ob >> 9) & 1) << 5)); }
__host__ __device__ __forceinline__ void stage_rc(int b, int& R, int& C) { const int st = b / 1024, sb = b % 1024, swz = sb ^ (((sb >> 9) & 1) << 5); R = (st >> 1) * 16 + swz / 64; C = (st & 1) * 32 + (swz % 64) / 2; }
__host__ __device__ __forceinline__ int perm32(int rho) { const int n = rho >> 4, i = rho & 15; return 8 * (i >> 2) + 4 * n + (i & 3); }

struct Unit { int pm, pn; };
struct Gemm { const bf16_t* A; const bf16_t* Bt; int M, N, K; };

struct StaticOrder {
    int nM, nN, nwg, G, c;
    __host__ __device__ void init(int M, int N, int G_, int c_) { nM = M / BM; nN = N / BM; nwg = nM * nN; G = G_; c = c_; }
    __host__ __device__ bool next(int i, Unit& u) const {
        const long L = (long)i * G + c; if (L >= nwg) return false;
        int wgid = (int)L; { const int q = nwg / NXCD, r = nwg % NXCD, xcd = wgid % NXCD, off = wgid / NXCD; wgid = (xcd < r ? xcd * (q + 1) : r * (q + 1) + (xcd - r) * q) + off; }
        const int nig = WGM * nN, gid = wgid / nig, fm = gid * WGM, gsz = (nM - fm) < WGM ? (nM - fm) : WGM;
        u.pm = fm + ((wgid % nig) % gsz); u.pn = (wgid % nig) / gsz; return true;
    }
    __device__ __forceinline__ void a_ready(const Unit&) const {}
    __device__ __forceinline__ void done(const Unit&) const {}
};

__device__ __forceinline__ unsigned cvt_pk_bf16(float lo, float hi) { unsigned r; asm volatile("v_cvt_pk_bf16_f32 %0, %1, %2" : "=v"(r) : "v"(lo), "v"(hi)); return r; }
typedef float f32x2 __attribute__((ext_vector_type(2)));
typedef unsigned u32x2 __attribute__((ext_vector_type(2)));
__device__ __forceinline__ float fast_sigmoid_arg2(float p) { return __builtin_amdgcn_rcpf(1.0f + __builtin_amdgcn_exp2f(p)); }
__device__ __forceinline__ float gelu_tanh(float x) {
    const float t = x * x; const float p = x * (-2.302208198f + (-0.1029432397f) * t); return x * fast_sigmoid_arg2(p);
}
__device__ __forceinline__ float silu_f(float x) { return x * fast_sigmoid_arg2(x * (-1.4426950409f)); }
__device__ __forceinline__ float dpp_ror1(float x) { return __builtin_bit_cast(float, __builtin_amdgcn_update_dpp(0, __builtin_bit_cast(int, x), 0x121, 0xf, 0xf, false)); }
__device__ __forceinline__ float dpp_ror2(float x) { return __builtin_bit_cast(float, __builtin_amdgcn_update_dpp(0, __builtin_bit_cast(int, x), 0x122, 0xf, 0xf, false)); }

struct EpiProj {
    static constexpr bool PERM = true, AFTER_DRAIN = false, PERMA = false, HAS_PRE = false;
    bf16_t* O; int ldc;
    __device__ __forceinline__ void operator()(const f32x4 (&acc)[2][2][4][2], const Unit& u, int wr, int wc, int fr, int fq) const {
        const int row0 = u.pm * BM + wr * 64 + fr, col0 = u.pn * BM + wc * 32 + 8 * fq; const bool act = u.pn < 4; const bool edge = !act && (u.pm & 15) == 15 && wr == 1;
#pragma unroll
        for (int ai = 0; ai < 2; ++ai)
#pragma unroll
            for (int m = 0; m < 4; ++m) { bf16_t* rowp = O + (size_t)(row0 + ai * HALF + m * 16) * ldc + col0;
#pragma unroll
                for (int bj = 0; bj < 2; ++bj) { f32x4 v0 = acc[ai][bj][m][0], v1 = acc[ai][bj][m][1];
                    if (act) {
#pragma unroll
                        for (int j = 0; j < 4; ++j) { v0[j] = gelu_tanh(v0[j]); v1[j] = gelu_tanh(v1[j]); } }
                    u32x4 w; w.x = cvt_pk_bf16(v0[0], v0[1]); w.y = cvt_pk_bf16(v0[2], v0[3]); w.z = cvt_pk_bf16(v1[0], v1[1]); w.w = cvt_pk_bf16(v1[2], v1[3]);
                    if (edge && ai == 1 && m == 3) {
                        __hip_atomic_store((unsigned long long*)(rowp + bj * HALF), (unsigned long long)w.x | ((unsigned long long)w.y << 32), __ATOMIC_RELAXED, __HIP_MEMORY_SCOPE_AGENT);
                        __hip_atomic_store((unsigned long long*)(rowp + bj * HALF + 4), (unsigned long long)w.z | ((unsigned long long)w.w << 32), __ATOMIC_RELAXED, __HIP_MEMORY_SCOPE_AGENT); }
                    else *(u32x4*)(rowp + bj * HALF) = w; } }
    }
};

struct EpiF32SS {
    static constexpr bool PERM = false, AFTER_DRAIN = false, PERMA = false, HAS_PRE = false;
    float* O; int ldc; float* ss;
    __device__ __forceinline__ void operator()(const f32x4 (&acc)[2][2][4][2], const Unit& u, int wr, int wc, int fr, int fq) const {
        const int row0 = u.pm * BM + wr * 64 + fr, col0 = u.pn * BM + wc * 32 + 4 * fq;
#pragma unroll
        for (int ai = 0; ai < 2; ++ai)
#pragma unroll
            for (int m = 0; m < 4; ++m) { const int row = row0 + ai * HALF + m * 16; float* rowp = O + (size_t)row * ldc + col0; float s = 0.f;
#pragma unroll
                for (int bj = 0; bj < 2; ++bj)
#pragma unroll
                    for (int n = 0; n < 2; ++n) { const f32x4 x = acc[ai][bj][m][n]; s += (x[0] * x[0] + x[1] * x[1]) + (x[2] * x[2] + x[3] * x[3]); *(f32x4*)(rowp + bj * HALF + n * 16) = x; }
                s += __shfl_xor(s, 16); s += __shfl_xor(s, 32);
                if (fq == 0) atomicAdd(ss + row, s); }
    }
};

struct EpiBf16SS {
    static constexpr bool PERM = true, AFTER_DRAIN = false, PERMA = false, HAS_PRE = false;
    bf16_t* O; int ldc; float* ss;
    __device__ __forceinline__ void operator()(const f32x4 (&acc)[2][2][4][2], const Unit& u, int wr, int wc, int fr, int fq) const {
        const int row0 = u.pm * BM + wr * 64 + fr, col0 = u.pn * BM + wc * 32 + 8 * fq;
#pragma unroll
        for (int ai = 0; ai < 2; ++ai)
#pragma unroll
            for (int m = 0; m < 4; ++m) { const int row = row0 + ai * HALF + m * 16; bf16_t* rowp = O + (size_t)row * ldc + col0; float s = 0.f;
#pragma unroll
                for (int bj = 0; bj < 2; ++bj) { const f32x4 v0 = acc[ai][bj][m][0], v1 = acc[ai][bj][m][1];
                    s += ((v0[0] * v0[0] + v0[1] * v0[1]) + (v0[2] * v0[2] + v0[3] * v0[3])) + ((v1[0] * v1[0] + v1[1] * v1[1]) + (v1[2] * v1[2] + v1[3] * v1[3]));
                    u32x4 w; w.x = cvt_pk_bf16(v0[0], v0[1]); w.y = cvt_pk_bf16(v0[2], v0[3]); w.z = cvt_pk_bf16(v1[0], v1[1]); w.w = cvt_pk_bf16(v1[2], v1[3]);
                    *(u32x4*)(rowp + bj * HALF) = w; }
                s += __shfl_xor(s, 16); s += __shfl_xor(s, 32);
                if (fq == 0) atomicAdd(ss + row, s); }
    }
};

__device__ __forceinline__ float dpp_shr1(float x) { return __builtin_bit_cast(float, __builtin_amdgcn_update_dpp(0, __builtin_bit_cast(int, x), 0x111, 0xf, 0xf, true)); }
struct EpiConv {
    static constexpr bool PERM = true, AFTER_DRAIN = false, PERMA = true, HAS_PRE = true;
    bf16_t* ACT; bf16_t* RAW; const float* cw; const float* cb; int FF; PG8_LAS unsigned char* CB;
    __device__ __forceinline__ void pre(const Unit& u, int par) const {
        const int tid = threadIdx.x, w = __builtin_amdgcn_readfirstlane(tid >> 6), l = tid & 63;
        if (w < 4) { const int vec = 2 * w + (l >> 5), k = vec & 3, hv = vec >> 2; const float* src = (k < 3 ? cw + (size_t)k * 2 * FF : cb) + hv * FF + u.pn * HALF + (l & 31) * 4;
            __builtin_amdgcn_global_load_lds((const unsigned*)src, (PG8_LAS unsigned*)(CB + par * 4096 + w * 1024), 16, 0, 0); }
    }
    __device__ __forceinline__ void run(const f32x4 (&acc)[2][2][4][2], const Unit& u, int wr, int wc, int fr, int fq, int par) const {
        const int f0 = u.pn * HALF + wc * 32 + 8 * fq; const int rowt = u.pm * BM + wr * 64 + 4 * fr; const int FF2 = 2 * FF;
        const PG8_LAS float* cbuf = (const PG8_LAS float*)(CB + par * 4096) + wc * 32 + 8 * fq;
        unsigned stash[2][4][2];
#pragma unroll
        for (int n = 0; n < 2; ++n) { const int f = f0 + 4 * n; const PG8_LAS float* cn = cbuf + 4 * n;
            const f32x4 w0g = *(const PG8_LAS f32x4*)(cn), w1g = *(const PG8_LAS f32x4*)(cn + 128), w2g = *(const PG8_LAS f32x4*)(cn + 256), bg = *(const PG8_LAS f32x4*)(cn + 384);
            const f32x4 w0v = *(const PG8_LAS f32x4*)(cn + 512), w1v = *(const PG8_LAS f32x4*)(cn + 640), w2v = *(const PG8_LAS f32x4*)(cn + 768), bv = *(const PG8_LAS f32x4*)(cn + 896);
#pragma unroll
            for (int ai = 0; ai < 2; ++ai) {
                f32x4 gm1, gm2, vm1, vm2;
#pragma unroll
                for (int j = 0; j < 4; ++j) { gm1[j] = dpp_shr1(acc[ai][0][3][n][j]); gm2[j] = dpp_shr1(acc[ai][0][2][n][j]); vm1[j] = dpp_shr1(acc[ai][1][3][n][j]); vm2[j] = dpp_shr1(acc[ai][1][2][n][j]); }
#pragma unroll
                for (int m = 0; m < 4; ++m) { const f32x4 g = acc[ai][0][m][n], v = acc[ai][1][m][n];
                    const f32x4 pg1 = (m == 0) ? gm1 : acc[ai][0][m > 0 ? m - 1 : 0][n], pg2 = (m == 0) ? gm2 : (m == 1 ? gm1 : acc[ai][0][m > 1 ? m - 2 : 0][n]);
                    const f32x4 pv1 = (m == 0) ? vm1 : acc[ai][1][m > 0 ? m - 1 : 0][n], pv2 = (m == 0) ? vm2 : (m == 1 ? vm1 : acc[ai][1][m > 1 ? m - 2 : 0][n]);
                    const f32x4 yg = bg + w0g * pg2 + w1g * pg1 + w2g * g, yv = bv + w0v * pv2 + w1v * pv1 + w2v * v; f32x4 a;
#pragma unroll
                    for (int j = 0; j < 4; ++j) a[j] = silu_f(yg[j]) * yv[j];
                    const unsigned lo = cvt_pk_bf16(a[0], a[1]), hi = cvt_pk_bf16(a[2], a[3]);
                    if (n == 0) { stash[ai][m][0] = lo; stash[ai][m][1] = hi; }
                    else if (!(m < 2 && fr == 0)) { u32x4 w; w.x = stash[ai][m][0]; w.y = stash[ai][m][1]; w.z = lo; w.w = hi; __builtin_nontemporal_store(w, (u32x4*)(ACT + (size_t)(rowt + ai * HALF + m) * FF + f0)); }
                    if ((m < 2 && fr == 0) || (m >= 2 && fr == 15)) { bf16_t* rp = RAW + ((size_t)((u.pm * 4 + ai * 2 + wr) * 4 + m)) * FF2 + f;
                        u32x2 gw, vw; gw.x = cvt_pk_bf16(g[0], g[1]); gw.y = cvt_pk_bf16(g[2], g[3]); vw.x = cvt_pk_bf16(v[0], v[1]); vw.y = cvt_pk_bf16(v[2], v[3]);
                        *(u32x2*)rp = gw; *(u32x2*)(rp + FF) = vw; } } } }
    }
};

struct RowStat {
    float* ss; unsigned* cnt; unsigned want; float inv_n, eps;
    __device__ __forceinline__ void run(const float (&part)[2][4], float (&rs)[2][4], const Unit& u, int wr, int fr, int fq) const {
        const int row0 = u.pm * BM + wr * 64 + fr; const int lane = fq * 16 + fr;
#pragma unroll
        for (int ai = 0; ai < 2; ++ai)
#pragma unroll
            for (int m = 0; m < 4; ++m) { float s = part[ai][m]; s += __shfl_xor(s, 16); s += __shfl_xor(s, 32); if (fq == 0) atomicAdd(ss + row0 + ai * HALF + m * 16, s); }
        asm volatile("s_waitcnt vmcnt(0)" ::: "memory");
        unsigned* c = cnt + 64 * u.pm;
        if (lane == 0) __hip_atomic_fetch_add(c, 1u, __ATOMIC_RELAXED, __HIP_MEMORY_SCOPE_AGENT);
        if (threadIdx.x < 64) { unsigned sp = 0;
            while ((unsigned)__builtin_amdgcn_readfirstlane(__hip_atomic_load(c, __ATOMIC_RELAXED, __HIP_MEMORY_SCOPE_AGENT)) < want) { __builtin_amdgcn_s_sleep(1); if (++sp > (1u << 22)) break; } }
        asm volatile("s_waitcnt vmcnt(0) lgkmcnt(0)" ::: "memory"); __builtin_amdgcn_s_barrier(); asm volatile("" ::: "memory");
#pragma unroll
        for (int ai = 0; ai < 2; ++ai)
#pragma unroll
            for (int m = 0; m < 4; ++m) { const float v = __hip_atomic_load(ss + row0 + ai * HALF + m * 16, __ATOMIC_RELAXED, __HIP_MEMORY_SCOPE_AGENT); rs[ai][m] = __builtin_amdgcn_rsqf(v * inv_n + eps); }
    }
};
template <int VAR = 0  > struct EpiMid {
    static constexpr bool PERM = false, AFTER_DRAIN = false, PERMA = false, HAS_PRE = false;
    const float* x; float* x1; bf16_t* xn; const float* mod; const float* post_g; const float* ffn_g; const float* sxx; float* ss1; float* ssxm; float* ssmm; unsigned* cnt; PG8_LAS float* A23; int ld, tiles_per_batch;
    __device__ __forceinline__ void operator()(f32x4 (&acc)[2][2][4][2], const Unit& u, int wr, int wc, int fr, int fq) const {
        const int col0 = u.pn * BM + wc * 32 + 4 * fq; const float* mb = mod + (size_t)(u.pm / tiles_per_batch) * (6 * ld); const int tid = threadIdx.x;
        const unsigned voff = (unsigned)((wr * 64 + fr) * ld + col0) * 4u;
        const size_t pbase = (size_t)u.pm * BM * ld; const int row0 = u.pm * BM + wr * 64 + fr;
        if (tid < 256) { const int c = u.pn * BM + tid; A23[tid] = mb[2 * ld + c] * post_g[c]; A23[256 + tid] = ffn_g[c] * (1.0f + mb[4 * ld + c]); A23[512 + tid] = mb[3 * ld + c]; }
        asm volatile("s_waitcnt vmcnt(0) lgkmcnt(0)" ::: "memory"); __builtin_amdgcn_s_barrier(); asm volatile("" ::: "memory");
        const PG8_LAS float* As = A23 + wc * 32 + 4 * fq;
#pragma unroll
        for (int ai = 0; ai < 2; ++ai)
#pragma unroll
            for (int m = 0; m < 4; ++m) { const char* xb = (const char*)(x + pbase + (size_t)(ai * HALF + m * 16) * ld); f32x4 s1 = {0.f, 0.f, 0.f, 0.f}, sx = s1, sm = s1;
#pragma unroll
                for (int bj = 0; bj < 2; ++bj)
#pragma unroll
                    for (int n = 0; n < 2; ++n) { const unsigned o = voff + (unsigned)(bj * HALF + n * 16) * 4u; const f32x4 xv = (VAR == 1) ? (f32x4){1.f, 1.f, 1.f, 1.f} : *(const f32x4*)(xb + o); const f32x4 mx = acc[ai][bj][m][n], cm = mx * *(const PG8_LAS f32x4*)(As + bj * HALF + n * 16);
                        s1 += mx * mx; sx += xv * cm; sm += cm * cm; }
                float a = (s1[0] + s1[1]) + (s1[2] + s1[3]), b = (sx[0] + sx[1]) + (sx[2] + sx[3]), c = (sm[0] + sm[1]) + (sm[2] + sm[3]);
                a += __shfl_xor(a, 16); a += __shfl_xor(a, 32); b += __shfl_xor(b, 16); b += __shfl_xor(b, 32); c += __shfl_xor(c, 16); c += __shfl_xor(c, 32);
                if (fq == 0) { const int r = row0 + ai * HALF + m * 16; atomicAdd(ss1 + r, a); atomicAdd(ssxm + r, b); atomicAdd(ssmm + r, c); }
                if (m == 3) asm volatile("" ::: "memory"); }
        asm volatile("s_waitcnt vmcnt(0)" ::: "memory");
        unsigned* cw = cnt + 64 * u.pm;
        if ((tid & 63) == 0) __hip_atomic_fetch_add(cw, 1u, __ATOMIC_RELAXED, __HIP_MEMORY_SCOPE_AGENT);
        if (tid < 64) { unsigned sp = 0;
            while ((unsigned)__builtin_amdgcn_readfirstlane(__hip_atomic_load(cw, __ATOMIC_RELAXED, __HIP_MEMORY_SCOPE_AGENT)) < 32u) { __builtin_amdgcn_s_sleep(1); if (++sp > (1u << 22)) break; } }
        asm volatile("s_waitcnt vmcnt(0) lgkmcnt(0)" ::: "memory"); __builtin_amdgcn_s_barrier(); asm volatile("" ::: "memory");
        const float inv_n = 1.0f / (float)ld; float rs1[2][4], rs2[2][4];
#pragma unroll
        for (int ai = 0; ai < 2; ++ai)
#pragma unroll
            for (int m = 0; m < 4; ++m) { const int r = row0 + ai * HALF + m * 16;
                const float S1 = __hip_atomic_load(ss1 + r, __ATOMIC_RELAXED, __HIP_MEMORY_SCOPE_AGENT), Sxm = __hip_atomic_load(ssxm + r, __ATOMIC_RELAXED, __HIP_MEMORY_SCOPE_AGENT), Smm = __hip_atomic_load(ssmm + r, __ATOMIC_RELAXED, __HIP_MEMORY_SCOPE_AGENT);
                const float r1 = __builtin_amdgcn_rsqf(S1 * inv_n + 1e-6f); rs1[ai][m] = r1;
                const float s2 = sxx[r] + 2.0f * r1 * Sxm + r1 * r1 * Smm; rs2[ai][m] = __builtin_amdgcn_rsqf(s2 * inv_n + 1e-6f); }
        if (VAR != 0) { if (rs1[0][0] + rs2[1][3] + rs1[1][2] + rs2[0][1] == 1.2345e33f) x1[row0] = rs1[0][1]; return; }
#pragma unroll
        for (int ai = 0; ai < 2; ++ai)
#pragma unroll
            for (int m = 0; m < 4; ++m) { const size_t gb = pbase + (size_t)(ai * HALF + m * 16) * ld; const char* xb = (const char*)(x + gb); char* ob = (char*)(x1 + gb); char* nb = (char*)(xn + gb);
#pragma unroll
                for (int bj = 0; bj < 2; ++bj)
#pragma unroll
                    for (int n = 0; n < 2; ++n) { const unsigned o = voff + (unsigned)(bj * HALF + n * 16) * 4u; const f32x4 xv = *(const f32x4*)(xb + o);
                        const f32x4 v = xv + acc[ai][bj][m][n] * rs1[ai][m] * *(const PG8_LAS f32x4*)(As + bj * HALF + n * 16);
                        *(f32x4*)(ob + o) = v;
                        const f32x4 a2 = *(const PG8_LAS f32x4*)(As + 256 + bj * HALF + n * 16), a3 = *(const PG8_LAS f32x4*)(As + 512 + bj * HALF + n * 16); const f32x4 h = v * rs2[ai][m] * a2 + a3;
                        u32x2 wv; wv.x = cvt_pk_bf16(h[0], h[1]); wv.y = cvt_pk_bf16(h[2], h[3]); *(u32x2*)(nb + (o >> 1)) = wv; }
                if (m == 3) asm volatile("" ::: "memory"); }
    }
};
struct EpiFinal {
    static constexpr bool PERM = false, AFTER_DRAIN = false, PERMA = false, HAS_PRE = false;
    const bf16_t* src; float* out; const float* mod; const float* post_g; RowStat st; int ld, tiles_per_batch;
    __device__ __forceinline__ void operator()(f32x4 (&acc)[2][2][4][2], const Unit& u, int wr, int wc, int fr, int fq) const {
        const int col0 = u.pn * BM + wc * 32 + 4 * fq; const float* mb = mod + (size_t)(u.pm / tiles_per_batch) * (6 * ld);
        const unsigned voff = (unsigned)((wr * 64 + fr) * ld + col0) * 4u, cvo = (unsigned)col0 * 4u; const size_t pbase = (size_t)u.pm * BM * ld;
        float part[2][4], rs[2][4];
#pragma unroll
        for (int ai = 0; ai < 2; ++ai)
#pragma unroll
            for (int m = 0; m < 4; ++m) { float s = 0.f;
#pragma unroll
                for (int bj = 0; bj < 2; ++bj)
#pragma unroll
                    for (int n = 0; n < 2; ++n) { const f32x4 v = acc[ai][bj][m][n]; s += (v[0] * v[0] + v[1] * v[1]) + (v[2] * v[2] + v[3] * v[3]); }
                part[ai][m] = s; }
        u32x2 xpre[2][4][2][2];
#pragma unroll
        for (int ai = 0; ai < 2; ++ai)
#pragma unroll
            for (int m = 0; m < 4; ++m) { const char* sb = (const char*)(src + pbase + (size_t)(ai * HALF + m * 16) * ld);
#pragma unroll
                for (int bj = 0; bj < 2; ++bj)
#pragma unroll
                    for (int n = 0; n < 2; ++n) xpre[ai][m][bj][n] = *(const u32x2*)(sb + ((voff + (unsigned)(bj * HALF + n * 16) * 4u) >> 1)); }
        st.run(part, rs, u, wr, fr, fq);
        f32x4 A1[2][2];
#pragma unroll
        for (int bj = 0; bj < 2; ++bj)
#pragma unroll
            for (int n = 0; n < 2; ++n) { const unsigned co = cvo + (unsigned)(bj * HALF + n * 16) * 4u; A1[bj][n] = *(const f32x4*)((const char*)(mb + 5 * ld) + co) * *(const f32x4*)((const char*)post_g + co); }
#pragma unroll
        for (int ai = 0; ai < 2; ++ai)
#pragma unroll
            for (int m = 0; m < 4; ++m) { char* ob = (char*)(out + pbase + (size_t)(ai * HALF + m * 16) * ld);
#pragma unroll
                for (int bj = 0; bj < 2; ++bj)
#pragma unroll
                    for (int n = 0; n < 2; ++n) { const unsigned o = voff + (unsigned)(bj * HALF + n * 16) * 4u; const u32x2 xw = xpre[ai][m][bj][n];
                        const f32x4 xv = {__builtin_bit_cast(float, xw.x << 16), __builtin_bit_cast(float, xw.x & 0xffff0000u), __builtin_bit_cast(float, xw.y << 16), __builtin_bit_cast(float, xw.y & 0xffff0000u)};
                        *(f32x4*)(ob + o) = xv + acc[ai][bj][m][n] * rs[ai][m] * A1[bj][n]; }
                if (m == 3) asm volatile("" ::: "memory"); }
    }
};

struct EpiSink {
    static constexpr bool PERM = false, AFTER_DRAIN = false, PERMA = false, HAS_PRE = false;
    float* O;
    __device__ __forceinline__ void operator()(f32x4 (&acc)[2][2][4][2], const Unit& u, int wr, int wc, int fr, int fq) const {
        f32x4 s = {0.f, 0.f, 0.f, 0.f};
#pragma unroll
        for (int ai = 0; ai < 2; ++ai)
#pragma unroll
            for (int bj = 0; bj < 2; ++bj)
#pragma unroll
                for (int m = 0; m < 4; ++m)
#pragma unroll
                    for (int n = 0; n < 2; ++n) s += acc[ai][bj][m][n];
        if (s[0] + s[1] + s[2] + s[3] == 1.2345e33f) O[u.pm * 256 + wr * 64 + fr + wc + fq] = s[0];
    }
};
template <class Epi, class Sched, bool ALIGN_EPI = false, bool SP2 = false>
__device__ __forceinline__ void gemm_phase(PG8_LAS unsigned char* lds, const Gemm g, const Sched& S, const Epi& E) {
    const int tid = threadIdx.x, wid = __builtin_amdgcn_readfirstlane(tid >> 6), lane = tid & 63, wr = wid >> 2, wc = wid & 3, fr = lane & 15, fq = lane >> 4;
    const int K = g.K, nt = K / BK;
    unsigned voffA[2], voffB[2];
#pragma unroll
    for (int i = 0; i < 2; ++i) { int R, C; stage_rc(tid * 16 + i * 8192, R, C); const int Rb = Epi::PERM ? ((R & ~31) + perm32(R & 31)) : R;
        const int Ra = Epi::PERMA ? ((R & ~63) + 4 * (R & 15) + ((R & 63) >> 4)) : R;
        voffA[i] = (unsigned)(Ra * K + C) * 2u; voffB[i] = (unsigned)(Rb * K + C) * 2u; }
    const size_t kstep = (size_t)(BK * 2);
    const size_t hstep = (size_t)HALF * K * 2;
    const size_t tstep = 2 * hstep;
    const unsigned ldsw = (unsigned)wid * 1024u;
    const int aoff = lds_byte(wr * 64 + fr, fq * 8), boff = lds_byte(wc * 32 + fr, fq * 8);
#define PG8_SA(b, h) (((b) * 2 + (h)) * HTB)
#define PG8_SB(b, h) ((4 + (b) * 2 + (h)) * HTB)
#define PG8_STAGE(bufoff, gbase, voff) do { _Pragma("unroll") for (int _i = 0; _i < 2; ++_i) \
        __builtin_amdgcn_global_load_lds((const unsigned*)((const char*)(gbase) + (voff)[_i]), (PG8_LAS unsigned*)(lds + (bufoff) + ldsw + _i * 8192), 16, 0, 0); } while (0)
#define PG8_LDA(dst, b, h) do { _Pragma("unroll") for (int m = 0; m < 4; ++m) _Pragma("unroll") for (int k = 0; k < 2; ++k) dst[m][k] = *(const PG8_LAS bf16x8*)(lds + PG8_SA(b, h) + aoff + m * 2048 + k * 1024); } while (0)
#define PG8_LDB(dst, b, h) do { _Pragma("unroll") for (int n = 0; n < 2; ++n) _Pragma("unroll") for (int k = 0; k < 2; ++k) dst[n][k] = *(const PG8_LAS bf16x8*)(lds + PG8_SB(b, h) + boff + n * 2048 + k * 1024); } while (0)
#define PG8_MMA(ai, bj, At, Bt) do { __builtin_amdgcn_s_setprio(1); _Pragma("unroll") for (int m = 0; m < 4; ++m) _Pragma("unroll") for (int n = 0; n < 2; ++n) _Pragma("unroll") for (int k = 0; k < 2; ++k) \
        acc[ai][bj][m][n] = __builtin_amdgcn_mfma_f32_16x16x32_bf16(Bt[n][k], At[m][k], acc[ai][bj][m][n], 0, 0, 0); __builtin_amdgcn_s_setprio(0); } while (0)
#define PG8_WAIT_V(n) asm volatile("s_waitcnt vmcnt(" #n ")" ::: "memory")
#define PG8_WAIT_L(n) asm volatile("s_waitcnt lgkmcnt(" #n ")" ::: "memory")
#define PG8_BAR __builtin_amdgcn_s_barrier()
#define PG8_SCHED __builtin_amdgcn_sched_barrier(0)
    Unit cur, nxt; int ui = 0;
    if (!S.next(0, cur)) return;
    f32x4 acc[2][2][4][2];
#pragma unroll
    for (int a = 0; a < 2; ++a)
#pragma unroll
        for (int b = 0; b < 2; ++b)
#pragma unroll
            for (int m = 0; m < 4; ++m)
#pragma unroll
                for (int n = 0; n < 2; ++n) acc[a][b][m][n] = (f32x4){0.f, 0.f, 0.f, 0.f};
    bf16x8 At[4][2], B0[2][2], B1[2][2];
    const char* cA = (const char*)g.A + (size_t)cur.pm * tstep; const char* cB = (const char*)g.Bt + (size_t)cur.pn * tstep;
    S.a_ready(cur);
    if constexpr (Epi::HAS_PRE) E.pre(cur, 0);
    if constexpr (SP2) {
        PG8_STAGE(PG8_SB(0, 0), cB, voffB); PG8_STAGE(PG8_SB(0, 1), cB + hstep, voffB); PG8_STAGE(PG8_SA(0, 0), cA, voffA); PG8_STAGE(PG8_SA(0, 1), cA + hstep, voffA);
        if (wr == 1) PG8_BAR;
        PG8_WAIT_V(2); PG8_BAR;
        PG8_STAGE(PG8_SB(1, 0), cB + kstep, voffB); PG8_STAGE(PG8_SA(1, 0), cA + kstep, voffA); PG8_STAGE(PG8_SB(1, 1), cB + hstep + kstep, voffB);
        PG8_WAIT_V(6); PG8_BAR;
    } else {
        PG8_STAGE(PG8_SB(0, 0), cB, voffB); PG8_STAGE(PG8_SA(0, 0), cA, voffA); PG8_STAGE(PG8_SB(0, 1), cB + hstep, voffB); PG8_STAGE(PG8_SA(0, 1), cA + hstep, voffA);
        if (wr == 1) PG8_BAR;
        PG8_WAIT_V(4); PG8_BAR;
        PG8_STAGE(PG8_SB(1, 0), cB + kstep, voffB); PG8_STAGE(PG8_SA(1, 0), cA + kstep, voffA); PG8_STAGE(PG8_SB(1, 1), cB + hstep + kstep, voffB);
        PG8_WAIT_V(6); PG8_BAR;
    }
    for (;;) {
        const bool has_next = S.next(ui + 1, nxt);
        const char* nA = has_next ? (const char*)g.A + (size_t)nxt.pm * tstep : cA; const char* nB = has_next ? (const char*)g.Bt + (size_t)nxt.pn * tstep : cB;
        for (int t = 0; t < nt; t += 2) {
            const bool last = (t == nt - 2);
            const char* a1 = cA + (size_t)(t + 1) * kstep;
            const char* a2 = last ? nA : cA + (size_t)(t + 2) * kstep; const char* b2 = last ? nB : cB + (size_t)(t + 2) * kstep;
            const char* a3 = a2 + kstep; const char* b3 = b2 + kstep;
            if (last && has_next) S.a_ready(nxt);
            if constexpr (SP2) {
            PG8_LDB(B0, 0, 0); PG8_LDB(B1, 0, 1); PG8_SCHED; PG8_LDA(At, 0, 0); PG8_STAGE(PG8_SA(1, 1), a1 + hstep, voffA);
            PG8_WAIT_V(8); PG8_WAIT_L(0); PG8_BAR; PG8_MMA(0, 0, At, B0); PG8_MMA(0, 1, At, B1); PG8_BAR; PG8_SCHED;
            PG8_LDA(At, 0, 1); PG8_STAGE(PG8_SB(0, 0), b2, voffB); PG8_STAGE(PG8_SB(0, 1), b2 + hstep, voffB); PG8_STAGE(PG8_SA(0, 0), a2, voffA);
            PG8_WAIT_V(8); PG8_WAIT_L(0); PG8_BAR; PG8_MMA(1, 0, At, B0); PG8_MMA(1, 1, At, B1); PG8_BAR; PG8_SCHED;
            PG8_LDB(B0, 1, 0); PG8_LDB(B1, 1, 1); PG8_SCHED; PG8_LDA(At, 1, 0); PG8_STAGE(PG8_SA(0, 1), a2 + hstep, voffA);
            PG8_WAIT_V(8); PG8_WAIT_L(0); PG8_BAR; PG8_MMA(0, 0, At, B0); PG8_MMA(0, 1, At, B1); PG8_BAR; PG8_SCHED;
            PG8_LDA(At, 1, 1); PG8_STAGE(PG8_SB(1, 0), b3, voffB); PG8_STAGE(PG8_SB(1, 1), b3 + hstep, voffB); PG8_STAGE(PG8_SA(1, 0), a3, voffA);
            PG8_WAIT_V(8); PG8_WAIT_L(0); PG8_BAR; PG8_MMA(1, 0, At, B0); PG8_MMA(1, 1, At, B1); PG8_BAR; PG8_SCHED;
            } else {
            PG8_LDB(B0, 0, 0); PG8_SCHED; PG8_LDA(At, 0, 0); PG8_STAGE(PG8_SA(1, 1), a1 + hstep, voffA);
            PG8_WAIT_L(8); PG8_BAR; PG8_WAIT_L(0); PG8_MMA(0, 0, At, B0); PG8_BAR; PG8_SCHED;
            PG8_LDB(B1, 0, 1); PG8_STAGE(PG8_SB(0, 0), b2, voffB);
            PG8_BAR; PG8_WAIT_L(0); PG8_MMA(0, 1, At, B1); PG8_BAR;
            PG8_LDA(At, 0, 1); PG8_STAGE(PG8_SA(0, 0), a2, voffA);
            PG8_BAR; PG8_WAIT_L(0); PG8_MMA(1, 0, At, B0); PG8_BAR; PG8_SCHED;
            PG8_STAGE(PG8_SB(0, 1), b2 + hstep, voffB);
            PG8_WAIT_V(6); PG8_BAR; PG8_MMA(1, 1, At, B1); PG8_BAR;
            PG8_LDB(B0, 1, 0); PG8_SCHED; PG8_LDA(At, 1, 0); PG8_STAGE(PG8_SA(0, 1), a2 + hstep, voffA);
            PG8_WAIT_L(8); PG8_BAR; PG8_WAIT_L(0); PG8_MMA(0, 0, At, B0); PG8_BAR; PG8_SCHED;
            PG8_LDB(B1, 1, 1); PG8_STAGE(PG8_SB(1, 0), b3, voffB);
            PG8_BAR; PG8_WAIT_L(0); PG8_MMA(0, 1, At, B1); PG8_BAR;
            PG8_LDA(At, 1, 1); PG8_STAGE(PG8_SA(1, 0), a3, voffA);
            PG8_BAR; PG8_WAIT_L(0); PG8_MMA(1, 0, At, B0); PG8_BAR; PG8_SCHED;
            PG8_STAGE(PG8_SB(1, 1), b3 + hstep, voffB);
            PG8_WAIT_V(6); PG8_BAR; PG8_MMA(1, 1, At, B1); PG8_BAR;
            }
        }
        if constexpr (ALIGN_EPI) { if (wr == 0) PG8_BAR; }
        if constexpr (Epi::HAS_PRE) { if (has_next) E.pre(nxt, (ui + 1) & 1); E.run(acc, cur, wr, wc, fr, fq, ui & 1); S.done(cur); }
        else if constexpr (!Epi::AFTER_DRAIN) { E(acc, cur, wr, wc, fr, fq); S.done(cur); }
        if (!has_next) break;
#pragma unroll
        for (int a = 0; a < 2; ++a)
#pragma unroll
            for (int b = 0; b < 2; ++b)
#pragma unroll
                for (int m = 0; m < 4; ++m)
#pragma unroll
                    for (int n = 0; n < 2; ++n) acc[a][b][m][n] = (f32x4){0.f, 0.f, 0.f, 0.f};
        cur = nxt; cA = nA; cB = nB; ++ui;
        if constexpr (ALIGN_EPI) { if (wr == 1) PG8_BAR; }
    }
    PG8_WAIT_V(0);
    if constexpr (!ALIGN_EPI) { if (wr == 0) PG8_BAR; }
    PG8_BAR;
    if constexpr (Epi::AFTER_DRAIN) { E.fused(acc, cur, wr, wc, fr, fq, lds, wid, lane); S.done(cur); }
#undef PG8_SA
#undef PG8_SB
#undef PG8_STAGE
#undef PG8_LDA
#undef PG8_LDB
#undef PG8_MMA
#undef PG8_WAIT_V
#undef PG8_WAIT_L
#undef PG8_BAR
#undef PG8_SCHED
}
}
constexpr int NWAVES = 8;
constexpr int BATCH = 4, SEQ = 8192, D = 1024, M = BATCH * SEQ;
constexpr int INW = 1536, AW = 512, FF = 2816, FF2 = 2 * FF, NMOD = 6 * D;
constexpr float EPS = 1e-6f;
constexpr size_t MiB = 1u << 20;
constexpr size_t WS_CTL = 0, CTL_ZERO_BYTES = 1 * MiB;
constexpr size_t OFF_MOD = 0, OFF_SS1 = 128 * 1024, OFF_SS2 = 256 * 1024, OFF_SS3 = 384 * 1024, OFF_BAR = 512 * 1024, OFF_CNT = 544 * 1024, OFF_SS4 = 896 * 1024;
constexpr size_t WS_WIN = 1 * MiB, WS_WOUT = 4 * MiB, WS_WUP = 6 * MiB, WS_WDOWN = 17 * MiB, WS_WSP = 23 * MiB, WS_WPOOL = WS_WSP + 256 * 1024;
constexpr size_t WS_SXX = 23 * MiB + 512 * 1024;
constexpr size_t WS_XN = 24 * MiB;
constexpr size_t WS_PROJ = 88 * MiB;
constexpr size_t WS_MIXIN = 184 * MiB;
constexpr size_t WS_MIXED = WS_PROJ;
constexpr size_t WS_ACT = 248 * MiB;
constexpr size_t WS_RAW = 424 * MiB;
constexpr size_t WS_X1B = 446 * MiB;
constexpr size_t WS_F = WS_ACT;
constexpr size_t WS_END = 510 * MiB;
static_assert(WS_XN + (size_t)M * D * 2 <= WS_PROJ && WS_PROJ + (size_t)M * INW * 2 <= WS_MIXIN && WS_MIXIN + (size_t)M * D * 2 <= WS_ACT && WS_ACT + (size_t)M * FF * 2 <= WS_RAW && WS_RAW + (size_t)(M / 64) * 4 * FF2 * 2 <= WS_X1B && WS_X1B + (size_t)M * D * 2 <= WS_END, "d_ws map");
static_assert(WS_WUP + (size_t)FF2 * D * 2 <= WS_WDOWN && WS_WDOWN + (size_t)D * FF * 2 <= WS_WSP && WS_WPOOL + 4 * 128 * 128 * 2 <= WS_XN, "d_ws weights");
constexpr int RING_BYTES = 131072, LDSCTL_OFF = RING_BYTES, LDS_BYTES = 147456;

#define GAS __attribute__((address_space(1)))
#define LAS __attribute__((address_space(3)))
typedef unsigned short bf16;
typedef unsigned v4u __attribute__((ext_vector_type(4)));
typedef unsigned v2u __attribute__((ext_vector_type(2)));
typedef float f32x4 __attribute__((ext_vector_type(4)));
typedef short bf16x8 __attribute__((ext_vector_type(8)));
#define LDS_WAIT() asm volatile("s_waitcnt lgkmcnt(0)" ::: "memory")
__device__ __forceinline__ unsigned f2bf(float f) { unsigned u = __builtin_bit_cast(unsigned, f); return (u + 0x7fffu + ((u >> 16) & 1u)) >> 16; }
__device__ __forceinline__ unsigned pk2(float lo, float hi) { unsigned r; asm("v_cvt_pk_bf16_f32 %0, %1, %2" : "=v"(r) : "v"(lo), "v"(hi)); return r; }
__device__ __forceinline__ float bf_lo(unsigned w) { return __builtin_bit_cast(float, w << 16); }
__device__ __forceinline__ float bf_hi(unsigned w) { return __builtin_bit_cast(float, w & 0xffff0000u); }
__device__ __forceinline__ float wave_sum(float v) {
#pragma unroll
    for (int o = 1; o < 64; o <<= 1) v += __shfl_xor(v, o);
    return v;
}
__device__ __forceinline__ float silu_acc(float x) { return x / (1.0f + __expf(-x)); }

struct Args { const float* in[19]; float* out; unsigned char* ws; int ph_lo, ph_hi; };
enum { I_X = 0, I_C, I_WADA, I_BADA, I_PREMIXG, I_POSTMIXG, I_WIN, I_SGUG, I_WSP, I_BSP, I_WPOOL, I_PSCALE, I_WOUT, I_PREFFNG, I_POSTFFNG, I_WUP, I_CONVW, I_CONVB, I_WDOWN };

__device__ __forceinline__ void transpose_item(const float* W, int K, int N, bf16* WT, int k0, int n0, int drow0, LAS float* scr, int lane) {
    { f32x4 v[8];
#pragma unroll
        for (int i = 0; i < 8; ++i) v[i] = __builtin_nontemporal_load((const f32x4*)(W + (size_t)(k0 + 8 * i + (lane >> 3)) * N + n0 + 4 * (lane & 7)));
#pragma unroll
        for (int i = 0; i < 8; ++i) { LAS float* d = scr + (8 * i + (lane >> 3)) * 33 + 4 * (lane & 7); d[0] = v[i].x; d[1] = v[i].y; d[2] = v[i].z; d[3] = v[i].w; } }
    LDS_WAIT(); asm volatile("" ::: "memory");
    const int c = lane & 7;
#pragma unroll
    for (int j = 0; j < 4; ++j) { const int n = (lane >> 3) + 8 * j; const LAS float* s = scr + (8 * c) * 33 + n;
        v4u o; o.x = pk2(s[0 * 33], s[1 * 33]); o.y = pk2(s[2 * 33], s[3 * 33]); o.z = pk2(s[4 * 33], s[5 * 33]); o.w = pk2(s[6 * 33], s[7 * 33]);
        *(v4u*)(WT + (size_t)(drow0 + n) * K + k0 + 8 * c) = o; }
    LDS_WAIT(); asm volatile("" ::: "memory");
}

__device__ __forceinline__ void p0_prologue(const Args& a, LAS unsigned char* lds, int gw, int NGW, int lane, int wave, bool with_mod, bool with_rest) {
    unsigned char* ws = a.ws;
    float* MOD = (float*)(ws + OFF_MOD);
    const float* c = a.in[I_C]; const float* wada = a.in[I_WADA]; const float* bada = a.in[I_BADA];
    for (int it = with_mod ? gw : 96 * 16; it < 96 * 16; it += NGW) { const int cb = it % 96, ks = it / 96, col = cb * 64 + lane; float a0 = 0.f, a1 = 0.f, a2 = 0.f, a3 = 0.f;
        const float sv0 = silu_acc(c[ks * 64 + lane]), sv1 = silu_acc(c[D + ks * 64 + lane]), sv2 = silu_acc(c[2 * D + ks * 64 + lane]), sv3 = silu_acc(c[3 * D + ks * 64 + lane]);
#pragma unroll 32
        for (int kk = 0; kk < 64; ++kk) { const float w = __builtin_nontemporal_load(wada + (size_t)(ks * 64 + kk) * NMOD + col);
            a0 += __builtin_bit_cast(float, __builtin_amdgcn_readlane(__builtin_bit_cast(int, sv0), kk)) * w; a1 += __builtin_bit_cast(float, __builtin_amdgcn_readlane(__builtin_bit_cast(int, sv1), kk)) * w;
            a2 += __builtin_bit_cast(float, __builtin_amdgcn_readlane(__builtin_bit_cast(int, sv2), kk)) * w; a3 += __builtin_bit_cast(float, __builtin_amdgcn_readlane(__builtin_bit_cast(int, sv3), kk)) * w; }
        if (ks == 0) { const float b = bada[col]; a0 += b; a1 += b; a2 += b; a3 += b; }
        atomicAdd(MOD + col, a0); atomicAdd(MOD + NMOD + col, a1); atomicAdd(MOD + 2 * NMOD + col, a2); atomicAdd(MOD + 3 * NMOD + col, a3); }
    if (!with_rest) return;
    LAS float* scr = (LAS float*)(lds + wave * 16384);
    constexpr int I_IN = (D / 64) * (INW / 32), I_OUT = (D / 64) * (D / 32), I_UP = (D / 64) * (FF2 / 32), I_DOWN = (FF / 64) * (D / 32), I_POOL = 4 * 2 * 4;
    constexpr int NITEMS = I_IN + I_OUT + I_UP + I_DOWN + I_POOL;
    for (int it = gw; it < NITEMS; it += NGW) { int r = it;
        if (r < I_IN) { const int nb = INW / 32, kb = r / nb, n0 = 32 * (r % nb); transpose_item(a.in[I_WIN], D, INW, (bf16*)(ws + WS_WIN), 64 * kb, n0, n0, scr, lane); continue; } r -= I_IN;
        if (r < I_OUT) { const int nb = D / 32, kb = r / nb, n0 = 32 * (r % nb); transpose_item(a.in[I_WOUT], D, D, (bf16*)(ws + WS_WOUT), 64 * kb, n0, n0, scr, lane); continue; } r -= I_OUT;
        if (r < I_UP) { const int nb = FF2 / 32, kb = r / nb, n0 = 32 * (r % nb); const int half = n0 / FF, f = n0 % FF, drow = 256 * (f / 128) + 128 * half + (f % 128);
            transpose_item(a.in[I_WUP], D, FF2, (bf16*)(ws + WS_WUP), 64 * kb, n0, drow, scr, lane); continue; } r -= I_UP;
        if (r < I_DOWN) { const int nb = D / 32, kb = r / nb, n0 = 32 * (r % nb); transpose_item(a.in[I_WDOWN], FF, D, (bf16*)(ws + WS_WDOWN), 64 * kb, n0, n0, scr, lane); continue; } r -= I_DOWN;
        { const int g = r / 8, q = r % 8, kb = q / 4, n0 = 32 * (q % 4); transpose_item(a.in[I_WPOOL] + (size_t)g * 16384, 128, 128, (bf16*)(ws + WS_WPOOL) + (size_t)g * 16384, 64 * kb, n0, n0, scr, lane); } }
    { const float* wsp = a.in[I_WSP]; bf16* o = (bf16*)(ws + WS_WSP);
        for (int e = gw * 64 + lane; e < 4 * 128 * 128; e += NGW * 64) { const int i = (e >> 7) & 127, j = e & 127; const float v = ((j >> 6) <= (i >> 6)) ? wsp[e] : 0.f; o[e] = (bf16)f2bf(v); } }
}

__device__ __forceinline__ void p1_norm(const Args& a, int gw, int NGW, int lane) {
    const float* MOD = (const float*)(a.ws + OFF_MOD); bf16* XN = (bf16*)(a.ws + WS_XN); const float* x = a.in[I_X]; const float* g = a.in[I_PREMIXG]; float* SXX = (float*)(a.ws + WS_SXX);
    const int rpw = M / NGW;
    for (int r0 = gw * rpw; r0 < M; r0 += NGW * rpw) { const int b = r0 / SEQ; const float* mb = MOD + (size_t)b * NMOD;
        f32x4 A[4], B[4];
#pragma unroll
        for (int j = 0; j < 4; ++j) { const int col = 4 * lane + 256 * j; const f32x4 gg = *(const f32x4*)(g + col), sc = *(const f32x4*)(mb + D + col); A[j] = gg * (1.0f + sc); B[j] = *(const f32x4*)(mb + col); }
        f32x4 nx[4];
        { const f32x4* xr = (const f32x4*)(x + (size_t)r0 * D) + lane;
#pragma unroll
            for (int j = 0; j < 4; ++j) nx[j] = __builtin_nontemporal_load(xr + 64 * j); }
        for (int r = r0; r < r0 + rpw; ++r) { f32x4 v[4]; float s = 0.f;
#pragma unroll
            for (int j = 0; j < 4; ++j) { v[j] = nx[j]; s += (v[j].x * v[j].x + v[j].y * v[j].y) + (v[j].z * v[j].z + v[j].w * v[j].w); }
            if (r + 1 < r0 + rpw) { const f32x4* xr = (const f32x4*)(x + (size_t)(r + 1) * D) + lane;
#pragma unroll
                for (int j = 0; j < 4; ++j) nx[j] = __builtin_nontemporal_load(xr + 64 * j); }
            const float st = wave_sum(s);
            const float rs = 1.0f / sqrtf(st * (1.0f / D) + EPS);
            v2u* o = (v2u*)(XN + (size_t)r * D) + lane;
#pragma unroll
            for (int j = 0; j < 4; ++j) { const f32x4 h = v[j] * rs * A[j] + B[j]; const unsigned long long w = (unsigned long long)pk2(h.x, h.y) | ((unsigned long long)pk2(h.z, h.w) << 32);
                __hip_atomic_store((unsigned long long*)(o + 64 * j), w, __ATOMIC_RELAXED, __HIP_MEMORY_SCOPE_AGENT); } } }
}

constexpr int P3_RA = 0, P3_RB = 34816, P3_RP = 69632, P3_RC = 108800, P3_PA = 272, P3_PV = 272;
__device__ __forceinline__ void p3_mma(LAS unsigned char* lds, bool natural_b, f32x4 (&acc)[4][2], int wr, int wc, int fr, int fq) {
#pragma unroll
    for (int m = 0; m < 4; ++m)
#pragma unroll
        for (int n = 0; n < 2; ++n) acc[m][n] = (f32x4){0.f, 0.f, 0.f, 0.f};
#pragma unroll
    for (int kk = 0; kk < 4; ++kk) { bf16x8 af[4], bfr[2];
#pragma unroll
        for (int m = 0; m < 4; ++m) af[m] = *(const LAS bf16x8*)(lds + P3_RA + (64 * wr + 16 * m + fr) * P3_PA + (32 * kk + 8 * fq) * 2);
        if (natural_b) {
            { const unsigned addr = (unsigned)(size_t)(lds + P3_RB) + (unsigned)((32 * kk + 8 * fq + (fr >> 2)) * P3_PV + (32 * wc + 4 * (fr & 3)) * 2);
                v2u l0, h0, l1, h1;
                asm volatile("ds_read_b64_tr_b16 %0, %4\n\tds_read_b64_tr_b16 %1, %4 offset:%5\n\tds_read_b64_tr_b16 %2, %4 offset:32\n\tds_read_b64_tr_b16 %3, %4 offset:%6\n\ts_waitcnt lgkmcnt(0)"
                             : "=&v"(l0), "=&v"(h0), "=&v"(l1), "=&v"(h1) : "v"(addr), "n"(4 * P3_PV), "n"(4 * P3_PV + 32) : "memory");
                v4u w0, w1; w0.x = l0.x; w0.y = l0.y; w0.z = h0.x; w0.w = h0.y; w1.x = l1.x; w1.y = l1.y; w1.z = h1.x; w1.w = h1.y;
                bfr[0] = __builtin_bit_cast(bf16x8, w0); bfr[1] = __builtin_bit_cast(bf16x8, w1); }
        } else {
#pragma unroll
            for (int n = 0; n < 2; ++n) bfr[n] = *(const LAS bf16x8*)(lds + P3_RB + (32 * wc + 16 * n + fr) * P3_PA + (32 * kk + 8 * fq) * 2);
        }
#pragma unroll
        for (int m = 0; m < 4; ++m)
#pragma unroll
            for (int n = 0; n < 2; ++n) acc[m][n] = __builtin_amdgcn_mfma_f32_16x16x32_bf16(bfr[n], af[m], acc[m][n], 0, 0, 0); }
}
template <int W> __device__ __forceinline__ void p3_pool(LAS unsigned char* lds, int tid, int s0) {
    const int ch = tid & 15, tq = 4 * (tid >> 4); const LAS unsigned char* rp = lds + P3_RP + ch * 16; float sum[8];
#pragma unroll
    for (int e = 0; e < 8; ++e) sum[e] = 0.f;
#pragma unroll 3
    for (int k = 1; k < W; ++k) { const v4u r = *(const LAS v4u*)(rp + (16 + tq - k) * P3_PA);
        sum[0] += bf_lo(r.x); sum[1] += bf_hi(r.x); sum[2] += bf_lo(r.y); sum[3] += bf_hi(r.y); sum[4] += bf_lo(r.z); sum[5] += bf_hi(r.z); sum[6] += bf_lo(r.w); sum[7] += bf_hi(r.w); }
#pragma unroll
    for (int rr = 0; rr < 4; ++rr) { const int t = tq + rr; const v4u cur = *(const LAS v4u*)(rp + (16 + t) * P3_PA);
        sum[0] += bf_lo(cur.x); sum[1] += bf_hi(cur.x); sum[2] += bf_lo(cur.y); sum[3] += bf_hi(cur.y); sum[4] += bf_lo(cur.z); sum[5] += bf_hi(cur.z); sum[6] += bf_lo(cur.w); sum[7] += bf_hi(cur.w);
        const int cnt = (s0 + t + 1) < W ? (s0 + t + 1) : W; const float inv = 1.0f / (float)cnt;
        v4u o; o.x = pk2(sum[0] * inv - bf_lo(cur.x), sum[1] * inv - bf_hi(cur.x)); o.y = pk2(sum[2] * inv - bf_lo(cur.y), sum[3] * inv - bf_hi(cur.y));
        o.z = pk2(sum[4] * inv - bf_lo(cur.z), sum[5] * inv - bf_hi(cur.z)); o.w = pk2(sum[6] * inv - bf_lo(cur.w), sum[7] * inv - bf_hi(cur.w));
        *(LAS v4u*)(lds + P3_RA + t * P3_PA + ch * 16) = o;
        if (rr < 3) { const v4u old = *(const LAS v4u*)(rp + (16 + t - (W - 1)) * P3_PA);
            sum[0] -= bf_lo(old.x); sum[1] -= bf_hi(old.x); sum[2] -= bf_lo(old.y); sum[3] -= bf_hi(old.y); sum[4] -= bf_lo(old.z); sum[5] -= bf_hi(old.z); sum[6] -= bf_lo(old.w); sum[7] -= bf_hi(old.w); } }
}
struct P3Regs { v4u a0, a1, a2, a3, b0, b1, b2, b3, b4; };
#define P3_RA_(R, it) ((it) == 0 ? (R).a0 : (it) == 1 ? (R).a1 : (it) == 2 ? (R).a2 : (R).a3)
#define P3_RB_(R, it) ((it) == 0 ? (R).b0 : (it) == 1 ? (R).b1 : (it) == 2 ? (R).b2 : (it) == 3 ? (R).b3 : (R).b4)
__device__ __forceinline__ void p3_prefetch(P3Regs& R, int item, int t0, int s0, int tid, const bf16* PROJ, const bf16* WSP, const bf16* WPOOL, bool xhalo = false) {
    if (item < 4) { const int h = item;
#pragma unroll
        for (int it = 0; it < 4; ++it) { const int idx = tid + 512 * it, row = idx >> 4, ch = idx & 15;
            const v4u va = *(const v4u*)(WSP + (size_t)h * 16384 + row * 128 + ch * 8), vb = __builtin_nontemporal_load((const v4u*)(PROJ + (size_t)(t0 + row) * INW + AW + 128 * h + 8 * ch));
            if (it == 0) { R.a0 = va; R.b0 = vb; } else if (it == 1) { R.a1 = va; R.b1 = vb; } else if (it == 2) { R.a2 = va; R.b2 = vb; } else { R.a3 = va; R.b3 = vb; } }
    } else { const int g = item - 4;
#pragma unroll
        for (int it = 0; it < 4; ++it) { const int idx = tid + 512 * it, row = idx >> 4, ch = idx & 15; const v4u va = *(const v4u*)(WPOOL + (size_t)g * 16384 + row * 128 + ch * 8);
            if (it == 0) R.a0 = va; else if (it == 1) R.a1 = va; else if (it == 2) R.a2 = va; else R.a3 = va; }
#pragma unroll
        for (int it = 0; it < 5; ++it) { const int idx = tid + 512 * it, row = idx >> 4, ch = idx & 15; v4u raw = {0u, 0u, 0u, 0u};
            if (row < 144 && s0 + row >= 16) { const bf16* src = PROJ + (size_t)(t0 + row - 16) * INW + 2 * AW + 128 * g + 8 * ch;
                if (xhalo && row < 16) { const unsigned long long w0 = __hip_atomic_load((const unsigned long long*)src, __ATOMIC_RELAXED, __HIP_MEMORY_SCOPE_AGENT), w1 = __hip_atomic_load((const unsigned long long*)src + 1, __ATOMIC_RELAXED, __HIP_MEMORY_SCOPE_AGENT);
                    raw.x = (unsigned)w0; raw.y = (unsigned)(w0 >> 32); raw.z = (unsigned)w1; raw.w = (unsigned)(w1 >> 32); }
                else raw = __builtin_nontemporal_load((const v4u*)src); }
            if (it == 0) R.b0 = raw; else if (it == 1) R.b1 = raw; else if (it == 2) R.b2 = raw; else if (it == 3) R.b3 = raw; else R.b4 = raw; } }
}
__device__ __forceinline__ void p3_item(P3Regs& R, const int item, const int t0, const int s0, const int tid0, LAS unsigned char* lds, const LAS float* RC, const bf16* PROJ, bf16* MIXIN, const bf16* WSP, const bf16* WPOOL,
                                        const int wr, const int wc, const int fr, const int fq, const bool xhalo) {
    f32x4 acc[4][2];
            int tl = tid0; asm volatile("" : "+v"(tl));
            const int tid = tl;
            if (item < 4) { const int h = item;
#pragma unroll
                for (int it = 0; it < 4; ++it) { const int idx = tid + 512 * it, row = idx >> 4, ch = idx & 15;
                    *(LAS v4u*)(lds + P3_RA + row * P3_PA + ch * 16) = P3_RA_(R, it);
                    const v4u raw = P3_RB_(R, it);
                    float v[8]; v[0] = bf_lo(raw.x); v[1] = bf_hi(raw.x); v[2] = bf_lo(raw.y); v[3] = bf_hi(raw.y); v[4] = bf_lo(raw.z); v[5] = bf_hi(raw.z); v[6] = bf_lo(raw.w); v[7] = bf_hi(raw.w);
                    float s = 0.f;
#pragma unroll
                    for (int e = 0; e < 8; ++e) s += v[e] * v[e];
                    s += __shfl_xor(s, 1); s += __shfl_xor(s, 2); s += __shfl_xor(s, 4); s += __shfl_xor(s, 8);
                    const float rs = __builtin_amdgcn_rsqf(s * (1.0f / 128.0f) + EPS);
                    const f32x4 g0 = *(const LAS f32x4*)(RC + 128 * h + 8 * ch), g1 = *(const LAS f32x4*)(RC + 128 * h + 8 * ch + 4);
                    v2u w0, w1; w0.x = pk2(v[0] * rs * g0.x, v[1] * rs * g0.y); w0.y = pk2(v[2] * rs * g0.z, v[3] * rs * g0.w); w1.x = pk2(v[4] * rs * g1.x, v[5] * rs * g1.y); w1.y = pk2(v[6] * rs * g1.z, v[7] * rs * g1.w);
                    v4u w01; w01.x = w0.x; w01.y = w0.y; w01.z = w1.x; w01.w = w1.y; *(LAS v4u*)(lds + P3_RB + row * P3_PV + ch * 16) = w01; }
                __syncthreads();
                if (item + 2 < 8) p3_prefetch(R, item + 2, t0, s0, tid, PROJ, WSP, WPOOL, xhalo);
                v2u ur[4][2]; float bias[4];
#pragma unroll
                for (int m = 0; m < 4; ++m) { const int i = 64 * wr + 16 * m + fr; bias[m] = RC[512 + 128 * h + i];
#pragma unroll
                    for (int n = 0; n < 2; ++n) ur[m][n] = *(const v2u*)(PROJ + (size_t)(t0 + i) * INW + 128 * h + 32 * wc + 16 * n + 4 * fq); }
                p3_mma(lds, true, acc, wr, wc, fr, fq);
#pragma unroll
                for (int m = 0; m < 4; ++m) { const int i = 64 * wr + 16 * m + fr;
#pragma unroll
                    for (int n = 0; n < 2; ++n) { const int c = 128 * h + 32 * wc + 16 * n + 4 * fq; const v2u u2 = ur[m][n]; const float bi = bias[m];
                        const f32x4 z = acc[m][n]; v2u w; w.x = pk2(bf_lo(u2.x) * (z[0] + bi), bf_hi(u2.x) * (z[1] + bi)); w.y = pk2(bf_lo(u2.y) * (z[2] + bi), bf_hi(u2.y) * (z[3] + bi));
                        *(v2u*)(MIXIN + (size_t)(t0 + i) * D + c) = w; } }
                __syncthreads();
            } else { const int g = item - 4, w = 2 << g;
#pragma unroll
                for (int it = 0; it < 4; ++it) { const int idx = tid + 512 * it, row = idx >> 4, ch = idx & 15; *(LAS v4u*)(lds + P3_RB + row * P3_PA + ch * 16) = P3_RA_(R, it); }
#pragma unroll
                for (int it = 0; it < 5; ++it) { const int idx = tid + 512 * it, row = idx >> 4, ch = idx & 15; if (row < 144) *(LAS v4u*)(lds + P3_RP + row * P3_PA + ch * 16) = P3_RB_(R, it); }
                __syncthreads();
                if (item + 2 < 8) p3_prefetch(R, item + 2, t0, s0, tid, PROJ, WSP, WPOOL, xhalo);
                switch (g) { case 0: p3_pool<2>(lds, tid, s0); break; case 1: p3_pool<4>(lds, tid, s0); break; case 2: p3_pool<8>(lds, tid, s0); break; default: p3_pool<16>(lds, tid, s0); break; }
                __syncthreads();
                p3_mma(lds, false, acc, wr, wc, fr, fq);
#pragma unroll
                for (int m = 0; m < 4; ++m) { const int t = 64 * wr + 16 * m + fr;
#pragma unroll
                    for (int n = 0; n < 2; ++n) { const int d = 128 * g + 32 * wc + 16 * n + 4 * fq; const f32x4 ps = *(const LAS f32x4*)(RC + 1024 + d); const f32x4 y = acc[m][n] * ps;
                        v2u wv; wv.x = pk2(y[0], y[1]); wv.y = pk2(y[2], y[3]); *(v2u*)(MIXIN + (size_t)(t0 + t) * D + AW + d) = wv; } }
                __syncthreads();
            }
}
__device__ __forceinline__ void p3_mixers(const Args& a, LAS unsigned char* lds, int tid0, int rb, unsigned* xwait, unsigned xgen) {
    const int lane = tid0 & 63, wave = tid0 >> 6, wr = wave >> 2, wc = wave & 3, fr = lane & 15, fq = lane >> 4;
    const bf16* PROJ = (const bf16*)(a.ws + WS_PROJ); bf16* MIXIN = (bf16*)(a.ws + WS_MIXIN);
    const bf16* WSP = (const bf16*)(a.ws + WS_WSP); const bf16* WPOOL = (const bf16*)(a.ws + WS_WPOOL);
    const float* sgug = a.in[I_SGUG]; const float* bsp = a.in[I_BSP]; const float* pscale = a.in[I_PSCALE];
    { LAS float* rc = (LAS float*)(lds + P3_RC); rc[tid0] = sgug[tid0]; rc[512 + tid0] = bsp[tid0]; rc[1024 + tid0] = pscale[tid0]; }
    __syncthreads();
    const LAS float* RC = (const LAS float*)(lds + P3_RC);
    for (int tb = rb; tb < M / 128; tb += gridDim.x) { const int t0 = tb * 128, s0 = t0 % SEQ;
        const bool xhalo = xwait != nullptr && (tb & 31) == 0 && s0 != 0;
        if (xhalo) { unsigned sp = 0; while ((unsigned)__builtin_amdgcn_readfirstlane(__hip_atomic_load(xwait, __ATOMIC_RELAXED, __HIP_MEMORY_SCOPE_AGENT)) < xgen) { __builtin_amdgcn_s_sleep(2); if (++sp > (1u << 22)) break; } }
        P3Regs R;
        p3_prefetch(R, 0, t0, s0, tid0, PROJ, WSP, WPOOL);
        P3Regs Rb;
        p3_prefetch(Rb, 1, t0, s0, tid0, PROJ, WSP, WPOOL);
        for (int it2 = 0; it2 < 4; ++it2) {
            p3_item(R, 2 * it2, t0, s0, tid0, lds, RC, PROJ, MIXIN, WSP, WPOOL, wr, wc, fr, fq, xhalo);
            p3_item(Rb, 2 * it2 + 1, t0, s0, tid0, lds, RC, PROJ, MIXIN, WSP, WPOOL, wr, wc, fr, fq, xhalo); } }
}

__device__ __forceinline__ void p4b_mid(const Args& a, int gw, int NGW, int lane) {
    const float* MOD = (const float*)(a.ws + OFF_MOD); const float* SS1 = (const float*)(a.ws + OFF_SS1); const bf16* MIXED = (const bf16*)(a.ws + WS_MIXED); bf16* XN = (bf16*)(a.ws + WS_XN);
    const float* x = a.in[I_X]; const float* pg = a.in[I_POSTMIXG]; const float* fg = a.in[I_PREFFNG]; bf16* X1B = (bf16*)(a.ws + WS_X1B);
    const int rpw = M / NGW;
    for (int r0 = gw * rpw; r0 < M; r0 += NGW * rpw) { const int b = r0 / SEQ; const float* mb = MOD + (size_t)b * NMOD;
        f32x4 A1[4], A2[4], A3[4];
#pragma unroll
        for (int j = 0; j < 4; ++j) { const int col = 4 * lane + 256 * j; A1[j] = *(const f32x4*)(mb + 2 * D + col) * *(const f32x4*)(pg + col);
            A2[j] = *(const f32x4*)(fg + col) * (1.0f + *(const f32x4*)(mb + 4 * D + col)); A3[j] = *(const f32x4*)(mb + 3 * D + col); }
        f32x4 nx[4]; v2u nm[4];
        { const f32x4* xr = (const f32x4*)(x + (size_t)r0 * D) + lane; const v2u* mr = (const v2u*)(MIXED + (size_t)r0 * INW) + lane;
#pragma unroll
            for (int j = 0; j < 4; ++j) { nx[j] = __builtin_nontemporal_load(xr + 64 * j); nm[j] = __builtin_nontemporal_load(mr + 64 * j); } }
        const float ssv = (lane < rpw) ? SS1[r0 + lane] : 0.f;
        for (int r = r0; r < r0 + rpw; ++r) {
            const float rs1 = __builtin_amdgcn_rsqf(__builtin_bit_cast(float, __builtin_amdgcn_readlane(__builtin_bit_cast(int, ssv), r - r0)) * (1.0f / D) + EPS); f32x4 v[4]; float s = 0.f;
#pragma unroll
            for (int j = 0; j < 4; ++j) { const v2u mw = nm[j]; const f32x4 mx = {bf_lo(mw.x), bf_hi(mw.x), bf_lo(mw.y), bf_hi(mw.y)};
                v[j] = nx[j] + mx * rs1 * A1[j]; s += (v[j].x * v[j].x + v[j].y * v[j].y) + (v[j].z * v[j].z + v[j].w * v[j].w); }
            if (r + 1 < r0 + rpw) { const f32x4* xr = (const f32x4*)(x + (size_t)(r + 1) * D) + lane; const v2u* mr = (const v2u*)(MIXED + (size_t)(r + 1) * INW) + lane;
#pragma unroll
                for (int j = 0; j < 4; ++j) { nx[j] = __builtin_nontemporal_load(xr + 64 * j); nm[j] = __builtin_nontemporal_load(mr + 64 * j); } }
            v2u* xrow = (v2u*)(X1B + (size_t)r * D) + lane;
#pragma unroll
            for (int j = 0; j < 4; ++j) { v2u w; w.x = pk2(v[j].x, v[j].y); w.y = pk2(v[j].z, v[j].w); __builtin_nontemporal_store(w, xrow + 64 * j); }
            const float rs = __builtin_amdgcn_rsqf(wave_sum(s) * (1.0f / D) + EPS);
            v2u* o = (v2u*)(XN + (size_t)r * D) + lane;
#pragma unroll
            for (int j = 0; j < 4; ++j) { const f32x4 h = v[j] * rs * A2[j] + A3[j]; const unsigned long long w = (unsigned long long)pk2(h.x, h.y) | ((unsigned long long)pk2(h.z, h.w) << 32);
                __hip_atomic_store((unsigned long long*)(o + 64 * j), w, __ATOMIC_RELAXED, __HIP_MEMORY_SCOPE_AGENT); } } }
}

__device__ __forceinline__ void p6b_fixup(const Args& a, int gw, int NGW, int lane) {
    const bf16* RAW = (const bf16*)(a.ws + WS_RAW); bf16* ACT = (bf16*)(a.ws + WS_ACT); const float* cw = a.in[I_CONVW]; const float* cb = a.in[I_CONVB];
    for (int it = 2 * gw; it < 2 * gw + 2; ++it) { const int q = it & 3, rr = (it >> 2) & 1, B = it >> 3; const int t = 64 * B + rr, s = t % SEQ;
        const bf16* cur = RAW + (size_t)(B * 4 + rr) * FF2;
        const bf16* p1 = (rr == 1) ? RAW + (size_t)(B * 4 + 0) * FF2 : (s == 0 ? nullptr : RAW + (size_t)((B - 1) * 4 + 3) * FF2);
        const bf16* p2 = (rr == 1) ? (s == 1 ? nullptr : RAW + (size_t)((B - 1) * 4 + 3) * FF2) : (s == 0 ? nullptr : RAW + (size_t)((B - 1) * 4 + 2) * FF2);
        for (int f = q * 704 + 4 * lane; f < q * 704 + 704; f += 256) { f32x4 y[2];
#pragma unroll
            for (int hv = 0; hv < 2; ++hv) { const int col = hv * FF + f; const f32x4 z = {0.f, 0.f, 0.f, 0.f};
                const v2u zz = {0u, 0u}; const v2u r0 = *(const v2u*)(cur + col), r1 = p1 ? *(const v2u*)(p1 + col) : zz, r2 = p2 ? *(const v2u*)(p2 + col) : zz; (void)z;
                const f32x4 u0 = {bf_lo(r0.x), bf_hi(r0.x), bf_lo(r0.y), bf_hi(r0.y)}, u1 = {bf_lo(r1.x), bf_hi(r1.x), bf_lo(r1.y), bf_hi(r1.y)}, u2 = {bf_lo(r2.x), bf_hi(r2.x), bf_lo(r2.y), bf_hi(r2.y)};
                y[hv] = *(const f32x4*)(cb + col) + *(const f32x4*)(cw + col) * u2 + *(const f32x4*)(cw + FF2 + col) * u1 + *(const f32x4*)(cw + 2 * FF2 + col) * u0; }
            v2u w; w.x = pk2(pg8::silu_f(y[0][0]) * y[1][0], pg8::silu_f(y[0][1]) * y[1][1]); w.y = pk2(pg8::silu_f(y[0][2]) * y[1][2], pg8::silu_f(y[0][3]) * y[1][3]);
            *(v2u*)(ACT + (size_t)t * FF + f) = w; } }
}

#define XB_TMO      128
#define XB_XCNT(j)  (256  + 64 * (j))
#define XB_XSUB(j)  (1280 + 64 * (j))
#define XB_XGEN(j)  (2304 + 64 * (j))
#define XB_TOP      3328
#define XB_TOPGEN   3392
#define XCD_BAR_WORDS 3456
#define XB_SPIN_CAP (1u << 18)

__device__ __forceinline__ unsigned xb_ld(unsigned* p)              { return __hip_atomic_load(p, __ATOMIC_RELAXED, __HIP_MEMORY_SCOPE_AGENT); }
__device__ __forceinline__ unsigned xb_add(unsigned* p, unsigned v) { return __hip_atomic_fetch_add(p, v, __ATOMIC_RELAXED, __HIP_MEMORY_SCOPE_AGENT); }
__device__ __forceinline__ unsigned xb_xcc_id() { return (unsigned)__builtin_amdgcn_s_getreg((3 << 11) | 20) & 0xFu; }
#define XB_SPIN(cond, bar) do { unsigned _sp = 0; while (cond) { __builtin_amdgcn_s_sleep(1); \
    if ((++_sp & 255u) == 0u) { if (xb_ld(&(bar)[XB_TMO])) break; if (_sp > XB_SPIN_CAP) { atomicAdd(&(bar)[XB_TMO], 1u); break; } } } } while (0)

struct XcdBarrier {
    unsigned* bar; unsigned x;
    volatile LAS unsigned* st;
};

__device__ __forceinline__ XcdBarrier xcd_barrier_post(unsigned* bar, volatile LAS unsigned* st) {
    XcdBarrier b; b.bar = bar; b.x = xb_xcc_id(); b.st = st;
    if (threadIdx.x == 0) st[2] = xb_add(&bar[XB_XCNT(b.x)], 1u);
    return b;
}
__device__ __forceinline__ void xcd_barrier_complete(unsigned* bar, unsigned x, unsigned& nloc, unsigned& nx) {
    const unsigned G = gridDim.x * gridDim.y * gridDim.z;
    unsigned sum, cnt, mine, sp = 0u;
    for (;;) {
        sum = 0u; cnt = 0u; mine = 0u;
#pragma unroll
        for (unsigned j = 0; j < 16; ++j) { const unsigned c = xb_ld(&bar[XB_XCNT(j)]); sum += c; cnt += (c > 0u) ? 1u : 0u; mine = (j == x) ? c : mine; }
        if (sum == G) break;
        __builtin_amdgcn_s_sleep(1);
        if ((++sp & 255u) == 0u) { if (xb_ld(&bar[XB_TMO])) break; if (sp > XB_SPIN_CAP) { atomicAdd(&bar[XB_TMO], 1u); break; } }
    }
    nloc = mine > 0u ? mine : 1u; nx = cnt > 0u ? cnt : 1u;
}

__device__ __forceinline__ void xcd_barrier(const XcdBarrier& b) {
    asm volatile("s_waitcnt vmcnt(0)" ::: "memory");
    __syncthreads();
    if (threadIdx.x == 0) {
        unsigned* bar = b.bar;
        __builtin_amdgcn_s_waitcnt(0);
        unsigned nloc = b.st[0], nx = b.st[1];
        if (nloc == 0u) { xcd_barrier_complete(bar, b.x, nloc, nx); b.st[0] = nloc; b.st[1] = nx; }
        const unsigned old = xb_add(&bar[XB_XSUB(b.x)], 1u);
        const unsigned gen = old / nloc;
        if (old + 1u == (gen + 1u) * nloc) {
            __builtin_amdgcn_fence(__ATOMIC_RELEASE, "agent");
            asm volatile("s_waitcnt vmcnt(0)" ::: "memory");
            const unsigned og = xb_add(&bar[XB_TOP], 1u);
            const unsigned tg = og / nx;
            if (og + 1u == (tg + 1u) * nx) xb_add(&bar[XB_TOPGEN], 1u);
            else XB_SPIN(xb_ld(&bar[XB_TOPGEN]) == tg, bar);
            __builtin_amdgcn_fence(__ATOMIC_ACQUIRE, "agent");
            xb_add(&bar[XB_XGEN(b.x)], 1u);
            asm volatile("s_waitcnt vmcnt(0)" ::: "memory");
        } else {
            XB_SPIN(xb_ld(&bar[XB_XGEN(b.x)]) == gen, bar);
            __builtin_amdgcn_fence(__ATOMIC_ACQUIRE, "agent");
            asm volatile("s_waitcnt vmcnt(0)" ::: "memory");
        }
    }
    __syncthreads();
}
#define XL_SUB(j)  (4096 + 64 * (j))
#define XL_GEN(j)  (5120 + 64 * (j))
__device__ __forceinline__ void xcd_local_barrier(const XcdBarrier& b) {
    asm volatile("s_waitcnt vmcnt(0)" ::: "memory");
    __syncthreads();
    if (threadIdx.x == 0) { unsigned* bar = b.bar; const unsigned nloc = b.st[0];
        const unsigned old = xb_add(&bar[XL_SUB(b.x)], 1u); const unsigned gen = old / nloc;
        if (old + 1u == (gen + 1u) * nloc) xb_add(&bar[XL_GEN(b.x)], 1u);
        else XB_SPIN(xb_ld(&bar[XL_GEN(b.x)]) == gen, bar);
        __builtin_amdgcn_fence(__ATOMIC_ACQUIRE, "agent");
        asm volatile("s_waitcnt vmcnt(0)" ::: "memory"); }
    __syncthreads();
}
__global__ void __launch_bounds__(NWAVES * 64, 2) mk_fwd(Args args) {
    extern __shared__ __attribute__((aligned(16))) unsigned char lds_raw[];
    LAS unsigned char* lds = (LAS unsigned char*)lds_raw;
    const int tid = threadIdx.x, lane = tid & 63, wave = __builtin_amdgcn_readfirstlane(tid >> 6);
    const int G = gridDim.x, gw = blockIdx.x * NWAVES + wave, NGW = G * NWAVES;
    const int lo = args.ph_lo, hi = args.ph_hi;
    unsigned char* ws = args.ws;
    if (tid < 64) ((LAS unsigned*)(lds + LDSCTL_OFF))[tid] = 0u;
    __syncthreads();
    XcdBarrier bar = xcd_barrier_post((unsigned*)(ws + OFF_BAR), (volatile LAS unsigned*)(lds + LDSCTL_OFF) + 8);
#define IN(k) (lo <= (k) && (k) < hi)
#define NREP(k) ((MK_REPEAT == (k) || ((k) == 4 && (MK_REPEAT == 41 || MK_REPEAT == 42))) ? 2 : 1)
#define SEAM(k) do { if (IN(k) && IN((k) + 1)) xcd_barrier(bar); } while (0)
    if (lo < 0) cg::this_grid().sync();
    if (IN(0)) { p0_prologue(args, lds, gw, NGW, lane, wave, true, true); }
    SEAM(0);
    int cvirt = (int)blockIdx.x; bool xlocal = false;
    if (lo == 0 && hi > 2 && (G & 7) == 0) { bool even = true;
#pragma unroll
        for (int j = 0; j < 16; ++j) { const unsigned cj = xb_ld(&bar.bar[XB_XCNT(j)]); even = even && (cj == (j < 8 ? (unsigned)(G >> 3) : 0u)); }
        if (even && bar.x < 8u) { cvirt = (int)(bar.st[2] * 8u + bar.x); xlocal = true; } }
    cvirt = __builtin_amdgcn_readfirstlane(cvirt);
    const int rb = xlocal ? (cvirt & 7) * (G >> 3) + (cvirt >> 3) : (int)blockIdx.x;
    unsigned lgen = 0;
#define LSEAM() do { if (xlocal) { xcd_local_barrier(bar); ++lgen; } else xcd_barrier(bar); } while (0)
    if (IN(1)) { for (int rep = 0; rep < NREP(1); ++rep) { if (rep) xcd_barrier(bar); p1_norm(args, rb * NWAVES + wave, NGW, lane); } }
    if (IN(1) && IN(2)) LSEAM();
    if (IN(2)) { pg8::Gemm g{(const bf16*)(ws + WS_XN), (const bf16*)(ws + WS_WIN), M, INW, D}; pg8::StaticOrder S; S.init(M, INW, G, cvirt);
        pg8::EpiProj E{(bf16*)(ws + WS_PROJ), INW};
        for (int rep = 0; rep < NREP(2); ++rep) { if (rep) xcd_barrier(bar); pg8::gemm_phase<pg8::EpiProj, pg8::StaticOrder, true, true>(lds, g, S, E); } }
    if (IN(2) && IN(3)) LSEAM();
    if (IN(3)) { for (int rep = 0; rep < NREP(3); ++rep) { if (rep) xcd_barrier(bar); __syncthreads(); p3_mixers(args, lds, tid, rb, (xlocal && bar.x > 0u) ? &bar.bar[XL_GEN(bar.x - 1u)] : nullptr, lgen); } }
    if (IN(3) && IN(4)) LSEAM();
    if (IN(4)) { pg8::Gemm g{(const bf16*)(ws + WS_MIXIN), (const bf16*)(ws + WS_WOUT), M, D, D}; pg8::StaticOrder S; S.init(M, D, G, cvirt);
        pg8::EpiBf16SS E{(bf16*)(ws + WS_MIXED), INW, (float*)(ws + OFF_SS1)};
        pg8::gemm_phase<pg8::EpiBf16SS, pg8::StaticOrder, true, true>(lds, g, S, E);
        LSEAM();
        p4b_mid(args, rb * NWAVES + wave, NGW, lane); }
    if (IN(4) && IN(5)) LSEAM();
    if (IN(5)) { pg8::Gemm g{(const bf16*)(ws + WS_XN), (const bf16*)(ws + WS_WUP), M, FF2, D}; pg8::StaticOrder S; S.init(M, FF2, G, cvirt);
        pg8::EpiConv E{(bf16*)(ws + WS_ACT), (bf16*)(ws + WS_RAW), args.in[I_CONVW], args.in[I_CONVB], FF, lds + LDSCTL_OFF + 4096};
        for (int rep = 0; rep < NREP(5); ++rep) { if (rep) xcd_barrier(bar); pg8::gemm_phase<pg8::EpiConv, pg8::StaticOrder, true, true>(lds, g, S, E); } }
    SEAM(5);
    if (IN(6)) { p6b_fixup(args, rb * NWAVES + wave, NGW, lane); }
    if (IN(6) && IN(7)) LSEAM();
    if (IN(7)) { pg8::Gemm g{(const bf16*)(ws + WS_ACT), (const bf16*)(ws + WS_WDOWN), M, D, FF}; pg8::StaticOrder S; S.init(M, D, G, cvirt);
        for (int rep = 0; rep < NREP(7); ++rep) { if (rep) xcd_barrier(bar);
        pg8::RowStat st{(float*)(ws + (rep ? 736 * 1024 : OFF_SS4)), (unsigned*)(ws + (rep ? 640 * 1024 : OFF_CNT + 32768)), 32u, 1.0f / D, EPS};
        pg8::EpiFinal E{(const bf16*)(ws + WS_X1B), rep ? (float*)(ws + WS_F) : args.out, (const float*)(ws + OFF_MOD), args.in[I_POSTFFNG], st, D, SEQ / 256};
        pg8::gemm_phase<pg8::EpiFinal, pg8::StaticOrder, true, true>(lds, g, S, E); } }
    if (MK_REPEAT == 17 && IN(7)) { xcd_barrier(bar); pg8::Gemm g{(const bf16*)(ws + WS_ACT), (const bf16*)(ws + WS_WDOWN), M, D, FF}; pg8::StaticOrder S; S.init(M, D, G, (int)blockIdx.x);
        pg8::EpiSink E{(float*)(ws + WS_F)}; pg8::gemm_phase<pg8::EpiSink, pg8::StaticOrder, true, true>(lds, g, S, E); }
#undef IN
#undef SEAM
}

constexpr int N_PHASES = 8;
extern "C" void kernel_launch(void* const* d_in, const int* in_sizes, int n_in, void* d_out, int out_size, void* d_ws, size_t ws_size, hipStream_t stream) {
    static int grid = 0;
    if (grid == 0) {
        if (n_in != 19 || in_sizes[0] != M * D || out_size != M * D || ws_size < WS_END) { fprintf(stderr, "kernel_launch: unexpected shapes (n_in %d, in0 %d, out %d, ws %zu)\n", n_in, n_in > 0 ? in_sizes[0] : -1, out_size, ws_size); grid = -1; return; }
        int dev = 0, cus = 0, per_cu = 0;
        (void)hipGetDevice(&dev); (void)hipDeviceGetAttribute(&cus, hipDeviceAttributeMultiprocessorCount, dev);
        if (hipFuncSetAttribute((const void*)mk_fwd, hipFuncAttributeMaxDynamicSharedMemorySize, LDS_BYTES) != hipSuccess) { fprintf(stderr, "kernel_launch: hipFuncSetAttribute failed\n"); grid = -1; return; }
        if (hipOccupancyMaxActiveBlocksPerMultiprocessor(&per_cu, (const void*)mk_fwd, NWAVES * 64, LDS_BYTES) != hipSuccess || per_cu < 1) { fprintf(stderr, "kernel_launch: occupancy query says %d blocks per CU\n", per_cu); per_cu = 1; }
        (void)hipGetLastError();
        grid = cus > 0 ? cus : 256;
    }
    if (grid < 0) return;
    (void)hipMemsetAsync((char*)d_ws + WS_CTL, 0, CTL_ZERO_BYTES, stream);
    Args a{};
    for (int i = 0; i < 19; ++i) a.in[i] = (const float*)d_in[i];
    a.out = (float*)d_out; a.ws = (unsigned char*)d_ws;
#if MK_N_LAUNCHES == 1
    a.ph_lo = 0; a.ph_hi = N_PHASES;
    void* kargs[] = {&a};
    hipError_t e = hipLaunchCooperativeKernel((const void*)mk_fwd, dim3(grid), dim3(NWAVES * 64), kargs, LDS_BYTES, stream);
    if (e != hipSuccess) fprintf(stderr, "kernel_launch: cooperative launch failed: %s (grid %d)\n", hipGetErrorString(e), grid);
#else
    for (int p = 0; p < N_PHASES; ++p) { a.ph_lo = p; a.ph_hi = p + 1; hipLaunchKernelGGL(mk_fwd, dim3(grid), dim3(NWAVES * 64), LDS_BYTES, stream, a); }
#endif
}
```

```cpp
#include <hip/hip_runtime.h>
#include <hip/hip_cooperative_groups.h>
#include <cstdio>
#include <cstdint>
namespace cg = cooperative_groups;
#ifndef MK_N_LAUNCHES
#define MK_N_LAUNCHES 1
#endif
#ifndef MK_REPEAT
#define MK_REPEAT -1
#endif
namespace pg8 {
#define PG8_LAS __attribute__((address_space(3)))
typedef unsigned short bf16_t;
typedef short bf16x8 __attribute__((ext_vector_type(8)));
typedef float f32x4 __attribute__((ext_vector_type(4)));
typedef unsigned u32x4 __attribute__((ext_vector_type(4)));
constexpr int BM = 256, BK = 64, HALF = 128, HTB = HALF * BK * 2  , STAGE_BYTES = 8 * HTB, NXCD = 8, WGM = 4;

__host__ __device__ __forceinline__ int lds_byte(int r, int c) { const int st = (r >> 4) * 2 + (c >> 5), rr = r & 15, cc = c & 31, ob = rr * 64 + cc * 2; return st * 1024 + (ob ^ (((ob >> 9) & 1) << 5)); }
__host__ __device__ __forceinline__ void stage_rc(int b, int& R, int& C) { const int st = b / 1024, sb = b % 1024, swz = sb ^ (((sb >> 9) & 1) << 5); R = (st >> 1) * 16 + swz / 64; C = (st & 1) * 32 + (swz % 64) / 2; }
__host__ __device__ __forceinline__ int perm32(int rho) { const int n = rho >> 4, i = rho & 15; return 8 * (i >> 2) + 4 * n + (i & 3); }

struct Unit { int pm, pn; };
struct Gemm { const bf16_t* A; const bf16_t* Bt; int M, N, K; };

struct StaticOrder {
    int nM, nN, nwg, G, c;
    __host__ __device__ void init(int M, int N, int G_, int c_) { nM = M / BM; nN = N / BM; nwg = nM * nN; G = G_; c = c_; }
    __host__ __device__ bool next(int i, Unit& u) const {
        const long L = (long)i * G + c; if (L >= nwg) return false;
        int wgid = (int)L; { const int q = nwg / NXCD, r = nwg % NXCD, xcd = wgid % NXCD, off = wgid / NXCD; wgid = (xcd < r ? xcd * (q + 1) : r * (q + 1) + (xcd - r) * q) + off; }
        const int nig = WGM * nN, gid = wgid / nig, fm = gid * WGM, gsz = (nM - fm) < WGM ? (nM - fm) : WGM;
        u.pm = fm + ((wgid % nig) % gsz); u.pn = (wgid % nig) / gsz; return true;
    }
    __device__ __forceinline__ void a_ready(const Unit&) const {}
    __device__ __forceinline__ void done(const Unit&) const {}
};

__device__ __forceinline__ unsigned cvt_pk_bf16(float lo, float hi) { unsigned r; asm volatile("v_cvt_pk_bf16_f32 %0, %1, %2" : "=v"(r) : "v"(lo), "v"(hi)); return r; }
typedef float f32x2 __attribute__((ext_vector_type(2)));
typedef unsigned u32x2 __attribute__((ext_vector_type(2)));
__device__ __forceinline__ float fast_sigmoid_arg2(float p) { return __builtin_amdgcn_rcpf(1.0f + __builtin_amdgcn_exp2f(p)); }
__device__ __forceinline__ float gelu_tanh(float x) {
    const float t = x * x; const float p = x * (-2.302208198f + (-0.1029432397f) * t); return x * fast_sigmoid_arg2(p);
}
__device__ __forceinline__ float silu_f(float x) { return x * fast_sigmoid_arg2(x * (-1.4426950409f)); }
__device__ __forceinline__ float dpp_ror1(float x) { return __builtin_bit_cast(float, __builtin_amdgcn_update_dpp(0, __builtin_bit_cast(int, x), 0x121, 0xf, 0xf, false)); }
__device__ __forceinline__ float dpp_ror2(float x) { return __builtin_bit_cast(float, __builtin_amdgcn_update_dpp(0, __builtin_bit_cast(int, x), 0x122, 0xf, 0xf, false)); }

struct EpiProj {
    static constexpr bool PERM = true, AFTER_DRAIN = false, PERMA = false, HAS_PRE = false;
    bf16_t* O; int ldc;
    __device__ __forceinline__ void operator()(const f32x4 (&acc)[2][2][4][2], const Unit& u, int wr, int wc, int fr, int fq) const {
        const int row0 = u.pm * BM + wr * 64 + fr, col0 = u.pn * BM + wc * 32 + 8 * fq; const bool act = u.pn < 4; const bool edge = !act && (u.pm & 15) == 15 && wr == 1;
#pragma unroll
        for (int ai = 0; ai < 2; ++ai)
#pragma unroll
            for (int m = 0; m < 4; ++m) { bf16_t* rowp = O + (size_t)(row0 + ai * HALF + m * 16) * ldc + col0;
#pragma unroll
                for (int bj = 0; bj < 2; ++bj) { f32x4 v0 = acc[ai][bj][m][0], v1 = acc[ai][bj][m][1];
                    if (act) {
#pragma unroll
                        for (int j = 0; j < 4; ++j) { v0[j] = gelu_tanh(v0[j]); v1[j] = gelu_tanh(v1[j]); } }
                    u32x4 w; w.x = cvt_pk_bf16(v0[0], v0[1]); w.y = cvt_pk_bf16(v0[2], v0[3]); w.z = cvt_pk_bf16(v1[0], v1[1]); w.w = cvt_pk_bf16(v1[2], v1[3]);
                    if (edge && ai == 1 && m == 3) {
                        __hip_atomic_store((unsigned long long*)(rowp + bj * HALF), (unsigned long long)w.x | ((unsigned long long)w.y << 32), __ATOMIC_RELAXED, __HIP_MEMORY_SCOPE_AGENT);
                        __hip_atomic_store((unsigned long long*)(rowp + bj * HALF + 4), (unsigned long long)w.z | ((unsigned long long)w.w << 32), __ATOMIC_RELAXED, __HIP_MEMORY_SCOPE_AGENT); }
                    else *(u32x4*)(rowp + bj * HALF) = w; } }
    }
};

struct EpiF32SS {
    static constexpr bool PERM = false, AFTER_DRAIN = false, PERMA = false, HAS_PRE = false;
    float* O; int ldc; float* ss;
    __device__ __forceinline__ void operator()(const f32x4 (&acc)[2][2][4][2], const Unit& u, int wr, int wc, int fr, int fq) const {
        const int row0 = u.pm * BM + wr * 64 + fr, col0 = u.pn * BM + wc * 32 + 4 * fq;
#pragma unroll
        for (int ai = 0; ai < 2; ++ai)
#pragma unroll
            for (int m = 0; m < 4; ++m) { const int row = row0 + ai * HALF + m * 16; float* rowp = O + (size_t)row * ldc + col0; float s = 0.f;
#pragma unroll
                for (int bj = 0; bj < 2; ++bj)
#pragma unroll
                    for (int n = 0; n < 2; ++n) { const f32x4 x = acc[ai][bj][m][n]; s += (x[0] * x[0] + x[1] * x[1]) + (x[2] * x[2] + x[3] * x[3]); *(f32x4*)(rowp + bj * HALF + n * 16) = x; }
                s += __shfl_xor(s, 16); s += __shfl_xor(s, 32);
                if (fq == 0) atomicAdd(ss + row, s); }
    }
};

struct EpiBf16SS {
    static constexpr bool PERM = true, AFTER_DRAIN = false, PERMA = false, HAS_PRE = false;
    bf16_t* O; int ldc; float* ss;
    __device__ __forceinline__ void operator()(const f32x4 (&acc)[2][2][4][2], const Unit& u, int wr, int wc, int fr, int fq) const {
        const int row0 = u.pm * BM + wr * 64 + fr, col0 = u.pn * BM + wc * 32 + 8 * fq;
#pragma unroll
        for (int ai = 0; ai < 2; ++ai)
#pragma unroll
            for (int m = 0; m < 4; ++m) { const int row = row0 + ai * HALF + m * 16; bf16_t* rowp = O + (size_t)row * ldc + col0; float s = 0.f;
#pragma unroll
                for (int bj = 0; bj < 2; ++bj) { const f32x4 v0 = acc[ai][bj][m][0], v1 = acc[ai][bj][m][1];
                    s += ((v0[0] * v0[0] + v0[1] * v0[1]) + (v0[2] * v0[2] + v0[3] * v0[3])) + ((v1[0] * v1[0] + v1[1] * v1[1]) + (v1[2] * v1[2] + v1[3] * v1[3]));
                    u32x4 w; w.x = cvt_pk_bf16(v0[0], v0[1]); w.y = cvt_pk_bf16(v0[2], v0[3]); w.z = cvt_pk_bf16(v1[0], v1[1]); w.w = cvt_pk_bf16(v1[2], v1[3]);
                    *(u32x4*)(rowp + bj * HALF) = w; }
                s += __shfl_xor(s, 16); s += __shfl_xor(s, 32);
                if (fq == 0) atomicAdd(ss + row, s); }
    }
};

__device__ __forceinline__ float dpp_shr1(float x) { return __builtin_bit_cast(float, __builtin_amdgcn_update_dpp(0, __builtin_bit_cast(int, x), 0x111, 0xf, 0xf, true)); }
struct EpiConv {
    static constexpr bool PERM = true, AFTER_DRAIN = false, PERMA = true, HAS_PRE = true;
    bf16_t* ACT; bf16_t* RAW; const float* cw; const float* cb; int FF; PG8_LAS unsigned char* CB;
    __device__ __forceinline__ void pre(const Unit& u, int par) const {
        const int tid = threadIdx.x, w = __builtin_amdgcn_readfirstlane(tid >> 6), l = tid & 63;
        if (w < 4) { const int vec = 2 * w + (l >> 5), k = vec & 3, hv = vec >> 2; const float* src = (k < 3 ? cw + (size_t)k * 2 * FF : cb) + hv * FF + u.pn * HALF + (l & 31) * 4;
            __builtin_amdgcn_global_load_lds((const unsigned*)src, (PG8_LAS unsigned*)(CB + par * 4096 + w * 1024), 16, 0, 0); }
    }
    __device__ __forceinline__ void run(const f32x4 (&acc)[2][2][4][2], const Unit& u, int wr, int wc, int fr, int fq, int par) const {
        const int f0 = u.pn * HALF + wc * 32 + 8 * fq; const int rowt = u.pm * BM + wr * 64 + 4 * fr; const int FF2 = 2 * FF;
        const PG8_LAS float* cbuf = (const PG8_LAS float*)(CB + par * 4096) + wc * 32 + 8 * fq;
        unsigned stash[2][4][2];
#pragma unroll
        for (int n = 0; n < 2; ++n) { const int f = f0 + 4 * n; const PG8_LAS float* cn = cbuf + 4 * n;
            const f32x4 w0g = *(const PG8_LAS f32x4*)(cn), w1g = *(const PG8_LAS f32x4*)(cn + 128), w2g = *(const PG8_LAS f32x4*)(cn + 256), bg = *(const PG8_LAS f32x4*)(cn + 384);
            const f32x4 w0v = *(const PG8_LAS f32x4*)(cn + 512), w1v = *(const PG8_LAS f32x4*)(cn + 640), w2v = *(const PG8_LAS f32x4*)(cn + 768), bv = *(const PG8_LAS f32x4*)(cn + 896);
#pragma unroll
            for (int ai = 0; ai < 2; ++ai) {
                f32x4 gm1, gm2, vm1, vm2;
#pragma unroll
                for (int j = 0; j < 4; ++j) { gm1[j] = dpp_shr1(acc[ai][0][3][n][j]); gm2[j] = dpp_shr1(acc[ai][0][2][n][j]); vm1[j] = dpp_shr1(acc[ai][1][3][n][j]); vm2[j] = dpp_shr1(acc[ai][1][2][n][j]); }
#pragma unroll
                for (int m = 0; m < 4; ++m) { const f32x4 g = acc[ai][0][m][n], v = acc[ai][1][m][n];
                    const f32x4 pg1 = (m == 0) ? gm1 : acc[ai][0][m > 0 ? m - 1 : 0][n], pg2 = (m == 0) ? gm2 : (m == 1 ? gm1 : acc[ai][0][m > 1 ? m - 2 : 0][n]);
                    const f32x4 pv1 = (m == 0) ? vm1 : acc[ai][1][m > 0 ? m - 1 : 0][n], pv2 = (m == 0) ? vm2 : (m == 1 ? vm1 : acc[ai][1][m > 1 ? m - 2 : 0][n]);
                    const f32x4 yg = bg + w0g * pg2 + w1g * pg1 + w2g * g, yv = bv + w0v * pv2 + w1v * pv1 + w2v * v; f32x4 a;
#pragma unroll
                    for (int j = 0; j < 4; ++j) a[j] = silu_f(yg[j]) * yv[j];
                    const unsigned lo = cvt_pk_bf16(a[0], a[1]), hi = cvt_pk_bf16(a[2], a[3]);
                    if (n == 0) { stash[ai][m][0] = lo; stash[ai][m][1] = hi; }
                    else if (!(m < 2 && fr == 0)) { u32x4 w; w.x = stash[ai][m][0]; w.y = stash[ai][m][1]; w.z = lo; w.w = hi; __builtin_nontemporal_store(w, (u32x4*)(ACT + (size_t)(rowt + ai * HALF + m) * FF + f0)); }
                    if ((m < 2 && fr == 0) || (m >= 2 && fr == 15)) { bf16_t* rp = RAW + ((size_t)((u.pm * 4 + ai * 2 + wr) * 4 + m)) * FF2 + f;
                        u32x2 gw, vw; gw.x = cvt_pk_bf16(g[0], g[1]); gw.y = cvt_pk_bf16(g[2], g[3]); vw.x = cvt_pk_bf16(v[0], v[1]); vw.y = cvt_pk_bf16(v[2], v[3]);
                        *(u32x2*)rp = gw; *(u32x2*)(rp + FF) = vw; } } } }
    }
};

struct RowStat {
    float* ss; unsigned* cnt; unsigned want; float inv_n, eps;
    __device__ __forceinline__ void run(const float (&part)[2][4], float (&rs)[2][4], const Unit& u, int wr, int fr, int fq) const {
        const int row0 = u.pm * BM + wr * 64 + fr; const int lane = fq * 16 + fr;
#pragma unroll
        for (int ai = 0; ai < 2; ++ai)
#pragma unroll
            for (int m = 0; m < 4; ++m) { float s = part[ai][m]; s += __shfl_xor(s, 16); s += __shfl_xor(s, 32); if (fq == 0) atomicAdd(ss + row0 + ai * HALF + m * 16, s); }
        asm volatile("s_waitcnt vmcnt(0)" ::: "memory");
        unsigned* c = cnt + 64 * u.pm;
        if (lane == 0) __hip_atomic_fetch_add(c, 1u, __ATOMIC_RELAXED, __HIP_MEMORY_SCOPE_AGENT);
        if (threadIdx.x < 64) { unsigned sp = 0;
            while ((unsigned)__builtin_amdgcn_readfirstlane(__hip_atomic_load(c, __ATOMIC_RELAXED, __HIP_MEMORY_SCOPE_AGENT)) < want) { __builtin_amdgcn_s_sleep(1); if (++sp > (1u << 22)) break; } }
        asm volatile("s_waitcnt vmcnt(0) lgkmcnt(0)" ::: "memory"); __builtin_amdgcn_s_barrier(); asm volatile("" ::: "memory");
#pragma unroll
        for (int ai = 0; ai < 2; ++ai)
#pragma unroll
            for (int m = 0; m < 4; ++m) { const float v = __hip_atomic_load(ss + row0 + ai * HALF + m * 16, __ATOMIC_RELAXED, __HIP_MEMORY_SCOPE_AGENT); rs[ai][m] = __builtin_amdgcn_rsqf(v * inv_n + eps); }
    }
};
template <int VAR = 0  > struct EpiMid {
    static constexpr bool PERM = false, AFTER_DRAIN = false, PERMA = false, HAS_PRE = false;
    const float* x; float* x1; bf16_t* xn; const float* mod; const float* post_g; const float* ffn_g; const float* sxx; float* ss1; float* ssxm; float* ssmm; unsigned* cnt; PG8_LAS float* A23; int ld, tiles_per_batch;
    __device__ __forceinline__ void operator()(f32x4 (&acc)[2][2][4][2], const Unit& u, int wr, int wc, int fr, int fq) const {
        const int col0 = u.pn * BM + wc * 32 + 4 * fq; const float* mb = mod + (size_t)(u.pm / tiles_per_batch) * (6 * ld); const int tid = threadIdx.x;
        const unsigned voff = (unsigned)((wr * 64 + fr) * ld + col0) * 4u;
        const size_t pbase = (size_t)u.pm * BM * ld; const int row0 = u.pm * BM + wr * 64 + fr;
        if (tid < 256) { const int c = u.pn * BM + tid; A23[tid] = mb[2 * ld + c] * post_g[c]; A23[256 + tid] = ffn_g[c] * (1.0f + mb[4 * ld + c]); A23[512 + tid] = mb[3 * ld + c]; }
        asm volatile("s_waitcnt vmcnt(0) lgkmcnt(0)" ::: "memory"); __builtin_amdgcn_s_barrier(); asm volatile("" ::: "memory");
        const PG8_LAS float* As = A23 + wc * 32 + 4 * fq;
#pragma unroll
        for (int ai = 0; ai < 2; ++ai)
#pragma unroll
            for (int m = 0; m < 4; ++m) { const char* xb = (const char*)(x + pbase + (size_t)(ai * HALF + m * 16) * ld); f32x4 s1 = {0.f, 0.f, 0.f, 0.f}, sx = s1, sm = s1;
#pragma unroll
                for (int bj = 0; bj < 2; ++bj)
#pragma unroll
                    for (int n = 0; n < 2; ++n) { const unsigned o = voff + (unsigned)(bj * HALF + n * 16) * 4u; const f32x4 xv = (VAR == 1) ? (f32x4){1.f, 1.f, 1.f, 1.f} : *(const f32x4*)(xb + o); const f32x4 mx = acc[ai][bj][m][n], cm = mx * *(const PG8_LAS f32x4*)(As + bj * HALF + n * 16);
                        s1 += mx * mx; sx += xv * cm; sm += cm * cm; }
                float a = (s1[0] + s1[1]) + (s1[2] + s1[3]), b = (sx[0] + sx[1]) + (sx[2] + sx[3]), c = (sm[0] + sm[1]) + (sm[2] + sm[3]);
                a += __shfl_xor(a, 16); a += __shfl_xor(a, 32); b += __shfl_xor(b, 16); b += __shfl_xor(b, 32); c += __shfl_xor(c, 16); c += __shfl_xor(c, 32);
                if (fq == 0) { const int r = row0 + ai * HALF + m * 16; atomicAdd(ss1 + r, a); atomicAdd(ssxm + r, b); atomicAdd(ssmm + r, c); }
                if (m == 3) asm volatile("" ::: "memory"); }
        asm volatile("s_waitcnt vmcnt(0)" ::: "memory");
        unsigned* cw = cnt + 64 * u.pm;
        if ((tid & 63) == 0) __hip_atomic_fetch_add(cw, 1u, __ATOMIC_RELAXED, __HIP_MEMORY_SCOPE_AGENT);
        if (tid < 64) { unsigned sp = 0;
            while ((unsigned)__builtin_amdgcn_readfirstlane(__hip_atomic_load(cw, __ATOMIC_RELAXED, __HIP_MEMORY_SCOPE_AGENT)) < 32u) { __builtin_amdgcn_s_sleep(1); if (++sp > (1u << 22)) break; } }
        asm volatile("s_waitcnt vmcnt(0) lgkmcnt(0)" ::: "memory"); __builtin_amdgcn_s_barrier(); asm volatile("" ::: "memory");
        const float inv_n = 1.0f / (float)ld; float rs1[2][4], rs2[2][4];
#pragma unroll
        for (int ai = 0; ai < 2; ++ai)
#pragma unroll
            for (int m = 0; m < 4; ++m) { const int r = row0 + ai * HALF + m * 16;
                const float S1 = __hip_atomic_load(ss1 + r, __ATOMIC_RELAXED, __HIP_MEMORY_SCOPE_AGENT), Sxm = __hip_atomic_load(ssxm + r, __ATOMIC_RELAXED, __HIP_MEMORY_SCOPE_AGENT), Smm = __hip_atomic_load(ssmm + r, __ATOMIC_RELAXED, __HIP_MEMORY_SCOPE_AGENT);
                const float r1 = __builtin_amdgcn_rsqf(S1 * inv_n + 1e-6f); rs1[ai][m] = r1;
                const float s2 = sxx[r] + 2.0f * r1 * Sxm + r1 * r1 * Smm; rs2[ai][m] = __builtin_amdgcn_rsqf(s2 * inv_n + 1e-6f); }
        if (VAR != 0) { if (rs1[0][0] + rs2[1][3] + rs1[1][2] + rs2[0][1] == 1.2345e33f) x1[row0] = rs1[0][1]; return; }
#pragma unroll
        for (int ai = 0; ai < 2; ++ai)
#pragma unroll
            for (int m = 0; m < 4; ++m) { const size_t gb = pbase + (size_t)(ai * HALF + m * 16) * ld; const char* xb = (const char*)(x + gb); char* ob = (char*)(x1 + gb); char* nb = (char*)(xn + gb);
#pragma unroll
                for (int bj = 0; bj < 2; ++bj)
#pragma unroll
                    for (int n = 0; n < 2; ++n) { const unsigned o = voff + (unsigned)(bj * HALF + n * 16) * 4u; const f32x4 xv = *(const f32x4*)(xb + o);
                        const f32x4 v = xv + acc[ai][bj][m][n] * rs1[ai][m] * *(const PG8_LAS f32x4*)(As + bj * HALF + n * 16);
                        *(f32x4*)(ob + o) = v;
                        const f32x4 a2 = *(const PG8_LAS f32x4*)(As + 256 + bj * HALF + n * 16), a3 = *(const PG8_LAS f32x4*)(As + 512 + bj * HALF + n * 16); const f32x4 h = v * rs2[ai][m] * a2 + a3;
                        u32x2 wv; wv.x = cvt_pk_bf16(h[0], h[1]); wv.y = cvt_pk_bf16(h[2], h[3]); *(u32x2*)(nb + (o >> 1)) = wv; }
                if (m == 3) asm volatile("" ::: "memory"); }
    }
};
struct EpiFinal {
    static constexpr bool PERM = false, AFTER_DRAIN = false, PERMA = false, HAS_PRE = false;
    const bf16_t* src; float* out; const float* mod; const float* post_g; RowStat st; int ld, tiles_per_batch;
    __device__ __forceinline__ void operator()(f32x4 (&acc)[2][2][4][2], const Unit& u, int wr, int wc, int fr, int fq) const {
        const int col0 = u.pn * BM + wc * 32 + 4 * fq; const float* mb = mod + (size_t)(u.pm / tiles_per_batch) * (6 * ld);
        const unsigned voff = (unsigned)((wr * 64 + fr) * ld + col0) * 4u, cvo = (unsigned)col0 * 4u; const size_t pbase = (size_t)u.pm * BM * ld;
        float part[2][4], rs[2][4];
#pragma unroll
        for (int ai = 0; ai < 2; ++ai)
#pragma unroll
            for (int m = 0; m < 4; ++m) { float s = 0.f;
#pragma unroll
                for (int bj = 0; bj < 2; ++bj)
#pragma unroll
                    for (int n = 0; n < 2; ++n) { const f32x4 v = acc[ai][bj][m][n]; s += (v[0] * v[0] + v[1] * v[1]) + (v[2] * v[2] + v[3] * v[3]); }
                part[ai][m] = s; }
        u32x2 xpre[2][4][2][2];
#pragma unroll
        for (int ai = 0; ai < 2; ++ai)
#pragma unroll
            for (int m = 0; m < 4; ++m) { const char* sb = (const char*)(src + pbase + (size_t)(ai * HALF + m * 16) * ld);
#pragma unroll
                for (int bj = 0; bj < 2; ++bj)
#pragma unroll
                    for (int n = 0; n < 2; ++n) xpre[ai][m][bj][n] = *(const u32x2*)(sb + ((voff + (unsigned)(bj * HALF + n * 16) * 4u) >> 1)); }
        st.run(part, rs, u, wr, fr, fq);
        f32x4 A1[2][2];
#pragma unroll
        for (int bj = 0; bj < 2; ++bj)
#pragma unroll
            for (int n = 0; n < 2; ++n) { const unsigned co = cvo + (unsigned)(bj * HALF + n * 16) * 4u; A1[bj][n] = *(const f32x4*)((const char*)(mb + 5 * ld) + co) * *(const f32x4*)((const char*)post_g + co); }
#pragma unroll
        for (int ai = 0; ai < 2; ++ai)
#pragma unroll
            for (int m = 0; m < 4; ++m) { char* ob = (char*)(out + pbase + (size_t)(ai * HALF + m * 16) * ld);
#pragma unroll
                for (int bj = 0; bj < 2; ++bj)
#pragma unroll
                    for (int n = 0; n < 2; ++n) { const unsigned o = voff + (unsigned)(bj * HALF + n * 16) * 4u; const u32x2 xw = xpre[ai][m][bj][n];
                        const f32x4 xv = {__builtin_bit_cast(float, xw.x << 16), __builtin_bit_cast(float, xw.x & 0xffff0000u), __builtin_bit_cast(float, xw.y << 16), __builtin_bit_cast(float, xw.y & 0xffff0000u)};
                        *(f32x4*)(ob + o) = xv + acc[ai][bj][m][n] * rs[ai][m] * A1[bj][n]; }
                if (m == 3) asm volatile("" ::: "memory"); }
    }
};

struct EpiSink {
    static constexpr bool PERM = false, AFTER_DRAIN = false, PERMA = false, HAS_PRE = false;
    float* O;
    __device__ __forceinline__ void operator()(f32x4 (&acc)[2][2][4][2], const Unit& u, int wr, int wc, int fr, int fq) const {
        f32x4 s = {0.f, 0.f, 0.f, 0.f};
#pragma unroll
        for (int ai = 0; ai < 2; ++ai)
#pragma unroll
            for (int bj = 0; bj < 2; ++bj)
#pragma unroll
                for (int m = 0; m < 4; ++m)
#pragma unroll
                    for (int n = 0; n < 2; ++n) s += acc[ai][bj][m][n];
        if (s[0] + s[1] + s[2] + s[3] == 1.2345e33f) O[u.pm * 256 + wr * 64 + fr + wc + fq] = s[0];
    }
};
template <class Epi, class Sched, bool ALIGN_EPI = false, bool SP2 = false>
__device__ __forceinline__ void gemm_phase(PG8_LAS unsigned char* lds, const Gemm g, const Sched& S, const Epi& E) {
    const int tid = threadIdx.x, wid = __builtin_amdgcn_readfirstlane(tid >> 6), lane = tid & 63, wr = wid >> 2, wc = wid & 3, fr = lane & 15, fq = lane >> 4;
    const int K = g.K, nt = K / BK;
    unsigned voffA[2], voffB[2];
#pragma unroll
    for (int i = 0; i < 2; ++i) { int R, C; stage_rc(tid * 16 + i * 8192, R, C); const int Rb = Epi::PERM ? ((R & ~31) + perm32(R & 31)) : R;
        const int Ra = Epi::PERMA ? ((R & ~63) + 4 * (R & 15) + ((R & 63) >> 4)) : R;
        voffA[i] = (unsigned)(Ra * K + C) * 2u; voffB[i] = (unsigned)(Rb * K + C) * 2u; }
    const size_t kstep = (size_t)(BK * 2);
    const size_t hstep = (size_t)HALF * K * 2;
    const size_t tstep = 2 * hstep;
    const unsigned ldsw = (unsigned)wid * 1024u;
    const int aoff = lds_byte(wr * 64 + fr, fq * 8), boff = lds_byte(wc * 32 + fr, fq * 8);
#define PG8_SA(b, h) (((b) * 2 + (h)) * HTB)
#define PG8_SB(b, h) ((4 + (b) * 2 + (h)) * HTB)
#define PG8_STAGE(bufoff, gbase, voff) do { _Pragma("unroll") for (int _i = 0; _i < 2; ++_i) \
        __builtin_amdgcn_global_load_lds((const unsigned*)((const char*)(gbase) + (voff)[_i]), (PG8_LAS unsigned*)(lds + (bufoff) + ldsw + _i * 8192), 16, 0, 0); } while (0)
#define PG8_LDA(dst, b, h) do { _Pragma("unroll") for (int m = 0; m < 4; ++m) _Pragma("unroll") for (int k = 0; k < 2; ++k) dst[m][k] = *(const PG8_LAS bf16x8*)(lds + PG8_SA(b, h) + aoff + m * 2048 + k * 1024); } while (0)
#define PG8_LDB(dst, b, h) do { _Pragma("unroll") for (int n = 0; n < 2; ++n) _Pragma("unroll") for (int k = 0; k < 2; ++k) dst[n][k] = *(const PG8_LAS bf16x8*)(lds + PG8_SB(b, h) + boff + n * 2048 + k * 1024); } while (0)
#define PG8_MMA(ai, bj, At, Bt) do { __builtin_amdgcn_s_setprio(1); _Pragma("unroll") for (int m = 0; m < 4; ++m) _Pragma("unroll") for (int n = 0; n < 2; ++n) _Pragma("unroll") for (int k = 0; k < 2; ++k) \
        acc[ai][bj][m][n] = __builtin_amdgcn_mfma_f32_16x16x32_bf16(Bt[n][k], At[m][k], acc[ai][bj][m][n], 0, 0, 0); __builtin_amdgcn_s_setprio(0); } while (0)
#define PG8_WAIT_V(n) asm volatile("s_waitcnt vmcnt(" #n ")" ::: "memory")
#define PG8_WAIT_L(n) asm volatile("s_waitcnt lgkmcnt(" #n ")" ::: "memory")
#define PG8_BAR __builtin_amdgcn_s_barrier()
#define PG8_SCHED __builtin_amdgcn_sched_barrier(0)
    Unit cur, nxt; int ui = 0;
    if (!S.next(0, cur)) return;
    f32x4 acc[2][2][4][2];
#pragma unroll
    for (int a = 0; a < 2; ++a)
#pragma unroll
        for (int b = 0; b < 2; ++b)
#pragma unroll
            for (int m = 0; m < 4; ++m)
#pragma unroll
                for (int n = 0; n < 2; ++n) acc[a][b][m][n] = (f32x4){0.f, 0.f, 0.f, 0.f};
    bf16x8 At[4][2], B0[2][2], B1[2][2];
    const char* cA = (const char*)g.A + (size_t)cur.pm * tstep; const char* cB = (const char*)g.Bt + (size_t)cur.pn * tstep;
    S.a_ready(cur);
    if constexpr (Epi::HAS_PRE) E.pre(cur, 0);
    if constexpr (SP2) {
        PG8_STAGE(PG8_SB(0, 0), cB, voffB); PG8_STAGE(PG8_SB(0, 1), cB + hstep, voffB); PG8_STAGE(PG8_SA(0, 0), cA, voffA); PG8_STAGE(PG8_SA(0, 1), cA + hstep, voffA);
        if (wr == 1) PG8_BAR;
        PG8_WAIT_V(2); PG8_BAR;
        PG8_STAGE(PG8_SB(1, 0), cB + kstep, voffB); PG8_STAGE(PG8_SA(1, 0), cA + kstep, voffA); PG8_STAGE(PG8_SB(1, 1), cB + hstep + kstep, voffB);
        PG8_WAIT_V(6); PG8_BAR;
    } else {
        PG8_STAGE(PG8_SB(0, 0), cB, voffB); PG8_STAGE(PG8_SA(0, 0), cA, voffA); PG8_STAGE(PG8_SB(0, 1), cB + hstep, voffB); PG8_STAGE(PG8_SA(0, 1), cA + hstep, voffA);
        if (wr == 1) PG8_BAR;
        PG8_WAIT_V(4); PG8_BAR;
        PG8_STAGE(PG8_SB(1, 0), cB + kstep, voffB); PG8_STAGE(PG8_SA(1, 0), cA + kstep, voffA); PG8_STAGE(PG8_SB(1, 1), cB + hstep + kstep, voffB);
        PG8_WAIT_V(6); PG8_BAR;
    }
    for (;;) {
        const bool has_next = S.next(ui + 1, nxt);
        const char* nA = has_next ? (const char*)g.A + (size_t)nxt.pm * tstep : cA; const char* nB = has_next ? (const char*)g.Bt + (size_t)nxt.pn * tstep : cB;
        for (int t = 0; t < nt; t += 2) {
            const bool last = (t == nt - 2);
            const char* a1 = cA + (size_t)(t + 1) * kstep;
            const char* a2 = last ? nA : cA + (size_t)(t + 2) * kstep; const char* b2 = last ? nB : cB + (size_t)(t + 2) * kstep;
            const char* a3 = a2 + kstep; const char* b3 = b2 + kstep;
            if (last && has_next) S.a_ready(nxt);
            if constexpr (SP2) {
            PG8_LDB(B0, 0, 0); PG8_LDB(B1, 0, 1); PG8_SCHED; PG8_LDA(At, 0, 0); PG8_STAGE(PG8_SA(1, 1), a1 + hstep, voffA);
            PG8_WAIT_V(8); PG8_WAIT_L(0); PG8_BAR; PG8_MMA(0, 0, At, B0); PG8_MMA(0, 1, At, B1); PG8_BAR; PG8_SCHED;
            PG8_LDA(At, 0, 1); PG8_STAGE(PG8_SB(0, 0), b2, voffB); PG8_STAGE(PG8_SB(0, 1), b2 + hstep, voffB); PG8_STAGE(PG8_SA(0, 0), a2, voffA);
            PG8_WAIT_V(8); PG8_WAIT_L(0); PG8_BAR; PG8_MMA(1, 0, At, B0); PG8_MMA(1, 1, At, B1); PG8_BAR; PG8_SCHED;
            PG8_LDB(B0, 1, 0); PG8_LDB(B1, 1, 1); PG8_SCHED; PG8_LDA(At, 1, 0); PG8_STAGE(PG8_SA(0, 1), a2 + hstep, voffA);
            PG8_WAIT_V(8); PG8_WAIT_L(0); PG8_BAR; PG8_MMA(0, 0, At, B0); PG8_MMA(0, 1, At, B1); PG8_BAR; PG8_SCHED;
            PG8_LDA(At, 1, 1); PG8_STAGE(PG8_SB(1, 0), b3, voffB); PG8_STAGE(PG8_SB(1, 1), b3 + hstep, voffB); PG8_STAGE(PG8_SA(1, 0), a3, voffA);
            PG8_WAIT_V(8); PG8_WAIT_L(0); PG8_BAR; PG8_MMA(1, 0, At, B0); PG8_MMA(1, 1, At, B1); PG8_BAR; PG8_SCHED;
            } else {
            PG8_LDB(B0, 0, 0); PG8_SCHED; PG8_LDA(At, 0, 0); PG8_STAGE(PG8_SA(1, 1), a1 + hstep, voffA);
            PG8_WAIT_L(8); PG8_BAR; PG8_WAIT_L(0); PG8_MMA(0, 0, At, B0); PG8_BAR; PG8_SCHED;
            PG8_LDB(B1, 0, 1); PG8_STAGE(PG8_SB(0, 0), b2, voffB);
            PG8_BAR; PG8_WAIT_L(0); PG8_MMA(0, 1, At, B1); PG8_BAR;
            PG8_LDA(At, 0, 1); PG8_STAGE(PG8_SA(0, 0), a2, voffA);
            PG8_BAR; PG8_WAIT_L(0); PG8_MMA(1, 0, At, B0); PG8_BAR; PG8_SCHED;
            PG8_STAGE(PG8_SB(0, 1), b2 + hstep, voffB);
            PG8_WAIT_V(6); PG8_BAR; PG8_MMA(1, 1, At, B1); PG8_BAR;
            PG8_LDB(B0, 1, 0); PG8_SCHED; PG8_LDA(At, 1, 0); PG8_STAGE(PG8_SA(0, 1), a2 + hstep, voffA);
            PG8_WAIT_L(8); PG8_BAR; PG8_WAIT_L(0); PG8_MMA(0, 0, At, B0); PG8_BAR; PG8_SCHED;
            PG8_LDB(B1, 1, 1); PG8_STAGE(PG8_SB(1, 0), b3, voffB);
            PG8_BAR; PG8_WAIT_L(0); PG8_MMA(0, 1, At, B1); PG8_BAR;
            PG8_LDA(At, 1, 1); PG8_STAGE(PG8_SA(1, 0), a3, voffA);
            PG8_BAR; PG8_WAIT_L(0); PG8_MMA(1, 0, At, B0); PG8_BAR; PG8_SCHED;
            PG8_STAGE(PG8_SB(1, 1), b3 + hstep, voffB);
            PG8_WAIT_V(6); PG8_BAR; PG8_MMA(1, 1, At, B1); PG8_BAR;
            }
        }
        if constexpr (ALIGN_EPI) { if (wr == 0) PG8_BAR; }
        if constexpr (Epi::HAS_PRE) { if (has_next) E.pre(nxt, (ui + 1) & 1); E.run(acc, cur, wr, wc, fr, fq, ui & 1); S.done(cur); }
        else if constexpr (!Epi::AFTER_DRAIN) { E(acc, cur, wr, wc, fr, fq); S.done(cur); }
        if (!has_next) break;
#pragma unroll
        for (int a = 0; a < 2; ++a)
#pragma unroll
            for (int b = 0; b < 2; ++b)
#pragma unroll
                for (int m = 0; m < 4; ++m)
#pragma unroll
                    for (int n = 0; n < 2; ++n) acc[a][b][m][n] = (f32x4){0.f, 0.f, 0.f, 0.f};
        cur = nxt; cA = nA; cB = nB; ++ui;
        if constexpr (ALIGN_EPI) { if (wr == 1) PG8_BAR; }
    }
    PG8_WAIT_V(0);
    if constexpr (!ALIGN_EPI) { if (wr == 0) PG8_BAR; }
    PG8_BAR;
    if constexpr (Epi::AFTER_DRAIN) { E.fused(acc, cur, wr, wc, fr, fq, lds, wid, lane); S.done(cur); }
#undef PG8_SA
#undef PG8_SB
#undef PG8_STAGE
#undef PG8_LDA
#undef PG8_LDB
#undef PG8_MMA
#undef PG8_WAIT_V
#undef PG8_WAIT_L
#undef PG8_BAR
#undef PG8_SCHED
}
}
constexpr int NWAVES = 8;
constexpr int BATCH = 4, SEQ = 8192, D = 1024, M = BATCH * SEQ;
constexpr int INW = 1536, AW = 512, FF = 2816, FF2 = 2 * FF, NMOD = 6 * D;
constexpr float EPS = 1e-6f;
constexpr size_t MiB = 1u << 20;
constexpr size_t WS_CTL = 0, CTL_ZERO_BYTES = 1 * MiB;
constexpr size_t OFF_MOD = 0, OFF_SS1 = 128 * 1024, OFF_SS2 = 256 * 1024, OFF_SS3 = 384 * 1024, OFF_BAR = 512 * 1024, OFF_CNT = 544 * 1024, OFF_SS4 = 896 * 1024;
constexpr size_t WS_WIN = 1 * MiB, WS_WOUT = 4 * MiB, WS_WUP = 6 * MiB, WS_WDOWN = 17 * MiB, WS_WSP = 23 * MiB, WS_WPOOL = WS_WSP + 256 * 1024;
constexpr size_t WS_SXX = 23 * MiB + 512 * 1024;
constexpr size_t WS_XN = 24 * MiB;
constexpr size_t WS_PROJ = 88 * MiB;
constexpr size_t WS_MIXIN = 184 * MiB;
constexpr size_t WS_MIXED = WS_PROJ;
constexpr size_t WS_ACT = 248 * MiB;
constexpr size_t WS_RAW = 424 * MiB;
constexpr size_t WS_X1B = 446 * MiB;
constexpr size_t WS_F = WS_ACT;
constexpr size_t WS_END = 510 * MiB;
static_assert(WS_XN + (size_t)M * D * 2 <= WS_PROJ && WS_PROJ + (size_t)M * INW * 2 <= WS_MIXIN && WS_MIXIN + (size_t)M * D * 2 <= WS_ACT && WS_ACT + (size_t)M * FF * 2 <= WS_RAW && WS_RAW + (size_t)(M / 64) * 4 * FF2 * 2 <= WS_X1B && WS_X1B + (size_t)M * D * 2 <= WS_END, "d_ws map");
static_assert(WS_WUP + (size_t)FF2 * D * 2 <= WS_WDOWN && WS_WDOWN + (size_t)D * FF * 2 <= WS_WSP && WS_WPOOL + 4 * 128 * 128 * 2 <= WS_XN, "d_ws weights");
constexpr int RING_BYTES = 131072, LDSCTL_OFF = RING_BYTES, LDS_BYTES = 147456;

#define GAS __attribute__((address_space(1)))
#define LAS __attribute__((address_space(3)))
typedef unsigned short bf16;
typedef unsigned v4u __attribute__((ext_vector_type(4)));
typedef unsigned v2u __attribute__((ext_vector_type(2)));
typedef float f32x4 __attribute__((ext_vector_type(4)));
typedef short bf16x8 __attribute__((ext_vector_type(8)));
#define LDS_WAIT() asm volatile("s_waitcnt lgkmcnt(0)" ::: "memory")
__device__ __forceinline__ unsigned f2bf(float f) { unsigned u = __builtin_bit_cast(unsigned, f); return (u + 0x7fffu + ((u >> 16) & 1u)) >> 16; }
__device__ __forceinline__ unsigned pk2(float lo, float hi) { unsigned r; asm("v_cvt_pk_bf16_f32 %0, %1, %2" : "=v"(r) : "v"(lo), "v"(hi)); return r; }
__device__ __forceinline__ float bf_lo(unsigned w) { return __builtin_bit_cast(float, w << 16); }
__device__ __forceinline__ float bf_hi(unsigned w) { return __builtin_bit_cast(float, w & 0xffff0000u); }
__device__ __forceinline__ float wave_sum(float v) {
#pragma unroll
    for (int o = 1; o < 64; o <<= 1) v += __shfl_xor(v, o);
    return v;
}
__device__ __forceinline__ float silu_acc(float x) { return x / (1.0f + __expf(-x)); }

struct Args { const float* in[19]; float* out; unsigned char* ws; int ph_lo, ph_hi; };
enum { I_X = 0, I_C, I_WADA, I_BADA, I_PREMIXG, I_POSTMIXG, I_WIN, I_SGUG, I_WSP, I_BSP, I_WPOOL, I_PSCALE, I_WOUT, I_PREFFNG, I_POSTFFNG, I_WUP, I_CONVW, I_CONVB, I_WDOWN };

__device__ __forceinline__ void transpose_item(const float* W, int K, int N, bf16* WT, int k0, int n0, int drow0, LAS float* scr, int lane) {
    { f32x4 v[8];
#pragma unroll
        for (int i = 0; i < 8; ++i) v[i] = __builtin_nontemporal_load((const f32x4*)(W + (size_t)(k0 + 8 * i + (lane >> 3)) * N + n0 + 4 * (lane & 7)));
#pragma unroll
        for (int i = 0; i < 8; ++i) { LAS float* d = scr + (8 * i + (lane >> 3)) * 33 + 4 * (lane & 7); d[0] = v[i].x; d[1] = v[i].y; d[2] = v[i].z; d[3] = v[i].w; } }
    LDS_WAIT(); asm volatile("" ::: "memory");
    const int c = lane & 7;
#pragma unroll
    for (int j = 0; j < 4; ++j) { const int n = (lane >> 3) + 8 * j; const LAS float* s = scr + (8 * c) * 33 + n;
        v4u o; o.x = pk2(s[0 * 33], s[1 * 33]); o.y = pk2(s[2 * 33], s[3 * 33]); o.z = pk2(s[4 * 33], s[5 * 33]); o.w = pk2(s[6 * 33], s[7 * 33]);
        *(v4u*)(WT + (size_t)(drow0 + n) * K + k0 + 8 * c) = o; }
    LDS_WAIT(); asm volatile("" ::: "memory");
}

__device__ __forceinline__ void p0_prologue(const Args& a, LAS unsigned char* lds, int gw, int NGW, int lane, int wave, bool with_mod, bool with_rest) {
    unsigned char* ws = a.ws;
    float* MOD = (float*)(ws + OFF_MOD);
    const float* c = a.in[I_C]; const float* wada = a.in[I_WADA]; const float* bada = a.in[I_BADA];
    for (int it = with_mod ? gw : 96 * 16; it < 96 * 16; it += NGW) { const int cb = it % 96, ks = it / 96, col = cb * 64 + lane; float a0 = 0.f, a1 = 0.f, a2 = 0.f, a3 = 0.f;
        const float sv0 = silu_acc(c[ks * 64 + lane]), sv1 = silu_acc(c[D + ks * 64 + lane]), sv2 = silu_acc(c[2 * D + ks * 64 + lane]), sv3 = silu_acc(c[3 * D + ks * 64 + lane]);
#pragma unroll 32
        for (int kk = 0; kk < 64; ++kk) { const float w = __builtin_nontemporal_load(wada + (size_t)(ks * 64 + kk) * NMOD + col);
            a0 += __builtin_bit_cast(float, __builtin_amdgcn_readlane(__builtin_bit_cast(int, sv0), kk)) * w; a1 += __builtin_bit_cast(float, __builtin_amdgcn_readlane(__builtin_bit_cast(int, sv1), kk)) * w;
            a2 += __builtin_bit_cast(float, __builtin_amdgcn_readlane(__builtin_bit_cast(int, sv2), kk)) * w; a3 += __builtin_bit_cast(float, __builtin_amdgcn_readlane(__builtin_bit_cast(int, sv3), kk)) * w; }
        if (ks == 0) { const float b = bada[col]; a0 += b; a1 += b; a2 += b; a3 += b; }
        atomicAdd(MOD + col, a0); atomicAdd(MOD + NMOD + col, a1); atomicAdd(MOD + 2 * NMOD + col, a2); atomicAdd(MOD + 3 * NMOD + col, a3); }
    if (!with_rest) return;
    LAS float* scr = (LAS float*)(lds + wave * 16384);
    constexpr int I_IN = (D / 64) * (INW / 32), I_OUT = (D / 64) * (D / 32), I_UP = (D / 64) * (FF2 / 32), I_DOWN = (FF / 64) * (D / 32), I_POOL = 4 * 2 * 4;
    constexpr int NITEMS = I_IN + I_OUT + I_UP + I_DOWN + I_POOL;
    for (int it = gw; it < NITEMS; it += NGW) { int r = it;
        if (r < I_IN) { const int nb = INW / 32, kb = r / nb, n0 = 32 * (r % nb); transpose_item(a.in[I_WIN], D, INW, (bf16*)(ws + WS_WIN), 64 * kb, n0, n0, scr, lane); continue; } r -= I_IN;
        if (r < I_OUT) { const int nb = D / 32, kb = r / nb, n0 = 32 * (r % nb); transpose_item(a.in[I_WOUT], D, D, (bf16*)(ws + WS_WOUT), 64 * kb, n0, n0, scr, lane); continue; } r -= I_OUT;
        if (r < I_UP) { const int nb = FF2 / 32, kb = r / nb, n0 = 32 * (r % nb); const int half = n0 / FF, f = n0 % FF, drow = 256 * (f / 128) + 128 * half + (f % 128);
            transpose_item(a.in[I_WUP], D, FF2, (bf16*)(ws + WS_WUP), 64 * kb, n0, drow, scr, lane); continue; } r -= I_UP;
        if (r < I_DOWN) { const int nb = D / 32, kb = r / nb, n0 = 32 * (r % nb); transpose_item(a.in[I_WDOWN], FF, D, (bf16*)(ws + WS_WDOWN), 64 * kb, n0, n0, scr, lane); continue; } r -= I_DOWN;
        { const int g = r / 8, q = r % 8, kb = q / 4, n0 = 32 * (q % 4); transpose_item(a.in[I_WPOOL] + (size_t)g * 16384, 128, 128, (bf16*)(ws + WS_WPOOL) + (size_t)g * 16384, 64 * kb, n0, n0, scr, lane); } }
    { const float* wsp = a.in[I_WSP]; bf16* o = (bf16*)(ws + WS_WSP);
        for (int e = gw * 64 + lane; e < 4 * 128 * 128; e += NGW * 64) { const int i = (e >> 7) & 127, j = e & 127; const float v = ((j >> 6) <= (i >> 6)) ? wsp[e] : 0.f; o[e] = (bf16)f2bf(v); } }
}

__device__ __forceinline__ void p1_norm(const Args& a, int gw, int NGW, int lane) {
    const float* MOD = (const float*)(a.ws + OFF_MOD); bf16* XN = (bf16*)(a.ws + WS_XN); const float* x = a.in[I_X]; const float* g = a.in[I_PREMIXG]; float* SXX = (float*)(a.ws + WS_SXX);
    const int rpw = M / NGW;
    for (int r0 = gw * rpw; r0 < M; r0 += NGW * rpw) { const int b = r0 / SEQ; const float* mb = MOD + (size_t)b * NMOD;
        f32x4 A[4], B[4];
#pragma unroll
        for (int j = 0; j < 4; ++j) { const int col = 4 * lane + 256 * j; const f32x4 gg = *(const f32x4*)(g + col), sc = *(const f32x4*)(mb + D + col); A[j] = gg * (1.0f + sc); B[j] = *(const f32x4*)(mb + col); }
        f32x4 nx[4];
        { const f32x4* xr = (const f32x4*)(x + (size_t)r0 * D) + lane;
#pragma unroll
            for (int j = 0; j < 4; ++j) nx[j] = __builtin_nontemporal_load(xr + 64 * j); }
        for (int r = r0; r < r0 + rpw; ++r) { f32x4 v[4]; float s = 0.f;
#pragma unroll
            for (int j = 0; j < 4; ++j) { v[j] = nx[j]; s += (v[j].x * v[j].x + v[j].y * v[j].y) + (v[j].z * v[j].z + v[j].w * v[j].w); }
            if (r + 1 < r0 + rpw) { const f32x4* xr = (const f32x4*)(x + (size_t)(r + 1) * D) + lane;
#pragma unroll
                for (int j = 0; j < 4; ++j) nx[j] = __builtin_nontemporal_load(xr + 64 * j); }
            const float st = wave_sum(s);
            const float rs = 1.0f / sqrtf(st * (1.0f / D) + EPS);
            v2u* o = (v2u*)(XN + (size_t)r * D) + lane;
#pragma unroll
            for (int j = 0; j < 4; ++j) { const f32x4 h = v[j] * rs * A[j] + B[j]; const unsigned long long w = (unsigned long long)pk2(h.x, h.y) | ((unsigned long long)pk2(h.z, h.w) << 32);
                __hip_atomic_store((unsigned long long*)(o + 64 * j), w, __ATOMIC_RELAXED, __HIP_MEMORY_SCOPE_AGENT); } } }
}

constexpr int P3_RA = 0, P3_RB = 34816, P3_RP = 69632, P3_RC = 108800, P3_PA = 272, P3_PV = 272;
__device__ __forceinline__ void p3_mma(LAS unsigned char* lds, bool natural_b, f32x4 (&acc)[4][2], int wr, int wc, int fr, int fq) {
#pragma unroll
    for (int m = 0; m < 4; ++m)
#pragma unroll
        for (int n = 0; n < 2; ++n) acc[m][n] = (f32x4){0.f, 0.f, 0.f, 0.f};
#pragma unroll
    for (int kk = 0; kk < 4; ++kk) { bf16x8 af[4], bfr[2];
#pragma unroll
        for (int m = 0; m < 4; ++m) af[m] = *(const LAS bf16x8*)(lds + P3_RA + (64 * wr + 16 * m + fr) * P3_PA + (32 * kk + 8 * fq) * 2);
        if (natural_b) {
            { const unsigned addr = (unsigned)(size_t)(lds + P3_RB) + (unsigned)((32 * kk + 8 * fq + (fr >> 2)) * P3_PV + (32 * wc + 8 * (fr & 3)) * 2);
                v2u l0, h0, l1, h1;
                asm volatile("ds_read_b64_tr_b16 %0, %4\n\tds_read_b64_tr_b16 %1, %4 offset:%5\n\tds_read_b64_tr_b16 %2, %4 offset:8\n\tds_read_b64_tr_b16 %3, %4 offset:%6\n\ts_waitcnt lgkmcnt(0)"
                             : "=&v"(l0), "=&v"(h0), "=&v"(l1), "=&v"(h1) : "v"(addr), "n"(4 * P3_PV), "n"(4 * P3_PV + 8) : "memory");
                v4u w0, w1; w0.x = l0.x; w0.y = l0.y; w0.z = h0.x; w0.w = h0.y; w1.x = l1.x; w1.y = l1.y; w1.z = h1.x; w1.w = h1.y;
                bfr[0] = __builtin_bit_cast(bf16x8, w0); bfr[1] = __builtin_bit_cast(bf16x8, w1); }
        } else {
#pragma unroll
            for (int n = 0; n < 2; ++n) bfr[n] = *(const LAS bf16x8*)(lds + P3_RB + (32 * wc + 8 * (fr >> 2) + 4 * n + (fr & 3)) * P3_PA + (32 * kk + 8 * fq) * 2);
        }
#pragma unroll
        for (int m = 0; m < 4; ++m)
#pragma unroll
            for (int n = 0; n < 2; ++n) acc[m][n] = __builtin_amdgcn_mfma_f32_16x16x32_bf16(bfr[n], af[m], acc[m][n], 0, 0, 0); }
}
template <int W> __device__ __forceinline__ void p3_pool(LAS unsigned char* lds, int tid, int s0) {
    const int ch = tid & 15, tq = 4 * (tid >> 4); const LAS unsigned char* rp = lds + P3_RP + ch * 16; float sum[8];
#pragma unroll
    for (int e = 0; e < 8; ++e) sum[e] = 0.f;
#pragma unroll 3
    for (int k = 1; k < W; ++k) { const v4u r = *(const LAS v4u*)(rp + (16 + tq - k) * P3_PA);
        sum[0] += bf_lo(r.x); sum[1] += bf_hi(r.x); sum[2] += bf_lo(r.y); sum[3] += bf_hi(r.y); sum[4] += bf_lo(r.z); sum[5] += bf_hi(r.z); sum[6] += bf_lo(r.w); sum[7] += bf_hi(r.w); }
#pragma unroll
    for (int rr = 0; rr < 4; ++rr) { const int t = tq + rr; const v4u cur = *(const LAS v4u*)(rp + (16 + t) * P3_PA);
        sum[0] += bf_lo(cur.x); sum[1] += bf_hi(cur.x); sum[2] += bf_lo(cur.y); sum[3] += bf_hi(cur.y); sum[4] += bf_lo(cur.z); sum[5] += bf_hi(cur.z); sum[6] += bf_lo(cur.w); sum[7] += bf_hi(cur.w);
        const int cnt = (s0 + t + 1) < W ? (s0 + t + 1) : W; const float inv = 1.0f / (float)cnt;
        v4u o; o.x = pk2(sum[0] * inv - bf_lo(cur.x), sum[1] * inv - bf_hi(cur.x)); o.y = pk2(sum[2] * inv - bf_lo(cur.y), sum[3] * inv - bf_hi(cur.y));
        o.z = pk2(sum[4] * inv - bf_lo(cur.z), sum[5] * inv - bf_hi(cur.z)); o.w = pk2(sum[6] * inv - bf_lo(cur.w), sum[7] * inv - bf_hi(cur.w));
        *(LAS v4u*)(lds + P3_RA + t * P3_PA + ch * 16) = o;
        if (rr < 3) { const v4u old = *(const LAS v4u*)(rp + (16 + t - (W - 1)) * P3_PA);
            sum[0] -= bf_lo(old.x); sum[1] -= bf_hi(old.x); sum[2] -= bf_lo(old.y); sum[3] -= bf_hi(old.y); sum[4] -= bf_lo(old.z); sum[5] -= bf_hi(old.z); sum[6] -= bf_lo(old.w); sum[7] -= bf_hi(old.w); } }
}
struct P3Regs { v4u a0, a1, a2, a3, b0, b1, b2, b3, b4; };
#define P3_RA_(R, it) ((it) == 0 ? (R).a0 : (it) == 1 ? (R).a1 : (it) == 2 ? (R).a2 : (R).a3)
#define P3_RB_(R, it) ((it) == 0 ? (R).b0 : (it) == 1 ? (R).b1 : (it) == 2 ? (R).b2 : (it) == 3 ? (R).b3 : (R).b4)
__device__ __forceinline__ void p3_prefetch(P3Regs& R, int item, int t0, int s0, int tid, const bf16* PROJ, const bf16* WSP, const bf16* WPOOL, bool xhalo = false) {
    if (item < 4) { const int h = item;
#pragma unroll
        for (int it = 0; it < 4; ++it) { const int idx = tid + 512 * it, row = idx >> 4, ch = idx & 15;
            const v4u va = *(const v4u*)(WSP + (size_t)h * 16384 + row * 128 + ch * 8), vb = __builtin_nontemporal_load((const v4u*)(PROJ + (size_t)(t0 + row) * INW + AW + 128 * h + 8 * ch));
            if (it == 0) { R.a0 = va; R.b0 = vb; } else if (it == 1) { R.a1 = va; R.b1 = vb; } else if (it == 2) { R.a2 = va; R.b2 = vb; } else { R.a3 = va; R.b3 = vb; } }
    } else { const int g = item - 4;
#pragma unroll
        for (int it = 0; it < 4; ++it) { const int idx = tid + 512 * it, row = idx >> 4, ch = idx & 15; const v4u va = *(const v4u*)(WPOOL + (size_t)g * 16384 + row * 128 + ch * 8);
            if (it == 0) R.a0 = va; else if (it == 1) R.a1 = va; else if (it == 2) R.a2 = va; else R.a3 = va; }
#pragma unroll
        for (int it = 0; it < 5; ++it) { const int idx = tid + 512 * it, row = idx >> 4, ch = idx & 15; v4u raw = {0u, 0u, 0u, 0u};
            if (row < 144 && s0 + row >= 16) { const bf16* src = PROJ + (size_t)(t0 + row - 16) * INW + 2 * AW + 128 * g + 8 * ch;
                if (xhalo && row < 16) { const unsigned long long w0 = __hip_atomic_load((const unsigned long long*)src, __ATOMIC_RELAXED, __HIP_MEMORY_SCOPE_AGENT), w1 = __hip_atomic_load((const unsigned long long*)src + 1, __ATOMIC_RELAXED, __HIP_MEMORY_SCOPE_AGENT);
                    raw.x = (unsigned)w0; raw.y = (unsigned)(w0 >> 32); raw.z = (unsigned)w1; raw.w = (unsigned)(w1 >> 32); }
                else raw = __builtin_nontemporal_load((const v4u*)src); }
            if (it == 0) R.b0 = raw; else if (it == 1) R.b1 = raw; else if (it == 2) R.b2 = raw; else if (it == 3) R.b3 = raw; else R.b4 = raw; } }
}
__device__ __forceinline__ void p3_item(P3Regs& R, const int item, const int t0, const int s0, const int tid0, LAS unsigned char* lds, const LAS float* RC, const bf16* PROJ, bf16* MIXIN, const bf16* WSP, const bf16* WPOOL,
                                        const int wr, const int wc, const int fr, const int fq, const bool xhalo) {
    f32x4 acc[4][2];
            int tl = tid0; asm volatile("" : "+v"(tl));
            const int tid = tl;
            if (item < 4) { const int h = item;
#pragma unroll
                for (int it = 0; it < 4; ++it) { const int idx = tid + 512 * it, row = idx >> 4, ch = idx & 15;
                    *(LAS v4u*)(lds + P3_RA + row * P3_PA + ch * 16) = P3_RA_(R, it);
                    const v4u raw = P3_RB_(R, it);
                    float v[8]; v[0] = bf_lo(raw.x); v[1] = bf_hi(raw.x); v[2] = bf_lo(raw.y); v[3] = bf_hi(raw.y); v[4] = bf_lo(raw.z); v[5] = bf_hi(raw.z); v[6] = bf_lo(raw.w); v[7] = bf_hi(raw.w);
                    float s = 0.f;
#pragma unroll
                    for (int e = 0; e < 8; ++e) s += v[e] * v[e];
                    s += __shfl_xor(s, 1); s += __shfl_xor(s, 2); s += __shfl_xor(s, 4); s += __shfl_xor(s, 8);
                    const float rs = __builtin_amdgcn_rsqf(s * (1.0f / 128.0f) + EPS);
                    const f32x4 g0 = *(const LAS f32x4*)(RC + 128 * h + 8 * ch), g1 = *(const LAS f32x4*)(RC + 128 * h + 8 * ch + 4);
                    v2u w0, w1; w0.x = pk2(v[0] * rs * g0.x, v[1] * rs * g0.y); w0.y = pk2(v[2] * rs * g0.z, v[3] * rs * g0.w); w1.x = pk2(v[4] * rs * g1.x, v[5] * rs * g1.y); w1.y = pk2(v[6] * rs * g1.z, v[7] * rs * g1.w);
                    v4u w01; w01.x = w0.x; w01.y = w0.y; w01.z = w1.x; w01.w = w1.y; *(LAS v4u*)(lds + P3_RB + row * P3_PV + ch * 16) = w01; }
                __syncthreads();
                if (item + 2 < 8) p3_prefetch(R, item + 2, t0, s0, tid, PROJ, WSP, WPOOL, xhalo);
                v4u ur[4]; float bias[4];
#pragma unroll
                for (int m = 0; m < 4; ++m) { const int i = 64 * wr + 16 * m + fr; bias[m] = RC[512 + 128 * h + i];
                    ur[m] = *(const v4u*)(PROJ + (size_t)(t0 + i) * INW + 128 * h + 32 * wc + 8 * fq); }
                p3_mma(lds, true, acc, wr, wc, fr, fq);
#pragma unroll
                for (int m = 0; m < 4; ++m) { const int i = 64 * wr + 16 * m + fr;
#pragma unroll
                    for (int n = 0; n < 1; ++n) { const int c = 128 * h + 32 * wc + 8 * fq; const v4u u4 = ur[m]; const float bi = bias[m]; const f32x4 z0 = acc[m][0], z1 = acc[m][1]; v4u w;
                        w.x = pk2(bf_lo(u4.x) * (z0[0] + bi), bf_hi(u4.x) * (z0[1] + bi)); w.y = pk2(bf_lo(u4.y) * (z0[2] + bi), bf_hi(u4.y) * (z0[3] + bi));
                        w.z = pk2(bf_lo(u4.z) * (z1[0] + bi), bf_hi(u4.z) * (z1[1] + bi)); w.w = pk2(bf_lo(u4.w) * (z1[2] + bi), bf_hi(u4.w) * (z1[3] + bi));
                        *(v4u*)(MIXIN + (size_t)(t0 + i) * D + c) = w; } }
                __syncthreads();
            } else { const int g = item - 4, w = 2 << g;
#pragma unroll
                for (int it = 0; it < 4; ++it) { const int idx = tid + 512 * it, row = idx >> 4, ch = idx & 15; *(LAS v4u*)(lds + P3_RB + row * P3_PA + ch * 16) = P3_RA_(R, it); }
#pragma unroll
                for (int it = 0; it < 5; ++it) { const int idx = tid + 512 * it, row = idx >> 4, ch = idx & 15; if (row < 144) *(LAS v4u*)(lds + P3_RP + row * P3_PA + ch * 16) = P3_RB_(R, it); }
                __syncthreads();
                if (item + 2 < 8) p3_prefetch(R, item + 2, t0, s0, tid, PROJ, WSP, WPOOL, xhalo);
                switch (g) { case 0: p3_pool<2>(lds, tid, s0); break; case 1: p3_pool<4>(lds, tid, s0); break; case 2: p3_pool<8>(lds, tid, s0); break; default: p3_pool<16>(lds, tid, s0); break; }
                __syncthreads();
                p3_mma(lds, false, acc, wr, wc, fr, fq);
#pragma unroll
                for (int m = 0; m < 4; ++m) { const int t = 64 * wr + 16 * m + fr;
#pragma unroll
                    for (int n = 0; n < 1; ++n) { const int d = 128 * g + 32 * wc + 8 * fq; const f32x4 y0 = acc[m][0] * *(const LAS f32x4*)(RC + 1024 + d), y1 = acc[m][1] * *(const LAS f32x4*)(RC + 1024 + d + 4);
                        v4u wv; wv.x = pk2(y0[0], y0[1]); wv.y = pk2(y0[2], y0[3]); wv.z = pk2(y1[0], y1[1]); wv.w = pk2(y1[2], y1[3]); *(v4u*)(MIXIN + (size_t)(t0 + t) * D + AW + d) = wv; } }
                __syncthreads();
            }
}
__device__ __forceinline__ void p3_mixers(const Args& a, LAS unsigned char* lds, int tid0, int rb, unsigned* xwait, unsigned xgen) {
    const int lane = tid0 & 63, wave = tid0 >> 6, wr = wave >> 2, wc = wave & 3, fr = lane & 15, fq = lane >> 4;
    const bf16* PROJ = (const bf16*)(a.ws + WS_PROJ); bf16* MIXIN = (bf16*)(a.ws + WS_MIXIN);
    const bf16* WSP = (const bf16*)(a.ws + WS_WSP); const bf16* WPOOL = (const bf16*)(a.ws + WS_WPOOL);
    const float* sgug = a.in[I_SGUG]; const float* bsp = a.in[I_BSP]; const float* pscale = a.in[I_PSCALE];
    { LAS float* rc = (LAS float*)(lds + P3_RC); rc[tid0] = sgug[tid0]; rc[512 + tid0] = bsp[tid0]; rc[1024 + tid0] = pscale[tid0]; }
    __syncthreads();
    const LAS float* RC = (const LAS float*)(lds + P3_RC);
    for (int tb = rb; tb < M / 128; tb += gridDim.x) { const int t0 = tb * 128, s0 = t0 % SEQ;
        const bool xhalo = xwait != nullptr && (tb & 31) == 0 && s0 != 0;
        if (xhalo) { unsigned sp = 0; while ((unsigned)__builtin_amdgcn_readfirstlane(__hip_atomic_load(xwait, __ATOMIC_RELAXED, __HIP_MEMORY_SCOPE_AGENT)) < xgen) { __builtin_amdgcn_s_sleep(2); if (++sp > (1u << 22)) break; } }
        P3Regs R;
        p3_prefetch(R, 0, t0, s0, tid0, PROJ, WSP, WPOOL);
        P3Regs Rb;
        p3_prefetch(Rb, 1, t0, s0, tid0, PROJ, WSP, WPOOL);
        for (int it2 = 0; it2 < 4; ++it2) {
            p3_item(R, 2 * it2, t0, s0, tid0, lds, RC, PROJ, MIXIN, WSP, WPOOL, wr, wc, fr, fq, xhalo);
            p3_item(Rb, 2 * it2 + 1, t0, s0, tid0, lds, RC, PROJ, MIXIN, WSP, WPOOL, wr, wc, fr, fq, xhalo); } }
}

__device__ __forceinline__ void p4b_mid(const Args& a, int gw, int NGW, int lane) {
    const float* MOD = (const float*)(a.ws + OFF_MOD); const float* SS1 = (const float*)(a.ws + OFF_SS1); const bf16* MIXED = (const bf16*)(a.ws + WS_MIXED); bf16* XN = (bf16*)(a.ws + WS_XN);
    const float* x = a.in[I_X]; const float* pg = a.in[I_POSTMIXG]; const float* fg = a.in[I_PREFFNG]; bf16* X1B = (bf16*)(a.ws + WS_X1B);
    const int rpw = M / NGW;
    for (int r0 = gw * rpw; r0 < M; r0 += NGW * rpw) { const int b = r0 / SEQ; const float* mb = MOD + (size_t)b * NMOD;
        f32x4 A1[4], A2[4], A3[4];
#pragma unroll
        for (int j = 0; j < 4; ++j) { const int col = 4 * lane + 256 * j; A1[j] = *(const f32x4*)(mb + 2 * D + col) * *(const f32x4*)(pg + col);
            A2[j] = *(const f32x4*)(fg + col) * (1.0f + *(const f32x4*)(mb + 4 * D + col)); A3[j] = *(const f32x4*)(mb + 3 * D + col); }
        f32x4 nx[4]; v2u nm[4];
        { const f32x4* xr = (const f32x4*)(x + (size_t)r0 * D) + lane; const v2u* mr = (const v2u*)(MIXED + (size_t)r0 * INW) + lane;
#pragma unroll
            for (int j = 0; j < 4; ++j) { nx[j] = __builtin_nontemporal_load(xr + 64 * j); nm[j] = __builtin_nontemporal_load(mr + 64 * j); } }
        const float ssv = (lane < rpw) ? SS1[r0 + lane] : 0.f;
        for (int r = r0; r < r0 + rpw; ++r) {
            const float rs1 = __builtin_amdgcn_rsqf(__builtin_bit_cast(float, __builtin_amdgcn_readlane(__builtin_bit_cast(int, ssv), r - r0)) * (1.0f / D) + EPS); f32x4 v[4]; float s = 0.f;
#pragma unroll
            for (int j = 0; j < 4; ++j) { const v2u mw = nm[j]; const f32x4 mx = {bf_lo(mw.x), bf_hi(mw.x), bf_lo(mw.y), bf_hi(mw.y)};
                v[j] = nx[j] + mx * rs1 * A1[j]; s += (v[j].x * v[j].x + v[j].y * v[j].y) + (v[j].z * v[j].z + v[j].w * v[j].w); }
            if (r + 1 < r0 + rpw) { const f32x4* xr = (const f32x4*)(x + (size_t)(r + 1) * D) + lane; const v2u* mr = (const v2u*)(MIXED + (size_t)(r + 1) * INW) + lane;
#pragma unroll
                for (int j = 0; j < 4; ++j) { nx[j] = __builtin_nontemporal_load(xr + 64 * j); nm[j] = __builtin_nontemporal_load(mr + 64 * j); } }
            v2u* xrow = (v2u*)(X1B + (size_t)r * D) + lane;
#pragma unroll
            for (int j = 0; j < 4; ++j) { v2u w; w.x = pk2(v[j].x, v[j].y); w.y = pk2(v[j].z, v[j].w); __builtin_nontemporal_store(w, xrow + 64 * j); }
            const float rs = __builtin_amdgcn_rsqf(wave_sum(s) * (1.0f / D) + EPS);
            v2u* o = (v2u*)(XN + (size_t)r * D) + lane;
#pragma unroll
            for (int j = 0; j < 4; ++j) { const f32x4 h = v[j] * rs * A2[j] + A3[j]; const unsigned long long w = (unsigned long long)pk2(h.x, h.y) | ((unsigned long long)pk2(h.z, h.w) << 32);
                __hip_atomic_store((unsigned long long*)(o + 64 * j), w, __ATOMIC_RELAXED, __HIP_MEMORY_SCOPE_AGENT); } } }
}

__device__ __forceinline__ void p6b_fixup(const Args& a, int gw, int NGW, int lane) {
    const bf16* RAW = (const bf16*)(a.ws + WS_RAW); bf16* ACT = (bf16*)(a.ws + WS_ACT); const float* cw = a.in[I_CONVW]; const float* cb = a.in[I_CONVB];
    for (int it = 2 * gw; it < 2 * gw + 2; ++it) { const int q = it & 3, rr = (it >> 2) & 1, B = it >> 3; const int t = 64 * B + rr, s = t % SEQ;
        const bf16* cur = RAW + (size_t)(B * 4 + rr) * FF2;
        const bf16* p1 = (rr == 1) ? RAW + (size_t)(B * 4 + 0) * FF2 : (s == 0 ? nullptr : RAW + (size_t)((B - 1) * 4 + 3) * FF2);
        const bf16* p2 = (rr == 1) ? (s == 1 ? nullptr : RAW + (size_t)((B - 1) * 4 + 3) * FF2) : (s == 0 ? nullptr : RAW + (size_t)((B - 1) * 4 + 2) * FF2);
        for (int f = q * 704 + 4 * lane; f < q * 704 + 704; f += 256) { f32x4 y[2];
#pragma unroll
            for (int hv = 0; hv < 2; ++hv) { const int col = hv * FF + f; const f32x4 z = {0.f, 0.f, 0.f, 0.f};
                const v2u zz = {0u, 0u}; const v2u r0 = *(const v2u*)(cur + col), r1 = p1 ? *(const v2u*)(p1 + col) : zz, r2 = p2 ? *(const v2u*)(p2 + col) : zz; (void)z;
                const f32x4 u0 = {bf_lo(r0.x), bf_hi(r0.x), bf_lo(r0.y), bf_hi(r0.y)}, u1 = {bf_lo(r1.x), bf_hi(r1.x), bf_lo(r1.y), bf_hi(r1.y)}, u2 = {bf_lo(r2.x), bf_hi(r2.x), bf_lo(r2.y), bf_hi(r2.y)};
                y[hv] = *(const f32x4*)(cb + col) + *(const f32x4*)(cw + col) * u2 + *(const f32x4*)(cw + FF2 + col) * u1 + *(const f32x4*)(cw + 2 * FF2 + col) * u0; }
            v2u w; w.x = pk2(pg8::silu_f(y[0][0]) * y[1][0], pg8::silu_f(y[0][1]) * y[1][1]); w.y = pk2(pg8::silu_f(y[0][2]) * y[1][2], pg8::silu_f(y[0][3]) * y[1][3]);
            *(v2u*)(ACT + (size_t)t * FF + f) = w; } }
}

#define XB_TMO      128
#define XB_XCNT(j)  (256  + 64 * (j))
#define XB_XSUB(j)  (1280 + 64 * (j))
#define XB_XGEN(j)  (2304 + 64 * (j))
#define XB_TOP      3328
#define XB_TOPGEN   3392
#define XCD_BAR_WORDS 3456
#define XB_SPIN_CAP (1u << 18)

__device__ __forceinline__ unsigned xb_ld(unsigned* p)              { return __hip_atomic_load(p, __ATOMIC_RELAXED, __HIP_MEMORY_SCOPE_AGENT); }
__device__ __forceinline__ unsigned xb_add(unsigned* p, unsigned v) { return __hip_atomic_fetch_add(p, v, __ATOMIC_RELAXED, __HIP_MEMORY_SCOPE_AGENT); }
__device__ __forceinline__ unsigned xb_xcc_id() { return (unsigned)__builtin_amdgcn_s_getreg((3 << 11) | 20) & 0xFu; }
#define XB_SPIN(cond, bar) do { unsigned _sp = 0; while (cond) { __builtin_amdgcn_s_sleep(1); \
    if ((++_sp & 255u) == 0u) { if (xb_ld(&(bar)[XB_TMO])) break; if (_sp > XB_SPIN_CAP) { atomicAdd(&(bar)[XB_TMO], 1u); break; } } } } while (0)

struct XcdBarrier {
    unsigned* bar; unsigned x;
    volatile LAS unsigned* st;
};

__device__ __forceinline__ XcdBarrier xcd_barrier_post(unsigned* bar, volatile LAS unsigned* st) {
    XcdBarrier b; b.bar = bar; b.x = xb_xcc_id(); b.st = st;
    if (threadIdx.x == 0) st[2] = xb_add(&bar[XB_XCNT(b.x)], 1u);
    return b;
}
__device__ __forceinline__ void xcd_barrier_complete(unsigned* bar, unsigned x, unsigned& nloc, unsigned& nx) {
    const unsigned G = gridDim.x * gridDim.y * gridDim.z;
    unsigned sum, cnt, mine, sp = 0u;
    for (;;) {
        sum = 0u; cnt = 0u; mine = 0u;
#pragma unroll
        for (unsigned j = 0; j < 16; ++j) { const unsigned c = xb_ld(&bar[XB_XCNT(j)]); sum += c; cnt += (c > 0u) ? 1u : 0u; mine = (j == x) ? c : mine; }
        if (sum == G) break;
        __builtin_amdgcn_s_sleep(1);
        if ((++sp & 255u) == 0u) { if (xb_ld(&bar[XB_TMO])) break; if (sp > XB_SPIN_CAP) { atomicAdd(&bar[XB_TMO], 1u); break; } }
    }
    nloc = mine > 0u ? mine : 1u; nx = cnt > 0u ? cnt : 1u;
}

__device__ __forceinline__ void xcd_barrier(const XcdBarrier& b) {
    asm volatile("s_waitcnt vmcnt(0)" ::: "memory");
    __syncthreads();
    if (threadIdx.x == 0) {
        unsigned* bar = b.bar;
        __builtin_amdgcn_s_waitcnt(0);
        unsigned nloc = b.st[0], nx = b.st[1];
        if (nloc == 0u) { xcd_barrier_complete(bar, b.x, nloc, nx); b.st[0] = nloc; b.st[1] = nx; }
        const unsigned old = xb_add(&bar[XB_XSUB(b.x)], 1u);
        const unsigned gen = old / nloc;
        if (old + 1u == (gen + 1u) * nloc) {
            __builtin_amdgcn_fence(__ATOMIC_RELEASE, "agent");
            asm volatile("s_waitcnt vmcnt(0)" ::: "memory");
            const unsigned og = xb_add(&bar[XB_TOP], 1u);
            const unsigned tg = og / nx;
            if (og + 1u == (tg + 1u) * nx) xb_add(&bar[XB_TOPGEN], 1u);
            else XB_SPIN(xb_ld(&bar[XB_TOPGEN]) == tg, bar);
            __builtin_amdgcn_fence(__ATOMIC_ACQUIRE, "agent");
            xb_add(&bar[XB_XGEN(b.x)], 1u);
            asm volatile("s_waitcnt vmcnt(0)" ::: "memory");
        } else {
            XB_SPIN(xb_ld(&bar[XB_XGEN(b.x)]) == gen, bar);
            __builtin_amdgcn_fence(__ATOMIC_ACQUIRE, "agent");
            asm volatile("s_waitcnt vmcnt(0)" ::: "memory");
        }
    }
    __syncthreads();
}
#define XL_SUB(j)  (4096 + 64 * (j))
#define XL_GEN(j)  (5120 + 64 * (j))
__device__ __forceinline__ void xcd_local_barrier(const XcdBarrier& b) {
    asm volatile("s_waitcnt vmcnt(0)" ::: "memory");
    __syncthreads();
    if (threadIdx.x == 0) { unsigned* bar = b.bar; const unsigned nloc = b.st[0];
        const unsigned old = xb_add(&bar[XL_SUB(b.x)], 1u); const unsigned gen = old / nloc;
        if (old + 1u == (gen + 1u) * nloc) xb_add(&bar[XL_GEN(b.x)], 1u);
        else XB_SPIN(xb_ld(&bar[XL_GEN(b.x)]) == gen, bar);
        __builtin_amdgcn_fence(__ATOMIC_ACQUIRE, "agent");
        asm volatile("s_waitcnt vmcnt(0)" ::: "memory"); }
    __syncthreads();
}
__global__ void __launch_bounds__(NWAVES * 64, 2) mk_fwd(Args args) {
    extern __shared__ __attribute__((aligned(16))) unsigned char lds_raw[];
    LAS unsigned char* lds = (LAS unsigned char*)lds_raw;
    const int tid = threadIdx.x, lane = tid & 63, wave = __builtin_amdgcn_readfirstlane(tid >> 6);
    const int G = gridDim.x, gw = blockIdx.x * NWAVES + wave, NGW = G * NWAVES;
    const int lo = args.ph_lo, hi = args.ph_hi;
    unsigned char* ws = args.ws;
    if (tid < 64) ((LAS unsigned*)(lds + LDSCTL_OFF))[tid] = 0u;
    __syncthreads();
    XcdBarrier bar = xcd_barrier_post((unsigned*)(ws + OFF_BAR), (volatile LAS unsigned*)(lds + LDSCTL_OFF) + 8);
#define IN(k) (lo <= (k) && (k) < hi)
#define NREP(k) ((MK_REPEAT == (k) || ((k) == 4 && (MK_REPEAT == 41 || MK_REPEAT == 42))) ? 2 : 1)
#define SEAM(k) do { if (IN(k) && IN((k) + 1)) xcd_barrier(bar); } while (0)
    if (lo < 0) cg::this_grid().sync();
    if (IN(0)) { p0_prologue(args, lds, gw, NGW, lane, wave, true, true); }
    SEAM(0);
    int cvirt = (int)blockIdx.x; bool xlocal = false;
    if (lo == 0 && hi > 2 && (G & 7) == 0) { bool even = true;
#pragma unroll
        for (int j = 0; j < 16; ++j) { const unsigned cj = xb_ld(&bar.bar[XB_XCNT(j)]); even = even && (cj == (j < 8 ? (unsigned)(G >> 3) : 0u)); }
        if (even && bar.x < 8u) { cvirt = (int)(bar.st[2] * 8u + bar.x); xlocal = true; } }
    cvirt = __builtin_amdgcn_readfirstlane(cvirt);
    const int rb = xlocal ? (cvirt & 7) * (G >> 3) + (cvirt >> 3) : (int)blockIdx.x;
    unsigned lgen = 0;
#define LSEAM() do { if (xlocal) { xcd_local_barrier(bar); ++lgen; } else xcd_barrier(bar); } while (0)
    if (IN(1)) { for (int rep = 0; rep < NREP(1); ++rep) { if (rep) xcd_barrier(bar); p1_norm(args, rb * NWAVES + wave, NGW, lane); } }
    if (IN(1) && IN(2)) LSEAM();
    if (IN(2)) { pg8::Gemm g{(const bf16*)(ws + WS_XN), (const bf16*)(ws + WS_WIN), M, INW, D}; pg8::StaticOrder S; S.init(M, INW, G, cvirt);
        pg8::EpiProj E{(bf16*)(ws + WS_PROJ), INW};
        for (int rep = 0; rep < NREP(2); ++rep) { if (rep) xcd_barrier(bar); pg8::gemm_phase<pg8::EpiProj, pg8::StaticOrder, true, true>(lds, g, S, E); } }
    if (IN(2) && IN(3)) LSEAM();
    if (IN(3)) { for (int rep = 0; rep < NREP(3); ++rep) { if (rep) xcd_barrier(bar); __syncthreads(); p3_mixers(args, lds, tid, rb, (xlocal && bar.x > 0u) ? &bar.bar[XL_GEN(bar.x - 1u)] : nullptr, lgen); } }
    if (IN(3) && IN(4)) LSEAM();
    if (IN(4)) { pg8::Gemm g{(const bf16*)(ws + WS_MIXIN), (const bf16*)(ws + WS_WOUT), M, D, D}; pg8::StaticOrder S; S.init(M, D, G, cvirt);
        pg8::EpiBf16SS E{(bf16*)(ws + WS_MIXED), INW, (float*)(ws + OFF_SS1)};
        pg8::gemm_phase<pg8::EpiBf16SS, pg8::StaticOrder, true, true>(lds, g, S, E);
        LSEAM();
        p4b_mid(args, rb * NWAVES + wave, NGW, lane); }
    if (IN(4) && IN(5)) LSEAM();
    if (IN(5)) { pg8::Gemm g{(const bf16*)(ws + WS_XN), (const bf16*)(ws + WS_WUP), M, FF2, D}; pg8::StaticOrder S; S.init(M, FF2, G, cvirt);
        pg8::EpiConv E{(bf16*)(ws + WS_ACT), (bf16*)(ws + WS_RAW), args.in[I_CONVW], args.in[I_CONVB], FF, lds + LDSCTL_OFF + 4096};
        for (int rep = 0; rep < NREP(5); ++rep) { if (rep) xcd_barrier(bar); pg8::gemm_phase<pg8::EpiConv, pg8::StaticOrder, true, true>(lds, g, S, E); } }
    SEAM(5);
    if (IN(6)) { p6b_fixup(args, rb * NWAVES + wave, NGW, lane); }
    if (IN(6) && IN(7)) LSEAM();
    if (IN(7)) { pg8::Gemm g{(const bf16*)(ws + WS_ACT), (const bf16*)(ws + WS_WDOWN), M, D, FF}; pg8::StaticOrder S; S.init(M, D, G, cvirt);
        for (int rep = 0; rep < NREP(7); ++rep) { if (rep) xcd_barrier(bar);
        pg8::RowStat st{(float*)(ws + (rep ? 736 * 1024 : OFF_SS4)), (unsigned*)(ws + (rep ? 640 * 1024 : OFF_CNT + 32768)), 32u, 1.0f / D, EPS};
        pg8::EpiFinal E{(const bf16*)(ws + WS_X1B), rep ? (float*)(ws + WS_F) : args.out, (const float*)(ws + OFF_MOD), args.in[I_POSTFFNG], st, D, SEQ / 256};
        pg8::gemm_phase<pg8::EpiFinal, pg8::StaticOrder, true, true>(lds, g, S, E); } }
    if (MK_REPEAT == 17 && IN(7)) { xcd_barrier(bar); pg8::Gemm g{(const bf16*)(ws + WS_ACT), (const bf16*)(ws + WS_WDOWN), M, D, FF}; pg8::StaticOrder S; S.init(M, D, G, (int)blockIdx.x);
        pg8::EpiSink E{(float*)(ws + WS_F)}; pg8::gemm_phase<pg8::EpiSink, pg8::StaticOrder, true, true>(lds, g, S, E); }
#undef IN
#undef SEAM
}

constexpr int N_PHASES = 8;
extern "C" void kernel_launch(void* const* d_in, const int* in_sizes, int n_in, void* d_out, int out_size, void* d_ws, size_t ws_size, hipStream_t stream) {
    static int grid = 0;
    if (grid == 0) {
        if (n_in != 19 || in_sizes[0] != M * D || out_size != M * D || ws_size < WS_END) { fprintf(stderr, "kernel_launch: unexpected shapes (n_in %d, in0 %d, out %d, ws %zu)\n", n_in, n_in > 0 ? in_sizes[0] : -1, out_size, ws_size); grid = -1; return; }
        int dev = 0, cus = 0, per_cu = 0;
        (void)hipGetDevice(&dev); (void)hipDeviceGetAttribute(&cus, hipDeviceAttributeMultiprocessorCount, dev);
        if (hipFuncSetAttribute((const void*)mk_fwd, hipFuncAttributeMaxDynamicSharedMemorySize, LDS_BYTES) != hipSuccess) { fprintf(stderr, "kernel_launch: hipFuncSetAttribute failed\n"); grid = -1; return; }
        if (hipOccupancyMaxActiveBlocksPerMultiprocessor(&per_cu, (const void*)mk_fwd, NWAVES * 64, LDS_BYTES) != hipSuccess || per_cu < 1) { fprintf(stderr, "kernel_launch: occupancy query says %d blocks per CU\n", per_cu); per_cu = 1; }
        (void)hipGetLastError();
        grid = cus > 0 ? cus : 256;
    }
    if (grid < 0) return;
    (void)hipMemsetAsync((char*)d_ws + WS_CTL, 0, CTL_ZERO_BYTES, stream);
    Args a{};
    for (int i = 0; i < 19; ++i) a.in[i] = (const float*)d_in[i];
    a.out = (float*)d_out; a.ws = (unsigned char*)d_ws;
#if MK_N_LAUNCHES == 1
    a.ph_lo = 0; a.ph_hi = N_PHASES;
    void* kargs[] = {&a};
    hipError_t e = hipLaunchCooperativeKernel((const void*)mk_fwd, dim3(grid), dim3(NWAVES * 64), kargs, LDS_BYTES, stream);
    if (e != hipSuccess) fprintf(stderr, "kernel_launch: cooperative launch failed: %s (grid %d)\n", hipGetErrorString(e), grid);
#else
    for (int p = 0; p < N_PHASES; ++p) { a.ph_lo = p; a.ph_hi = p + 1; hipLaunchKernelGGL(mk_fwd, dim3(grid), dim3(NWAVES * 64), LDS_BYTES, stream, a); }
#endif
}
```

```cpp
#include <hip/hip_runtime.h>
#include <hip/hip_cooperative_groups.h>
#include <cstdio>
#include <cstdint>
namespace cg = cooperative_groups;
#ifndef MK_N_LAUNCHES
#define MK_N_LAUNCHES 1
#endif
#ifndef MK_REPEAT
#define MK_REPEAT -1
#endif
namespace pg8 {
#define PG8_LAS __attribute__((address_space(3)))
typedef unsigned short bf16_t;
typedef short bf16x8 __attribute__((ext_vector_type(8)));
typedef float f32x4 __attribute__((ext_vector_type(4)));
typedef unsigned u32x4 __attribute__((ext_vector_type(4)));
constexpr int BM = 256, BK = 64, HALF = 128, HTB = HALF * BK * 2  , STAGE_BYTES = 8 * HTB, NXCD = 8, WGM = 4;

__host__ __device__ __forceinline__ int lds_byte(int r, int c) { const int st = (r >> 4) * 2 + (c >> 5), rr = r & 15, cc = c & 31, ob = rr * 64 + cc * 2; return st * 1024 + (ob ^ (((ob >> 9) & 1) << 5)); }
__host__ __device__ __forceinline__ void stage_rc(int b, int& R, int& C) { const int st = b / 1024, sb = b % 1024, swz = sb ^ (((sb >> 9) & 1) << 5); R = (st >> 1) * 16 + swz / 64; C = (st & 1) * 32 + (swz % 64) / 2; }
__host__ __device__ __forceinline__ int perm32(int rho) { const int n = rho >> 4, i = rho & 15; return 8 * (i >> 2) + 4 * n + (i & 3); }

struct Unit { int pm, pn; };
struct Gemm { const bf16_t* A; const bf16_t* Bt; int M, N, K; };

struct StaticOrder {
    int nM, nN, nwg, G, c;
    __host__ __device__ void init(int M, int N, int G_, int c_) { nM = M / BM; nN = N / BM; nwg = nM * nN; G = G_; c = c_; }
    __host__ __device__ bool next(int i, Unit& u) const {
        const long L = (long)i * G + c; if (L >= nwg) return false;
        int wgid = (int)L; { const int q = nwg / NXCD, r = nwg % NXCD, xcd = wgid % NXCD, off = wgid / NXCD; wgid = (xcd < r ? xcd * (q + 1) : r * (q + 1) + (xcd - r) * q) + off; }
        const int nig = WGM * nN, gid = wgid / nig, fm = gid * WGM, gsz = (nM - fm) < WGM ? (nM - fm) : WGM;
        u.pm = fm + ((wgid % nig) % gsz); u.pn = (wgid % nig) / gsz; return true;
    }
    __device__ __forceinline__ void a_ready(const Unit&) const {}
    __device__ __forceinline__ void done(const Unit&) const {}
};

__device__ __forceinline__ unsigned cvt_pk_bf16(float lo, float hi) { unsigned r; asm volatile("v_cvt_pk_bf16_f32 %0, %1, %2" : "=v"(r) : "v"(lo), "v"(hi)); return r; }
typedef float f32x2 __attribute__((ext_vector_type(2)));
typedef unsigned u32x2 __attribute__((ext_vector_type(2)));
__device__ __forceinline__ float fast_sigmoid_arg2(float p) { return __builtin_amdgcn_rcpf(1.0f + __builtin_amdgcn_exp2f(p)); }
__device__ __forceinline__ float gelu_tanh(float x) {
    const float t = x * x; const float p = x * (-2.302208198f + (-0.1029432397f) * t); return x * fast_sigmoid_arg2(p);
}
__device__ __forceinline__ float silu_f(float x) { return x * fast_sigmoid_arg2(x * (-1.4426950409f)); }
__device__ __forceinline__ float dpp_ror1(float x) { return __builtin_bit_cast(float, __builtin_amdgcn_update_dpp(0, __builtin_bit_cast(int, x), 0x121, 0xf, 0xf, false)); }
__device__ __forceinline__ float dpp_ror2(float x) { return __builtin_bit_cast(float, __builtin_amdgcn_update_dpp(0, __builtin_bit_cast(int, x), 0x122, 0xf, 0xf, false)); }

struct EpiProj {
    static constexpr bool PERM = true, AFTER_DRAIN = false, PERMA = false, HAS_PRE = false;
    bf16_t* O; int ldc;
    __device__ __forceinline__ void operator()(const f32x4 (&acc)[2][2][4][2], const Unit& u, int wr, int wc, int fr, int fq) const {
        const int row0 = u.pm * BM + wr * 64 + fr, col0 = u.pn * BM + wc * 32 + 8 * fq; const bool act = u.pn < 4; const bool edge = !act && (u.pm & 15) == 15 && wr == 1;
#pragma unroll
        for (int ai = 0; ai < 2; ++ai)
#pragma unroll
            for (int m = 0; m < 4; ++m) { bf16_t* rowp = O + (size_t)(row0 + ai * HALF + m * 16) * ldc + col0;
#pragma unroll
                for (int bj = 0; bj < 2; ++bj) { f32x4 v0 = acc[ai][bj][m][0], v1 = acc[ai][bj][m][1];
                    if (act) {
#pragma unroll
                        for (int j = 0; j < 4; ++j) { v0[j] = gelu_tanh(v0[j]); v1[j] = gelu_tanh(v1[j]); } }
                    u32x4 w; w.x = cvt_pk_bf16(v0[0], v0[1]); w.y = cvt_pk_bf16(v0[2], v0[3]); w.z = cvt_pk_bf16(v1[0], v1[1]); w.w = cvt_pk_bf16(v1[2], v1[3]);
                    if (edge && ai == 1 && m == 3) {
                        __hip_atomic_store((unsigned long long*)(rowp + bj * HALF), (unsigned long long)w.x | ((unsigned long long)w.y << 32), __ATOMIC_RELAXED, __HIP_MEMORY_SCOPE_AGENT);
                        __hip_atomic_store((unsigned long long*)(rowp + bj * HALF + 4), (unsigned long long)w.z | ((unsigned long long)w.w << 32), __ATOMIC_RELAXED, __HIP_MEMORY_SCOPE_AGENT); }
                    else *(u32x4*)(rowp + bj * HALF) = w; } }
    }
};

struct EpiF32SS {
    static constexpr bool PERM = false, AFTER_DRAIN = false, PERMA = false, HAS_PRE = false;
    float* O; int ldc; float* ss;
    __device__ __forceinline__ void operator()(const f32x4 (&acc)[2][2][4][2], const Unit& u, int wr, int wc, int fr, int fq) const {
        const int row0 = u.pm * BM + wr * 64 + fr, col0 = u.pn * BM + wc * 32 + 4 * fq;
#pragma unroll
        for (int ai = 0; ai < 2; ++ai)
#pragma unroll
            for (int m = 0; m < 4; ++m) { const int row = row0 + ai * HALF + m * 16; float* rowp = O + (size_t)row * ldc + col0; float s = 0.f;
#pragma unroll
                for (int bj = 0; bj < 2; ++bj)
#pragma unroll
                    for (int n = 0; n < 2; ++n) { const f32x4 x = acc[ai][bj][m][n]; s += (x[0] * x[0] + x[1] * x[1]) + (x[2] * x[2] + x[3] * x[3]); *(f32x4*)(rowp + bj * HALF + n * 16) = x; }
                s += __shfl_xor(s, 16); s += __shfl_xor(s, 32);
                if (fq == 0) atomicAdd(ss + row, s); }
    }
};

struct EpiBf16SS {
    static constexpr bool PERM = true, AFTER_DRAIN = false, PERMA = false, HAS_PRE = false;
    bf16_t* O; int ldc; float* ss;
    __device__ __forceinline__ void operator()(const f32x4 (&acc)[2][2][4][2], const Unit& u, int wr, int wc, int fr, int fq) const {
        const int row0 = u.pm * BM + wr * 64 + fr, col0 = u.pn * BM + wc * 32 + 8 * fq;
#pragma unroll
        for (int ai = 0; ai < 2; ++ai)
#pragma unroll
            for (int m = 0; m < 4; ++m) { const int row = row0 + ai * HALF + m * 16; bf16_t* rowp = O + (size_t)row * ldc + col0; float s = 0.f;
#pragma unroll
                for (int bj = 0; bj < 2; ++bj) { const f32x4 v0 = acc[ai][bj][m][0], v1 = acc[ai][bj][m][1];
                    s += ((v0[0] * v0[0] + v0[1] * v0[1]) + (v0[2] * v0[2] + v0[3] * v0[3])) + ((v1[0] * v1[0] + v1[1] * v1[1]) + (v1[2] * v1[2] + v1[3] * v1[3]));
                    u32x4 w; w.x = cvt_pk_bf16(v0[0], v0[1]); w.y = cvt_pk_bf16(v0[2], v0[3]); w.z = cvt_pk_bf16(v1[0], v1[1]); w.w = cvt_pk_bf16(v1[2], v1[3]);
                    *(u32x4*)(rowp + bj * HALF) = w; }
                s += __shfl_xor(s, 16); s += __shfl_xor(s, 32);
                if (fq == 0) atomicAdd(ss + row, s); }
    }
};

__device__ __forceinline__ float dpp_shr1(float x) { return __builtin_bit_cast(float, __builtin_amdgcn_update_dpp(0, __builtin_bit_cast(int, x), 0x111, 0xf, 0xf, true)); }
struct EpiConv {
    static constexpr bool PERM = true, AFTER_DRAIN = false, PERMA = true, HAS_PRE = true;
    bf16_t* ACT; bf16_t* RAW; const float* cw; const float* cb; int FF; PG8_LAS unsigned char* CB;
    __device__ __forceinline__ void pre(const Unit& u, int par) const {
        const int tid = threadIdx.x, w = __builtin_amdgcn_readfirstlane(tid >> 6), l = tid & 63;
        if (w < 4) { const int vec = 2 * w + (l >> 5), k = vec & 3, hv = vec >> 2; const float* src = (k < 3 ? cw + (size_t)k * 2 * FF : cb) + hv * FF + u.pn * HALF + (l & 31) * 4;
            __builtin_amdgcn_global_load_lds((const unsigned*)src, (PG8_LAS unsigned*)(CB + par * 4096 + w * 1024), 16, 0, 0); }
    }
    __device__ __forceinline__ void run(const f32x4 (&acc)[2][2][4][2], const Unit& u, int wr, int wc, int fr, int fq, int par) const {
        const int f0 = u.pn * HALF + wc * 32 + 8 * fq; const int rowt = u.pm * BM + wr * 64 + 4 * fr; const int FF2 = 2 * FF;
        const PG8_LAS float* cbuf = (const PG8_LAS float*)(CB + par * 4096) + wc * 32 + 8 * fq;
        unsigned stash[2][4][2];
#pragma unroll
        for (int n = 0; n < 2; ++n) { const int f = f0 + 4 * n; const PG8_LAS float* cn = cbuf + 4 * n;
            const f32x4 w0g = *(const PG8_LAS f32x4*)(cn), w1g = *(const PG8_LAS f32x4*)(cn + 128), w2g = *(const PG8_LAS f32x4*)(cn + 256), bg = *(const PG8_LAS f32x4*)(cn + 384);
            const f32x4 w0v = *(const PG8_LAS f32x4*)(cn + 512), w1v = *(const PG8_LAS f32x4*)(cn + 640), w2v = *(const PG8_LAS f32x4*)(cn + 768), bv = *(const PG8_LAS f32x4*)(cn + 896);
#pragma unroll
            for (int ai = 0; ai < 2; ++ai) {
                f32x4 gm1, gm2, vm1, vm2;
#pragma unroll
                for (int j = 0; j < 4; ++j) { gm1[j] = dpp_shr1(acc[ai][0][3][n][j]); gm2[j] = dpp_shr1(acc[ai][0][2][n][j]); vm1[j] = dpp_shr1(acc[ai][1][3][n][j]); vm2[j] = dpp_shr1(acc[ai][1][2][n][j]); }
#pragma unroll
                for (int m = 0; m < 4; ++m) { const f32x4 g = acc[ai][0][m][n], v = acc[ai][1][m][n];
                    const f32x4 pg1 = (m == 0) ? gm1 : acc[ai][0][m > 0 ? m - 1 : 0][n], pg2 = (m == 0) ? gm2 : (m == 1 ? gm1 : acc[ai][0][m > 1 ? m - 2 : 0][n]);
                    const f32x4 pv1 = (m == 0) ? vm1 : acc[ai][1][m > 0 ? m - 1 : 0][n], pv2 = (m == 0) ? vm2 : (m == 1 ? vm1 : acc[ai][1][m > 1 ? m - 2 : 0][n]);
                    const f32x4 yg = bg + w0g * pg2 + w1g * pg1 + w2g * g, yv = bv + w0v * pv2 + w1v * pv1 + w2v * v; f32x4 a;
#pragma unroll
                    for (int j = 0; j < 4; ++j) a[j] = silu_f(yg[j]) * yv[j];
                    const unsigned lo = cvt_pk_bf16(a[0], a[1]), hi = cvt_pk_bf16(a[2], a[3]);
                    if (n == 0) { stash[ai][m][0] = lo; stash[ai][m][1] = hi; }
                    else if (!(m < 2 && fr == 0)) { u32x4 w; w.x = stash[ai][m][0]; w.y = stash[ai][m][1]; w.z = lo; w.w = hi; __builtin_nontemporal_store(w, (u32x4*)(ACT + (size_t)(rowt + ai * HALF + m) * FF + f0)); }
                    if ((m < 2 && fr == 0) || (m >= 2 && fr == 15)) { bf16_t* rp = RAW + ((size_t)((u.pm * 4 + ai * 2 + wr) * 4 + m)) * FF2 + f;
                        u32x2 gw, vw; gw.x = cvt_pk_bf16(g[0], g[1]); gw.y = cvt_pk_bf16(g[2], g[3]); vw.x = cvt_pk_bf16(v[0], v[1]); vw.y = cvt_pk_bf16(v[2], v[3]);
                        *(u32x2*)rp = gw; *(u32x2*)(rp + FF) = vw; } } } }
    }
};

struct RowStat {
    float* ss; unsigned* cnt; unsigned want; float inv_n, eps;
    __device__ __forceinline__ void run(const float (&part)[2][4], float (&rs)[2][4], const Unit& u, int wr, int fr, int fq) const {
        const int row0 = u.pm * BM + wr * 64 + fr; const int lane = fq * 16 + fr;
#pragma unroll
        for (int ai = 0; ai < 2; ++ai)
#pragma unroll
            for (int m = 0; m < 4; ++m) { float s = part[ai][m]; s += __shfl_xor(s, 16); s += __shfl_xor(s, 32); if (fq == 0) atomicAdd(ss + row0 + ai * HALF + m * 16, s); }
        asm volatile("s_waitcnt vmcnt(0)" ::: "memory");
        unsigned* c = cnt + 64 * u.pm;
        if (lane == 0) __hip_atomic_fetch_add(c, 1u, __ATOMIC_RELAXED, __HIP_MEMORY_SCOPE_AGENT);
        if (threadIdx.x < 64) { unsigned sp = 0;
            while ((unsigned)__builtin_amdgcn_readfirstlane(__hip_atomic_load(c, __ATOMIC_RELAXED, __HIP_MEMORY_SCOPE_AGENT)) < want) { __builtin_amdgcn_s_sleep(1); if (++sp > (1u << 22)) break; } }
        asm volatile("s_waitcnt vmcnt(0) lgkmcnt(0)" ::: "memory"); __builtin_amdgcn_s_barrier(); asm volatile("" ::: "memory");
#pragma unroll
        for (int ai = 0; ai < 2; ++ai)
#pragma unroll
            for (int m = 0; m < 4; ++m) { const float v = __hip_atomic_load(ss + row0 + ai * HALF + m * 16, __ATOMIC_RELAXED, __HIP_MEMORY_SCOPE_AGENT); rs[ai][m] = __builtin_amdgcn_rsqf(v * inv_n + eps); }
    }
};
template <int VAR = 0  > struct EpiMid {
    static constexpr bool PERM = false, AFTER_DRAIN = false, PERMA = false, HAS_PRE = false;
    const float* x; float* x1; bf16_t* xn; const float* mod; const float* post_g; const float* ffn_g; const float* sxx; float* ss1; float* ssxm; float* ssmm; unsigned* cnt; PG8_LAS float* A23; int ld, tiles_per_batch;
    __device__ __forceinline__ void operator()(f32x4 (&acc)[2][2][4][2], const Unit& u, int wr, int wc, int fr, int fq) const {
        const int col0 = u.pn * BM + wc * 32 + 4 * fq; const float* mb = mod + (size_t)(u.pm / tiles_per_batch) * (6 * ld); const int tid = threadIdx.x;
        const unsigned voff = (unsigned)((wr * 64 + fr) * ld + col0) * 4u;
        const size_t pbase = (size_t)u.pm * BM * ld; const int row0 = u.pm * BM + wr * 64 + fr;
        if (tid < 256) { const int c = u.pn * BM + tid; A23[tid] = mb[2 * ld + c] * post_g[c]; A23[256 + tid] = ffn_g[c] * (1.0f + mb[4 * ld + c]); A23[512 + tid] = mb[3 * ld + c]; }
        asm volatile("s_waitcnt vmcnt(0) lgkmcnt(0)" ::: "memory"); __builtin_amdgcn_s_barrier(); asm volatile("" ::: "memory");
        const PG8_LAS float* As = A23 + wc * 32 + 4 * fq;
#pragma unroll
        for (int ai = 0; ai < 2; ++ai)
#pragma unroll
            for (int m = 0; m < 4; ++m) { const char* xb = (const char*)(x + pbase + (size_t)(ai * HALF + m * 16) * ld); f32x4 s1 = {0.f, 0.f, 0.f, 0.f}, sx = s1, sm = s1;
#pragma unroll
                for (int bj = 0; bj < 2; ++bj)
#pragma unroll
                    for (int n = 0; n < 2; ++n) { const unsigned o = voff + (unsigned)(bj * HALF + n * 16) * 4u; const f32x4 xv = (VAR == 1) ? (f32x4){1.f, 1.f, 1.f, 1.f} : *(const f32x4*)(xb + o); const f32x4 mx = acc[ai][bj][m][n], cm = mx * *(const PG8_LAS f32x4*)(As + bj * HALF + n * 16);
                        s1 += mx * mx; sx += xv * cm; sm += cm * cm; }
                float a = (s1[0] + s1[1]) + (s1[2] + s1[3]), b = (sx[0] + sx[1]) + (sx[2] + sx[3]), c = (sm[0] + sm[1]) + (sm[2] + sm[3]);
                a += __shfl_xor(a, 16); a += __shfl_xor(a, 32); b += __shfl_xor(b, 16); b += __shfl_xor(b, 32); c += __shfl_xor(c, 16); c += __shfl_xor(c, 32);
                if (fq == 0) { const int r = row0 + ai * HALF + m * 16; atomicAdd(ss1 + r, a); atomicAdd(ssxm + r, b); atomicAdd(ssmm + r, c); }
                if (m == 3) asm volatile("" ::: "memory"); }
        asm volatile("s_waitcnt vmcnt(0)" ::: "memory");
        unsigned* cw = cnt + 64 * u.pm;
        if ((tid & 63) == 0) __hip_atomic_fetch_add(cw, 1u, __ATOMIC_RELAXED, __HIP_MEMORY_SCOPE_AGENT);
        if (tid < 64) { unsigned sp = 0;
            while ((unsigned)__builtin_amdgcn_readfirstlane(__hip_atomic_load(cw, __ATOMIC_RELAXED, __HIP_MEMORY_SCOPE_AGENT)) < 32u) { __builtin_amdgcn_s_sleep(1); if (++sp > (1u << 22)) break; } }
        asm volatile("s_waitcnt vmcnt(0) lgkmcnt(0)" ::: "memory"); __builtin_amdgcn_s_barrier(); asm volatile("" ::: "memory");
        const float inv_n = 1.0f / (float)ld; float rs1[2][4], rs2[2][4];
#pragma unroll
        for (int ai = 0; ai < 2; ++ai)
#pragma unroll
            for (int m = 0; m < 4; ++m) { const int r = row0 + ai * HALF + m * 16;
                const float S1 = __hip_atomic_load(ss1 + r, __ATOMIC_RELAXED, __HIP_MEMORY_SCOPE_AGENT), Sxm = __hip_atomic_load(ssxm + r, __ATOMIC_RELAXED, __HIP_MEMORY_SCOPE_AGENT), Smm = __hip_atomic_load(ssmm + r, __ATOMIC_RELAXED, __HIP_MEMORY_SCOPE_AGENT);
                const float r1 = __builtin_amdgcn_rsqf(S1 * inv_n + 1e-6f); rs1[ai][m] = r1;
                const float s2 = sxx[r] + 2.0f * r1 * Sxm + r1 * r1 * Smm; rs2[ai][m] = __builtin_amdgcn_rsqf(s2 * inv_n + 1e-6f); }
        if (VAR != 0) { if (rs1[0][0] + rs2[1][3] + rs1[1][2] + rs2[0][1] == 1.2345e33f) x1[row0] = rs1[0][1]; return; }
#pragma unroll
        for (int ai = 0; ai < 2; ++ai)
#pragma unroll
            for (int m = 0; m < 4; ++m) { const size_t gb = pbase + (size_t)(ai * HALF + m * 16) * ld; const char* xb = (const char*)(x + gb); char* ob = (char*)(x1 + gb); char* nb = (char*)(xn + gb);
#pragma unroll
                for (int bj = 0; bj < 2; ++bj)
#pragma unroll
                    for (int n = 0; n < 2; ++n) { const unsigned o = voff + (unsigned)(bj * HALF + n * 16) * 4u; const f32x4 xv = *(const f32x4*)(xb + o);
                        const f32x4 v = xv + acc[ai][bj][m][n] * rs1[ai][m] * *(const PG8_LAS f32x4*)(As + bj * HALF + n * 16);
                        *(f32x4*)(ob + o) = v;
                        const f32x4 a2 = *(const PG8_LAS f32x4*)(As + 256 + bj * HALF + n * 16), a3 = *(const PG8_LAS f32x4*)(As + 512 + bj * HALF + n * 16); const f32x4 h = v * rs2[ai][m] * a2 + a3;
                        u32x2 wv; wv.x = cvt_pk_bf16(h[0], h[1]); wv.y = cvt_pk_bf16(h[2], h[3]); *(u32x2*)(nb + (o >> 1)) = wv; }
                if (m == 3) asm volatile("" ::: "memory"); }
    }
};
struct EpiFinal {
    static constexpr bool PERM = false, AFTER_DRAIN = false, PERMA = false, HAS_PRE = false;
    const bf16_t* src; float* out; const float* mod; const float* post_g; RowStat st; int ld, tiles_per_batch;
    __device__ __forceinline__ void operator()(f32x4 (&acc)[2][2][4][2], const Unit& u, int wr, int wc, int fr, int fq) const {
        const int col0 = u.pn * BM + wc * 32 + 4 * fq; const float* mb = mod + (size_t)(u.pm / tiles_per_batch) * (6 * ld);
        const unsigned voff = (unsigned)((wr * 64 + fr) * ld + col0) * 4u, cvo = (unsigned)col0 * 4u; const size_t pbase = (size_t)u.pm * BM * ld;
        float part[2][4], rs[2][4];
#pragma unroll
        for (int ai = 0; ai < 2; ++ai)
#pragma unroll
            for (int m = 0; m < 4; ++m) { float s = 0.f;
#pragma unroll
                for (int bj = 0; bj < 2; ++bj)
#pragma unroll
                    for (int n = 0; n < 2; ++n) { const f32x4 v = acc[ai][bj][m][n]; s += (v[0] * v[0] + v[1] * v[1]) + (v[2] * v[2] + v[3] * v[3]); }
                part[ai][m] = s; }
        u32x4 xpre[2][4][2];
        const unsigned voffx = (unsigned)((wr * 64 + fr) * ld + u.pn * BM + wc * 32 + 8 * fq) * 2u;
#pragma unroll
        for (int ai = 0; ai < 2; ++ai)
#pragma unroll
            for (int m = 0; m < 4; ++m) { const char* sb = (const char*)(src + pbase + (size_t)(ai * HALF + m * 16) * ld);
#pragma unroll
                for (int bj = 0; bj < 2; ++bj)
#pragma unroll
                    for (int n = 0; n < 1; ++n) xpre[ai][m][bj] = *(const u32x4*)(sb + voffx + (unsigned)(bj * HALF) * 2u); }
        st.run(part, rs, u, wr, fr, fq);
        f32x4 A1[2][2];
#pragma unroll
        for (int bj = 0; bj < 2; ++bj)
#pragma unroll
            for (int n = 0; n < 2; ++n) { const unsigned co = cvo + (unsigned)(bj * HALF + n * 16) * 4u; A1[bj][n] = *(const f32x4*)((const char*)(mb + 5 * ld) + co) * *(const f32x4*)((const char*)post_g + co); }
#pragma unroll
        for (int ai = 0; ai < 2; ++ai)
#pragma unroll
            for (int m = 0; m < 4; ++m) { char* ob = (char*)(out + pbase + (size_t)(ai * HALF + m * 16) * ld);
#pragma unroll
                for (int bj = 0; bj < 2; ++bj)
#pragma unroll
                    for (int n = 0; n < 2; ++n) { const unsigned o = voff + (unsigned)(bj * HALF + n * 16) * 4u; u32x2 xw; xw.x = n ? xpre[ai][m][bj].z : xpre[ai][m][bj].x; xw.y = n ? xpre[ai][m][bj].w : xpre[ai][m][bj].y;
                        const f32x4 xv = {__builtin_bit_cast(float, xw.x << 16), __builtin_bit_cast(float, xw.x & 0xffff0000u), __builtin_bit_cast(float, xw.y << 16), __builtin_bit_cast(float, xw.y & 0xffff0000u)};
                        *(f32x4*)(ob + o) = xv + acc[ai][bj][m][n] * rs[ai][m] * A1[bj][n]; }
                if (m == 3) asm volatile("" ::: "memory"); }
    }
};

struct EpiSink {
    static constexpr bool PERM = false, AFTER_DRAIN = false, PERMA = false, HAS_PRE = false;
    float* O;
    __device__ __forceinline__ void operator()(f32x4 (&acc)[2][2][4][2], const Unit& u, int wr, int wc, int fr, int fq) const {
        f32x4 s = {0.f, 0.f, 0.f, 0.f};
#pragma unroll
        for (int ai = 0; ai < 2; ++ai)
#pragma unroll
            for (int bj = 0; bj < 2; ++bj)
#pragma unroll
                for (int m = 0; m < 4; ++m)
#pragma unroll
                    for (int n = 0; n < 2; ++n) s += acc[ai][bj][m][n];
        if (s[0] + s[1] + s[2] + s[3] == 1.2345e33f) O[u.pm * 256 + wr * 64 + fr + wc + fq] = s[0];
    }
};
template <class Epi, class Sched, bool ALIGN_EPI = false, bool SP2 = false>
__device__ __forceinline__ void gemm_phase(PG8_LAS unsigned char* lds, const Gemm g, const Sched& S, const Epi& E) {
    const int tid = threadIdx.x, wid = __builtin_amdgcn_readfirstlane(tid >> 6), lane = tid & 63, wr = wid >> 2, wc = wid & 3, fr = lane & 15, fq = lane >> 4;
    const int K = g.K, nt = K / BK;
    unsigned voffA[2], voffB[2];
#pragma unroll
    for (int i = 0; i < 2; ++i) { int R, C; stage_rc(tid * 16 + i * 8192, R, C); const int Rb = Epi::PERM ? ((R & ~31) + perm32(R & 31)) : R;
        const int Ra = Epi::PERMA ? ((R & ~63) + 4 * (R & 15) + ((R & 63) >> 4)) : R;
        voffA[i] = (unsigned)(Ra * K + C) * 2u; voffB[i] = (unsigned)(Rb * K + C) * 2u; }
    const size_t kstep = (size_t)(BK * 2);
    const size_t hstep = (size_t)HALF * K * 2;
    const size_t tstep = 2 * hstep;
    const unsigned ldsw = (unsigned)wid * 1024u;
    const int aoff = lds_byte(wr * 64 + fr, fq * 8), boff = lds_byte(wc * 32 + fr, fq * 8);
#define PG8_SA(b, h) (((b) * 2 + (h)) * HTB)
#define PG8_SB(b, h) ((4 + (b) * 2 + (h)) * HTB)
#define PG8_STAGE(bufoff, gbase, voff) do { _Pragma("unroll") for (int _i = 0; _i < 2; ++_i) \
        __builtin_amdgcn_global_load_lds((const unsigned*)((const char*)(gbase) + (voff)[_i]), (PG8_LAS unsigned*)(lds + (bufoff) + ldsw + _i * 8192), 16, 0, 0); } while (0)
#define PG8_LDA(dst, b, h) do { _Pragma("unroll") for (int m = 0; m < 4; ++m) _Pragma("unroll") for (int k = 0; k < 2; ++k) dst[m][k] = *(const PG8_LAS bf16x8*)(lds + PG8_SA(b, h) + aoff + m * 2048 + k * 1024); } while (0)
#define PG8_LDB(dst, b, h) do { _Pragma("unroll") for (int n = 0; n < 2; ++n) _Pragma("unroll") for (int k = 0; k < 2; ++k) dst[n][k] = *(const PG8_LAS bf16x8*)(lds + PG8_SB(b, h) + boff + n * 2048 + k * 1024); } while (0)
#define PG8_MMA(ai, bj, At, Bt) do { __builtin_amdgcn_s_setprio(1); _Pragma("unroll") for (int m = 0; m < 4; ++m) _Pragma("unroll") for (int n = 0; n < 2; ++n) _Pragma("unroll") for (int k = 0; k < 2; ++k) \
        acc[ai][bj][m][n] = __builtin_amdgcn_mfma_f32_16x16x32_bf16(Bt[n][k], At[m][k], acc[ai][bj][m][n], 0, 0, 0); __builtin_amdgcn_s_setprio(0); } while (0)
#define PG8_WAIT_V(n) asm volatile("s_waitcnt vmcnt(" #n ")" ::: "memory")
#define PG8_WAIT_L(n) asm volatile("s_waitcnt lgkmcnt(" #n ")" ::: "memory")
#define PG8_BAR __builtin_amdgcn_s_barrier()
#define PG8_SCHED __builtin_amdgcn_sched_barrier(0)
    Unit cur, nxt; int ui = 0;
    if (!S.next(0, cur)) return;
    f32x4 acc[2][2][4][2];
#pragma unroll
    for (int a = 0; a < 2; ++a)
#pragma unroll
        for (int b = 0; b < 2; ++b)
#pragma unroll
            for (int m = 0; m < 4; ++m)
#pragma unroll
                for (int n = 0; n < 2; ++n) acc[a][b][m][n] = (f32x4){0.f, 0.f, 0.f, 0.f};
    bf16x8 At[4][2], B0[2][2], B1[2][2];
    const char* cA = (const char*)g.A + (size_t)cur.pm * tstep; const char* cB = (const char*)g.Bt + (size_t)cur.pn * tstep;
    S.a_ready(cur);
    if constexpr (Epi::HAS_PRE) E.pre(cur, 0);
    if constexpr (SP2) {
        PG8_STAGE(PG8_SB(0, 0), cB, voffB); PG8_STAGE(PG8_SB(0, 1), cB + hstep, voffB); PG8_STAGE(PG8_SA(0, 0), cA, voffA); PG8_STAGE(PG8_SA(0, 1), cA + hstep, voffA);
        if (wr == 1) PG8_BAR;
        PG8_WAIT_V(2); PG8_BAR;
        PG8_STAGE(PG8_SB(1, 0), cB + kstep, voffB); PG8_STAGE(PG8_SA(1, 0), cA + kstep, voffA); PG8_STAGE(PG8_SB(1, 1), cB + hstep + kstep, voffB);
        PG8_WAIT_V(6); PG8_BAR;
    } else {
        PG8_STAGE(PG8_SB(0, 0), cB, voffB); PG8_STAGE(PG8_SA(0, 0), cA, voffA); PG8_STAGE(PG8_SB(0, 1), cB + hstep, voffB); PG8_STAGE(PG8_SA(0, 1), cA + hstep, voffA);
        if (wr == 1) PG8_BAR;
        PG8_WAIT_V(4); PG8_BAR;
        PG8_STAGE(PG8_SB(1, 0), cB + kstep, voffB); PG8_STAGE(PG8_SA(1, 0), cA + kstep, voffA); PG8_STAGE(PG8_SB(1, 1), cB + hstep + kstep, voffB);
        PG8_WAIT_V(6); PG8_BAR;
    }
    for (;;) {
        const bool has_next = S.next(ui + 1, nxt);
        const char* nA = has_next ? (const char*)g.A + (size_t)nxt.pm * tstep : cA; const char* nB = has_next ? (const char*)g.Bt + (size_t)nxt.pn * tstep : cB;
        for (int t = 0; t < nt; t += 2) {
            const bool last = (t == nt - 2);
            const char* a1 = cA + (size_t)(t + 1) * kstep;
            const char* a2 = last ? nA : cA + (size_t)(t + 2) * kstep; const char* b2 = last ? nB : cB + (size_t)(t + 2) * kstep;
            const char* a3 = a2 + kstep; const char* b3 = b2 + kstep;
            if (last && has_next) S.a_ready(nxt);
            if constexpr (SP2) {
            PG8_LDB(B0, 0, 0); PG8_LDB(B1, 0, 1); PG8_SCHED; PG8_LDA(At, 0, 0); PG8_STAGE(PG8_SA(1, 1), a1 + hstep, voffA);
            PG8_WAIT_V(8); PG8_WAIT_L(0); PG8_BAR; PG8_MMA(0, 0, At, B0); PG8_MMA(0, 1, At, B1); PG8_BAR; PG8_SCHED;
            PG8_LDA(At, 0, 1); PG8_STAGE(PG8_SB(0, 0), b2, voffB); PG8_STAGE(PG8_SB(0, 1), b2 + hstep, voffB); PG8_STAGE(PG8_SA(0, 0), a2, voffA);
            PG8_WAIT_V(8); PG8_WAIT_L(0); PG8_BAR; PG8_MMA(1, 0, At, B0); PG8_MMA(1, 1, At, B1); PG8_BAR; PG8_SCHED;
            PG8_LDB(B0, 1, 0); PG8_LDB(B1, 1, 1); PG8_SCHED; PG8_LDA(At, 1, 0); PG8_STAGE(PG8_SA(0, 1), a2 + hstep, voffA);
            PG8_WAIT_V(8); PG8_WAIT_L(0); PG8_BAR; PG8_MMA(0, 0, At, B0); PG8_MMA(0, 1, At, B1); PG8_BAR; PG8_SCHED;
            PG8_LDA(At, 1, 1); PG8_STAGE(PG8_SB(1, 0), b3, voffB); PG8_STAGE(PG8_SB(1, 1), b3 + hstep, voffB); PG8_STAGE(PG8_SA(1, 0), a3, voffA);
            PG8_WAIT_V(8); PG8_WAIT_L(0); PG8_BAR; PG8_MMA(1, 0, At, B0); PG8_MMA(1, 1, At, B1); PG8_BAR; PG8_SCHED;
            } else {
            PG8_LDB(B0, 0, 0); PG8_SCHED; PG8_LDA(At, 0, 0); PG8_STAGE(PG8_SA(1, 1), a1 + hstep, voffA);
            PG8_WAIT_L(8); PG8_BAR; PG8_WAIT_L(0); PG8_MMA(0, 0, At, B0); PG8_BAR; PG8_SCHED;
            PG8_LDB(B1, 0, 1); PG8_STAGE(PG8_SB(0, 0), b2, voffB);
            PG8_BAR; PG8_WAIT_L(0); PG8_MMA(0, 1, At, B1); PG8_BAR;
            PG8_LDA(At, 0, 1); PG8_STAGE(PG8_SA(0, 0), a2, voffA);
            PG8_BAR; PG8_WAIT_L(0); PG8_MMA(1, 0, At, B0); PG8_BAR; PG8_SCHED;
            PG8_STAGE(PG8_SB(0, 1), b2 + hstep, voffB);
            PG8_WAIT_V(6); PG8_BAR; PG8_MMA(1, 1, At, B1); PG8_BAR;
            PG8_LDB(B0, 1, 0); PG8_SCHED; PG8_LDA(At, 1, 0); PG8_STAGE(PG8_SA(0, 1), a2 + hstep, voffA);
            PG8_WAIT_L(8); PG8_BAR; PG8_WAIT_L(0); PG8_MMA(0, 0, At, B0); PG8_BAR; PG8_SCHED;
            PG8_LDB(B1, 1, 1); PG8_STAGE(PG8_SB(1, 0), b3, voffB);
            PG8_BAR; PG8_WAIT_L(0); PG8_MMA(0, 1, At, B1); PG8_BAR;
            PG8_LDA(At, 1, 1); PG8_STAGE(PG8_SA(1, 0), a3, voffA);
            PG8_BAR; PG8_WAIT_L(0); PG8_MMA(1, 0, At, B0); PG8_BAR; PG8_SCHED;
            PG8_STAGE(PG8_SB(1, 1), b3 + hstep, voffB);
            PG8_WAIT_V(6); PG8_BAR; PG8_MMA(1, 1, At, B1); PG8_BAR;
            }
        }
        if constexpr (ALIGN_EPI) { if (wr == 0) PG8_BAR; }
        if constexpr (Epi::HAS_PRE) { if (has_next) E.pre(nxt, (ui + 1) & 1); E.run(acc, cur, wr, wc, fr, fq, ui & 1); S.done(cur); }
        else if constexpr (!Epi::AFTER_DRAIN) { E(acc, cur, wr, wc, fr, fq); S.done(cur); }
        if (!has_next) break;
#pragma unroll
        for (int a = 0; a < 2; ++a)
#pragma unroll
            for (int b = 0; b < 2; ++b)
#pragma unroll
                for (int m = 0; m < 4; ++m)
#pragma unroll
                    for (int n = 0; n < 2; ++n) acc[a][b][m][n] = (f32x4){0.f, 0.f, 0.f, 0.f};
        cur = nxt; cA = nA; cB = nB; ++ui;
        if constexpr (ALIGN_EPI) { if (wr == 1) PG8_BAR; }
    }
    PG8_WAIT_V(0);
    if constexpr (!ALIGN_EPI) { if (wr == 0) PG8_BAR; }
    PG8_BAR;
    if constexpr (Epi::AFTER_DRAIN) { E.fused(acc, cur, wr, wc, fr, fq, lds, wid, lane); S.done(cur); }
#undef PG8_SA
#undef PG8_SB
#undef PG8_STAGE
#undef PG8_LDA
#undef PG8_LDB
#undef PG8_MMA
#undef PG8_WAIT_V
#undef PG8_WAIT_L
#undef PG8_BAR
#undef PG8_SCHED
}
}
constexpr int NWAVES = 8;
constexpr int BATCH = 4, SEQ = 8192, D = 1024, M = BATCH * SEQ;
constexpr int INW = 1536, AW = 512, FF = 2816, FF2 = 2 * FF, NMOD = 6 * D;
constexpr float EPS = 1e-6f;
constexpr size_t MiB = 1u << 20;
constexpr size_t WS_CTL = 0, CTL_ZERO_BYTES = 1 * MiB;
constexpr size_t OFF_MOD = 0, OFF_SS1 = 128 * 1024, OFF_SS2 = 256 * 1024, OFF_SS3 = 384 * 1024, OFF_BAR = 512 * 1024, OFF_CNT = 544 * 1024, OFF_SS4 = 896 * 1024;
constexpr size_t WS_WIN = 1 * MiB, WS_WOUT = 4 * MiB, WS_WUP = 6 * MiB, WS_WDOWN = 17 * MiB, WS_WSP = 23 * MiB, WS_WPOOL = WS_WSP + 256 * 1024;
constexpr size_t WS_SXX = 23 * MiB + 512 * 1024;
constexpr size_t WS_XN = 24 * MiB;
constexpr size_t WS_PROJ = 88 * MiB;
constexpr size_t WS_MIXIN = 184 * MiB;
constexpr size_t WS_MIXED = WS_PROJ;
constexpr size_t WS_ACT = 248 * MiB;
constexpr size_t WS_RAW = 424 * MiB;
constexpr size_t WS_X1B = 446 * MiB;
constexpr size_t WS_F = WS_ACT;
constexpr size_t WS_END = 510 * MiB;
static_assert(WS_XN + (size_t)M * D * 2 <= WS_PROJ && WS_PROJ + (size_t)M * INW * 2 <= WS_MIXIN && WS_MIXIN + (size_t)M * D * 2 <= WS_ACT && WS_ACT + (size_t)M * FF * 2 <= WS_RAW && WS_RAW + (size_t)(M / 64) * 4 * FF2 * 2 <= WS_X1B && WS_X1B + (size_t)M * D * 2 <= WS_END, "d_ws map");
static_assert(WS_WUP + (size_t)FF2 * D * 2 <= WS_WDOWN && WS_WDOWN + (size_t)D * FF * 2 <= WS_WSP && WS_WPOOL + 4 * 128 * 128 * 2 <= WS_XN, "d_ws weights");
constexpr int RING_BYTES = 131072, LDSCTL_OFF = RING_BYTES, LDS_BYTES = 147456;

#define GAS __attribute__((address_space(1)))
#define LAS __attribute__((address_space(3)))
typedef unsigned short bf16;
typedef unsigned v4u __attribute__((ext_vector_type(4)));
typedef unsigned v2u __attribute__((ext_vector_type(2)));
typedef float f32x4 __attribute__((ext_vector_type(4)));
typedef short bf16x8 __attribute__((ext_vector_type(8)));
#define LDS_WAIT() asm volatile("s_waitcnt lgkmcnt(0)" ::: "memory")
__device__ __forceinline__ unsigned f2bf(float f) { unsigned u = __builtin_bit_cast(unsigned, f); return (u + 0x7fffu + ((u >> 16) & 1u)) >> 16; }
__device__ __forceinline__ unsigned pk2(float lo, float hi) { unsigned r; asm("v_cvt_pk_bf16_f32 %0, %1, %2" : "=v"(r) : "v"(lo), "v"(hi)); return r; }
__device__ __forceinline__ float bf_lo(unsigned w) { return __builtin_bit_cast(float, w << 16); }
__device__ __forceinline__ float bf_hi(unsigned w) { return __builtin_bit_cast(float, w & 0xffff0000u); }
__device__ __forceinline__ float wave_sum(float v) {
#pragma unroll
    for (int o = 1; o < 64; o <<= 1) v += __shfl_xor(v, o);
    return v;
}
__device__ __forceinline__ float silu_acc(float x) { return x / (1.0f + __expf(-x)); }

struct Args { const float* in[19]; float* out; unsigned char* ws; int ph_lo, ph_hi; };
enum { I_X = 0, I_C, I_WADA, I_BADA, I_PREMIXG, I_POSTMIXG, I_WIN, I_SGUG, I_WSP, I_BSP, I_WPOOL, I_PSCALE, I_WOUT, I_PREFFNG, I_POSTFFNG, I_WUP, I_CONVW, I_CONVB, I_WDOWN };

__device__ __forceinline__ void transpose_item(const float* W, int K, int N, bf16* WT, int k0, int n0, int drow0, LAS float* scr, int lane) {
    { f32x4 v[8];
#pragma unroll
        for (int i = 0; i < 8; ++i) v[i] = __builtin_nontemporal_load((const f32x4*)(W + (size_t)(k0 + 8 * i + (lane >> 3)) * N + n0 + 4 * (lane & 7)));
#pragma unroll
        for (int i = 0; i < 8; ++i) { LAS float* d = scr + (8 * i + (lane >> 3)) * 33 + 4 * (lane & 7); d[0] = v[i].x; d[1] = v[i].y; d[2] = v[i].z; d[3] = v[i].w; } }
    LDS_WAIT(); asm volatile("" ::: "memory");
    const int c = lane & 7;
#pragma unroll
    for (int j = 0; j < 4; ++j) { const int n = (lane >> 3) + 8 * j; const LAS float* s = scr + (8 * c) * 33 + n;
        v4u o; o.x = pk2(s[0 * 33], s[1 * 33]); o.y = pk2(s[2 * 33], s[3 * 33]); o.z = pk2(s[4 * 33], s[5 * 33]); o.w = pk2(s[6 * 33], s[7 * 33]);
        *(v4u*)(WT + (size_t)(drow0 + n) * K + k0 + 8 * c) = o; }
    LDS_WAIT(); asm volatile("" ::: "memory");
}

__device__ __forceinline__ void p0_prologue(const Args& a, LAS unsigned char* lds, int gw, int NGW, int lane, int wave, bool with_mod, bool with_rest) {
    unsigned char* ws = a.ws;
    float* MOD = (float*)(ws + OFF_MOD);
    const float* c = a.in[I_C]; const float* wada = a.in[I_WADA]; const float* bada = a.in[I_BADA];
    for (int it = with_mod ? gw : 96 * 16; it < 96 * 16; it += NGW) { const int cb = it % 96, ks = it / 96, col = cb * 64 + lane; float a0 = 0.f, a1 = 0.f, a2 = 0.f, a3 = 0.f;
        const float sv0 = silu_acc(c[ks * 64 + lane]), sv1 = silu_acc(c[D + ks * 64 + lane]), sv2 = silu_acc(c[2 * D + ks * 64 + lane]), sv3 = silu_acc(c[3 * D + ks * 64 + lane]);
#pragma unroll 32
        for (int kk = 0; kk < 64; ++kk) { const float w = __builtin_nontemporal_load(wada + (size_t)(ks * 64 + kk) * NMOD + col);
            a0 += __builtin_bit_cast(float, __builtin_amdgcn_readlane(__builtin_bit_cast(int, sv0), kk)) * w; a1 += __builtin_bit_cast(float, __builtin_amdgcn_readlane(__builtin_bit_cast(int, sv1), kk)) * w;
            a2 += __builtin_bit_cast(float, __builtin_amdgcn_readlane(__builtin_bit_cast(int, sv2), kk)) * w; a3 += __builtin_bit_cast(float, __builtin_amdgcn_readlane(__builtin_bit_cast(int, sv3), kk)) * w; }
        if (ks == 0) { const float b = bada[col]; a0 += b; a1 += b; a2 += b; a3 += b; }
        atomicAdd(MOD + col, a0); atomicAdd(MOD + NMOD + col, a1); atomicAdd(MOD + 2 * NMOD + col, a2); atomicAdd(MOD + 3 * NMOD + col, a3); }
    if (!with_rest) return;
    LAS float* scr = (LAS float*)(lds + wave * 16384);
    constexpr int I_IN = (D / 64) * (INW / 32), I_OUT = (D / 64) * (D / 32), I_UP = (D / 64) * (FF2 / 32), I_DOWN = (FF / 64) * (D / 32), I_POOL = 4 * 2 * 4;
    constexpr int NITEMS = I_IN + I_OUT + I_UP + I_DOWN + I_POOL;
    for (int it = gw; it < NITEMS; it += NGW) { int r = it;
        if (r < I_IN) { const int nb = INW / 32, kb = r / nb, n0 = 32 * (r % nb); transpose_item(a.in[I_WIN], D, INW, (bf16*)(ws + WS_WIN), 64 * kb, n0, n0, scr, lane); continue; } r -= I_IN;
        if (r < I_OUT) { const int nb = D / 32, kb = r / nb, n0 = 32 * (r % nb); transpose_item(a.in[I_WOUT], D, D, (bf16*)(ws + WS_WOUT), 64 * kb, n0, n0, scr, lane); continue; } r -= I_OUT;
        if (r < I_UP) { const int nb = FF2 / 32, kb = r / nb, n0 = 32 * (r % nb); const int half = n0 / FF, f = n0 % FF, drow = 256 * (f / 128) + 128 * half + (f % 128);
            transpose_item(a.in[I_WUP], D, FF2, (bf16*)(ws + WS_WUP), 64 * kb, n0, drow, scr, lane); continue; } r -= I_UP;
        if (r < I_DOWN) { const int nb = D / 32, kb = r / nb, n0 = 32 * (r % nb); transpose_item(a.in[I_WDOWN], FF, D, (bf16*)(ws + WS_WDOWN), 64 * kb, n0, n0, scr, lane); continue; } r -= I_DOWN;
        { const int g = r / 8, q = r % 8, kb = q / 4, n0 = 32 * (q % 4); transpose_item(a.in[I_WPOOL] + (size_t)g * 16384, 128, 128, (bf16*)(ws + WS_WPOOL) + (size_t)g * 16384, 64 * kb, n0, n0, scr, lane); } }
    { const float* wsp = a.in[I_WSP]; bf16* o = (bf16*)(ws + WS_WSP);
        for (int e = gw * 64 + lane; e < 4 * 128 * 128; e += NGW * 64) { const int i = (e >> 7) & 127, j = e & 127; const float v = ((j >> 6) <= (i >> 6)) ? wsp[e] : 0.f; o[e] = (bf16)f2bf(v); } }
}

__device__ __forceinline__ void p1_norm(const Args& a, int gw, int NGW, int lane) {
    const float* MOD = (const float*)(a.ws + OFF_MOD); bf16* XN = (bf16*)(a.ws + WS_XN); const float* x = a.in[I_X]; const float* g = a.in[I_PREMIXG]; float* SXX = (float*)(a.ws + WS_SXX);
    const int rpw = M / NGW;
    for (int r0 = gw * rpw; r0 < M; r0 += NGW * rpw) { const int b = r0 / SEQ; const float* mb = MOD + (size_t)b * NMOD;
        f32x4 A[4], B[4];
#pragma unroll
        for (int j = 0; j < 4; ++j) { const int col = 4 * lane + 256 * j; const f32x4 gg = *(const f32x4*)(g + col), sc = *(const f32x4*)(mb + D + col); A[j] = gg * (1.0f + sc); B[j] = *(const f32x4*)(mb + col); }
        f32x4 nx[4];
        { const f32x4* xr = (const f32x4*)(x + (size_t)r0 * D) + lane;
#pragma unroll
            for (int j = 0; j < 4; ++j) nx[j] = __builtin_nontemporal_load(xr + 64 * j); }
        for (int r = r0; r < r0 + rpw; ++r) { f32x4 v[4]; float s = 0.f;
#pragma unroll
            for (int j = 0; j < 4; ++j) { v[j] = nx[j]; s += (v[j].x * v[j].x + v[j].y * v[j].y) + (v[j].z * v[j].z + v[j].w * v[j].w); }
            if (r + 1 < r0 + rpw) { const f32x4* xr = (const f32x4*)(x + (size_t)(r + 1) * D) + lane;
#pragma unroll
                for (int j = 0; j < 4; ++j) nx[j] = __builtin_nontemporal_load(xr + 64 * j); }
            const float st = wave_sum(s);
            const float rs = 1.0f / sqrtf(st * (1.0f / D) + EPS);
            v2u* o = (v2u*)(XN + (size_t)r * D) + lane;
#pragma unroll
            for (int j = 0; j < 4; ++j) { const f32x4 h = v[j] * rs * A[j] + B[j]; const unsigned long long w = (unsigned long long)pk2(h.x, h.y) | ((unsigned long long)pk2(h.z, h.w) << 32);
                __hip_atomic_store((unsigned long long*)(o + 64 * j), w, __ATOMIC_RELAXED, __HIP_MEMORY_SCOPE_AGENT); } } }
}

constexpr int P3_RA = 0, P3_RB = 34816, P3_RP = 69632, P3_RC = 108800, P3_PA = 272, P3_PV = 272;
__device__ __forceinline__ void p3_mma(LAS unsigned char* lds, bool natural_b, f32x4 (&acc)[4][2], int wr, int wc, int fr, int fq) {
#pragma unroll
    for (int m = 0; m < 4; ++m)
#pragma unroll
        for (int n = 0; n < 2; ++n) acc[m][n] = (f32x4){0.f, 0.f, 0.f, 0.f};
#pragma unroll
    for (int kk = 0; kk < 4; ++kk) { bf16x8 af[4], bfr[2];
#pragma unroll
        for (int m = 0; m < 4; ++m) af[m] = *(const LAS bf16x8*)(lds + P3_RA + (64 * wr + 16 * m + fr) * P3_PA + (32 * kk + 8 * fq) * 2);
        if (natural_b) {
            { const unsigned addr = (unsigned)(size_t)(lds + P3_RB) + (unsigned)((32 * kk + 8 * fq + (fr >> 2)) * P3_PV + (32 * wc + 8 * (fr & 3)) * 2);
                v2u l0, h0, l1, h1;
                asm volatile("ds_read_b64_tr_b16 %0, %4\n\tds_read_b64_tr_b16 %1, %4 offset:%5\n\tds_read_b64_tr_b16 %2, %4 offset:8\n\tds_read_b64_tr_b16 %3, %4 offset:%6\n\ts_waitcnt lgkmcnt(0)"
                             : "=&v"(l0), "=&v"(h0), "=&v"(l1), "=&v"(h1) : "v"(addr), "n"(4 * P3_PV), "n"(4 * P3_PV + 8) : "memory");
                v4u w0, w1; w0.x = l0.x; w0.y = l0.y; w0.z = h0.x; w0.w = h0.y; w1.x = l1.x; w1.y = l1.y; w1.z = h1.x; w1.w = h1.y;
                bfr[0] = __builtin_bit_cast(bf16x8, w0); bfr[1] = __builtin_bit_cast(bf16x8, w1); }
        } else {
#pragma unroll
            for (int n = 0; n < 2; ++n) bfr[n] = *(const LAS bf16x8*)(lds + P3_RB + (32 * wc + 8 * (fr >> 2) + 4 * n + (fr & 3)) * P3_PA + (32 * kk + 8 * fq) * 2);
        }
#pragma unroll
        for (int m = 0; m < 4; ++m)
#pragma unroll
            for (int n = 0; n < 2; ++n) acc[m][n] = __builtin_amdgcn_mfma_f32_16x16x32_bf16(bfr[n], af[m], acc[m][n], 0, 0, 0); }
}
template <int W> __device__ __forceinline__ void p3_pool(LAS unsigned char* lds, int tid, int s0) {
    const int ch = tid & 15, tq = 4 * (tid >> 4); const LAS unsigned char* rp = lds + P3_RP + ch * 16; float sum[8];
#pragma unroll
    for (int e = 0; e < 8; ++e) sum[e] = 0.f;
#pragma unroll 3
    for (int k = 1; k < W; ++k) { const v4u r = *(const LAS v4u*)(rp + (16 + tq - k) * P3_PA);
        sum[0] += bf_lo(r.x); sum[1] += bf_hi(r.x); sum[2] += bf_lo(r.y); sum[3] += bf_hi(r.y); sum[4] += bf_lo(r.z); sum[5] += bf_hi(r.z); sum[6] += bf_lo(r.w); sum[7] += bf_hi(r.w); }
#pragma unroll
    for (int rr = 0; rr < 4; ++rr) { const int t = tq + rr; const v4u cur = *(const LAS v4u*)(rp + (16 + t) * P3_PA);
        sum[0] += bf_lo(cur.x); sum[1] += bf_hi(cur.x); sum[2] += bf_lo(cur.y); sum[3] += bf_hi(cur.y); sum[4] += bf_lo(cur.z); sum[5] += bf_hi(cur.z); sum[6] += bf_lo(cur.w); sum[7] += bf_hi(cur.w);
        const int cnt = (s0 + t + 1) < W ? (s0 + t + 1) : W; const float inv = 1.0f / (float)cnt;
        v4u o; o.x = pk2(sum[0] * inv - bf_lo(cur.x), sum[1] * inv - bf_hi(cur.x)); o.y = pk2(sum[2] * inv - bf_lo(cur.y), sum[3] * inv - bf_hi(cur.y));
        o.z = pk2(sum[4] * inv - bf_lo(cur.z), sum[5] * inv - bf_hi(cur.z)); o.w = pk2(sum[6] * inv - bf_lo(cur.w), sum[7] * inv - bf_hi(cur.w));
        *(LAS v4u*)(lds + P3_RA + t * P3_PA + ch * 16) = o;
        if (rr < 3) { const v4u old = *(const LAS v4u*)(rp + (16 + t - (W - 1)) * P3_PA);
            sum[0] -= bf_lo(old.x); sum[1] -= bf_hi(old.x); sum[2] -= bf_lo(old.y); sum[3] -= bf_hi(old.y); sum[4] -= bf_lo(old.z); sum[5] -= bf_hi(old.z); sum[6] -= bf_lo(old.w); sum[7] -= bf_hi(old.w); } }
}
struct P3Regs { v4u a0, a1, a2, a3, b0, b1, b2, b3, b4; };
#define P3_RA_(R, it) ((it) == 0 ? (R).a0 : (it) == 1 ? (R).a1 : (it) == 2 ? (R).a2 : (R).a3)
#define P3_RB_(R, it) ((it) == 0 ? (R).b0 : (it) == 1 ? (R).b1 : (it) == 2 ? (R).b2 : (it) == 3 ? (R).b3 : (R).b4)
__device__ __forceinline__ void p3_prefetch(P3Regs& R, int item, int t0, int s0, int tid, const bf16* PROJ, const bf16* WSP, const bf16* WPOOL, bool xhalo = false) {
    if (item < 4) { const int h = item;
#pragma unroll
        for (int it = 0; it < 4; ++it) { const int idx = tid + 512 * it, row = idx >> 4, ch = idx & 15;
            const v4u va = *(const v4u*)(WSP + (size_t)h * 16384 + row * 128 + ch * 8), vb = __builtin_nontemporal_load((const v4u*)(PROJ + (size_t)(t0 + row) * INW + AW + 128 * h + 8 * ch));
            if (it == 0) { R.a0 = va; R.b0 = vb; } else if (it == 1) { R.a1 = va; R.b1 = vb; } else if (it == 2) { R.a2 = va; R.b2 = vb; } else { R.a3 = va; R.b3 = vb; } }
    } else { const int g = item - 4;
#pragma unroll
        for (int it = 0; it < 4; ++it) { const int idx = tid + 512 * it, row = idx >> 4, ch = idx & 15; const v4u va = *(const v4u*)(WPOOL + (size_t)g * 16384 + row * 128 + ch * 8);
            if (it == 0) R.a0 = va; else if (it == 1) R.a1 = va; else if (it == 2) R.a2 = va; else R.a3 = va; }
#pragma unroll
        for (int it = 0; it < 5; ++it) { const int idx = tid + 512 * it, row = idx >> 4, ch = idx & 15; v4u raw = {0u, 0u, 0u, 0u};
            if (row < 144 && s0 + row >= 16) { const bf16* src = PROJ + (size_t)(t0 + row - 16) * INW + 2 * AW + 128 * g + 8 * ch;
                if (xhalo && row < 16) { const unsigned long long w0 = __hip_atomic_load((const unsigned long long*)src, __ATOMIC_RELAXED, __HIP_MEMORY_SCOPE_AGENT), w1 = __hip_atomic_load((const unsigned long long*)src + 1, __ATOMIC_RELAXED, __HIP_MEMORY_SCOPE_AGENT);
                    raw.x = (unsigned)w0; raw.y = (unsigned)(w0 >> 32); raw.z = (unsigned)w1; raw.w = (unsigned)(w1 >> 32); }
                else raw = __builtin_nontemporal_load((const v4u*)src); }
            if (it == 0) R.b0 = raw; else if (it == 1) R.b1 = raw; else if (it == 2) R.b2 = raw; else if (it == 3) R.b3 = raw; else R.b4 = raw; } }
}
__device__ __forceinline__ void p3_item(P3Regs& R, const int item, const int t0, const int s0, const int tid0, LAS unsigned char* lds, const LAS float* RC, const bf16* PROJ, bf16* MIXIN, const bf16* WSP, const bf16* WPOOL,
                                        const int wr, const int wc, const int fr, const int fq, const bool xhalo) {
    f32x4 acc[4][2];
            int tl = tid0; asm volatile("" : "+v"(tl));
            const int tid = tl;
            if (item < 4) { const int h = item;
#pragma unroll
                for (int it = 0; it < 4; ++it) { const int idx = tid + 512 * it, row = idx >> 4, ch = idx & 15;
                    *(LAS v4u*)(lds + P3_RA + row * P3_PA + ch * 16) = P3_RA_(R, it);
                    const v4u raw = P3_RB_(R, it);
                    float v[8]; v[0] = bf_lo(raw.x); v[1] = bf_hi(raw.x); v[2] = bf_lo(raw.y); v[3] = bf_hi(raw.y); v[4] = bf_lo(raw.z); v[5] = bf_hi(raw.z); v[6] = bf_lo(raw.w); v[7] = bf_hi(raw.w);
                    float s = 0.f;
#pragma unroll
                    for (int e = 0; e < 8; ++e) s += v[e] * v[e];
                    s += __shfl_xor(s, 1); s += __shfl_xor(s, 2); s += __shfl_xor(s, 4); s += __shfl_xor(s, 8);
                    const float rs = __builtin_amdgcn_rsqf(s * (1.0f / 128.0f) + EPS);
                    const f32x4 g0 = *(const LAS f32x4*)(RC + 128 * h + 8 * ch), g1 = *(const LAS f32x4*)(RC + 128 * h + 8 * ch + 4);
                    v2u w0, w1; w0.x = pk2(v[0] * rs * g0.x, v[1] * rs * g0.y); w0.y = pk2(v[2] * rs * g0.z, v[3] * rs * g0.w); w1.x = pk2(v[4] * rs * g1.x, v[5] * rs * g1.y); w1.y = pk2(v[6] * rs * g1.z, v[7] * rs * g1.w);
                    v4u w01; w01.x = w0.x; w01.y = w0.y; w01.z = w1.x; w01.w = w1.y; *(LAS v4u*)(lds + P3_RB + row * P3_PV + ch * 16) = w01; }
                __syncthreads();
                if (item + 2 < 8) p3_prefetch(R, item + 2, t0, s0, tid, PROJ, WSP, WPOOL, xhalo);
                v4u ur[4]; float bias[4];
#pragma unroll
                for (int m = 0; m < 4; ++m) { const int i = 64 * wr + 16 * m + fr; bias[m] = RC[512 + 128 * h + i];
                    ur[m] = *(const v4u*)(PROJ + (size_t)(t0 + i) * INW + 128 * h + 32 * wc + 8 * fq); }
                p3_mma(lds, true, acc, wr, wc, fr, fq);
#pragma unroll
                for (int m = 0; m < 4; ++m) { const int i = 64 * wr + 16 * m + fr;
#pragma unroll
                    for (int n = 0; n < 1; ++n) { const int c = 128 * h + 32 * wc + 8 * fq; const v4u u4 = ur[m]; const float bi = bias[m]; const f32x4 z0 = acc[m][0], z1 = acc[m][1]; v4u w;
                        w.x = pk2(bf_lo(u4.x) * (z0[0] + bi), bf_hi(u4.x) * (z0[1] + bi)); w.y = pk2(bf_lo(u4.y) * (z0[2] + bi), bf_hi(u4.y) * (z0[3] + bi));
                        w.z = pk2(bf_lo(u4.z) * (z1[0] + bi), bf_hi(u4.z) * (z1[1] + bi)); w.w = pk2(bf_lo(u4.w) * (z1[2] + bi), bf_hi(u4.w) * (z1[3] + bi));
                        *(v4u*)(MIXIN + (size_t)(t0 + i) * D + c) = w; } }
                __syncthreads();
            } else { const int g = item - 4, w = 2 << g;
#pragma unroll
                for (int it = 0; it < 4; ++it) { const int idx = tid + 512 * it, row = idx >> 4, ch = idx & 15; *(LAS v4u*)(lds + P3_RB + row * P3_PA + ch * 16) = P3_RA_(R, it); }
#pragma unroll
                for (int it = 0; it < 5; ++it) { const int idx = tid + 512 * it, row = idx >> 4, ch = idx & 15; if (row < 144) *(LAS v4u*)(lds + P3_RP + row * P3_PA + ch * 16) = P3_RB_(R, it); }
                __syncthreads();
                if (item + 2 < 8) p3_prefetch(R, item + 2, t0, s0, tid, PROJ, WSP, WPOOL, xhalo);
                switch (g) { case 0: p3_pool<2>(lds, tid, s0); break; case 1: p3_pool<4>(lds, tid, s0); break; case 2: p3_pool<8>(lds, tid, s0); break; default: p3_pool<16>(lds, tid, s0); break; }
                __syncthreads();
                p3_mma(lds, false, acc, wr, wc, fr, fq);
#pragma unroll
                for (int m = 0; m < 4; ++m) { const int t = 64 * wr + 16 * m + fr;
#pragma unroll
                    for (int n = 0; n < 1; ++n) { const int d = 128 * g + 32 * wc + 8 * fq; const f32x4 y0 = acc[m][0] * *(const LAS f32x4*)(RC + 1024 + d), y1 = acc[m][1] * *(const LAS f32x4*)(RC + 1024 + d + 4);
                        v4u wv; wv.x = pk2(y0[0], y0[1]); wv.y = pk2(y0[2], y0[3]); wv.z = pk2(y1[0], y1[1]); wv.w = pk2(y1[2], y1[3]); *(v4u*)(MIXIN + (size_t)(t0 + t) * D + AW + d) = wv; } }
                __syncthreads();
            }
}
__device__ __forceinline__ void p3_mixers(const Args& a, LAS unsigned char* lds, int tid0, int rb, unsigned* xwait, unsigned xgen) {
    const int lane = tid0 & 63, wave = tid0 >> 6, wr = wave >> 2, wc = wave & 3, fr = lane & 15, fq = lane >> 4;
    const bf16* PROJ = (const bf16*)(a.ws + WS_PROJ); bf16* MIXIN = (bf16*)(a.ws + WS_MIXIN);
    const bf16* WSP = (const bf16*)(a.ws + WS_WSP); const bf16* WPOOL = (const bf16*)(a.ws + WS_WPOOL);
    const float* sgug = a.in[I_SGUG]; const float* bsp = a.in[I_BSP]; const float* pscale = a.in[I_PSCALE];
    { LAS float* rc = (LAS float*)(lds + P3_RC); rc[tid0] = sgug[tid0]; rc[512 + tid0] = bsp[tid0]; rc[1024 + tid0] = pscale[tid0]; }
    __syncthreads();
    const LAS float* RC = (const LAS float*)(lds + P3_RC);
    for (int tb = rb; tb < M / 128; tb += gridDim.x) { const int t0 = tb * 128, s0 = t0 % SEQ;
        const bool xhalo = xwait != nullptr && (tb & 31) == 0 && s0 != 0;
        if (xhalo) { unsigned sp = 0; while ((unsigned)__builtin_amdgcn_readfirstlane(__hip_atomic_load(xwait, __ATOMIC_RELAXED, __HIP_MEMORY_SCOPE_AGENT)) < xgen) { __builtin_amdgcn_s_sleep(2); if (++sp > (1u << 22)) break; } }
        P3Regs R;
        p3_prefetch(R, 0, t0, s0, tid0, PROJ, WSP, WPOOL);
        P3Regs Rb;
        p3_prefetch(Rb, 1, t0, s0, tid0, PROJ, WSP, WPOOL);
        for (int it2 = 0; it2 < 4; ++it2) {
            p3_item(R, 2 * it2, t0, s0, tid0, lds, RC, PROJ, MIXIN, WSP, WPOOL, wr, wc, fr, fq, xhalo);
            p3_item(Rb, 2 * it2 + 1, t0, s0, tid0, lds, RC, PROJ, MIXIN, WSP, WPOOL, wr, wc, fr, fq, xhalo); } }
}

__device__ __forceinline__ void p4b_mid(const Args& a, int gw, int NGW, int lane) {
    const float* MOD = (const float*)(a.ws + OFF_MOD); const float* SS1 = (const float*)(a.ws + OFF_SS1); const bf16* MIXED = (const bf16*)(a.ws + WS_MIXED); bf16* XN = (bf16*)(a.ws + WS_XN);
    const float* x = a.in[I_X]; const float* pg = a.in[I_POSTMIXG]; const float* fg = a.in[I_PREFFNG]; bf16* X1B = (bf16*)(a.ws + WS_X1B);
    const int rpw = M / NGW;
    for (int r0 = gw * rpw; r0 < M; r0 += NGW * rpw) { const int b = r0 / SEQ; const float* mb = MOD + (size_t)b * NMOD;
        f32x4 A1[4], A2[4], A3[4];
#pragma unroll
        for (int j = 0; j < 4; ++j) { const int col = 4 * lane + 256 * j; A1[j] = *(const f32x4*)(mb + 2 * D + col) * *(const f32x4*)(pg + col);
            A2[j] = *(const f32x4*)(fg + col) * (1.0f + *(const f32x4*)(mb + 4 * D + col)); A3[j] = *(const f32x4*)(mb + 3 * D + col); }
        f32x4 nx[4]; v2u nm[4];
        { const f32x4* xr = (const f32x4*)(x + (size_t)r0 * D) + lane; const v2u* mr = (const v2u*)(MIXED + (size_t)r0 * INW) + lane;
#pragma unroll
            for (int j = 0; j < 4; ++j) { nx[j] = __builtin_nontemporal_load(xr + 64 * j); nm[j] = __builtin_nontemporal_load(mr + 64 * j); } }
        const float ssv = (lane < rpw) ? SS1[r0 + lane] : 0.f;
        for (int r = r0; r < r0 + rpw; ++r) {
            const float rs1 = __builtin_amdgcn_rsqf(__builtin_bit_cast(float, __builtin_amdgcn_readlane(__builtin_bit_cast(int, ssv), r - r0)) * (1.0f / D) + EPS); f32x4 v[4]; float s = 0.f;
#pragma unroll
            for (int j = 0; j < 4; ++j) { const v2u mw = nm[j]; const f32x4 mx = {bf_lo(mw.x), bf_hi(mw.x), bf_lo(mw.y), bf_hi(mw.y)};
                v[j] = nx[j] + mx * rs1 * A1[j]; s += (v[j].x * v[j].x + v[j].y * v[j].y) + (v[j].z * v[j].z + v[j].w * v[j].w); }
            if (r + 1 < r0 + rpw) { const f32x4* xr = (const f32x4*)(x + (size_t)(r + 1) * D) + lane; const v2u* mr = (const v2u*)(MIXED + (size_t)(r + 1) * INW) + lane;
#pragma unroll
                for (int j = 0; j < 4; ++j) { nx[j] = __builtin_nontemporal_load(xr + 64 * j); nm[j] = __builtin_nontemporal_load(mr + 64 * j); } }
            v2u* xrow = (v2u*)(X1B + (size_t)r * D) + (8 * (lane >> 3) + 2 * (lane & 3) + ((lane >> 2) & 1));
#pragma unroll
            for (int j = 0; j < 4; ++j) { v2u w; w.x = pk2(v[j].x, v[j].y); w.y = pk2(v[j].z, v[j].w); __builtin_nontemporal_store(w, xrow + 64 * j); }
            const float rs = __builtin_amdgcn_rsqf(wave_sum(s) * (1.0f / D) + EPS);
            v2u* o = (v2u*)(XN + (size_t)r * D) + lane;
#pragma unroll
            for (int j = 0; j < 4; ++j) { const f32x4 h = v[j] * rs * A2[j] + A3[j]; const unsigned long long w = (unsigned long long)pk2(h.x, h.y) | ((unsigned long long)pk2(h.z, h.w) << 32);
                __hip_atomic_store((unsigned long long*)(o + 64 * j), w, __ATOMIC_RELAXED, __HIP_MEMORY_SCOPE_AGENT); } } }
}

__device__ __forceinline__ void p6b_fixup(const Args& a, int gw, int NGW, int lane) {
    const bf16* RAW = (const bf16*)(a.ws + WS_RAW); bf16* ACT = (bf16*)(a.ws + WS_ACT); const float* cw = a.in[I_CONVW]; const float* cb = a.in[I_CONVB];
    for (int it = 2 * gw; it < 2 * gw + 2; ++it) { const int q = it & 3, rr = (it >> 2) & 1, B = it >> 3; const int t = 64 * B + rr, s = t % SEQ;
        const bf16* cur = RAW + (size_t)(B * 4 + rr) * FF2;
        const bf16* p1 = (rr == 1) ? RAW + (size_t)(B * 4 + 0) * FF2 : (s == 0 ? nullptr : RAW + (size_t)((B - 1) * 4 + 3) * FF2);
        const bf16* p2 = (rr == 1) ? (s == 1 ? nullptr : RAW + (size_t)((B - 1) * 4 + 3) * FF2) : (s == 0 ? nullptr : RAW + (size_t)((B - 1) * 4 + 2) * FF2);
        for (int f = q * 704 + 4 * lane; f < q * 704 + 704; f += 256) { f32x4 y[2];
#pragma unroll
            for (int hv = 0; hv < 2; ++hv) { const int col = hv * FF + f; const f32x4 z = {0.f, 0.f, 0.f, 0.f};
                const v2u zz = {0u, 0u}; const v2u r0 = *(const v2u*)(cur + col), r1 = p1 ? *(const v2u*)(p1 + col) : zz, r2 = p2 ? *(const v2u*)(p2 + col) : zz; (void)z;
                const f32x4 u0 = {bf_lo(r0.x), bf_hi(r0.x), bf_lo(r0.y), bf_hi(r0.y)}, u1 = {bf_lo(r1.x), bf_hi(r1.x), bf_lo(r1.y), bf_hi(r1.y)}, u2 = {bf_lo(r2.x), bf_hi(r2.x), bf_lo(r2.y), bf_hi(r2.y)};
                y[hv] = *(const f32x4*)(cb + col) + *(const f32x4*)(cw + col) * u2 + *(const f32x4*)(cw + FF2 + col) * u1 + *(const f32x4*)(cw + 2 * FF2 + col) * u0; }
            v2u w; w.x = pk2(pg8::silu_f(y[0][0]) * y[1][0], pg8::silu_f(y[0][1]) * y[1][1]); w.y = pk2(pg8::silu_f(y[0][2]) * y[1][2], pg8::silu_f(y[0][3]) * y[1][3]);
            *(v2u*)(ACT + (size_t)t * FF + f) = w; } }
}

#define XB_TMO      128
#define XB_XCNT(j)  (256  + 64 * (j))
#define XB_XSUB(j)  (1280 + 64 * (j))
#define XB_XGEN(j)  (2304 + 64 * (j))
#define XB_TOP      3328
#define XB_TOPGEN   3392
#define XCD_BAR_WORDS 3456
#define XB_SPIN_CAP (1u << 18)

__device__ __forceinline__ unsigned xb_ld(unsigned* p)              { return __hip_atomic_load(p, __ATOMIC_RELAXED, __HIP_MEMORY_SCOPE_AGENT); }
__device__ __forceinline__ unsigned xb_add(unsigned* p, unsigned v) { return __hip_atomic_fetch_add(p, v, __ATOMIC_RELAXED, __HIP_MEMORY_SCOPE_AGENT); }
__device__ __forceinline__ unsigned xb_xcc_id() { return (unsigned)__builtin_amdgcn_s_getreg((3 << 11) | 20) & 0xFu; }
#define XB_SPIN(cond, bar) do { unsigned _sp = 0; while (cond) { __builtin_amdgcn_s_sleep(1); \
    if ((++_sp & 255u) == 0u) { if (xb_ld(&(bar)[XB_TMO])) break; if (_sp > XB_SPIN_CAP) { atomicAdd(&(bar)[XB_TMO], 1u); break; } } } } while (0)

struct XcdBarrier {
    unsigned* bar; unsigned x;
    volatile LAS unsigned* st;
};

__device__ __forceinline__ XcdBarrier xcd_barrier_post(unsigned* bar, volatile LAS unsigned* st) {
    XcdBarrier b; b.bar = bar; b.x = xb_xcc_id(); b.st = st;
    if (threadIdx.x == 0) st[2] = xb_add(&bar[XB_XCNT(b.x)], 1u);
    return b;
}
__device__ __forceinline__ void xcd_barrier_complete(unsigned* bar, unsigned x, unsigned& nloc, unsigned& nx) {
    const unsigned G = gridDim.x * gridDim.y * gridDim.z;
    unsigned sum, cnt, mine, sp = 0u;
    for (;;) {
        sum = 0u; cnt = 0u; mine = 0u;
#pragma unroll
        for (unsigned j = 0; j < 16; ++j) { const unsigned c = xb_ld(&bar[XB_XCNT(j)]); sum += c; cnt += (c > 0u) ? 1u : 0u; mine = (j == x) ? c : mine; }
        if (sum == G) break;
        __builtin_amdgcn_s_sleep(1);
        if ((++sp & 255u) == 0u) { if (xb_ld(&bar[XB_TMO])) break; if (sp > XB_SPIN_CAP) { atomicAdd(&bar[XB_TMO], 1u); break; } }
    }
    nloc = mine > 0u ? mine : 1u; nx = cnt > 0u ? cnt : 1u;
}

__device__ __forceinline__ void xcd_barrier(const XcdBarrier& b) {
    asm volatile("s_waitcnt vmcnt(0)" ::: "memory");
    __syncthreads();
    if (threadIdx.x == 0) {
        unsigned* bar = b.bar;
        __builtin_amdgcn_s_waitcnt(0);
        unsigned nloc = b.st[0], nx = b.st[1];
        if (nloc == 0u) { xcd_barrier_complete(bar, b.x, nloc, nx); b.st[0] = nloc; b.st[1] = nx; }
        const unsigned old = xb_add(&bar[XB_XSUB(b.x)], 1u);
        const unsigned gen = old / nloc;
        if (old + 1u == (gen + 1u) * nloc) {
            __builtin_amdgcn_fence(__ATOMIC_RELEASE, "agent");
            asm volatile("s_waitcnt vmcnt(0)" ::: "memory");
            const unsigned og = xb_add(&bar[XB_TOP], 1u);
            const unsigned tg = og / nx;
            if (og + 1u == (tg + 1u) * nx) xb_add(&bar[XB_TOPGEN], 1u);
            else XB_SPIN(xb_ld(&bar[XB_TOPGEN]) == tg, bar);
            __builtin_amdgcn_fence(__ATOMIC_ACQUIRE, "agent");
            xb_add(&bar[XB_XGEN(b.x)], 1u);
            asm volatile("s_waitcnt vmcnt(0)" ::: "memory");
        } else {
            XB_SPIN(xb_ld(&bar[XB_XGEN(b.x)]) == gen, bar);
            __builtin_amdgcn_fence(__ATOMIC_ACQUIRE, "agent");
            asm volatile("s_waitcnt vmcnt(0)" ::: "memory");
        }
    }
    __syncthreads();
}
#define XL_SUB(j)  (4096 + 64 * (j))
#define XL_GEN(j)  (5120 + 64 * (j))
__device__ __forceinline__ void xcd_local_barrier(const XcdBarrier& b) {
    asm volatile("s_waitcnt vmcnt(0)" ::: "memory");
    __syncthreads();
    if (threadIdx.x == 0) { unsigned* bar = b.bar; const unsigned nloc = b.st[0];
        const unsigned old = xb_add(&bar[XL_SUB(b.x)], 1u); const unsigned gen = old / nloc;
        if (old + 1u == (gen + 1u) * nloc) xb_add(&bar[XL_GEN(b.x)], 1u);
        else XB_SPIN(xb_ld(&bar[XL_GEN(b.x)]) == gen, bar);
        __builtin_amdgcn_fence(__ATOMIC_ACQUIRE, "agent");
        asm volatile("s_waitcnt vmcnt(0)" ::: "memory"); }
    __syncthreads();
}
__global__ void __launch_bounds__(NWAVES * 64, 2) mk_fwd(Args args) {
    extern __shared__ __attribute__((aligned(16))) unsigned char lds_raw[];
    LAS unsigned char* lds = (LAS unsigned char*)lds_raw;
    const int tid = threadIdx.x, lane = tid & 63, wave = __builtin_amdgcn_readfirstlane(tid >> 6);
    const int G = gridDim.x, gw = blockIdx.x * NWAVES + wave, NGW = G * NWAVES;
    const int lo = args.ph_lo, hi = args.ph_hi;
    unsigned char* ws = args.ws;
    if (tid < 64) ((LAS unsigned*)(lds + LDSCTL_OFF))[tid] = 0u;
    __syncthreads();
    XcdBarrier bar = xcd_barrier_post((unsigned*)(ws + OFF_BAR), (volatile LAS unsigned*)(lds + LDSCTL_OFF) + 8);
#define IN(k) (lo <= (k) && (k) < hi)
#define NREP(k) ((MK_REPEAT == (k) || ((k) == 4 && (MK_REPEAT == 41 || MK_REPEAT == 42))) ? 2 : 1)
#define SEAM(k) do { if (IN(k) && IN((k) + 1)) xcd_barrier(bar); } while (0)
    if (lo < 0) cg::this_grid().sync();
    if (IN(0)) { p0_prologue(args, lds, gw, NGW, lane, wave, true, true); }
    SEAM(0);
    int cvirt = (int)blockIdx.x; bool xlocal = false;
    if (lo == 0 && hi > 2 && (G & 7) == 0) { bool even = true;
#pragma unroll
        for (int j = 0; j < 16; ++j) { const unsigned cj = xb_ld(&bar.bar[XB_XCNT(j)]); even = even && (cj == (j < 8 ? (unsigned)(G >> 3) : 0u)); }
        if (even && bar.x < 8u) { cvirt = (int)(bar.st[2] * 8u + bar.x); xlocal = true; } }
    cvirt = __builtin_amdgcn_readfirstlane(cvirt);
    const int rb = xlocal ? (cvirt & 7) * (G >> 3) + (cvirt >> 3) : (int)blockIdx.x;
    unsigned lgen = 0;
#define LSEAM() do { if (xlocal) { xcd_local_barrier(bar); ++lgen; } else xcd_barrier(bar); } while (0)
    if (IN(1)) { for (int rep = 0; rep < NREP(1); ++rep) { if (rep) xcd_barrier(bar); p1_norm(args, rb * NWAVES + wave, NGW, lane); } }
    if (IN(1) && IN(2)) LSEAM();
    if (IN(2)) { pg8::Gemm g{(const bf16*)(ws + WS_XN), (const bf16*)(ws + WS_WIN), M, INW, D}; pg8::StaticOrder S; S.init(M, INW, G, cvirt);
        pg8::EpiProj E{(bf16*)(ws + WS_PROJ), INW};
        for (int rep = 0; rep < NREP(2); ++rep) { if (rep) xcd_barrier(bar); pg8::gemm_phase<pg8::EpiProj, pg8::StaticOrder, true, true>(lds, g, S, E); } }
    if (IN(2) && IN(3)) LSEAM();
    if (IN(3)) { for (int rep = 0; rep < NREP(3); ++rep) { if (rep) xcd_barrier(bar); __syncthreads(); p3_mixers(args, lds, tid, rb, (xlocal && bar.x > 0u) ? &bar.bar[XL_GEN(bar.x - 1u)] : nullptr, lgen); } }
    if (IN(3) && IN(4)) LSEAM();
    if (IN(4)) { pg8::Gemm g{(const bf16*)(ws + WS_MIXIN), (const bf16*)(ws + WS_WOUT), M, D, D}; pg8::StaticOrder S; S.init(M, D, G, cvirt);
        pg8::EpiBf16SS E{(bf16*)(ws + WS_MIXED), INW, (float*)(ws + OFF_SS1)};
        pg8::gemm_phase<pg8::EpiBf16SS, pg8::StaticOrder, true, true>(lds, g, S, E);
        LSEAM();
        p4b_mid(args, rb * NWAVES + wave, NGW, lane); }
    if (IN(4) && IN(5)) LSEAM();
    if (IN(5)) { pg8::Gemm g{(const bf16*)(ws + WS_XN), (const bf16*)(ws + WS_WUP), M, FF2, D}; pg8::StaticOrder S; S.init(M, FF2, G, cvirt);
        pg8::EpiConv E{(bf16*)(ws + WS_ACT), (bf16*)(ws + WS_RAW), args.in[I_CONVW], args.in[I_CONVB], FF, lds + LDSCTL_OFF + 4096};
        for (int rep = 0; rep < NREP(5); ++rep) { if (rep) xcd_barrier(bar); pg8::gemm_phase<pg8::EpiConv, pg8::StaticOrder, true, true>(lds, g, S, E); } }
    SEAM(5);
    if (IN(6)) { p6b_fixup(args, rb * NWAVES + wave, NGW, lane); }
    if (IN(6) && IN(7)) LSEAM();
    if (IN(7)) { pg8::Gemm g{(const bf16*)(ws + WS_ACT), (const bf16*)(ws + WS_WDOWN), M, D, FF}; pg8::StaticOrder S; S.init(M, D, G, cvirt);
        for (int rep = 0; rep < NREP(7); ++rep) { if (rep) xcd_barrier(bar);
        pg8::RowStat st{(float*)(ws + (rep ? 736 * 1024 : OFF_SS4)), (unsigned*)(ws + (rep ? 640 * 1024 : OFF_CNT + 32768)), 32u, 1.0f / D, EPS};
        pg8::EpiFinal E{(const bf16*)(ws + WS_X1B), rep ? (float*)(ws + WS_F) : args.out, (const float*)(ws + OFF_MOD), args.in[I_POSTFFNG], st, D, SEQ / 256};
        pg8::gemm_phase<pg8::EpiFinal, pg8::StaticOrder, true, true>(lds, g, S, E); } }
    if (MK_REPEAT == 17 && IN(7)) { xcd_barrier(bar); pg8::Gemm g{(const bf16*)(ws + WS_ACT), (const bf16*)(ws + WS_WDOWN), M, D, FF}; pg8::StaticOrder S; S.init(M, D, G, (int)blockIdx.x);
        pg8::EpiSink E{(float*)(ws + WS_F)}; pg8::gemm_phase<pg8::EpiSink, pg8::StaticOrder, true, true>(lds, g, S, E); }
#undef IN
#undef SEAM
}

constexpr int N_PHASES = 8;
extern "C" void kernel_launch(void* const* d_in, const int* in_sizes, int n_in, void* d_out, int out_size, void* d_ws, size_t ws_size, hipStream_t stream) {
    static int grid = 0;
    if (grid == 0) {
        if (n_in != 19 || in_sizes[0] != M * D || out_size != M * D || ws_size < WS_END) { fprintf(stderr, "kernel_launch: unexpected shapes (n_in %d, in0 %d, out %d, ws %zu)\n", n_in, n_in > 0 ? in_sizes[0] : -1, out_size, ws_size); grid = -1; return; }
        int dev = 0, cus = 0, per_cu = 0;
        (void)hipGetDevice(&dev); (void)hipDeviceGetAttribute(&cus, hipDeviceAttributeMultiprocessorCount, dev);
        if (hipFuncSetAttribute((const void*)mk_fwd, hipFuncAttributeMaxDynamicSharedMemorySize, LDS_BYTES) != hipSuccess) { fprintf(stderr, "kernel_launch: hipFuncSetAttribute failed\n"); grid = -1; return; }
        if (hipOccupancyMaxActiveBlocksPerMultiprocessor(&per_cu, (const void*)mk_fwd, NWAVES * 64, LDS_BYTES) != hipSuccess || per_cu < 1) { fprintf(stderr, "kernel_launch: occupancy query says %d blocks per CU\n", per_cu); per_cu = 1; }
        (void)hipGetLastError();
        grid = cus > 0 ? cus : 256;
    }
    if (grid < 0) return;
    (void)hipMemsetAsync((char*)d_ws + WS_CTL, 0, CTL_ZERO_BYTES, stream);
    Args a{};
    for (int i = 0; i < 19; ++i) a.in[i] = (const float*)d_in[i];
    a.out = (float*)d_out; a.ws = (unsigned char*)d_ws;
#if MK_N_LAUNCHES == 1
    a.ph_lo = 0; a.ph_hi = N_PHASES;
    void* kargs[] = {&a};
    hipError_t e = hipLaunchCooperativeKernel((const void*)mk_fwd, dim3(grid), dim3(NWAVES * 64), kargs, LDS_BYTES, stream);
    if (e != hipSuccess) fprintf(stderr, "kernel_launch: cooperative launch failed: %s (grid %d)\n", hipGetErrorString(e), grid);
#else
    for (int p = 0; p < N_PHASES; ++p) { a.ph_lo = p; a.ph_hi = p + 1; hipLaunchKernelGGL(mk_fwd, dim3(grid), dim3(NWAVES * 64), LDS_BYTES, stream, a); }
#endif
}
```
